# Optimizing an MI355X kernel written in HIP

```python
import numpy as np
import jax
import jax.numpy as jnp
from jax import lax

D_MODEL = 1024
BATCH = 8
SEQ = 2048
DEPTH = 1

GRID_W = 64
CTX_LEN = 256
ADALN_CHUNKS = 6
NORM_EPS = 1e-6

GLA_HEADS = 4
GLA_DV = D_MODEL // GLA_HEADS
GLA_DK = GLA_DV // 2
GLA_KEY_W = GLA_HEADS * GLA_DK
GLA_VAL_W = GLA_HEADS * GLA_DV
GLA_LORA = 16
GLA_GATE_NORM = 16.0
GLA_CHUNK = 64

RWKV_N = 64
RWKV_HEADS = D_MODEL // RWKV_N
RWKV_W = RWKV_HEADS * RWKV_N
RWKV_DECAY_LORA = 64
RWKV_AAA_LORA = 64
RWKV_GATE_LORA = 160
RWKV_LN_EPS = 64e-5

GLA_SPLITS = (GLA_KEY_W, GLA_KEY_W, GLA_VAL_W, GLA_VAL_W, GLA_LORA, GLA_LORA)
RWKV_SPLITS = (RWKV_W, RWKV_W, RWKV_W, RWKV_DECAY_LORA, RWKV_DECAY_LORA, RWKV_AAA_LORA, RWKV_GATE_LORA)
GLA_COLS = sum(GLA_SPLITS)
RWKV_COLS = sum(RWKV_SPLITS)
BRANCH_GATE_COLS = 2 * D_MODEL
IN_COLS = GLA_COLS + RWKV_COLS + BRANCH_GATE_COLS

PEER_HEADS = 8
PEER_N_KEYS = 128
PEER_EXPERTS = PEER_N_KEYS * PEER_N_KEYS
PEER_HALF = 128
PEER_TOPK = 16
PEER_BLOCK = 128

kernel_name = 'hybrid_gla_rwkv7_peer_prefix_dit'


def _split(z, sizes):
    return jnp.split(z, np.cumsum(sizes)[:-1].tolist(), axis=-1)


def _rmsnorm(x, w, eps=NORM_EPS):
    xf = x.astype(jnp.float32)
    y = xf * lax.rsqrt(jnp.mean(xf * xf, axis=-1, keepdims=True) + eps)
    return (y * w.astype(jnp.float32)).astype(x.dtype)


def _modulate(h, shift, scale):
    return h * (1 + scale) + shift


def _grid_shift(z, rows):
    b, l, ch = z.shape
    zg = z.reshape(b, rows, GRID_W, ch // 4, 4)
    left = jnp.pad(zg[:, :, :-1, :, 0], ((0, 0), (0, 0), (1, 0), (0, 0)))
    right = jnp.pad(zg[:, :, 1:, :, 1], ((0, 0), (0, 0), (0, 1), (0, 0)))
    up = jnp.pad(zg[:, :-1, :, :, 2], ((0, 0), (1, 0), (0, 0), (0, 0)))
    down = jnp.pad(zg[:, 1:, :, :, 3], ((0, 0), (0, 1), (0, 0), (0, 0)))
    return jnp.stack([left, right, up, down], axis=-1).reshape(b, l, ch)


def _seq_shift(z):
    b, l, ch = z.shape
    zs = z.reshape(b, l, ch // 2, 2)
    prev = jnp.pad(zs[:, :-1, :, 0], ((0, 0), (1, 0), (0, 0)))
    nxt = jnp.pad(zs[:, 1:, :, 1], ((0, 0), (0, 1), (0, 0)))
    return jnp.stack([prev, nxt], axis=-1).reshape(b, l, ch)


def _gla_scan(q, k, v, log_a, s0):
    b, l, h, _ = q.shape
    n = l // GLA_CHUNK

    def chunks(t):
        return t.reshape(b, n, GLA_CHUNK, h, t.shape[-1]).transpose(1, 0, 3, 2, 4)

    mask = jnp.tril(jnp.ones((GLA_CHUNK, GLA_CHUNK), dtype=bool))

    def step(s, xs):
        qc, kc, vc, gc = xs
        bcum = jnp.cumsum(gc, axis=-2)
        blast = bcum[..., -1:, :]
        q_dec = qc * jnp.exp(bcum)
        k_dec = kc * jnp.exp(-bcum)
        att = jnp.where(mask, jnp.einsum('bhid,bhjd->bhij', q_dec, k_dec), 0.0)
        o = jnp.einsum('bhid,bhde->bhie', q_dec, s) + jnp.einsum('bhij,bhje->bhie', att, vc)
        s_new = (jnp.exp(blast[..., 0, :])[..., None] * s
                 + jnp.einsum('bhjd,bhje->bhde', kc * jnp.exp(blast - bcum), vc))
        return s_new, o

    s_fin, o = lax.scan(step, s0, (chunks(q), chunks(k), chunks(v), chunks(log_a)))
    o = o.transpose(1, 0, 3, 2, 4).reshape(b, l, h, v.shape[-1])
    return o, s_fin


def _rwkv7_scan(r, decay, k, v, kk, a, s0, reverse):
    xs = tuple(jnp.moveaxis(t, 1, 0) for t in (r, decay, k, v, kk, a))

    def step(s, xt):
        rt, dt, kt, vt, kkt, at = xt
        sa = jnp.einsum('bhvk,bhk->bhv', s, kkt)
        s = (s * dt[:, :, None, :] - sa[..., None] * (kkt * at)[:, :, None, :]
             + vt[..., None] * kt[:, :, None, :])
        return s, jnp.einsum('bhvk,bhk->bhv', s, rt)

    s_fin, o = lax.scan(step, s0, xs, reverse=reverse)
    return jnp.moveaxis(o, 0, 1), s_fin


def _token_mixer(hm, rows, init_states, need_out, lp):
    b, l, _ = hm.shape
    f32 = jnp.float32

    def heads(t, nh):
        return t.reshape(b, l, nh, -1).astype(f32)

    def flip(t):
        return jnp.flip(t, axis=1)

    z = hm @ lp['w_in']
    z_gla, z_rwkv, z_gate = _split(z, (GLA_COLS, RWKV_COLS, BRANCH_GATE_COLS))
    sg_f0, sg_b0, sr_f0, sr_b0 = init_states

    q, k, v, g_out, alo_f, alo_b = _split(z_gla, GLA_SPLITS)

    def gla_log_decay(alo, d):
        return jax.nn.log_sigmoid(alo @ lp['gla_w_a2'][d] + lp['gla_b_a'][d]) / GLA_GATE_NORM

    qh = heads(q, GLA_HEADS) * GLA_DK ** -0.5
    kh = heads(k, GLA_HEADS)
    vh = heads(v, GLA_HEADS)
    lf = heads(gla_log_decay(alo_f, 0), GLA_HEADS)
    lb = heads(gla_log_decay(alo_b, 1), GLA_HEADS)
    og_f, sg_f = _gla_scan(qh, kh, vh, lf, sg_f0)
    og_b, sg_b = _gla_scan(flip(qh), flip(kh), flip(vh), flip(lb), sg_b0)

    zs = _seq_shift(z_rwkv) if rows is None else _grid_shift(z_rwkv, rows)
    zm = z_rwkv + (zs - z_rwkv) * lp['rwkv_mu']
    r, kr, vr, wlo_f, wlo_b, alo, glo = _split(zm, RWKV_SPLITS)

    def rwkv_decay(wlo, d):
        w = -jax.nn.softplus(-(lp['rwkv_w0'][d] + jnp.tanh(wlo) @ lp['rwkv_w2'][d])) - 0.5
        return jnp.exp(-jnp.exp(heads(w, RWKV_HEADS)))

    a = jax.nn.sigmoid(lp['rwkv_a0'] + alo @ lp['rwkv_a2'])
    kk = heads(kr * lp['rwkv_k_k'], RWKV_HEADS)
    kk = kk / jnp.maximum(jnp.linalg.norm(kk, axis=-1, keepdims=True), 1e-12)
    kr = kr * (1 + (a - 1) * lp['rwkv_k_a'])
    rh = heads(r, RWKV_HEADS)
    krh = heads(kr, RWKV_HEADS)
    vrh = heads(vr, RWKV_HEADS)
    ah = heads(a, RWKV_HEADS)
    or_f, sr_f = _rwkv7_scan(rh, rwkv_decay(wlo_f, 0), krh, vrh, kk, ah, sr_f0, False)
    or_b, sr_b = _rwkv7_scan(rh, rwkv_decay(wlo_b, 1), krh, vrh, kk, ah, sr_b0, True)
    states = (sg_f, sg_b, sr_f, sr_b)
    if not need_out:
        return None, states

    og = og_f + flip(og_b)
    og = og * lax.rsqrt(jnp.mean(og * og, axis=-1, keepdims=True) + NORM_EPS)
    og = og * lp['gla_norm_w'].reshape(GLA_HEADS, GLA_DV).astype(f32)
    y_gla = og.reshape(b, l, GLA_VAL_W).astype(hm.dtype) * jax.nn.silu(g_out)

    o_r = or_f + or_b
    mu = jnp.mean(o_r, axis=-1, keepdims=True)
    var = jnp.mean(jnp.square(o_r - mu), axis=-1, keepdims=True)
    o_r = ((o_r - mu) * lax.rsqrt(var + RWKV_LN_EPS) * lp['rwkv_ln_w'].reshape(RWKV_HEADS, RWKV_N)
           + lp['rwkv_ln_b'].reshape(RWKV_HEADS, RWKV_N))
    o_r = o_r + jnp.sum(rh * krh * lp['rwkv_r_k'], axis=-1, keepdims=True) * vrh
    y_rwkv = o_r.reshape(b, l, RWKV_W).astype(hm.dtype) * (jax.nn.sigmoid(glo) @ lp['rwkv_g2'])

    gate_gla, gate_rwkv = jnp.split(z_gate, 2, axis=-1)
    y = jax.nn.sigmoid(gate_gla) * y_gla + jax.nn.sigmoid(gate_rwkv) * y_rwkv
    return y @ lp['w_out'], states


def _peer(h, w_q, sub_keys, exp_u, exp_v):
    b, l, d = h.shape
    q = (h @ w_q).reshape(b, l, PEER_HEADS, 2, PEER_HALF)
    s = jnp.einsum('blhpd,hpnd->blhpn', q, sub_keys).astype(jnp.float32)
    s1, i1 = lax.top_k(s[..., 0, :], PEER_TOPK)
    s2, i2 = lax.top_k(s[..., 1, :], PEER_TOPK)
    cand_s = (s1[..., :, None] + s2[..., None, :]).reshape(b, l, PEER_HEADS, PEER_TOPK * PEER_TOPK)
    cand_i = (i1[..., :, None] * PEER_N_KEYS + i2[..., None, :]).reshape(b, l, PEER_HEADS, PEER_TOPK * PEER_TOPK)
    top_s, pos = lax.top_k(cand_s, PEER_TOPK)
    idx = jnp.take_along_axis(cand_i, pos, axis=-1)
    gates = jax.nn.softmax(top_s, axis=-1).astype(h.dtype)
    n_blocks = (b * l) // PEER_BLOCK
    slots = PEER_HEADS * PEER_TOPK
    xs = (h.reshape(n_blocks, PEER_BLOCK, d),
          idx.reshape(n_blocks, PEER_BLOCK, slots),
          gates.reshape(n_blocks, PEER_BLOCK, slots))

    def block(args):
        xt, it, gt = args
        u = jnp.take(exp_u, it, axis=0)
        act = jax.nn.gelu(jnp.einsum('tsd,td->ts', u, xt), approximate=False)
        vv = jnp.take(exp_v, it, axis=0)
        return jnp.einsum('ts,tsd->td', gt * act, vv)

    return lax.map(block, xs).reshape(b, l, d)


def setup_inputs(seed: int = 0) -> dict:
    key = jax.random.key(seed)
    ks = iter(jax.random.split(key, 29))
    D = D_MODEL
    L = DEPTH

    def nrm(shape, scale):
        return scale * jax.random.normal(next(ks), shape, jnp.float32)

    def uni(shape, lo, hi):
        return jax.random.uniform(next(ks), shape, jnp.float32, lo, hi)

    return {
        'x': nrm((BATCH, SEQ, D), 1.0),
        'c': nrm((BATCH, D), 1.0),
        'ctx': nrm((BATCH, CTX_LEN, D), 1.0),
        'c_ctx': nrm((D,), 1.0),
        'norm1_w': 1.0 + nrm((L, D), 0.02),
        'w_mod': nrm((L, D, ADALN_CHUNKS * D), 0.5 * D ** -0.5),
        'b_mod': nrm((L, ADALN_CHUNKS * D), 0.02),
        'w_in': nrm((L, D, IN_COLS), D ** -0.5),
        'gla_w_a2': nrm((L, 2, GLA_LORA, GLA_KEY_W), GLA_LORA ** -0.5),
        'gla_b_a': nrm((L, 2, GLA_KEY_W), 0.1),
        'gla_norm_w': 1.0 + nrm((L, GLA_VAL_W), 0.02),
        'rwkv_mu': uni((L, RWKV_COLS), 0.2, 0.8),
        'rwkv_w0': uni((L, 2, RWKV_W), -6.0, -1.0),
        'rwkv_w2': nrm((L, 2, RWKV_DECAY_LORA, RWKV_W), 0.5 * RWKV_DECAY_LORA ** -0.5),
        'rwkv_a0': nrm((L, RWKV_W), 0.1),
        'rwkv_a2': nrm((L, RWKV_AAA_LORA, RWKV_W), 0.5 * RWKV_AAA_LORA ** -0.5),
        'rwkv_g2': nrm((L, RWKV_GATE_LORA, RWKV_W), RWKV_GATE_LORA ** -0.5),
        'rwkv_k_k': 0.85 + nrm((L, RWKV_W), 0.02),
        'rwkv_k_a': 1.0 + nrm((L, RWKV_W), 0.02),
        'rwkv_r_k': nrm((L, RWKV_HEADS, RWKV_N), 0.1),
        'rwkv_ln_w': 1.0 + nrm((L, RWKV_W), 0.02),
        'rwkv_ln_b': nrm((L, RWKV_W), 0.02),
        'w_out': nrm((L, D, D), D ** -0.5),
        'norm2_w': 1.0 + nrm((L, D), 0.02),
        'peer_w_q': nrm((L, D, PEER_HEADS * 2 * PEER_HALF), D ** -0.5),
        'peer_sub_keys': nrm((L, PEER_HEADS, 2, PEER_N_KEYS, PEER_HALF), PEER_HALF ** -0.5),
        'peer_u': nrm((L, PEER_EXPERTS, D), D ** -0.5),
        'peer_v': nrm((L, PEER_EXPERTS, D), 1.0),
        'final_norm_w': 1.0 + nrm((D,), 0.02),
    }


def reference(x, c, ctx, c_ctx, norm1_w, w_mod, b_mod, w_in, gla_w_a2, gla_b_a, gla_norm_w,
              rwkv_mu, rwkv_w0, rwkv_w2, rwkv_a0, rwkv_a2, rwkv_g2, rwkv_k_k, rwkv_k_a, rwkv_r_k,
              rwkv_ln_w, rwkv_ln_b, w_out, norm2_w, peer_w_q, peer_sub_keys, peer_u, peer_v,
              final_norm_w):
    b, seq, _ = x.shape
    rows = seq // GRID_W
    f32 = jnp.float32
    zero_states = (jnp.zeros((b, GLA_HEADS, GLA_DK, GLA_DV), f32),
                   jnp.zeros((b, GLA_HEADS, GLA_DK, GLA_DV), f32),
                   jnp.zeros((b, RWKV_HEADS, RWKV_N, RWKV_N), f32),
                   jnp.zeros((b, RWKV_HEADS, RWKV_N, RWKV_N), f32))
    h_lat, h_ctx = x, ctx
    for layer in range(DEPTH):
        last = layer == DEPTH - 1
        lp = {
            'w_in': w_in[layer], 'gla_w_a2': gla_w_a2[layer], 'gla_b_a': gla_b_a[layer],
            'gla_norm_w': gla_norm_w[layer], 'rwkv_mu': rwkv_mu[layer], 'rwkv_w0': rwkv_w0[layer],
            'rwkv_w2': rwkv_w2[layer], 'rwkv_a0': rwkv_a0[layer], 'rwkv_a2': rwkv_a2[layer],
            'rwkv_g2': rwkv_g2[layer], 'rwkv_k_k': rwkv_k_k[layer], 'rwkv_k_a': rwkv_k_a[layer],
            'rwkv_r_k': rwkv_r_k[layer], 'rwkv_ln_w': rwkv_ln_w[layer], 'rwkv_ln_b': rwkv_ln_b[layer],
            'w_out': w_out[layer],
        }
        m_lat = jnp.split((jax.nn.silu(c) @ w_mod[layer] + b_mod[layer])[:, None, :], ADALN_CHUNKS, axis=-1)
        m_ctx = jnp.split(jax.nn.silu(c_ctx) @ w_mod[layer] + b_mod[layer], ADALN_CHUNKS, axis=-1)

        a_ctx = _modulate(_rmsnorm(h_ctx, norm1_w[layer]), m_ctx[0], m_ctx[1])
        y_ctx, ctx_states = _token_mixer(a_ctx, None, zero_states, not last, lp)

        a_lat = _modulate(_rmsnorm(h_lat, norm1_w[layer]), m_lat[0], m_lat[1])
        y_lat, _ = _token_mixer(a_lat, rows, ctx_states, True, lp)
        h_lat = h_lat + m_lat[2] * y_lat
        f_lat = _peer(_modulate(_rmsnorm(h_lat, norm2_w[layer]), m_lat[3], m_lat[4]),
                      peer_w_q[layer], peer_sub_keys[layer], peer_u[layer], peer_v[layer])
        h_lat = h_lat + m_lat[5] * f_lat

        if not last:
            h_ctx = h_ctx + m_ctx[2] * y_ctx
            f_ctx = _peer(_modulate(_rmsnorm(h_ctx, norm2_w[layer]), m_ctx[3], m_ctx[4]),
                          peer_w_q[layer], peer_sub_keys[layer], peer_u[layer], peer_v[layer])
            h_ctx = h_ctx + m_ctx[5] * f_ctx
    return _rmsnorm(h_lat, final_norm_w)
```

```cpp
#include <hip/hip_runtime.h>
#include <stdint.h>
#include <stdio.h>

#ifndef MK_N_LAUNCHES
#define MK_N_LAUNCHES 1
#endif

namespace pg8 {
#define PG8_LAS __attribute__((address_space(3)))
typedef unsigned short bf16_t;
typedef short bf16x8 __attribute__((ext_vector_type(8)));
typedef float f32x4 __attribute__((ext_vector_type(4)));
typedef unsigned u32x4 __attribute__((ext_vector_type(4)));
constexpr int BM = 256, BK = 64, HALF = 128, HTB = HALF * BK * 2  , STAGE_BYTES = 8 * HTB, NXCD = 8, WGM = 8;

__host__ __device__ __forceinline__ int lds_byte(int r, int c) { const int st = (r >> 4) * 2 + (c >> 5), rr = r & 15, cc = c & 31, ob = rr * 64 + cc * 2; return st * 1024 + (ob ^ (((ob >> 9) & 1) << 5)); }
__host__ __device__ __forceinline__ void stage_rc(int b, int& R, int& C) { const int st = b / 1024, sb = b % 1024, swz = sb ^ (((sb >> 9) & 1) << 5); R = (st >> 1) * 16 + swz / 64; C = (st & 1) * 32 + (swz % 64) / 2; }
__host__ __device__ __forceinline__ int perm32(int rho) { const int n = rho >> 4, i = rho & 15; return 8 * (i >> 2) + 4 * n + (i & 3); }

struct Unit { int pm, pn; };
struct Gemm { const bf16_t* A; const bf16_t* Bt; int M, N, K; };

struct StaticOrder {
    int nM, nN, nwg, G, c;
    __host__ __device__ void init(int M, int N, int G_, int c_) { nM = M / BM; nN = N / BM; nwg = nM * nN; G = G_; c = c_; }
    __host__ __device__ bool next(int i, Unit& u) const {
        const long L = (long)i * G + c; if (L >= nwg) return false;
        int wgid = (int)L; { const int q = nwg / NXCD, r = nwg % NXCD, xcd = wgid % NXCD, off = wgid / NXCD; wgid = (xcd < r ? xcd * (q + 1) : r * (q + 1) + (xcd - r) * q) + off; }
        const int nig = WGM * nN, gid = wgid / nig, fm = gid * WGM, gsz = (nM - fm) < WGM ? (nM - fm) : WGM;
        u.pm = fm + ((wgid % nig) % gsz); u.pn = (wgid % nig) / gsz; return true;
    }
    __device__ __forceinline__ void a_ready(const Unit&) const {}
    __device__ __forceinline__ void done(const Unit&) const {}
};
__device__ __forceinline__ unsigned cvt_pk_bf16(float lo, float hi) { unsigned r; asm volatile("v_cvt_pk_bf16_f32 %0, %1, %2" : "=v"(r) : "v"(lo), "v"(hi)); return r; }
template <class Epi, class Sched, bool STAMP = false>
__device__ __forceinline__ void gemm_phase(PG8_LAS unsigned char* lds, const Gemm g, const Sched& S, const Epi& E, unsigned long long* stamps) {
    const int tid = threadIdx.x, wid = __builtin_amdgcn_readfirstlane(tid >> 6), lane = tid & 63, wr = wid >> 2, wc = wid & 3, fr = lane & 15, fq = lane >> 4;
    const int K = g.K, nt = K / BK;
    int ts_lo = 0, ts_hi = 0, nts = 0; const unsigned long long rt_entry = STAMP ? (unsigned long long)wall_clock64() : 0ull;
#define PG8_STAMP() do { if (STAMP && wid == 0 && nts < 64) { const unsigned long long _c = (unsigned long long)clock64(); \
        ts_lo = (lane == nts) ? (int)(unsigned)_c : ts_lo; ts_hi = (lane == nts) ? (int)(unsigned)(_c >> 32) : ts_hi; ++nts; } } while (0)
    PG8_STAMP();
    unsigned voffA[2], voffB[2];
#pragma unroll
    for (int i = 0; i < 2; ++i) { int R, C; stage_rc(tid * 16 + i * 8192, R, C); const int Rb = Epi::PERM ? ((R & ~31) + perm32(R & 31)) : R;
        voffA[i] = (unsigned)(R * K + C) * 2u; voffB[i] = (unsigned)(Rb * K + C) * 2u; }
    const size_t kstep = (size_t)(BK * 2);
    const size_t hstep = (size_t)HALF * K * 2;
    const size_t tstep = 2 * hstep;
    const unsigned ldsw = (unsigned)wid * 1024u;
    const int aoff = lds_byte(wr * 64 + fr, fq * 8), boff = lds_byte(wc * 32 + fr, fq * 8);
#define PG8_SA(b, h) (((b) * 2 + (h)) * HTB)
#define PG8_SB(b, h) ((4 + (b) * 2 + (h)) * HTB)
#define PG8_STAGE(bufoff, gbase, voff) do { _Pragma("unroll") for (int _i = 0; _i < 2; ++_i) \
        __builtin_amdgcn_global_load_lds((const unsigned*)((const char*)(gbase) + (voff)[_i]), (PG8_LAS unsigned*)(lds + (bufoff) + ldsw + _i * 8192), 16, 0, 0); } while (0)
#define PG8_LDA(dst, b, h) do { _Pragma("unroll") for (int m = 0; m < 4; ++m) _Pragma("unroll") for (int k = 0; k < 2; ++k) dst[m][k] = *(const PG8_LAS bf16x8*)(lds + PG8_SA(b, h) + aoff + m * 2048 + k * 1024); } while (0)
#define PG8_LDB(dst, b, h) do { _Pragma("unroll") for (int n = 0; n < 2; ++n) _Pragma("unroll") for (int k = 0; k < 2; ++k) dst[n][k] = *(const PG8_LAS bf16x8*)(lds + PG8_SB(b, h) + boff + n * 2048 + k * 1024); } while (0)
#define PG8_MMA(ai, bj, At, Bt) do { __builtin_amdgcn_s_setprio(1); _Pragma("unroll") for (int m = 0; m < 4; ++m) _Pragma("unroll") for (int n = 0; n < 2; ++n) _Pragma("unroll") for (int k = 0; k < 2; ++k) \
        acc[ai][bj][m][n] = __builtin_amdgcn_mfma_f32_16x16x32_bf16(Bt[n][k], At[m][k], acc[ai][bj][m][n], 0, 0, 0); __builtin_amdgcn_s_setprio(0); } while (0)
#define PG8_WAIT_V(n) asm volatile("s_waitcnt vmcnt(" #n ")" ::: "memory")
#define PG8_WAIT_L(n) asm volatile("s_waitcnt lgkmcnt(" #n ")" ::: "memory")
#define PG8_BAR __builtin_amdgcn_s_barrier()
#define PG8_SCHED __builtin_amdgcn_sched_barrier(0)
    Unit cur, nxt; int ui = 0;
    if (!S.next(0, cur)) return;
    f32x4 acc[2][2][4][2];
#pragma unroll
    for (int a = 0; a < 2; ++a)
#pragma unroll
        for (int b = 0; b < 2; ++b)
#pragma unroll
            for (int m = 0; m < 4; ++m)
#pragma unroll
                for (int n = 0; n < 2; ++n) acc[a][b][m][n] = (f32x4){0.f, 0.f, 0.f, 0.f};
    bf16x8 At[4][2], B0[2][2], B1[2][2];
    const char* cA = (const char*)g.A + (size_t)cur.pm * tstep; const char* cB = (const char*)g.Bt + (size_t)cur.pn * tstep;
    S.a_ready(cur);
    PG8_STAGE(PG8_SB(0, 0), cB, voffB); PG8_STAGE(PG8_SA(0, 0), cA, voffA); PG8_STAGE(PG8_SB(0, 1), cB + hstep, voffB); PG8_STAGE(PG8_SA(0, 1), cA + hstep, voffA);
    if (wr == 1) PG8_BAR;
    PG8_WAIT_V(4); PG8_BAR;
    PG8_STAGE(PG8_SB(1, 0), cB + kstep, voffB); PG8_STAGE(PG8_SA(1, 0), cA + kstep, voffA); PG8_STAGE(PG8_SB(1, 1), cB + hstep + kstep, voffB);
    PG8_WAIT_V(6); PG8_BAR;
    PG8_STAMP();
    for (;;) {
        const bool has_next = S.next(ui + 1, nxt);
        const char* nA = has_next ? (const char*)g.A + (size_t)nxt.pm * tstep : cA; const char* nB = has_next ? (const char*)g.Bt + (size_t)nxt.pn * tstep : cB;
        for (int t = 0; t < nt; t += 2) {
            const bool last = (t == nt - 2);
            const char* a1 = cA + (size_t)(t + 1) * kstep;
            const char* a2 = last ? nA : cA + (size_t)(t + 2) * kstep; const char* b2 = last ? nB : cB + (size_t)(t + 2) * kstep;
            const char* a3 = a2 + kstep; const char* b3 = b2 + kstep;
            if (last && has_next) S.a_ready(nxt);
            PG8_LDB(B0, 0, 0); PG8_SCHED; PG8_LDA(At, 0, 0); PG8_STAGE(PG8_SA(1, 1), a1 + hstep, voffA);
            PG8_WAIT_L(8); PG8_BAR; PG8_WAIT_L(0); PG8_MMA(0, 0, At, B0); PG8_BAR; PG8_SCHED;
            PG8_LDB(B1, 0, 1); PG8_STAGE(PG8_SB(0, 0), b2, voffB);
            PG8_BAR; PG8_WAIT_L(0); PG8_MMA(0, 1, At, B1); PG8_BAR;
            PG8_LDA(At, 0, 1); PG8_STAGE(PG8_SA(0, 0), a2, voffA);
            PG8_BAR; PG8_WAIT_L(0); PG8_MMA(1, 0, At, B0); PG8_BAR; PG8_SCHED;
            PG8_STAGE(PG8_SB(0, 1), b2 + hstep, voffB);
            PG8_WAIT_V(6); PG8_BAR; PG8_MMA(1, 1, At, B1); PG8_BAR;
            PG8_LDB(B0, 1, 0); PG8_SCHED; PG8_LDA(At, 1, 0); PG8_STAGE(PG8_SA(0, 1), a2 + hstep, voffA);
            PG8_WAIT_L(8); PG8_BAR; PG8_WAIT_L(0); PG8_MMA(0, 0, At, B0); PG8_BAR; PG8_SCHED;
            PG8_LDB(B1, 1, 1); PG8_STAGE(PG8_SB(1, 0), b3, voffB);
            PG8_BAR; PG8_WAIT_L(0); PG8_MMA(0, 1, At, B1); PG8_BAR;
            PG8_LDA(At, 1, 1); PG8_STAGE(PG8_SA(1, 0), a3, voffA);
            PG8_BAR; PG8_WAIT_L(0); PG8_MMA(1, 0, At, B0); PG8_BAR; PG8_SCHED;
            PG8_STAGE(PG8_SB(1, 1), b3 + hstep, voffB);
            PG8_WAIT_V(6); PG8_BAR; PG8_MMA(1, 1, At, B1); PG8_BAR;
        }
        PG8_STAMP();
        if constexpr (!Epi::AFTER_DRAIN) { E(acc, cur, wr, wc, fr, fq); S.done(cur); }
        PG8_STAMP();
        if (!has_next) break;
#pragma unroll
        for (int a = 0; a < 2; ++a)
#pragma unroll
            for (int b = 0; b < 2; ++b)
#pragma unroll
                for (int m = 0; m < 4; ++m)
#pragma unroll
                    for (int n = 0; n < 2; ++n) acc[a][b][m][n] = (f32x4){0.f, 0.f, 0.f, 0.f};
        cur = nxt; cA = nA; cB = nB; ++ui;
    }
    PG8_WAIT_V(0);
    if (wr == 0) PG8_BAR;
    PG8_BAR;
    if constexpr (Epi::AFTER_DRAIN) { E.fused(acc, cur, wr, wc, fr, fq, lds, wid, lane); S.done(cur); }
    PG8_STAMP();
    if (STAMP && wid == 0) { stamps[lane] = lane < nts ? (((unsigned long long)(unsigned)ts_hi << 32) | (unsigned)ts_lo) : 0ull;
        if (lane == 62) stamps[62] = rt_entry; if (lane == 63) stamps[63] = (unsigned long long)wall_clock64(); }
#undef PG8_STAMP
#undef PG8_SA
#undef PG8_SB
#undef PG8_STAGE
#undef PG8_LDA
#undef PG8_LDB
#undef PG8_MMA
#undef PG8_WAIT_V
#undef PG8_WAIT_L
#undef PG8_BAR
#undef PG8_SCHED
}
}

#define XB_TMO      128
#define XB_XCNT(j)  (256  + 64 * (j))
#define XB_XSUB(j)  (1280 + 64 * (j))
#define XB_XGEN(j)  (2304 + 64 * (j))
#define XB_TOP      3328
#define XB_TOPGEN   3392
#define XCD_BAR_WORDS 3456
#define XB_SPIN_CAP (1u << 18)
#define LAS __attribute__((address_space(3)))

__device__ __forceinline__ unsigned xb_ld(unsigned* p)              { return __hip_atomic_load(p, __ATOMIC_RELAXED, __HIP_MEMORY_SCOPE_AGENT); }
__device__ __forceinline__ unsigned xb_add(unsigned* p, unsigned v) { return __hip_atomic_fetch_add(p, v, __ATOMIC_RELAXED, __HIP_MEMORY_SCOPE_AGENT); }
__device__ __forceinline__ unsigned xb_xcc_id() { return (unsigned)__builtin_amdgcn_s_getreg((3 << 11) | 20) & 0xFu; }
#define XB_SPIN(cond, bar) do { unsigned _sp = 0; while (cond) { __builtin_amdgcn_s_sleep(1); \
    if ((++_sp & 255u) == 0u) { if (xb_ld(&(bar)[XB_TMO])) break; if (_sp > XB_SPIN_CAP) { atomicAdd(&(bar)[XB_TMO], 1u); break; } } } } while (0)

struct XcdBarrier {
    unsigned* bar; unsigned x;
    volatile LAS unsigned* st;
};

__device__ __forceinline__ XcdBarrier xcd_barrier_post(unsigned* bar, volatile LAS unsigned* st) {
    XcdBarrier b; b.bar = bar; b.x = xb_xcc_id(); b.st = st;
    if (threadIdx.x == 0) (void)xb_add(&bar[XB_XCNT(b.x)], 1u);
    return b;
}
__device__ __forceinline__ void xcd_barrier_complete(unsigned* bar, unsigned x, unsigned& nloc, unsigned& nx) {
    const unsigned G = gridDim.x * gridDim.y * gridDim.z;
    unsigned sum, cnt, mine, sp = 0u;
    for (;;) {
        sum = 0u; cnt = 0u; mine = 0u;
#pragma unroll
        for (unsigned j = 0; j < 16; ++j) { const unsigned c = xb_ld(&bar[XB_XCNT(j)]); sum += c; cnt += (c > 0u) ? 1u : 0u; mine = (j == x) ? c : mine; }
        if (sum == G) break;
        __builtin_amdgcn_s_sleep(1);
        if ((++sp & 255u) == 0u) { if (xb_ld(&bar[XB_TMO])) break; if (sp > XB_SPIN_CAP) { atomicAdd(&bar[XB_TMO], 1u); break; } }
    }
    nloc = mine > 0u ? mine : 1u; nx = cnt > 0u ? cnt : 1u;
}

__device__ __forceinline__ void xcd_barrier(const XcdBarrier& b) {
    asm volatile("s_waitcnt vmcnt(0)" ::: "memory");
    __syncthreads();
    if (threadIdx.x == 0) {
        unsigned* bar = b.bar;
        __builtin_amdgcn_s_waitcnt(0);
        unsigned nloc = b.st[0], nx = b.st[1];
        if (nloc == 0u) { xcd_barrier_complete(bar, b.x, nloc, nx); b.st[0] = nloc; b.st[1] = nx; }
        const unsigned old = xb_add(&bar[XB_XSUB(b.x)], 1u);
        const unsigned gen = old / nloc;
        if (old + 1u == (gen + 1u) * nloc) {
            __builtin_amdgcn_fence(__ATOMIC_RELEASE, "agent");
            asm volatile("s_waitcnt vmcnt(0)" ::: "memory");
            const unsigned og = xb_add(&bar[XB_TOP], 1u);
            const unsigned tg = og / nx;
            if (og + 1u == (tg + 1u) * nx) xb_add(&bar[XB_TOPGEN], 1u);
            else XB_SPIN(xb_ld(&bar[XB_TOPGEN]) == tg, bar);
            __builtin_amdgcn_fence(__ATOMIC_ACQUIRE, "agent");
            xb_add(&bar[XB_XGEN(b.x)], 1u);
            asm volatile("s_waitcnt vmcnt(0)" ::: "memory");
        } else {
            XB_SPIN(xb_ld(&bar[XB_XGEN(b.x)]) == gen, bar);
            __builtin_amdgcn_fence(__ATOMIC_ACQUIRE, "agent");
            asm volatile("s_waitcnt vmcnt(0)" ::: "memory");
        }
    }
    __syncthreads();
}

typedef unsigned short bf16_t;
typedef short bf16x8 __attribute__((ext_vector_type(8)));
typedef float f32x4 __attribute__((ext_vector_type(4)));
typedef unsigned u32x4 __attribute__((ext_vector_type(4)));
typedef unsigned u32x2 __attribute__((ext_vector_type(2)));

constexpr int NT = 512;
constexpr int D = 1024, NB = 8, SEQ = 2048, CTXL = 256;
constexpr int MLAT = NB * SEQ, MCTX = NB * CTXL, MALL = MLAT + MCTX;
constexpr int ZG_LD = 2048, ZR_LD = 3584, Z3_LD = 3072;
constexpr int N1 = 5632, N2 = 3072, NIN = N1 + N2;
constexpr int ZR_OFF = 32;
constexpr int MODW = 6144;
constexpr int LDS_BYTES = 163840, LDS_HDR = 64;

constexpr size_t WS_CTL   = 0;
constexpr size_t WS_MOD   = 65536;
constexpr size_t WS_BONUS = WS_MOD + 262144;
constexpr size_t WS_WIN   = WS_BONUS + 1048576;
constexpr size_t WS_WOUT  = WS_WIN + (size_t)NIN * 1024 * 2;
constexpr size_t WS_WQ    = WS_WOUT + (size_t)1024 * 1024 * 2;
constexpr size_t WS_G2T   = WS_WQ + (size_t)2048 * 1024 * 2;
constexpr size_t WS_SK    = WS_G2T + (size_t)1024 * 192 * 2;
constexpr size_t WS_A1    = WS_SK + (size_t)16 * 128 * 128 * 2;
constexpr size_t WS_ZG    = WS_A1 + (size_t)MALL * 1024 * 2;
constexpr size_t WS_ZR    = WS_ZG + (size_t)MALL * ZG_LD * 2;
constexpr size_t WS_END   = WS_ZR + (size_t)MALL * ZR_LD * 2;
constexpr size_t WS_ORF   = WS_ZG;
constexpr size_t WS_ORB   = WS_ZG + (size_t)MLAT * 1024 * 2;
constexpr size_t WS_Q     = WS_ZG;
constexpr size_t WS_Z3    = WS_ZR;
constexpr size_t WS_UT    = WS_ZR;
constexpr size_t WS_VT    = WS_UT + (size_t)16384 * 1024 * 2;
constexpr size_t WS_IDX   = WS_VT + (size_t)16384 * 1024 * 2;
constexpr size_t WS_GATE  = WS_IDX + (size_t)MLAT * 128 * 4;
static_assert(WS_GATE + (size_t)MLAT * 128 * 4 <= WS_END, "ws map");
static_assert(WS_ORB + (size_t)MLAT * 1024 * 2 <= WS_ZR, "ws map");

struct Ctx {
    const float *x, *c, *ctx, *c_ctx, *norm1_w, *w_mod, *b_mod, *w_in, *gla_w_a2, *gla_b_a, *gla_norm_w, *rwkv_mu, *rwkv_w0, *rwkv_w2, *rwkv_a0, *rwkv_a2, *rwkv_g2,
        *rwkv_k_k, *rwkv_k_a, *rwkv_r_k, *rwkv_ln_w, *rwkv_ln_b, *w_out, *norm2_w, *peer_w_q, *peer_sub_keys, *peer_u, *peer_v, *final_norm_w;
    float* out; unsigned char* ws;
};
struct Args { const float* in[29]; float* out; unsigned char* ws; int ph_lo, ph_hi; };

typedef __bf16 hwbf16x2 __attribute__((ext_vector_type(2)));
typedef float f32x2v __attribute__((ext_vector_type(2)));
__device__ __forceinline__ unsigned pk2(float lo, float hi) { const f32x2v f = {lo, hi}; const hwbf16x2 v = __builtin_convertvector(f, hwbf16x2); return __builtin_bit_cast(unsigned, v); }
__device__ __forceinline__ bf16_t f2bf(float f) { return (bf16_t)(pk2(f, 0.f) & 0xffffu); }
__device__ __forceinline__ float bflo(unsigned w) { return __uint_as_float(w << 16); }
__device__ __forceinline__ float bfhi(unsigned w) { return __uint_as_float(w & 0xffff0000u); }
__device__ __forceinline__ float bf2f(bf16_t b) { return __uint_as_float(((unsigned)b) << 16); }
__device__ __forceinline__ void unpack8(const u32x4 w, float* o) { o[0] = bflo(w.x); o[1] = bfhi(w.x); o[2] = bflo(w.y); o[3] = bfhi(w.y); o[4] = bflo(w.z); o[5] = bfhi(w.z); o[6] = bflo(w.w); o[7] = bfhi(w.w); }
__device__ __forceinline__ u32x4 pack8(const float* v) { u32x4 w; w.x = pk2(v[0], v[1]); w.y = pk2(v[2], v[3]); w.z = pk2(v[4], v[5]); w.w = pk2(v[6], v[7]); return w; }
__device__ __forceinline__ u32x4 ldg16(const bf16_t* p) { return *(const u32x4*)p; }
__device__ __forceinline__ float sigmoidf_(float x) { return 1.0f / (1.0f + __expf(-x)); }
__device__ __forceinline__ float wave_sum(float v) {
#pragma unroll
    for (int o = 32; o > 0; o >>= 1) v += __shfl_xor(v, o);
    return v;
}
#define LDS_FENCE() asm volatile("s_waitcnt lgkmcnt(0)" ::: "memory")

__device__ __forceinline__ int win_src(int n) {
    if (n < 2048) return n;
    if (n < N1) { const int j = n - 2048; if (j < 16) return 3072 + j; if (j < 32) return 3088 + (j - 16); if (j < 32 + 3424) return 3104 + (j - 32); return -1; }
    const int j = n - N1; return j < 1024 ? 2048 + j : 6528 + (j - 1024);
}
template <int MODE> __device__ __forceinline__ void transpose_tile(const float* __restrict__ src, int ld, bf16_t* __restrict__ dst, int n0, int k0, LAS float* tile) {
    const int tid = threadIdx.x;
#pragma unroll
    for (int e = 0; e < 8; ++e) { const int idx = tid + e * NT, kk = idx >> 6, nn = idx & 63; const int n = n0 + nn; const int s = MODE == 0 ? win_src(n) : n;
        tile[kk * 65 + nn] = s >= 0 ? src[(size_t)(k0 + kk) * ld + s] : 0.f; }
    __syncthreads();
#pragma unroll
    for (int e = 0; e < 4; ++e) { const int idx = tid + e * NT, nn = idx >> 5, kp = idx & 31;
        *(unsigned*)(dst + (size_t)(n0 + nn) * 1024 + k0 + kp * 2) = pk2(tile[(kp * 2) * 65 + nn], tile[(kp * 2 + 1) * 65 + nn]); }
    __syncthreads();
}
__device__ __forceinline__ void p0_prologue(const Ctx& c, LAS unsigned char* lds) {
    const int tid = threadIdx.x, G = gridDim.x, bx = blockIdx.x;
    LAS float* tile = (LAS float*)lds;
    bf16_t* Wt_in = (bf16_t*)(c.ws + WS_WIN); bf16_t* Wt_out = (bf16_t*)(c.ws + WS_WOUT); bf16_t* Wt_q = (bf16_t*)(c.ws + WS_WQ);
    constexpr int T_IN = (NIN / 64) * 16, T_OUT = 16 * 16, T_Q = 32 * 16;
    for (int t = bx; t < T_IN + T_OUT + T_Q; t += G) {
        if (t < T_IN) transpose_tile<0>(c.w_in, 8576, Wt_in, (t >> 4) * 64, (t & 15) * 64, tile);
        else if (t < T_IN + T_OUT) { const int u = t - T_IN; transpose_tile<1>(c.w_out, 1024, Wt_out, (u >> 4) * 64, (u & 15) * 64, tile); }
        else { const int u = t - T_IN - T_OUT; transpose_tile<1>(c.peer_w_q, 2048, Wt_q, (u >> 4) * 64, (u & 15) * 64, tile); }
    }
    bf16_t* g2t = (bf16_t*)(c.ws + WS_G2T); bf16_t* sk = (bf16_t*)(c.ws + WS_SK);
    for (int i = bx * NT + tid; i < 1024 * 192; i += G * NT) { const int n = i / 192, j = i - n * 192; g2t[i] = f2bf(j < 160 ? c.rwkv_g2[j * 1024 + n] : 0.f); }
    for (int i = bx * NT + tid; i < 16 * 128 * 128; i += G * NT) sk[i] = f2bf(c.peer_sub_keys[i]);
    LAS float* sc = (LAS float*)lds;
    LAS float* part = sc + 9 * 1024;
    float* m = (float*)(c.ws + WS_MOD);
    for (int cg = bx; cg < MODW / 24; cg += G) {
        __syncthreads();
        for (int i = tid; i < 9 * 1024; i += NT) { const float v = i < 8192 ? c.c[i] : c.c_ctx[i - 8192]; sc[i] = v * sigmoidf_(v); }
        __syncthreads();
        const int c0 = cg * 24;
        if (tid < 504) { const int col = tid % 24, kp = tid / 24; float acc[9];
#pragma unroll
            for (int r = 0; r < 9; ++r) acc[r] = 0.f;
            for (int k = kp; k < 1024; k += 21) { const float w = c.w_mod[(size_t)k * MODW + c0 + col];
#pragma unroll
                for (int r = 0; r < 9; ++r) acc[r] += sc[r * 1024 + k] * w; }
#pragma unroll
            for (int r = 0; r < 9; ++r) part[(kp * 9 + r) * 24 + col] = acc[r]; }
        __syncthreads();
        if (tid < 216) { const int r = tid / 24, col = tid % 24; float s = c.b_mod[c0 + col];
            for (int kp = 0; kp < 21; ++kp) s += part[(kp * 9 + r) * 24 + col];
            m[r * MODW + c0 + col] = s; }
    }
    __syncthreads();
}

__device__ __forceinline__ void norm_mod_row(const float* __restrict__ src, const float* __restrict__ nw, const float* __restrict__ shift, const float* __restrict__ scale, bf16_t* __restrict__ dst, int lane) {
    f32x4 v[4]; float ss = 0.f;
#pragma unroll
    for (int j = 0; j < 4; ++j) { v[j] = *(const f32x4*)(src + (j * 64 + lane) * 4); ss += v[j][0] * v[j][0] + v[j][1] * v[j][1] + v[j][2] * v[j][2] + v[j][3] * v[j][3]; }
    ss = wave_sum(ss);
    const float rstd = rsqrtf(ss * (1.0f / 1024.0f) + 1e-6f);
#pragma unroll
    for (int j = 0; j < 4; ++j) { const int c0 = (j * 64 + lane) * 4; const f32x4 w = *(const f32x4*)(nw + c0), sh = *(const f32x4*)(shift + c0), sc = *(const f32x4*)(scale + c0);
        float y[4];
#pragma unroll
        for (int e = 0; e < 4; ++e) y[e] = v[j][e] * rstd * w[e] * (1.0f + sc[e]) + sh[e];
        u32x2 o; o.x = pk2(y[0], y[1]); o.y = pk2(y[2], y[3]); *(u32x2*)(dst + c0) = o; }
}
__device__ __forceinline__ void p1_norm1(const Ctx& c) {
    const int lane = threadIdx.x & 63, wave = threadIdx.x >> 6; const float* m = (const float*)(c.ws + WS_MOD); bf16_t* A1 = (bf16_t*)(c.ws + WS_A1);
    for (int row = blockIdx.x * 8 + wave; row < MALL; row += gridDim.x * 8) {
        const float* src = row < MLAT ? c.x + (size_t)row * D : c.ctx + (size_t)(row - MLAT) * D; const int mr = row < MLAT ? row / SEQ : 8;
        norm_mod_row(src, c.norm1_w, m + mr * MODW, m + mr * MODW + 1024, A1 + (size_t)row * D, lane);
    }
}
template <int MODE  > struct EpiB {
    static constexpr bool PERM = true, AFTER_DRAIN = false;
    bf16_t* O0; bf16_t* O1; int ldc;
    __device__ __forceinline__ void operator()(const pg8::f32x4 (&acc)[2][2][4][2], const pg8::Unit& u, int wr, int wc, int fr, int fq) const {
        const int row0 = u.pm * 256 + wr * 64 + fr; int colt = u.pn * 256; bf16_t* base = O0; int ld = ldc;
        if (MODE == 0) { if (u.pn >= 8) { base = O1; ld = ZR_LD; colt -= 2048; } else { ld = ZG_LD; } }
        const int col0 = colt + wc * 32 + 8 * fq;
        const bool is_silu = (MODE == 1) && (u.pn < 4);
#pragma unroll
        for (int ai = 0; ai < 2; ++ai)
#pragma unroll
            for (int m = 0; m < 4; ++m) { bf16_t* rowp = base + (size_t)(row0 + ai * 128 + m * 16) * ld + col0;
#pragma unroll
                for (int bj = 0; bj < 2; ++bj) { float v[8];
#pragma unroll
                    for (int j = 0; j < 4; ++j) { v[j] = acc[ai][bj][m][0][j]; v[4 + j] = acc[ai][bj][m][1][j]; }
                    if (MODE == 1) {
#pragma unroll
                        for (int j = 0; j < 8; ++j) { const float s = sigmoidf_(v[j]); v[j] = is_silu ? v[j] * s : s; } }
                    *(u32x4*)(rowp + bj * 128) = pack8(v); } }
    }
};
struct EpiH1 {
    static constexpr bool PERM = false, AFTER_DRAIN = false;
    const float* x; const float* m; float* h1;
    __device__ __forceinline__ void operator()(const pg8::f32x4 (&acc)[2][2][4][2], const pg8::Unit& u, int wr, int wc, int fr, int fq) const {
        const int row0 = u.pm * 256 + wr * 64 + fr, col0 = u.pn * 256 + wc * 32 + 4 * fq;
        const float* g = m + (size_t)((u.pm * 256) / SEQ) * MODW + 2048;
        f32x4 gv[2][2];
#pragma unroll
        for (int bj = 0; bj < 2; ++bj)
#pragma unroll
            for (int n = 0; n < 2; ++n) gv[bj][n] = *(const f32x4*)(g + col0 + bj * 128 + n * 16);
#pragma unroll
        for (int ai = 0; ai < 2; ++ai)
#pragma unroll
            for (int mm = 0; mm < 4; ++mm) { const size_t ro = (size_t)(row0 + ai * 128 + mm * 16) * D + col0;
#pragma unroll
                for (int bj = 0; bj < 2; ++bj)
#pragma unroll
                    for (int n = 0; n < 2; ++n) { const f32x4 xv = *(const f32x4*)(x + ro + bj * 128 + n * 16); *(f32x4*)(h1 + ro + bj * 128 + n * 16) = xv + gv[bj][n] * acc[ai][bj][mm][n]; } }
    }
};

#define MFMA16(a, b, c) __builtin_amdgcn_mfma_f32_16x16x32_bf16(a, b, c, 0, 0, 0)
__device__ __forceinline__ float logsigmoidf_(float x) { return fminf(x, 0.f) - __logf(1.0f + __expf(-fabsf(x))); }
__device__ __forceinline__ void p3_gla(const Ctx& c, LAS unsigned char* lds) {
    const int tid = threadIdx.x, lane = tid & 63, wave = tid >> 6, l15 = lane & 15, lq = lane >> 4;
    LAS bf16_t* Qd = (LAS bf16_t*)lds;
    LAS bf16_t* Kd = Qd + 64 * 136;
    LAS bf16_t* Kt = Kd + 64 * 136;
    LAS bf16_t* Vt = Kt + 128 * 72;
    LAS bf16_t* At = Vt + 64 * 72;
    LAS bf16_t* St = At + 64 * 72;
    LAS float* GC = (LAS float*)(St + 64 * 136);
    LAS float* ALO = GC + 64 * 128;
    LAS float* WA = ALO + 64 * 16;
    LAS float* BA = WA + 16 * 128;
    LAS float* EBL = BA + 128;
    const bf16_t* Zg = (const bf16_t*)(c.ws + WS_ZG); const bf16_t* Zr = (const bf16_t*)(c.ws + WS_ZR);
    bf16_t* og_f = (bf16_t*)c.out; bf16_t* og_b = og_f + (size_t)MLAT * D;
    const int ti = tid >> 3, seg = tid & 7;
    for (int u = blockIdx.x; u < 256; u += gridDim.x) {
        const int dir = u & 1, dvs = (u >> 1) & 3, h = (u >> 3) & 3, b = u >> 5;
        bf16_t* og = dir ? og_b : og_f;
        __syncthreads();
        for (int i = tid; i < 16 * 128; i += NT) { const int j = i >> 7, d = i & 127; WA[i] = c.gla_w_a2[(size_t)(dir * 16 + j) * 512 + h * 128 + d]; }
        if (tid < 128) BA[tid] = c.gla_b_a[dir * 512 + h * 128 + tid];
        for (int i = tid; i < 64 * 136 / 2; i += NT) ((LAS unsigned*)St)[i] = 0u;
        f32x4 accS[4];
#pragma unroll
        for (int n = 0; n < 4; ++n) accS[n] = (f32x4){0.f, 0.f, 0.f, 0.f};
        for (int step = 0; step < 36; ++step) {
            const bool lat = step >= 4;
            const int cidx = lat ? (dir ? 31 - (step - 4) : step - 4) : (dir ? 3 - step : step);
            const int rbase = (lat ? b * SEQ : MLAT + b * CTXL) + cidx * 64;
            const size_t R = (size_t)(rbase + (dir ? 63 - ti : ti));
            u32x4 qw[2], kw[2], vw;
            if (lat) { qw[0] = ldg16(Zg + R * ZG_LD + h * 128 + seg * 16); qw[1] = ldg16(Zg + R * ZG_LD + h * 128 + seg * 16 + 8); }
            kw[0] = ldg16(Zg + R * ZG_LD + 512 + h * 128 + seg * 16); kw[1] = ldg16(Zg + R * ZG_LD + 512 + h * 128 + seg * 16 + 8);
            vw = ldg16(Zg + R * ZG_LD + 1024 + h * 256 + dvs * 64 + seg * 8);
            if (seg < 2) { float a8[8]; unpack8(ldg16(Zr + R * ZR_LD + dir * 16 + seg * 8), a8);
#pragma unroll
                for (int e = 0; e < 8; ++e) ALO[ti * 16 + seg * 8 + e] = a8[e]; }
            __syncthreads();
            { float al[16];
#pragma unroll
                for (int j = 0; j < 16; ++j) al[j] = ALO[ti * 16 + j];
#pragma unroll
                for (int dd = 0; dd < 16; ++dd) { const int d = seg * 16 + dd; float s = BA[d];
#pragma unroll
                    for (int j = 0; j < 16; ++j) s += al[j] * WA[j * 128 + d];
                    GC[ti * 128 + d] = logsigmoidf_(s) * (1.0f / 16.0f); } }
            __syncthreads();
            { const int d = tid & 127, qq = tid >> 7; float a = 0.f;
#pragma unroll
                for (int r = 0; r < 16; ++r) { a += GC[(qq * 16 + r) * 128 + d]; GC[(qq * 16 + r) * 128 + d] = a; } }
            __syncthreads();
            { float q16[16], k16[16], v8[8];
                if (lat) { unpack8(qw[0], q16); unpack8(qw[1], q16 + 8); }
                unpack8(kw[0], k16); unpack8(kw[1], k16 + 8); unpack8(vw, v8);
                u32x4 qo[2], ko[2]; float qd[16], kd[16];
#pragma unroll
                for (int dd = 0; dd < 16; ++dd) { const int d = seg * 16 + dd;
                    const float e15 = GC[15 * 128 + d], e31 = GC[31 * 128 + d], e47 = GC[47 * 128 + d], e63 = GC[63 * 128 + d];
                    const float off = (ti >= 16 ? e15 : 0.f) + (ti >= 32 ? e31 : 0.f) + (ti >= 48 ? e47 : 0.f);
                    const float bc = GC[ti * 128 + d] + off, bl = e15 + e31 + e47 + e63;
                    const float e1 = __expf(bc), e2 = __expf(-bc), ebl = __expf(bl);
                    qd[dd] = lat ? q16[dd] * 0.08838834764831845f * e1 : 0.f; kd[dd] = k16[dd] * e2;
                    Kt[d * 72 + ti] = f2bf(kd[dd] * ebl);
                    if (ti == 0) EBL[d] = ebl; }
                qo[0] = pack8(qd); qo[1] = pack8(qd + 8); ko[0] = pack8(kd); ko[1] = pack8(kd + 8);
                *(LAS u32x4*)(Qd + ti * 136 + seg * 16) = qo[0]; *(LAS u32x4*)(Qd + ti * 136 + seg * 16 + 8) = qo[1];
                *(LAS u32x4*)(Kd + ti * 136 + seg * 16) = ko[0]; *(LAS u32x4*)(Kd + ti * 136 + seg * 16 + 8) = ko[1];
#pragma unroll
                for (int e = 0; e < 8; ++e) Vt[(seg * 8 + e) * 72 + ti] = f2bf(v8[e]); }
            __syncthreads();
            const int mt = wave >> 1;
            if (lat) {
#pragma unroll
                for (int t2 = 0; t2 < 2; ++t2) { const int nt = (wave & 1) * 2 + t2; f32x4 a = (f32x4){0.f, 0.f, 0.f, 0.f};
#pragma unroll
                    for (int ks = 0; ks < 4; ++ks) a = MFMA16(*(LAS bf16x8*)(Qd + (mt * 16 + l15) * 136 + ks * 32 + lq * 8), *(LAS bf16x8*)(Kd + (nt * 16 + l15) * 136 + ks * 32 + lq * 8), a);
#pragma unroll
                    for (int r = 0; r < 4; ++r) { const int i = mt * 16 + lq * 4 + r, j = nt * 16 + l15; At[i * 72 + j] = f2bf(j <= i ? a[r] : 0.f); } }
            }
            __syncthreads();
            if (lat) {
#pragma unroll
                for (int t2 = 0; t2 < 2; ++t2) { const int nt = (wave & 1) * 2 + t2; f32x4 a = (f32x4){0.f, 0.f, 0.f, 0.f};
#pragma unroll
                    for (int ks = 0; ks < 4; ++ks) a = MFMA16(*(LAS bf16x8*)(Qd + (mt * 16 + l15) * 136 + ks * 32 + lq * 8), *(LAS bf16x8*)(St + (nt * 16 + l15) * 136 + ks * 32 + lq * 8), a);
#pragma unroll
                    for (int ks = 0; ks < 2; ++ks) a = MFMA16(*(LAS bf16x8*)(At + (mt * 16 + l15) * 72 + ks * 32 + lq * 8), *(LAS bf16x8*)(Vt + (nt * 16 + l15) * 72 + ks * 32 + lq * 8), a);
#pragma unroll
                    for (int r = 0; r < 4; ++r) { const int i = mt * 16 + lq * 4 + r; const size_t Ro = (size_t)(rbase + (dir ? 63 - i : i));
                        og[Ro * D + h * 256 + dvs * 64 + nt * 16 + l15] = f2bf(a[r]); } }
            }
            { float eb[4];
#pragma unroll
                for (int r = 0; r < 4; ++r) eb[r] = EBL[wave * 16 + lq * 4 + r];
#pragma unroll
                for (int nt = 0; nt < 4; ++nt) {
#pragma unroll
                    for (int r = 0; r < 4; ++r) accS[nt][r] *= eb[r];
#pragma unroll
                    for (int ks = 0; ks < 2; ++ks) accS[nt] = MFMA16(*(LAS bf16x8*)(Kt + (wave * 16 + l15) * 72 + ks * 32 + lq * 8), *(LAS bf16x8*)(Vt + (nt * 16 + l15) * 72 + ks * 32 + lq * 8), accS[nt]); } }
            __syncthreads();
#pragma unroll
            for (int nt = 0; nt < 4; ++nt) { u32x2 w; w.x = pk2(accS[nt][0], accS[nt][1]); w.y = pk2(accS[nt][2], accS[nt][3]); *(LAS u32x2*)(St + (nt * 16 + l15) * 136 + wave * 16 + lq * 4) = w; }
        }
    }
    __syncthreads();
}
template <bool LAT> __device__ __forceinline__ void load_mixed8(const bf16_t* __restrict__ Zr, int rowbase, int tl, int col, const float* mu8, float* out) {
    float own[8], zs[8], nb[8];
    const bf16_t* p = Zr + (size_t)(rowbase + tl) * ZR_LD + col;
    unpack8(ldg16(p), own);
    if (LAT) {
        const int x = tl & 63, y = tl >> 6;
#pragma unroll
        for (int ty = 0; ty < 4; ++ty) {
            const bool ok = ty == 0 ? (x > 0) : ty == 1 ? (x < 63) : ty == 2 ? (y > 0) : (y < 31);
            const int dl = ty == 0 ? -1 : ty == 1 ? 1 : ty == 2 ? -64 : 64;
            u32x4 w = (u32x4){0u, 0u, 0u, 0u};
            if (ok) w = ldg16(p + (ptrdiff_t)dl * ZR_LD);
            unpack8(w, nb); zs[ty] = nb[ty]; zs[ty + 4] = nb[ty + 4];
        }
    } else {
#pragma unroll
        for (int ty = 0; ty < 2; ++ty) {
            const bool ok = ty == 0 ? (tl > 0) : (tl < CTXL - 1);
            u32x4 w = (u32x4){0u, 0u, 0u, 0u};
            if (ok) w = ldg16(p + (ptrdiff_t)(ty == 0 ? -1 : 1) * ZR_LD);
            unpack8(w, nb); zs[ty] = nb[ty]; zs[ty + 2] = nb[ty + 2]; zs[ty + 4] = nb[ty + 4]; zs[ty + 6] = nb[ty + 6];
        }
    }
#pragma unroll
    for (int e = 0; e < 8; ++e) out[e] = own[e] + (zs[e] - own[e]) * mu8[e];
}

#define DPPB(j) " row_newbcast:" #j " row_mask:0xf bank_mask:0xf\n"
#define SA1(j, acc) "v_fmac_f32_dpp %" #acc ", %18, %" #j DPPB(j)
#define UPD(j, o) "v_mul_f32_dpp %" #j ", %18, %" #j DPPB(j) "v_fmac_f32_dpp %" #j ", %19, %22" DPPB(j) "v_fmac_f32_dpp %" #j ", %20, %23" DPPB(j) "v_fmac_f32_dpp %" #o ", %21, %" #j DPPB(j)
__device__ __forceinline__ float reduce4(float x) {
    const unsigned u = __float_as_uint(x);
    auto r = __builtin_amdgcn_permlane32_swap(u, u, false, false);
    const float y = __uint_as_float(r[0]) + __uint_as_float(r[1]);
    const unsigned v = __float_as_uint(y);
    auto s = __builtin_amdgcn_permlane16_swap(v, v, false, false);
    return __uint_as_float(s[0]) + __uint_as_float(s[1]);
}
__device__ __forceinline__ void p4_rwkv(const Ctx& c, LAS unsigned char* lds) {
    const int tid = threadIdx.x, lane = tid & 63, wave = tid >> 6, l15 = lane & 15, lq = lane >> 4;
    LAS float* BUF = (LAS float*)lds;
    LAS float* W2L = BUF + 2 * 6 * 2048;
    LAS float* A2L = W2L + 4096;
    LAS float* TW = A2L + 4096;
    LAS float* AL = TW + 32 * 65;
    LAS bf16_t* OB = (LAS bf16_t*)(AL + 32 * 65);
    LAS float* PAR = (LAS float*)(OB + 2 * 2048);
    const bf16_t* Zr = (const bf16_t*)(c.ws + WS_ZR);
    float* bonus = (float*)(c.ws + WS_BONUS);
    for (int u = blockIdx.x; u < 256; u += gridDim.x) {
        const int dir = u & 1, h = (u >> 1) & 15, b = u >> 5;
        bf16_t* orr = (bf16_t*)(c.ws + (dir ? WS_ORB : WS_ORF));
        __syncthreads();
        for (int i = tid; i < 4096; i += NT) { const int j = i >> 6, ch = i & 63; W2L[i] = c.rwkv_w2[(size_t)(dir * 64 + j) * 1024 + h * 64 + ch]; A2L[i] = c.rwkv_a2[(size_t)j * 1024 + h * 64 + ch]; }
        if (tid < 64) { const int ch = tid, hc = h * 64 + ch;
            PAR[0 * 64 + ch] = c.rwkv_mu[hc]; PAR[1 * 64 + ch] = c.rwkv_mu[1024 + hc]; PAR[2 * 64 + ch] = c.rwkv_mu[2048 + hc]; PAR[3 * 64 + ch] = c.rwkv_mu[3072 + dir * 64 + ch]; PAR[4 * 64 + ch] = c.rwkv_mu[3200 + ch];
            PAR[5 * 64 + ch] = c.rwkv_w0[dir * 1024 + hc]; PAR[6 * 64 + ch] = c.rwkv_a0[hc]; PAR[7 * 64 + ch] = c.rwkv_k_k[hc]; PAR[8 * 64 + ch] = c.rwkv_k_a[hc]; PAR[9 * 64 + ch] = c.rwkv_r_k[hc]; }
        __syncthreads();
        float S[16];
#pragma unroll
        for (int j = 0; j < 16; ++j) S[j] = 0.f;
        for (int s = 0; s <= 73; ++s) {
            if (wave >= 4) {
                const int pt = tid - 256, tok = pt >> 3, cg = pt & 7;
                if (s >= 2 && s - 2 >= 8) {
                    const int sp = s - 2, cidx = dir ? 63 - (sp - 8) : sp - 8, tl = cidx * 32 + (dir ? 31 - tok : tok);
                    *(u32x4*)(orr + (size_t)(b * SEQ + tl) * D + h * 64 + cg * 8) = *(LAS u32x4*)(OB + ((sp & 1) * 32 + tok) * 64 + cg * 8);
                }
                if (s < 72) {
                    const bool lat = s >= 8;
                    const int cidx = lat ? (dir ? 63 - (s - 8) : s - 8) : (dir ? 7 - s : s);
                    const int tl = cidx * 32 + (dir ? 31 - tok : tok), rowbase = lat ? b * SEQ : MLAT + b * CTXL;
                    float rm[8], km[8], vm[8], wl[8], al[8], mu8[8];
#define LDMU(k) { const f32x4 m0 = *(LAS f32x4*)(PAR + (k) * 64 + cg * 8), m1 = *(LAS f32x4*)(PAR + (k) * 64 + cg * 8 + 4); mu8[0] = m0[0]; mu8[1] = m0[1]; mu8[2] = m0[2]; mu8[3] = m0[3]; mu8[4] = m1[0]; mu8[5] = m1[1]; mu8[6] = m1[2]; mu8[7] = m1[3]; }
                    if (lat) {
                        LDMU(0); load_mixed8<true>(Zr, rowbase, tl, ZR_OFF + h * 64 + cg * 8, mu8, rm);
                        LDMU(1); load_mixed8<true>(Zr, rowbase, tl, ZR_OFF + 1024 + h * 64 + cg * 8, mu8, km);
                        LDMU(2); load_mixed8<true>(Zr, rowbase, tl, ZR_OFF + 2048 + h * 64 + cg * 8, mu8, vm);
                        LDMU(3); load_mixed8<true>(Zr, rowbase, tl, ZR_OFF + 3072 + dir * 64 + cg * 8, mu8, wl);
                        LDMU(4); load_mixed8<true>(Zr, rowbase, tl, ZR_OFF + 3200 + cg * 8, mu8, al);
                    } else {
                        LDMU(0); load_mixed8<false>(Zr, rowbase, tl, ZR_OFF + h * 64 + cg * 8, mu8, rm);
                        LDMU(1); load_mixed8<false>(Zr, rowbase, tl, ZR_OFF + 1024 + h * 64 + cg * 8, mu8, km);
                        LDMU(2); load_mixed8<false>(Zr, rowbase, tl, ZR_OFF + 2048 + h * 64 + cg * 8, mu8, vm);
                        LDMU(3); load_mixed8<false>(Zr, rowbase, tl, ZR_OFF + 3072 + dir * 64 + cg * 8, mu8, wl);
                        LDMU(4); load_mixed8<false>(Zr, rowbase, tl, ZR_OFF + 3200 + cg * 8, mu8, al);
                    }
#pragma unroll
                    for (int e = 0; e < 8; ++e) { TW[tok * 65 + cg * 8 + e] = tanhf(wl[e]); AL[tok * 65 + cg * 8 + e] = al[e]; }
                    LDS_FENCE();
                    float aw[8], aa[8];
                    LDMU(5);
#pragma unroll
                    for (int e = 0; e < 8; ++e) aw[e] = mu8[e];
                    LDMU(6);
#pragma unroll
                    for (int e = 0; e < 8; ++e) aa[e] = mu8[e];
                    for (int j = 0; j < 64; ++j) { const float tw = TW[tok * 65 + j], av = AL[tok * 65 + j];
                        const f32x4 w0 = *(LAS f32x4*)(W2L + j * 64 + cg * 8), w1 = *(LAS f32x4*)(W2L + j * 64 + cg * 8 + 4), a0 = *(LAS f32x4*)(A2L + j * 64 + cg * 8), a1 = *(LAS f32x4*)(A2L + j * 64 + cg * 8 + 4);
#pragma unroll
                        for (int e = 0; e < 4; ++e) { aw[e] += tw * w0[e]; aw[4 + e] += tw * w1[e]; aa[e] += av * a0[e]; aa[4 + e] += av * a1[e]; } }
                    LDS_FENCE();
                    float kkv[8], ss = 0.f, dec[8], av8[8], kp[8], bs = 0.f;
                    LDMU(7);
#pragma unroll
                    for (int e = 0; e < 8; ++e) { kkv[e] = km[e] * mu8[e]; ss += kkv[e] * kkv[e]; }
                    ss += __shfl_xor(ss, 1); ss += __shfl_xor(ss, 2); ss += __shfl_xor(ss, 4);
                    const float inv = 1.0f / fmaxf(sqrtf(ss), 1e-12f);
                    LDMU(8);
#pragma unroll
                    for (int e = 0; e < 8; ++e) {
                        const float xw = aw[e]; const float sp = fmaxf(-xw, 0.f) + log1pf(__expf(-fabsf(xw)));
                        dec[e] = __expf(-__expf(-sp - 0.5f));
                        av8[e] = sigmoidf_(aa[e]);
                        kp[e] = km[e] * (1.0f + (av8[e] - 1.0f) * mu8[e]);
                        kkv[e] *= inv; }
                    LDMU(9);
#pragma unroll
                    for (int e = 0; e < 8; ++e) bs += rm[e] * kp[e] * mu8[e];
                    bs += __shfl_xor(bs, 1); bs += __shfl_xor(bs, 2); bs += __shfl_xor(bs, 4);
                    if (lat && dir == 0 && cg == 0) bonus[(size_t)(b * SEQ + tl) * 16 + h] = bs;
                    LAS float* Bn = BUF + (s & 1) * 6 * 2048 + tok * 64 + cg * 8;
#define ST8(k, arr) { *(LAS f32x4*)(Bn + (k) * 2048) = (f32x4){arr[0], arr[1], arr[2], arr[3]}; *(LAS f32x4*)(Bn + (k) * 2048 + 4) = (f32x4){arr[4], arr[5], arr[6], arr[7]}; }
                    float ka[8];
#pragma unroll
                    for (int e = 0; e < 8; ++e) ka[e] = kkv[e] * av8[e];
                    ST8(0, rm); ST8(1, dec); ST8(2, kp); ST8(3, ka); ST8(4, kkv); ST8(5, vm);
#undef ST8
#undef LDMU
                }
            } else if (s >= 1 && s <= 72) {
                const int sp = s - 1; const bool lat = sp >= 8;
                const LAS float* B = BUF + (sp & 1) * 6 * 2048;
                LAS bf16_t* ob = OB + (sp & 1) * 2048;
                float n_kk = B[4 * 2048 + lane], n_w = B[1 * 2048 + lane], n_ka = B[3 * 2048 + lane], n_k = B[2 * 2048 + lane], n_r = B[lane], n_v = B[5 * 2048 + wave * 16 + l15];
                for (int t = 0; t < 32; ++t) {
                    const float kkv = n_kk, wv = n_w, kav = n_ka, kv = n_k, rv = n_r, vv = n_v;
                    if (t < 31) { const int o = (t + 1) * 64; n_kk = B[4 * 2048 + o + lane]; n_w = B[1 * 2048 + o + lane]; n_ka = B[3 * 2048 + o + lane]; n_k = B[2 * 2048 + o + lane]; n_r = B[o + lane]; n_v = B[5 * 2048 + o + wave * 16 + l15]; }
                    float sa0 = 0.f, sa1 = 0.f;
                    asm volatile("s_nop 1\n"
                        SA1(0, 16) SA1(1, 17) SA1(2, 16) SA1(3, 17) SA1(4, 16) SA1(5, 17) SA1(6, 16) SA1(7, 17) SA1(8, 16) SA1(9, 17) SA1(10, 16) SA1(11, 17) SA1(12, 16) SA1(13, 17) SA1(14, 16) SA1(15, 17)
                        : "+v"(S[0]), "+v"(S[1]), "+v"(S[2]), "+v"(S[3]), "+v"(S[4]), "+v"(S[5]), "+v"(S[6]), "+v"(S[7]), "+v"(S[8]), "+v"(S[9]), "+v"(S[10]), "+v"(S[11]), "+v"(S[12]), "+v"(S[13]), "+v"(S[14]), "+v"(S[15]),
                          "+v"(sa0), "+v"(sa1) : "v"(kkv));
                    const float nsa = -reduce4(sa0 + sa1);
                    float o0 = 0.f, o1 = 0.f;
                    asm volatile("s_nop 1\n"
                        UPD(0, 16) UPD(1, 17) UPD(2, 16) UPD(3, 17) UPD(4, 16) UPD(5, 17) UPD(6, 16) UPD(7, 17) UPD(8, 16) UPD(9, 17) UPD(10, 16) UPD(11, 17) UPD(12, 16) UPD(13, 17) UPD(14, 16) UPD(15, 17)
                        : "+v"(S[0]), "+v"(S[1]), "+v"(S[2]), "+v"(S[3]), "+v"(S[4]), "+v"(S[5]), "+v"(S[6]), "+v"(S[7]), "+v"(S[8]), "+v"(S[9]), "+v"(S[10]), "+v"(S[11]), "+v"(S[12]), "+v"(S[13]), "+v"(S[14]), "+v"(S[15]),
                          "+v"(o0), "+v"(o1) : "v"(wv), "v"(kav), "v"(kv), "v"(rv), "v"(nsa), "v"(vv));
                    if (lat) { const float o = reduce4(o0 + o1); if (lq == 0) ob[t * 64 + wave * 16 + l15] = f2bf(o); }
                }
            }
            __syncthreads();
        }
    }
}
__device__ __forceinline__ void p5_post(const Ctx& c, LAS unsigned char* lds) {
    const int tid = threadIdx.x, lane = tid & 63, wave = tid >> 6, l15 = lane & 15, lq = lane >> 4;
    LAS bf16_t* SG = (LAS bf16_t*)lds;
    LAS bf16_t* GL = SG + 64 * 200;
    const bf16_t* Zr = (const bf16_t*)(c.ws + WS_ZR); const bf16_t* g2t = (const bf16_t*)(c.ws + WS_G2T);
    bf16_t* og_f = (bf16_t*)c.out; const bf16_t* og_b = og_f + (size_t)MLAT * D;
    bf16_t* or_f = (bf16_t*)(c.ws + WS_ORF); const bf16_t* or_b = (const bf16_t*)(c.ws + WS_ORB);
    const float* bonus = (const float*)(c.ws + WS_BONUS);
    for (int u = blockIdx.x; u < MLAT / 64; u += gridDim.x) {
        const int rowbase = (u >> 5) * SEQ, tl0 = (u & 31) * 64;
        __syncthreads();
        { const int tok = tid >> 3, seg = tid & 7;
#pragma unroll
            for (int k = 0; k < 3; ++k) { const int sgi = seg + 8 * k; float g8[8];
                if (sgi < 20) { float mu8[8];
#pragma unroll
                    for (int e = 0; e < 8; ++e) mu8[e] = c.rwkv_mu[3264 + sgi * 8 + e];
                    load_mixed8<true>(Zr, rowbase, tl0 + tok, ZR_OFF + 3264 + sgi * 8, mu8, g8);
#pragma unroll
                    for (int e = 0; e < 8; ++e) g8[e] = sigmoidf_(g8[e]);
                } else {
#pragma unroll
                    for (int e = 0; e < 8; ++e) g8[e] = 0.f; }
                *(LAS u32x4*)(SG + tok * 200 + sgi * 8) = pack8(g8); } }
        __syncthreads();
#pragma unroll 1
        for (int half = 0; half < 2; ++half) {
            f32x4 acc[4][4];
#pragma unroll
            for (int mt = 0; mt < 4; ++mt)
#pragma unroll
                for (int nt = 0; nt < 4; ++nt) acc[mt][nt] = (f32x4){0.f, 0.f, 0.f, 0.f};
#pragma unroll
            for (int ks = 0; ks < 6; ++ks) { bf16x8 bfr[4], afr[4];
#pragma unroll
                for (int nt = 0; nt < 4; ++nt) bfr[nt] = *(const bf16x8*)(g2t + (size_t)(wave * 128 + (half * 4 + nt) * 16 + l15) * 192 + ks * 32 + lq * 8);
#pragma unroll
                for (int mt = 0; mt < 4; ++mt) afr[mt] = *(LAS bf16x8*)(SG + (mt * 16 + l15) * 200 + ks * 32 + lq * 8);
#pragma unroll
                for (int mt = 0; mt < 4; ++mt)
#pragma unroll
                    for (int nt = 0; nt < 4; ++nt) acc[mt][nt] = MFMA16(afr[mt], bfr[nt], acc[mt][nt]); }
#pragma unroll
            for (int mt = 0; mt < 4; ++mt)
#pragma unroll
                for (int nt = 0; nt < 4; ++nt)
#pragma unroll
                    for (int r = 0; r < 4; ++r) GL[(mt * 16 + lq * 4 + r) * 1032 + wave * 128 + (half * 4 + nt) * 16 + l15] = f2bf(acc[mt][nt][r]);
        }
        __syncthreads();
        for (int ii = 0; ii < 8; ++ii) {
            const int i = wave * 8 + ii; const size_t R = (size_t)rowbase + tl0 + i; const int ch0 = lane * 16;
            { float s[16], t[16]; unpack8(ldg16(og_f + R * D + ch0), s); unpack8(ldg16(og_f + R * D + ch0 + 8), s + 8); unpack8(ldg16(og_b + R * D + ch0), t); unpack8(ldg16(og_b + R * D + ch0 + 8), t + 8);
                float ssq = 0.f;
#pragma unroll
                for (int e = 0; e < 16; ++e) { s[e] += t[e]; ssq += s[e] * s[e]; }
                ssq += __shfl_xor(ssq, 1); ssq += __shfl_xor(ssq, 2); ssq += __shfl_xor(ssq, 4); ssq += __shfl_xor(ssq, 8);
                const float rs = rsqrtf(ssq * (1.0f / 256.0f) + 1e-6f);
#pragma unroll
                for (int e = 0; e < 16; ++e) s[e] = s[e] * rs * c.gla_norm_w[ch0 + e];
                *(u32x4*)(og_f + R * D + ch0) = pack8(s); *(u32x4*)(og_f + R * D + ch0 + 8) = pack8(s + 8); }
            { float s[16], t[16]; unpack8(ldg16(or_f + R * D + ch0), s); unpack8(ldg16(or_f + R * D + ch0 + 8), s + 8); unpack8(ldg16(or_b + R * D + ch0), t); unpack8(ldg16(or_b + R * D + ch0 + 8), t + 8);
                float sm = 0.f;
#pragma unroll
                for (int e = 0; e < 16; ++e) { s[e] += t[e]; sm += s[e]; }
                sm += __shfl_xor(sm, 1); sm += __shfl_xor(sm, 2);
                const float mean = sm * (1.0f / 64.0f); float sv = 0.f;
#pragma unroll
                for (int e = 0; e < 16; ++e) { s[e] -= mean; sv += s[e] * s[e]; }
                sv += __shfl_xor(sv, 1); sv += __shfl_xor(sv, 2);
                const float rs = rsqrtf(sv * (1.0f / 64.0f) + 64e-5f);
                const float bn = bonus[R * 16 + (lane >> 2)];
                float vm[16], mu8[8], g[16];
#pragma unroll
                for (int e = 0; e < 8; ++e) mu8[e] = c.rwkv_mu[2048 + ch0 + e];
                load_mixed8<true>(Zr, rowbase, tl0 + i, ZR_OFF + 2048 + ch0, mu8, vm);
#pragma unroll
                for (int e = 0; e < 8; ++e) mu8[e] = c.rwkv_mu[2048 + ch0 + 8 + e];
                load_mixed8<true>(Zr, rowbase, tl0 + i, ZR_OFF + 2048 + ch0 + 8, mu8, vm + 8);
                unpack8(*(LAS u32x4*)(GL + i * 1032 + ch0), g); unpack8(*(LAS u32x4*)(GL + i * 1032 + ch0 + 8), g + 8);
#pragma unroll
                for (int e = 0; e < 16; ++e) s[e] = (s[e] * rs * c.rwkv_ln_w[ch0 + e] + c.rwkv_ln_b[ch0 + e] + bn * vm[e]) * g[e];
                *(u32x4*)(or_f + R * D + ch0) = pack8(s); *(u32x4*)(or_f + R * D + ch0 + 8) = pack8(s + 8); }
        }
    }
    __syncthreads();
}

__device__ __forceinline__ void p7_combine(const Ctx& c) {
    const bf16_t* Z3 = (const bf16_t*)(c.ws + WS_Z3); const bf16_t* yg = (const bf16_t*)c.out; const bf16_t* yr = (const bf16_t*)(c.ws + WS_ORF); bf16_t* Y = (bf16_t*)(c.ws + WS_A1);
    for (int idx = blockIdx.x * NT + threadIdx.x; idx < MLAT * 128; idx += gridDim.x * NT) {
        const size_t row = idx >> 7; const int c8 = (idx & 127) * 8;
        float go[8], sg[8], sr[8], a[8], b[8], y[8];
        unpack8(ldg16(Z3 + row * Z3_LD + c8), go); unpack8(ldg16(Z3 + row * Z3_LD + 1024 + c8), sg); unpack8(ldg16(Z3 + row * Z3_LD + 2048 + c8), sr);
        unpack8(ldg16(yg + row * D + c8), a); unpack8(ldg16(yr + row * D + c8), b);
#pragma unroll
        for (int e = 0; e < 8; ++e) y[e] = sg[e] * a[e] * go[e] + sr[e] * b[e];
        *(u32x4*)(Y + row * D + c8) = pack8(y);
    }
}

__device__ __forceinline__ void p9_norm2_tables(const Ctx& c) {
    const int lane = threadIdx.x & 63, wave = threadIdx.x >> 6; const float* m = (const float*)(c.ws + WS_MOD); bf16_t* A2 = (bf16_t*)(c.ws + WS_A1);
    for (int row = blockIdx.x * 8 + wave; row < MLAT; row += gridDim.x * 8) { const int b = row / SEQ;
        norm_mod_row(c.out + (size_t)row * D, c.norm2_w, m + b * MODW + 3072, m + b * MODW + 4096, A2 + (size_t)row * D, lane); }
    bf16_t* UT = (bf16_t*)(c.ws + WS_UT); bf16_t* VT = (bf16_t*)(c.ws + WS_VT);
    for (size_t i = ((size_t)blockIdx.x * NT + threadIdx.x) * 4; i < (size_t)16384 * 1024; i += (size_t)gridDim.x * NT * 4) {
        const f32x4 a = *(const f32x4*)(c.peer_u + i), b = *(const f32x4*)(c.peer_v + i);
        u32x2 o; o.x = pk2(a[0], a[1]); o.y = pk2(a[2], a[3]); *(u32x2*)(UT + i) = o;
        o.x = pk2(b[0], b[1]); o.y = pk2(b[2], b[3]); *(u32x2*)(VT + i) = o; }
}
__device__ __forceinline__ int sortable(float v) { const int b = __float_as_int(v); return b ^ ((b >> 31) & 0x7fffffff); }
#define CAS16(t, x) { _Pragma("unroll") for (int _i = 0; _i < 16; ++_i) { const int _hi = max(t[_i], x); x = min(t[_i], x); t[_i] = _hi; } }
__device__ __forceinline__ void p11_topk(const Ctx& c, LAS unsigned char* lds) {
    const int tid = threadIdx.x, lane = tid & 63, wave = tid >> 6, l15 = lane & 15, lq = lane >> 4;
    LAS float* SC = (LAS float*)lds;
    LAS float* S1 = SC + 128 * 129;
    LAS int* I1 = (LAS int*)(S1 + 2048);
    const bf16_t* Q = (const bf16_t*)(c.ws + WS_Q); const bf16_t* SK = (const bf16_t*)(c.ws + WS_SK);
    int* IDX = (int*)(c.ws + WS_IDX); float* GATE = (float*)(c.ws + WS_GATE);
    for (int u = blockIdx.x; u < (MLAT / 64) * 8; u += gridDim.x) {
        const int tile = u >> 3, h = u & 7, R0 = tile * 64;
        __syncthreads();
        { const int p = wave >> 2, ntp = (wave & 3) * 2;
            f32x4 acc[4][2];
#pragma unroll
            for (int mt = 0; mt < 4; ++mt) { acc[mt][0] = (f32x4){0.f, 0.f, 0.f, 0.f}; acc[mt][1] = (f32x4){0.f, 0.f, 0.f, 0.f}; }
#pragma unroll
            for (int ks = 0; ks < 4; ++ks) { bf16x8 a[4], bb[2];
#pragma unroll
                for (int mt = 0; mt < 4; ++mt) a[mt] = *(const bf16x8*)(Q + (size_t)(R0 + mt * 16 + l15) * 2048 + h * 256 + p * 128 + ks * 32 + lq * 8);
#pragma unroll
                for (int t2 = 0; t2 < 2; ++t2) bb[t2] = *(const bf16x8*)(SK + (size_t)((h * 2 + p) * 128 + (ntp + t2) * 16 + l15) * 128 + ks * 32 + lq * 8);
#pragma unroll
                for (int mt = 0; mt < 4; ++mt)
#pragma unroll
                    for (int t2 = 0; t2 < 2; ++t2) acc[mt][t2] = MFMA16(a[mt], bb[t2], acc[mt][t2]); }
#pragma unroll
            for (int mt = 0; mt < 4; ++mt)
#pragma unroll
                for (int t2 = 0; t2 < 2; ++t2)
#pragma unroll
                    for (int r = 0; r < 4; ++r) SC[((mt * 16 + lq * 4 + r) * 2 + p) * 129 + (ntp + t2) * 16 + l15] = acc[mt][t2][r]; }
        __syncthreads();
        if (tid < 128) {
            int t[16];
#pragma unroll
            for (int i = 0; i < 16; ++i) t[i] = (int)0x80000000;
#pragma unroll 4
            for (int n = 0; n < 128; ++n) { int x = (sortable(SC[tid * 129 + n]) & ~127) | (127 - n); CAS16(t, x); }
#pragma unroll
            for (int i = 0; i < 16; ++i) { const int n = 127 - (t[i] & 127); I1[tid * 16 + i] = n; S1[tid * 16 + i] = SC[tid * 129 + n]; }
        }
        __syncthreads();
        if (tid < 64) {
            float s1[16], s2[16]; int t[16];
#pragma unroll
            for (int i = 0; i < 16; ++i) { s1[i] = S1[(tid * 2) * 16 + i]; s2[i] = S1[(tid * 2 + 1) * 16 + i]; t[i] = (int)0x80000000; }
#pragma unroll
            for (int i = 0; i < 16; ++i)
#pragma unroll
                for (int j = 0; j < 16; ++j) if ((i + 1) * (j + 1) <= 16) { int x = (sortable(s1[i] + s2[j]) & ~255) | (255 - (i * 16 + j)); CAS16(t, x); }
            float sv[16]; int ev[16]; float mx = -3.0e38f;
#pragma unroll
            for (int k = 0; k < 16; ++k) { const int id = 255 - (t[k] & 255), i = id >> 4, j = id & 15;
                sv[k] = S1[(tid * 2) * 16 + i] + S1[(tid * 2 + 1) * 16 + j]; ev[k] = I1[(tid * 2) * 16 + i] * 128 + I1[(tid * 2 + 1) * 16 + j]; mx = fmaxf(mx, sv[k]); }
            float den = 0.f;
#pragma unroll
            for (int k = 0; k < 16; ++k) { sv[k] = __expf(sv[k] - mx); den += sv[k]; }
            const float inv = 1.0f / den; const size_t o = (size_t)(R0 + tid) * 128 + h * 16;
#pragma unroll
            for (int k = 0; k < 16; ++k) { IDX[o + k] = ev[k]; GATE[o + k] = sv[k] * inv; }
        }
    }
    __syncthreads();
}

__device__ __forceinline__ void p12_peer(const Ctx& c) {
    const int lane = threadIdx.x & 63, wave = __builtin_amdgcn_readfirstlane(threadIdx.x >> 6);
    const bf16_t* A2 = (const bf16_t*)(c.ws + WS_A1); const bf16_t* UT = (const bf16_t*)(c.ws + WS_UT); const bf16_t* VT = (const bf16_t*)(c.ws + WS_VT);
    const int* IDX = (const int*)(c.ws + WS_IDX); const float* GATE = (const float*)(c.ws + WS_GATE); const float* m = (const float*)(c.ws + WS_MOD);
    for (int R = blockIdx.x * 8 + wave; R < MLAT; R += gridDim.x * 8) {
        float a[16], acc[16];
        unpack8(ldg16(A2 + (size_t)R * D + lane * 8), a); unpack8(ldg16(A2 + (size_t)R * D + 512 + lane * 8), a + 8);
#pragma unroll
        for (int e = 0; e < 16; ++e) acc[e] = 0.f;
        const int* ip = IDX + (size_t)R * 128; const float* gp = GATE + (size_t)R * 128;
        for (int s0 = 0; s0 < 128; s0 += 4) {
            u32x4 uw[4][2], vw[4][2]; float gt[4];
#pragma unroll
            for (int k = 0; k < 4; ++k) { const size_t e = (size_t)ip[s0 + k]; gt[k] = gp[s0 + k];
                uw[k][0] = ldg16(UT + e * D + lane * 8); uw[k][1] = ldg16(UT + e * D + 512 + lane * 8);
                vw[k][0] = ldg16(VT + e * D + lane * 8); vw[k][1] = ldg16(VT + e * D + 512 + lane * 8); }
            float dot[4];
#pragma unroll
            for (int k = 0; k < 4; ++k) { float uf[16]; unpack8(uw[k][0], uf); unpack8(uw[k][1], uf + 8); float d = 0.f;
#pragma unroll
                for (int e = 0; e < 16; ++e) d += a[e] * uf[e];
                dot[k] = d; }
#pragma unroll
            for (int o = 32; o > 0; o >>= 1) {
#pragma unroll
                for (int k = 0; k < 4; ++k) dot[k] += __shfl_xor(dot[k], o); }
#pragma unroll
            for (int k = 0; k < 4; ++k) { const float x = dot[k]; const float cf = gt[k] * 0.5f * x * (1.0f + erff(x * 0.70710678118654752f)); float vf[16]; unpack8(vw[k][0], vf); unpack8(vw[k][1], vf + 8);
#pragma unroll
                for (int e = 0; e < 16; ++e) acc[e] += cf * vf[e]; }
        }
        const int b = R / SEQ; const float* g2 = m + b * MODW + 5120; float* hrow = c.out + (size_t)R * D; float h2[16]; float ss = 0.f;
#pragma unroll
        for (int q = 0; q < 4; ++q) { const int ch = (q >> 1) * 512 + lane * 8 + (q & 1) * 4; const f32x4 hv = *(const f32x4*)(hrow + ch), gv = *(const f32x4*)(g2 + ch);
#pragma unroll
            for (int e = 0; e < 4; ++e) { const float v = hv[e] + gv[e] * acc[(q >> 1) * 8 + (q & 1) * 4 + e]; h2[q * 4 + e] = v; ss += v * v; } }
        ss = wave_sum(ss);
        const float rstd = rsqrtf(ss * (1.0f / 1024.0f) + 1e-6f);
#pragma unroll
        for (int q = 0; q < 4; ++q) { const int ch = (q >> 1) * 512 + lane * 8 + (q & 1) * 4; const f32x4 w = *(const f32x4*)(c.final_norm_w + ch); f32x4 o;
#pragma unroll
            for (int e = 0; e < 4; ++e) o[e] = h2[q * 4 + e] * rstd * w[e];
            *(f32x4*)(hrow + ch) = o; }
    }
}

constexpr int N_PHASES = 13;
__global__ void __launch_bounds__(NT, 2) fwd_kernel(Args args) {
    extern __shared__ __attribute__((aligned(16))) unsigned char lds_raw[];
    LAS unsigned char* lds0 = (LAS unsigned char*)lds_raw;
    LAS unsigned char* lds = lds0 + LDS_HDR;
    Ctx c;
    c.x = args.in[0]; c.c = args.in[1]; c.ctx = args.in[2]; c.c_ctx = args.in[3]; c.norm1_w = args.in[4]; c.w_mod = args.in[5]; c.b_mod = args.in[6]; c.w_in = args.in[7];
    c.gla_w_a2 = args.in[8]; c.gla_b_a = args.in[9]; c.gla_norm_w = args.in[10]; c.rwkv_mu = args.in[11]; c.rwkv_w0 = args.in[12]; c.rwkv_w2 = args.in[13]; c.rwkv_a0 = args.in[14];
    c.rwkv_a2 = args.in[15]; c.rwkv_g2 = args.in[16]; c.rwkv_k_k = args.in[17]; c.rwkv_k_a = args.in[18]; c.rwkv_r_k = args.in[19]; c.rwkv_ln_w = args.in[20]; c.rwkv_ln_b = args.in[21];
    c.w_out = args.in[22]; c.norm2_w = args.in[23]; c.peer_w_q = args.in[24]; c.peer_sub_keys = args.in[25]; c.peer_u = args.in[26]; c.peer_v = args.in[27]; c.final_norm_w = args.in[28];
    c.out = args.out; c.ws = args.ws;
    if (threadIdx.x < 16) ((LAS unsigned*)lds0)[threadIdx.x] = 0u;
    __syncthreads();
    const int lo = args.ph_lo, hi = args.ph_hi;
    const bool multi = (hi - lo) > 1;
    XcdBarrier bar; bar.bar = (unsigned*)(c.ws + WS_CTL); bar.x = 0; bar.st = (volatile LAS unsigned*)lds0;
    if (multi) bar = xcd_barrier_post((unsigned*)(c.ws + WS_CTL), (volatile LAS unsigned*)lds0);
#define IN(k) (lo <= (k) && (k) < hi)
#define SEAM(k) do { if (IN(k) && IN((k) + 1)) xcd_barrier(bar); } while (0)
    const bf16_t* Wt_in = (const bf16_t*)(c.ws + WS_WIN);
    if (IN(0)) { p0_prologue(c, lds); } SEAM(0);
    if (IN(1)) { p1_norm1(c); } SEAM(1);
    if (IN(2)) { pg8::Gemm g{(const bf16_t*)(c.ws + WS_A1), Wt_in, MALL, N1, D}; pg8::StaticOrder S; S.init(MALL, N1, gridDim.x, blockIdx.x);
        EpiB<0> E{(bf16_t*)(c.ws + WS_ZG), (bf16_t*)(c.ws + WS_ZR), 0};
        pg8::gemm_phase<EpiB<0>, pg8::StaticOrder, false>((PG8_LAS unsigned char*)lds, g, S, E, nullptr); } SEAM(2);
    if (IN(3)) { p3_gla(c, lds); } SEAM(3);
    if (IN(4)) { p4_rwkv(c, lds); } SEAM(4);
    if (IN(5)) { p5_post(c, lds); } SEAM(5);
    if (IN(6)) { pg8::Gemm g{(const bf16_t*)(c.ws + WS_A1), Wt_in + (size_t)N1 * D, MLAT, N2, D}; pg8::StaticOrder S; S.init(MLAT, N2, gridDim.x, blockIdx.x);
        EpiB<1> E{(bf16_t*)(c.ws + WS_Z3), nullptr, Z3_LD};
        pg8::gemm_phase<EpiB<1>, pg8::StaticOrder, false>((PG8_LAS unsigned char*)lds, g, S, E, nullptr); } SEAM(6);
    if (IN(7)) { p7_combine(c); } SEAM(7);
    if (IN(8)) { pg8::Gemm g{(const bf16_t*)(c.ws + WS_A1), (const bf16_t*)(c.ws + WS_WOUT), MLAT, D, D}; pg8::StaticOrder S; S.init(MLAT, D, gridDim.x, blockIdx.x);
        EpiH1 E{c.x, (const float*)(c.ws + WS_MOD), c.out};
        pg8::gemm_phase<EpiH1, pg8::StaticOrder, false>((PG8_LAS unsigned char*)lds, g, S, E, nullptr); } SEAM(8);
    if (IN(9)) { p9_norm2_tables(c); } SEAM(9);
    if (IN(10)) { pg8::Gemm g{(const bf16_t*)(c.ws + WS_A1), (const bf16_t*)(c.ws + WS_WQ), MLAT, 2048, D}; pg8::StaticOrder S; S.init(MLAT, 2048, gridDim.x, blockIdx.x);
        EpiB<2> E{(bf16_t*)(c.ws + WS_Q), nullptr, 2048};
        pg8::gemm_phase<EpiB<2>, pg8::StaticOrder, false>((PG8_LAS unsigned char*)lds, g, S, E, nullptr); } SEAM(10);
    if (IN(11)) { p11_topk(c, lds); } SEAM(11);
    if (IN(12)) { p12_peer(c); }
#undef IN
#undef SEAM
}

extern "C" void kernel_launch(void* const* d_in, const int* in_sizes, int n_in, void* d_out, int out_size, void* d_ws, size_t ws_size, hipStream_t stream) {
    static int grid = 0;
    if (grid == 0) {
        if (n_in != 29 || out_size != MLAT * D || ws_size < WS_END) { fprintf(stderr, "kernel_launch: unexpected shapes (n_in %d, out %d, ws %zu < %zu)\n", n_in, out_size, ws_size, (size_t)WS_END); grid = -1; return; }
        int dev = 0, cus = 0, per_cu = 0;
        if (hipGetDevice(&dev) != hipSuccess || hipDeviceGetAttribute(&cus, hipDeviceAttributeMultiprocessorCount, dev) != hipSuccess) { grid = -1; return; }
        if (hipFuncSetAttribute((const void*)fwd_kernel, hipFuncAttributeMaxDynamicSharedMemorySize, LDS_BYTES) != hipSuccess) { fprintf(stderr, "kernel_launch: hipFuncSetAttribute failed\n"); grid = -1; return; }
        if (hipOccupancyMaxActiveBlocksPerMultiprocessor(&per_cu, (const void*)fwd_kernel, NT, LDS_BYTES) != hipSuccess || per_cu < 1) fprintf(stderr, "kernel_launch: occupancy query reports %d\n", per_cu);
        (void)hipGetLastError();
        grid = cus;
    }
    if (grid < 0) return;
    (void)hipMemsetAsync((char*)d_ws + WS_CTL, 0, 65536, stream);
    Args a{};
    for (int i = 0; i < 29; ++i) a.in[i] = (const float*)d_in[i];
    a.out = (float*)d_out; a.ws = (unsigned char*)d_ws;
#if MK_N_LAUNCHES == 1
    a.ph_lo = 0; a.ph_hi = N_PHASES;
    hipLaunchKernelGGL(fwd_kernel, dim3(grid), dim3(NT), LDS_BYTES, stream, a);
#else
    for (int p = 0; p < N_PHASES; ++p) { a.ph_lo = p; a.ph_hi = p + 1; hipLaunchKernelGGL(fwd_kernel, dim3(grid), dim3(NT), LDS_BYTES, stream, a); }
#endif
}
```

```cpp
#include <hip/hip_runtime.h>
#include <stdint.h>
#include <stdio.h>

#ifndef MK_N_LAUNCHES
#define MK_N_LAUNCHES 1
#endif

namespace pg8 {
#define PG8_LAS __attribute__((address_space(3)))
typedef unsigned short bf16_t;
typedef short bf16x8 __attribute__((ext_vector_type(8)));
typedef float f32x4 __attribute__((ext_vector_type(4)));
typedef unsigned u32x4 __attribute__((ext_vector_type(4)));
constexpr int BM = 256, BK = 64, HALF = 128, HTB = HALF * BK * 2  , STAGE_BYTES = 8 * HTB, NXCD = 8, WGM = 8;

__host__ __device__ __forceinline__ int lds_byte(int r, int c) { const int st = (r >> 4) * 2 + (c >> 5), rr = r & 15, cc = c & 31, ob = rr * 64 + cc * 2; return st * 1024 + (ob ^ (((ob >> 9) & 1) << 5)); }
__host__ __device__ __forceinline__ void stage_rc(int b, int& R, int& C) { const int st = b / 1024, sb = b % 1024, swz = sb ^ (((sb >> 9) & 1) << 5); R = (st >> 1) * 16 + swz / 64; C = (st & 1) * 32 + (swz % 64) / 2; }
__host__ __device__ __forceinline__ int perm32(int rho) { const int n = rho >> 4, i = rho & 15; return 8 * (i >> 2) + 4 * n + (i & 3); }

struct Unit { int pm, pn; };
struct Gemm { const bf16_t* A; const bf16_t* Bt; int M, N, K; };

struct StaticOrder {
    int nM, nN, nwg, G, c;
    __host__ __device__ void init(int M, int N, int G_, int c_) { nM = M / BM; nN = N / BM; nwg = nM * nN; G = G_; c = c_; }
    __host__ __device__ bool next(int i, Unit& u) const {
        const long L = (long)i * G + c; if (L >= nwg) return false;
        int wgid = (int)L; { const int q = nwg / NXCD, r = nwg % NXCD, xcd = wgid % NXCD, off = wgid / NXCD; wgid = (xcd < r ? xcd * (q + 1) : r * (q + 1) + (xcd - r) * q) + off; }
        const int nig = WGM * nN, gid = wgid / nig, fm = gid * WGM, gsz = (nM - fm) < WGM ? (nM - fm) : WGM;
        u.pm = fm + ((wgid % nig) % gsz); u.pn = (wgid % nig) / gsz; return true;
    }
    __device__ __forceinline__ void a_ready(const Unit&) const {}
    __device__ __forceinline__ void done(const Unit&) const {}
};
__device__ __forceinline__ unsigned cvt_pk_bf16(float lo, float hi) { unsigned r; asm volatile("v_cvt_pk_bf16_f32 %0, %1, %2" : "=v"(r) : "v"(lo), "v"(hi)); return r; }
template <class Epi, class Sched, bool STAMP = false>
__device__ __forceinline__ void gemm_phase(PG8_LAS unsigned char* lds, const Gemm g, const Sched& S, const Epi& E, unsigned long long* stamps) {
    const int tid = threadIdx.x, wid = __builtin_amdgcn_readfirstlane(tid >> 6), lane = tid & 63, wr = wid >> 2, wc = wid & 3, fr = lane & 15, fq = lane >> 4;
    const int K = g.K, nt = K / BK;
    int ts_lo = 0, ts_hi = 0, nts = 0; const unsigned long long rt_entry = STAMP ? (unsigned long long)wall_clock64() : 0ull;
#define PG8_STAMP() do { if (STAMP && wid == 0 && nts < 64) { const unsigned long long _c = (unsigned long long)clock64(); \
        ts_lo = (lane == nts) ? (int)(unsigned)_c : ts_lo; ts_hi = (lane == nts) ? (int)(unsigned)(_c >> 32) : ts_hi; ++nts; } } while (0)
    PG8_STAMP();
    unsigned voffA[2], voffB[2];
#pragma unroll
    for (int i = 0; i < 2; ++i) { int R, C; stage_rc(tid * 16 + i * 8192, R, C); const int Rb = Epi::PERM ? ((R & ~31) + perm32(R & 31)) : R;
        voffA[i] = (unsigned)(R * K + C) * 2u; voffB[i] = (unsigned)(Rb * K + C) * 2u; }
    const size_t kstep = (size_t)(BK * 2);
    const size_t hstep = (size_t)HALF * K * 2;
    const size_t tstep = 2 * hstep;
    const unsigned ldsw = (unsigned)wid * 1024u;
    const int aoff = lds_byte(wr * 64 + fr, fq * 8), boff = lds_byte(wc * 32 + fr, fq * 8);
#define PG8_SA(b, h) (((b) * 2 + (h)) * HTB)
#define PG8_SB(b, h) ((4 + (b) * 2 + (h)) * HTB)
#define PG8_STAGE(bufoff, gbase, voff) do { _Pragma("unroll") for (int _i = 0; _i < 2; ++_i) \
        __builtin_amdgcn_global_load_lds((const unsigned*)((const char*)(gbase) + (voff)[_i]), (PG8_LAS unsigned*)(lds + (bufoff) + ldsw + _i * 8192), 16, 0, 0); } while (0)
#define PG8_LDA(dst, b, h) do { _Pragma("unroll") for (int m = 0; m < 4; ++m) _Pragma("unroll") for (int k = 0; k < 2; ++k) dst[m][k] = *(const PG8_LAS bf16x8*)(lds + PG8_SA(b, h) + aoff + m * 2048 + k * 1024); } while (0)
#define PG8_LDB(dst, b, h) do { _Pragma("unroll") for (int n = 0; n < 2; ++n) _Pragma("unroll") for (int k = 0; k < 2; ++k) dst[n][k] = *(const PG8_LAS bf16x8*)(lds + PG8_SB(b, h) + boff + n * 2048 + k * 1024); } while (0)
#define PG8_MMA(ai, bj, At, Bt) do { __builtin_amdgcn_s_setprio(1); _Pragma("unroll") for (int m = 0; m < 4; ++m) _Pragma("unroll") for (int n = 0; n < 2; ++n) _Pragma("unroll") for (int k = 0; k < 2; ++k) \
        acc[ai][bj][m][n] = __builtin_amdgcn_mfma_f32_16x16x32_bf16(Bt[n][k], At[m][k], acc[ai][bj][m][n], 0, 0, 0); __builtin_amdgcn_s_setprio(0); } while (0)
#define PG8_WAIT_V(n) asm volatile("s_waitcnt vmcnt(" #n ")" ::: "memory")
#define PG8_WAIT_L(n) asm volatile("s_waitcnt lgkmcnt(" #n ")" ::: "memory")
#define PG8_BAR __builtin_amdgcn_s_barrier()
#define PG8_SCHED __builtin_amdgcn_sched_barrier(0)
    Unit cur, nxt; int ui = 0;
    if (!S.next(0, cur)) return;
    f32x4 acc[2][2][4][2];
#pragma unroll
    for (int a = 0; a < 2; ++a)
#pragma unroll
        for (int b = 0; b < 2; ++b)
#pragma unroll
            for (int m = 0; m < 4; ++m)
#pragma unroll
                for (int n = 0; n < 2; ++n) acc[a][b][m][n] = (f32x4){0.f, 0.f, 0.f, 0.f};
    bf16x8 At[4][2], B0[2][2], B1[2][2];
    const char* cA = (const char*)g.A + (size_t)cur.pm * tstep; const char* cB = (const char*)g.Bt + (size_t)cur.pn * tstep;
    S.a_ready(cur);
    PG8_STAGE(PG8_SB(0, 0), cB, voffB); PG8_STAGE(PG8_SA(0, 0), cA, voffA); PG8_STAGE(PG8_SB(0, 1), cB + hstep, voffB); PG8_STAGE(PG8_SA(0, 1), cA + hstep, voffA);
    if (wr == 1) PG8_BAR;
    PG8_WAIT_V(4); PG8_BAR;
    PG8_STAGE(PG8_SB(1, 0), cB + kstep, voffB); PG8_STAGE(PG8_SA(1, 0), cA + kstep, voffA); PG8_STAGE(PG8_SB(1, 1), cB + hstep + kstep, voffB);
    PG8_WAIT_V(6); PG8_BAR;
    PG8_STAMP();
    for (;;) {
        const bool has_next = S.next(ui + 1, nxt);
        const char* nA = has_next ? (const char*)g.A + (size_t)nxt.pm * tstep : cA; const char* nB = has_next ? (const char*)g.Bt + (size_t)nxt.pn * tstep : cB;
        for (int t = 0; t < nt; t += 2) {
            const bool last = (t == nt - 2);
            const char* a1 = cA + (size_t)(t + 1) * kstep;
            const char* a2 = last ? nA : cA + (size_t)(t + 2) * kstep; const char* b2 = last ? nB : cB + (size_t)(t + 2) * kstep;
            const char* a3 = a2 + kstep; const char* b3 = b2 + kstep;
            if (last && has_next) S.a_ready(nxt);
            PG8_LDB(B0, 0, 0); PG8_SCHED; PG8_LDA(At, 0, 0); PG8_STAGE(PG8_SA(1, 1), a1 + hstep, voffA);
            PG8_WAIT_L(8); PG8_BAR; PG8_WAIT_L(0); PG8_MMA(0, 0, At, B0); PG8_BAR; PG8_SCHED;
            PG8_LDB(B1, 0, 1); PG8_STAGE(PG8_SB(0, 0), b2, voffB);
            PG8_BAR; PG8_WAIT_L(0); PG8_MMA(0, 1, At, B1); PG8_BAR;
            PG8_LDA(At, 0, 1); PG8_STAGE(PG8_SA(0, 0), a2, voffA);
            PG8_BAR; PG8_WAIT_L(0); PG8_MMA(1, 0, At, B0); PG8_BAR; PG8_SCHED;
            PG8_STAGE(PG8_SB(0, 1), b2 + hstep, voffB);
            PG8_WAIT_V(6); PG8_BAR; PG8_MMA(1, 1, At, B1); PG8_BAR;
            PG8_LDB(B0, 1, 0); PG8_SCHED; PG8_LDA(At, 1, 0); PG8_STAGE(PG8_SA(0, 1), a2 + hstep, voffA);
            PG8_WAIT_L(8); PG8_BAR; PG8_WAIT_L(0); PG8_MMA(0, 0, At, B0); PG8_BAR; PG8_SCHED;
            PG8_LDB(B1, 1, 1); PG8_STAGE(PG8_SB(1, 0), b3, voffB);
            PG8_BAR; PG8_WAIT_L(0); PG8_MMA(0, 1, At, B1); PG8_BAR;
            PG8_LDA(At, 1, 1); PG8_STAGE(PG8_SA(1, 0), a3, voffA);
            PG8_BAR; PG8_WAIT_L(0); PG8_MMA(1, 0, At, B0); PG8_BAR; PG8_SCHED;
            PG8_STAGE(PG8_SB(1, 1), b3 + hstep, voffB);
            PG8_WAIT_V(6); PG8_BAR; PG8_MMA(1, 1, At, B1); PG8_BAR;
        }
        PG8_STAMP();
        if constexpr (!Epi::AFTER_DRAIN) { E(acc, cur, wr, wc, fr, fq); S.done(cur); }
        PG8_STAMP();
        if (!has_next) break;
#pragma unroll
        for (int a = 0; a < 2; ++a)
#pragma unroll
            for (int b = 0; b < 2; ++b)
#pragma unroll
                for (int m = 0; m < 4; ++m)
#pragma unroll
                    for (int n = 0; n < 2; ++n) acc[a][b][m][n] = (f32x4){0.f, 0.f, 0.f, 0.f};
        cur = nxt; cA = nA; cB = nB; ++ui;
    }
    PG8_WAIT_V(0);
    if (wr == 0) PG8_BAR;
    PG8_BAR;
    if constexpr (Epi::AFTER_DRAIN) { E.fused(acc, cur, wr, wc, fr, fq, lds, wid, lane); S.done(cur); }
    PG8_STAMP();
    if (STAMP && wid == 0) { stamps[lane] = lane < nts ? (((unsigned long long)(unsigned)ts_hi << 32) | (unsigned)ts_lo) : 0ull;
        if (lane == 62) stamps[62] = rt_entry; if (lane == 63) stamps[63] = (unsigned long long)wall_clock64(); }
#undef PG8_STAMP
#undef PG8_SA
#undef PG8_SB
#undef PG8_STAGE
#undef PG8_LDA
#undef PG8_LDB
#undef PG8_MMA
#undef PG8_WAIT_V
#undef PG8_WAIT_L
#undef PG8_BAR
#undef PG8_SCHED
}
}

#define XB_TMO      128
#define XB_XCNT(j)  (256  + 64 * (j))
#define XB_XSUB(j)  (1280 + 64 * (j))
#define XB_XGEN(j)  (2304 + 64 * (j))
#define XB_TOP      3328
#define XB_TOPGEN   3392
#define XCD_BAR_WORDS 3456
#define XB_SPIN_CAP (1u << 18)
#define LAS __attribute__((address_space(3)))

__device__ __forceinline__ unsigned xb_ld(unsigned* p)              { return __hip_atomic_load(p, __ATOMIC_RELAXED, __HIP_MEMORY_SCOPE_AGENT); }
__device__ __forceinline__ unsigned xb_add(unsigned* p, unsigned v) { return __hip_atomic_fetch_add(p, v, __ATOMIC_RELAXED, __HIP_MEMORY_SCOPE_AGENT); }
__device__ __forceinline__ unsigned xb_xcc_id() { return (unsigned)__builtin_amdgcn_s_getreg((3 << 11) | 20) & 0xFu; }
#define XB_SPIN(cond, bar) do { unsigned _sp = 0; while (cond) { __builtin_amdgcn_s_sleep(1); \
    if ((++_sp & 255u) == 0u) { if (xb_ld(&(bar)[XB_TMO])) break; if (_sp > XB_SPIN_CAP) { atomicAdd(&(bar)[XB_TMO], 1u); break; } } } } while (0)

struct XcdBarrier {
    unsigned* bar; unsigned x;
    volatile LAS unsigned* st;
};

__device__ __forceinline__ XcdBarrier xcd_barrier_post(unsigned* bar, volatile LAS unsigned* st) {
    XcdBarrier b; b.bar = bar; b.x = xb_xcc_id(); b.st = st;
    if (threadIdx.x == 0) (void)xb_add(&bar[XB_XCNT(b.x)], 1u);
    return b;
}
__device__ __forceinline__ void xcd_barrier_complete(unsigned* bar, unsigned x, unsigned& nloc, unsigned& nx) {
    const unsigned G = gridDim.x * gridDim.y * gridDim.z;
    unsigned sum, cnt, mine, sp = 0u;
    for (;;) {
        sum = 0u; cnt = 0u; mine = 0u;
#pragma unroll
        for (unsigned j = 0; j < 16; ++j) { const unsigned c = xb_ld(&bar[XB_XCNT(j)]); sum += c; cnt += (c > 0u) ? 1u : 0u; mine = (j == x) ? c : mine; }
        if (sum == G) break;
        __builtin_amdgcn_s_sleep(1);
        if ((++sp & 255u) == 0u) { if (xb_ld(&bar[XB_TMO])) break; if (sp > XB_SPIN_CAP) { atomicAdd(&bar[XB_TMO], 1u); break; } }
    }
    nloc = mine > 0u ? mine : 1u; nx = cnt > 0u ? cnt : 1u;
}

__device__ __forceinline__ void xcd_barrier(const XcdBarrier& b) {
    asm volatile("s_waitcnt vmcnt(0)" ::: "memory");
    __syncthreads();
    if (threadIdx.x == 0) {
        unsigned* bar = b.bar;
        __builtin_amdgcn_s_waitcnt(0);
        unsigned nloc = b.st[0], nx = b.st[1];
        if (nloc == 0u) { xcd_barrier_complete(bar, b.x, nloc, nx); b.st[0] = nloc; b.st[1] = nx; }
        const unsigned old = xb_add(&bar[XB_XSUB(b.x)], 1u);
        const unsigned gen = old / nloc;
        if (old + 1u == (gen + 1u) * nloc) {
            __builtin_amdgcn_fence(__ATOMIC_RELEASE, "agent");
            asm volatile("s_waitcnt vmcnt(0)" ::: "memory");
            const unsigned og = xb_add(&bar[XB_TOP], 1u);
            const unsigned tg = og / nx;
            if (og + 1u == (tg + 1u) * nx) xb_add(&bar[XB_TOPGEN], 1u);
            else XB_SPIN(xb_ld(&bar[XB_TOPGEN]) == tg, bar);
            __builtin_amdgcn_fence(__ATOMIC_ACQUIRE, "agent");
            xb_add(&bar[XB_XGEN(b.x)], 1u);
            asm volatile("s_waitcnt vmcnt(0)" ::: "memory");
        } else {
            XB_SPIN(xb_ld(&bar[XB_XGEN(b.x)]) == gen, bar);
            __builtin_amdgcn_fence(__ATOMIC_ACQUIRE, "agent");
            asm volatile("s_waitcnt vmcnt(0)" ::: "memory");
        }
    }
    __syncthreads();
}

typedef unsigned short bf16_t;
typedef short bf16x8 __attribute__((ext_vector_type(8)));
typedef float f32x4 __attribute__((ext_vector_type(4)));
typedef unsigned u32x4 __attribute__((ext_vector_type(4)));
typedef unsigned u32x2 __attribute__((ext_vector_type(2)));

constexpr int IDSTR = 132;
#ifndef GATHER_SWEEP
#define GATHER_SWEEP 1
#endif
#ifndef DUP_MASK
#define DUP_MASK 0
#endif
#define DUP(k) ((DUP_MASK >> (k)) & 1)
constexpr int NT = 512;
constexpr int D = 1024, NB = 8, SEQ = 2048, CTXL = 256;
constexpr int MLAT = NB * SEQ, MCTX = NB * CTXL, MALL = MLAT + MCTX;
constexpr int ZG_LD = 2048, ZR_LD = 3584, Z3_LD = 3072;
constexpr int N1 = 5632, N2 = 3072, NIN = N1 + N2;
constexpr int ZR_OFF = 32;
constexpr int MODW = 6144;
constexpr int LDS_BYTES = 163840, LDS_HDR = 64;

constexpr size_t WS_CTL   = 0;
constexpr size_t WS_MOD   = 65536;
constexpr size_t WS_BONUS = WS_MOD + 262144;
constexpr size_t WS_WIN   = WS_BONUS + 1048576;
constexpr size_t WS_WOUT  = WS_WIN + (size_t)NIN * 1024 * 2;
constexpr size_t WS_WQ    = WS_WOUT + (size_t)1024 * 1024 * 2;
constexpr size_t WS_G2T   = WS_WQ + (size_t)2048 * 1024 * 2;
constexpr size_t WS_SK    = WS_G2T + (size_t)1024 * 192 * 2;
constexpr size_t WS_A1    = WS_SK + (size_t)16 * 128 * 128 * 2;
constexpr size_t WS_ZG    = WS_A1 + (size_t)MALL * 1024 * 2;
constexpr size_t WS_ZR    = WS_ZG + (size_t)MALL * ZG_LD * 2;
constexpr size_t WS_ZL    = WS_ZR + (size_t)MALL * ZR_LD * 2;
constexpr int ZL_LD = 352;
constexpr size_t WS_END   = WS_ZL + (size_t)MALL * ZL_LD * 2;
constexpr size_t WS_ORF   = WS_ZG;
constexpr size_t WS_ORB   = WS_ZG + (size_t)MLAT * 1024 * 2;
constexpr size_t WS_Q     = WS_ZG;
constexpr size_t WS_Z3    = WS_ZR;
constexpr size_t WS_UT    = WS_ZR;
constexpr size_t WS_VT    = WS_UT + (size_t)16384 * 1024;
constexpr size_t WS_IDX   = WS_VT + (size_t)16384 * 1024;
constexpr size_t WS_GATE  = WS_IDX + (size_t)MLAT * 128 * 4;
static_assert(WS_GATE + (size_t)MLAT * 128 * 4 <= WS_ZL, "ws map");
static_assert(WS_ORB + (size_t)MLAT * 1024 * 2 <= WS_ZR, "ws map");

typedef const float* const __attribute__((address_space(4))) * KArgPtr;
struct Ctx { KArgPtr in; float* out; unsigned char* ws; };
#define CIN(k) (c.in[k])
struct Args { const float* in[29]; float* out; unsigned char* ws; int ph_lo, ph_hi; };

typedef __bf16 hwbf16x2 __attribute__((ext_vector_type(2)));
typedef float f32x2v __attribute__((ext_vector_type(2)));
__device__ __forceinline__ unsigned pk2(float lo, float hi) { const f32x2v f = {lo, hi}; const hwbf16x2 v = __builtin_convertvector(f, hwbf16x2); return __builtin_bit_cast(unsigned, v); }
__device__ __forceinline__ bf16_t f2bf(float f) { return (bf16_t)(pk2(f, 0.f) & 0xffffu); }
__device__ __forceinline__ float bflo(unsigned w) { return __uint_as_float(w << 16); }
__device__ __forceinline__ float bfhi(unsigned w) { return __uint_as_float(w & 0xffff0000u); }
__device__ __forceinline__ float bf2f(bf16_t b) { return __uint_as_float(((unsigned)b) << 16); }
__device__ __forceinline__ void unpack8(const u32x4 w, float* o) { o[0] = bflo(w.x); o[1] = bfhi(w.x); o[2] = bflo(w.y); o[3] = bfhi(w.y); o[4] = bflo(w.z); o[5] = bfhi(w.z); o[6] = bflo(w.w); o[7] = bfhi(w.w); }
__device__ __forceinline__ u32x4 pack8(const float* v) { u32x4 w; w.x = pk2(v[0], v[1]); w.y = pk2(v[2], v[3]); w.z = pk2(v[4], v[5]); w.w = pk2(v[6], v[7]); return w; }
__device__ __forceinline__ u32x4 ldg16(const bf16_t* p) { return *(const u32x4*)p; }
__device__ __forceinline__ float fexp(float x) { return __builtin_amdgcn_exp2f(x * 1.4426950408889634f); }
__device__ __forceinline__ float flog(float x) { return __builtin_amdgcn_logf(x) * 0.6931471805599453f; }
__device__ __forceinline__ float sigmoidf_(float x) { return __builtin_amdgcn_rcpf(1.0f + fexp(-x)); }
__device__ __forceinline__ float wave_sum(float v) {
#pragma unroll
    for (int o = 32; o > 0; o >>= 1) v += __shfl_xor(v, o);
    return v;
}
#define LDS_FENCE() asm volatile("s_waitcnt lgkmcnt(0)" ::: "memory")

__device__ __forceinline__ int win_src(int n) {
    if (n < 2048) return n;
    if (n < N1) { const int j = n - 2048; if (j < 16) return 3072 + j; if (j < 32) return 3088 + (j - 16); if (j < 32 + 3424) { int cr = j - 32; if (cr < 3072) { const int p = cr & 15; cr = (cr & ~15) + (p & 3) * 4 + (p >> 2); } return 3104 + cr; } return -1; }
    const int j = n - N1; return j < 1024 ? 2048 + j : 6528 + (j - 1024);
}
template <int MODE> __device__ __forceinline__ void transpose_tile(const float* __restrict__ src, int ld, bf16_t* __restrict__ dst, int n0, int k0, LAS float* tile) {
    const int tid = threadIdx.x;
#pragma unroll
    for (int e = 0; e < 8; ++e) { const int idx = tid + e * NT, kk = idx >> 6, nn = idx & 63; const int n = n0 + nn; const int s = MODE == 0 ? win_src(n) : n;
        tile[kk * 65 + nn] = s >= 0 ? src[(size_t)(k0 + kk) * ld + s] : 0.f; }
    __syncthreads();
#pragma unroll
    for (int e = 0; e < 4; ++e) { const int idx = tid + e * NT, nn = idx >> 5, kp = idx & 31;
        *(unsigned*)(dst + (size_t)(n0 + nn) * 1024 + k0 + kp * 2) = pk2(tile[(kp * 2) * 65 + nn], tile[(kp * 2 + 1) * 65 + nn]); }
    __syncthreads();
}
__device__ __forceinline__ void p0_prologue(const Ctx& c, LAS unsigned char* lds) {
    const int tid = threadIdx.x, G = gridDim.x, bx = blockIdx.x;
    LAS float* tile = (LAS float*)lds;
    bf16_t* Wt_in = (bf16_t*)(c.ws + WS_WIN); bf16_t* Wt_out = (bf16_t*)(c.ws + WS_WOUT); bf16_t* Wt_q = (bf16_t*)(c.ws + WS_WQ);
    constexpr int T_IN = (NIN / 64) * 16, T_OUT = 16 * 16, T_Q = 32 * 16;
    for (int rep_ = 0; rep_ < (DUP(22) ? 2 : 1); ++rep_)
    for (int t = bx; t < T_IN + T_OUT + T_Q; t += G) {
        if (t < T_IN) transpose_tile<0>(CIN(7), 8576, Wt_in, (t >> 4) * 64, (t & 15) * 64, tile);
        else if (t < T_IN + T_OUT) { const int u = t - T_IN; transpose_tile<1>(CIN(22), 1024, Wt_out, (u >> 4) * 64, (u & 15) * 64, tile); }
        else { const int u = t - T_IN - T_OUT; transpose_tile<1>(CIN(24), 2048, Wt_q, (u >> 4) * 64, (u & 15) * 64, tile); }
    }
    bf16_t* g2t = (bf16_t*)(c.ws + WS_G2T); bf16_t* sk = (bf16_t*)(c.ws + WS_SK);
    for (int i = bx * NT + tid; i < 1024 * 192; i += G * NT) { const int n = i / 192, j = i - n * 192; g2t[i] = f2bf(j < 160 ? CIN(16)[j * 1024 + n] : 0.f); }
    for (int i = bx * NT + tid; i < 16 * 128 * 128; i += G * NT) sk[i] = f2bf(CIN(25)[i]);
    LAS float* sc = (LAS float*)lds;
    LAS float* part = sc + 9 * 1024;
    float* m = (float*)(c.ws + WS_MOD);
    for (int rep_ = 0; rep_ < (DUP(23) ? 2 : 1); ++rep_)
    for (int cg = bx; cg < MODW / 24; cg += G) {
        __syncthreads();
        for (int i = tid; i < 9 * 1024; i += NT) { const float v = i < 8192 ? CIN(1)[i] : CIN(3)[i - 8192]; sc[i] = v * sigmoidf_(v); }
        __syncthreads();
        const int c0 = cg * 24;
        if (tid < 504) { const int col = tid % 24, kp = tid / 24; float acc[9];
#pragma unroll
            for (int r = 0; r < 9; ++r) acc[r] = 0.f;
            for (int k = kp; k < 1024; k += 21) { const float w = CIN(5)[(size_t)k * MODW + c0 + col];
#pragma unroll
                for (int r = 0; r < 9; ++r) acc[r] += sc[r * 1024 + k] * w; }
#pragma unroll
            for (int r = 0; r < 9; ++r) part[(kp * 9 + r) * 24 + col] = acc[r]; }
        __syncthreads();
        if (tid < 216) { const int r = tid / 24, col = tid % 24; float s = CIN(6)[c0 + col];
            for (int kp = 0; kp < 21; ++kp) s += part[(kp * 9 + r) * 24 + col];
            m[r * MODW + c0 + col] = s; }
    }
    __syncthreads();
}

__device__ __forceinline__ void norm_mod_row(const float* __restrict__ src, const float* __restrict__ nw, const float* __restrict__ shift, const float* __restrict__ scale, bf16_t* __restrict__ dst, int lane) {
    f32x4 v[4]; float ss = 0.f;
#pragma unroll
    for (int j = 0; j < 4; ++j) { v[j] = *(const f32x4*)(src + (j * 64 + lane) * 4); ss += v[j][0] * v[j][0] + v[j][1] * v[j][1] + v[j][2] * v[j][2] + v[j][3] * v[j][3]; }
    ss = wave_sum(ss);
    const float rstd = rsqrtf(ss * (1.0f / 1024.0f) + 1e-6f);
#pragma unroll
    for (int j = 0; j < 4; ++j) { const int c0 = (j * 64 + lane) * 4; const f32x4 w = *(const f32x4*)(nw + c0), sh = *(const f32x4*)(shift + c0), sc = *(const f32x4*)(scale + c0);
        float y[4];
#pragma unroll
        for (int e = 0; e < 4; ++e) y[e] = v[j][e] * rstd * w[e] * (1.0f + sc[e]) + sh[e];
        u32x2 o; o.x = pk2(y[0], y[1]); o.y = pk2(y[2], y[3]); *(u32x2*)(dst + c0) = o; }
}
__device__ __forceinline__ void norm_mod_row2(const float* __restrict__ s0, const float* __restrict__ s1, const float* __restrict__ nw, const float* __restrict__ sh0, const float* __restrict__ sc0,
                                              const float* __restrict__ sh1, const float* __restrict__ sc1, bf16_t* __restrict__ d0, bf16_t* __restrict__ d1, int lane) {
    f32x4 v0[4], v1[4]; float a0 = 0.f, a1 = 0.f;
#pragma unroll
    for (int j = 0; j < 4; ++j) { v0[j] = *(const f32x4*)(s0 + (j * 64 + lane) * 4); v1[j] = *(const f32x4*)(s1 + (j * 64 + lane) * 4); }
#pragma unroll
    for (int j = 0; j < 4; ++j) { a0 += v0[j][0] * v0[j][0] + v0[j][1] * v0[j][1] + v0[j][2] * v0[j][2] + v0[j][3] * v0[j][3]; a1 += v1[j][0] * v1[j][0] + v1[j][1] * v1[j][1] + v1[j][2] * v1[j][2] + v1[j][3] * v1[j][3]; }
#pragma unroll
    for (int o = 32; o > 0; o >>= 1) { a0 += __shfl_xor(a0, o); a1 += __shfl_xor(a1, o); }
    const float r0 = rsqrtf(a0 * (1.0f / 1024.0f) + 1e-6f), r1 = rsqrtf(a1 * (1.0f / 1024.0f) + 1e-6f);
#pragma unroll
    for (int j = 0; j < 4; ++j) { const int c0 = (j * 64 + lane) * 4; const f32x4 w = *(const f32x4*)(nw + c0), h0 = *(const f32x4*)(sh0 + c0), g0 = *(const f32x4*)(sc0 + c0), h1 = *(const f32x4*)(sh1 + c0), g1 = *(const f32x4*)(sc1 + c0);
        float y0[4], y1[4];
#pragma unroll
        for (int e = 0; e < 4; ++e) { y0[e] = v0[j][e] * r0 * w[e] * (1.0f + g0[e]) + h0[e]; y1[e] = v1[j][e] * r1 * w[e] * (1.0f + g1[e]) + h1[e]; }
        u32x2 o; o.x = pk2(y0[0], y0[1]); o.y = pk2(y0[2], y0[3]); *(u32x2*)(d0 + c0) = o; o.x = pk2(y1[0], y1[1]); o.y = pk2(y1[2], y1[3]); *(u32x2*)(d1 + c0) = o; }
}
__device__ __forceinline__ void p1_norm1(const Ctx& c) {
    const int lane = threadIdx.x & 63, wave = threadIdx.x >> 6; const float* m = (const float*)(c.ws + WS_MOD); bf16_t* A1 = (bf16_t*)(c.ws + WS_A1);
    const int stride = gridDim.x * 8;
    for (int row = blockIdx.x * 8 + wave; row < MALL; row += 2 * stride) {
        const int rb = row + stride;
        const float* s0 = row < MLAT ? CIN(0) + (size_t)row * D : CIN(2) + (size_t)(row - MLAT) * D; const int m0 = row < MLAT ? row / SEQ : 8;
        if (rb < MALL) { const float* s1 = rb < MLAT ? CIN(0) + (size_t)rb * D : CIN(2) + (size_t)(rb - MLAT) * D; const int m1 = rb < MLAT ? rb / SEQ : 8;
            norm_mod_row2(s0, s1, CIN(4), m + m0 * MODW, m + m0 * MODW + 1024, m + m1 * MODW, m + m1 * MODW + 1024, A1 + (size_t)row * D, A1 + (size_t)rb * D, lane); }
        else norm_mod_row(s0, CIN(4), m + m0 * MODW, m + m0 * MODW + 1024, A1 + (size_t)row * D, lane);
    }
}
template <int MODE  > struct EpiB {
    static constexpr bool PERM = true, AFTER_DRAIN = false;
    bf16_t* O0; bf16_t* O1; int ldc;
    __device__ __forceinline__ void operator()(const pg8::f32x4 (&acc)[2][2][4][2], const pg8::Unit& u, int wr, int wc, int fr, int fq) const {
        const int row0 = u.pm * 256 + wr * 64 + fr; int colt = u.pn * 256; bf16_t* base = O0; int ld = ldc;
        if (MODE == 0) { if (u.pn >= 8) { base = O1; ld = ZR_LD; colt -= 2048; } else { ld = ZG_LD; } }
        const int col0 = colt + wc * 32 + 8 * fq;
        const bool is_silu = (MODE == 1) && (u.pn < 4);
#pragma unroll
        for (int ai = 0; ai < 2; ++ai)
#pragma unroll
            for (int m = 0; m < 4; ++m) { bf16_t* rowp = base + (size_t)(row0 + ai * 128 + m * 16) * ld + col0;
#pragma unroll
                for (int bj = 0; bj < 2; ++bj) { float v[8];
#pragma unroll
                    for (int j = 0; j < 4; ++j) { v[j] = acc[ai][bj][m][0][j]; v[4 + j] = acc[ai][bj][m][1][j]; }
                    if (MODE == 1) {
#pragma unroll
                        for (int j = 0; j < 8; ++j) { const float s = sigmoidf_(v[j]); v[j] = is_silu ? v[j] * s : s; } }
                    *(u32x4*)(rowp + bj * 128) = pack8(v); } }
    }
};
template <int STEP> struct EpiMix {
    static constexpr bool PERM = true, AFTER_DRAIN = false;
    bf16_t* T; bf16_t* YR;
    __device__ __forceinline__ void operator()(const pg8::f32x4 (&acc)[2][2][4][2], const pg8::Unit& u, int wr, int wc, int fr, int fq) const {
        const int row0 = u.pm * 256 + wr * 64 + fr, col0 = u.pn * 256 + wc * 32 + 8 * fq;
#pragma unroll
        for (int ai = 0; ai < 2; ++ai)
#pragma unroll
            for (int m = 0; m < 4; ++m) { const size_t ro = (size_t)(row0 + ai * 128 + m * 16) * D + col0;
#pragma unroll
                for (int bj = 0; bj < 2; ++bj) { float v[8], t[8];
#pragma unroll
                    for (int j = 0; j < 4; ++j) { v[j] = acc[ai][bj][m][0][j]; v[4 + j] = acc[ai][bj][m][1][j]; }
                    unpack8(ldg16(T + ro + bj * 128), t);
                    if (STEP == 0) {
#pragma unroll
                        for (int j = 0; j < 8; ++j) t[j] *= v[j] * sigmoidf_(v[j]);
                        *(u32x4*)(T + ro + bj * 128) = pack8(t);
                    } else if (STEP == 1) {
#pragma unroll
                        for (int j = 0; j < 8; ++j) t[j] *= sigmoidf_(v[j]);
                        *(u32x4*)(T + ro + bj * 128) = pack8(t);
                    } else { float r[8]; unpack8(ldg16(YR + ro + bj * 128), r);
#pragma unroll
                        for (int j = 0; j < 8; ++j) t[j] += sigmoidf_(v[j]) * r[j];
                        *(u32x4*)(YR + ro + bj * 128) = pack8(t); } } }
    }
};
struct EpiH1 {
    static constexpr bool PERM = false, AFTER_DRAIN = false;
    const float* x; const float* m; float* h1;
    __device__ __forceinline__ void operator()(const pg8::f32x4 (&acc)[2][2][4][2], const pg8::Unit& u, int wr, int wc, int fr, int fq) const {
        const int row0 = u.pm * 256 + wr * 64 + fr, col0 = u.pn * 256 + wc * 32 + 4 * fq;
        const float* g = m + (size_t)((u.pm * 256) / SEQ) * MODW + 2048;
        f32x4 gv[2][2];
#pragma unroll
        for (int bj = 0; bj < 2; ++bj)
#pragma unroll
            for (int n = 0; n < 2; ++n) gv[bj][n] = *(const f32x4*)(g + col0 + bj * 128 + n * 16);
#pragma unroll
        for (int ai = 0; ai < 2; ++ai)
#pragma unroll
            for (int mm = 0; mm < 4; ++mm) { const size_t ro = (size_t)(row0 + ai * 128 + mm * 16) * D + col0;
#pragma unroll
                for (int bj = 0; bj < 2; ++bj)
#pragma unroll
                    for (int n = 0; n < 2; ++n) { const f32x4 xv = *(const f32x4*)(x + ro + bj * 128 + n * 16); *(f32x4*)(h1 + ro + bj * 128 + n * 16) = xv + gv[bj][n] * acc[ai][bj][mm][n]; } }
    }
};

struct Gemm1Order : pg8::StaticOrder {
    __device__ bool next(int i, pg8::Unit& u) const {
        const long L = (long)i * G + c;
        if (L < 1408) return pg8::StaticOrder::next(i, u);
        const int k = (int)(L - 1408); if (k >= 128) return false;
        const int t = k >> 3; u.pm = 64 + (k & 7); u.pn = t < 6 ? 2 + t : (t == 6 ? 8 : 5 + t);
        return true;
    }
};

#define MFMA16(a, b, c) __builtin_amdgcn_mfma_f32_16x16x32_bf16(a, b, c, 0, 0, 0)
__device__ __forceinline__ float logsigmoidf_(float x) { return fminf(x, 0.f) - flog(1.0f + fexp(-fabsf(x))); }
#define DPP_F(x, ctrl) __builtin_bit_cast(float, __builtin_amdgcn_update_dpp(0, __builtin_bit_cast(int, (x)), (ctrl), 0xf, 0xf, true))
constexpr int GLA_OP_BYTES = 17408 + 17408 + 18432 + 9216 + 512;
__device__ __forceinline__ void p3_gla(const Ctx& c, LAS unsigned char* lds) {
    const int tid = threadIdx.x, lane = tid & 63, wave = tid >> 6, l15 = lane & 15, lq = lane >> 4;
    LAS bf16_t* St = (LAS bf16_t*)(lds + 2 * GLA_OP_BYTES);
    LAS bf16_t* WAT = St + 64 * 136;
    LAS float* BA = (LAS float*)(WAT + 128 * 40);
    LAS bf16_t* OBF = (LAS bf16_t*)(BA + 128);
    const bf16_t* Zg = (const bf16_t*)(c.ws + WS_ZG); const bf16_t* Zr = (const bf16_t*)(c.ws + WS_ZR);
    bf16_t* og_f = (bf16_t*)c.out; bf16_t* og_b = og_f + (size_t)MLAT * D;
    const int ti = tid >> 3, seg = tid & 7;
    for (int u = blockIdx.x; u < 256; u += gridDim.x) {
        const int dir = u & 1, dvs = (u >> 1) & 3, h = (u >> 3) & 3, b = u >> 5;
        bf16_t* og = dir ? og_b : og_f;
        __syncthreads();
        for (int i = tid; i < 128 * 40; i += NT) { const int d = i / 40, j = i - d * 40; WAT[i] = f2bf(j < 16 ? CIN(8)[(size_t)(dir * 16 + j) * 512 + h * 128 + d] : 0.f); }
        if (tid < 128) BA[tid] = CIN(9)[dir * 512 + h * 128 + tid];
        for (int i = tid; i < 64 * 136 / 2; i += NT) ((LAS unsigned*)St)[i] = 0u;
        f32x4 accS[4];
#pragma unroll
        for (int n = 0; n < 4; ++n) accS[n] = (f32x4){0.f, 0.f, 0.f, 0.f};
        __syncthreads();
        const int d0 = wave * 16 + lq * 4;
        const bf16x8 wfr = *(LAS bf16x8*)(WAT + (wave * 16 + l15) * 40 + lq * 8);
        float bad[4];
#pragma unroll
        for (int r = 0; r < 4; ++r) bad[r] = BA[d0 + r];
#pragma unroll 1
        for (int step = 0; step <= 36; ++step) {
            const bool latn = step >= 4;
            const int cidxn = latn ? (dir ? 31 - (step - 4) : step - 4) : (dir ? 3 - step : step);
            const int rbasen = (latn ? b * SEQ : MLAT + b * CTXL) + cidxn * 64;
            u32x4 vw = (u32x4){0u, 0u, 0u, 0u}, alw[4]; u32x2 qw[4], kw[4];
            if (step < 36) {
                vw = ldg16(Zg + (size_t)(rbasen + (dir ? 63 - ti : ti)) * ZG_LD + 1024 + h * 256 + dvs * 64 + seg * 8);
#pragma unroll
                for (int mt = 0; mt < 4; ++mt) { const int t = mt * 16 + l15; const size_t R = (size_t)(rbasen + (dir ? 63 - t : t));
                    alw[mt] = (u32x4){0u, 0u, 0u, 0u}; if (lq < 2) alw[mt] = ldg16(Zr + R * ZR_LD + dir * 16 + lq * 8);
                    qw[mt] = (u32x2){0u, 0u}; if (latn) qw[mt] = *(const u32x2*)(Zg + R * ZG_LD + h * 128 + d0);
                    kw[mt] = *(const u32x2*)(Zg + R * ZG_LD + 512 + h * 128 + d0); }
            }
            const int sp = step - 1; const bool lat = sp >= 4;
            const int cidx = lat ? (dir ? 31 - (sp - 4) : sp - 4) : (dir ? 3 - sp : sp);
            const int rbase = (lat ? b * SEQ : MLAT + b * CTXL) + cidx * 64;
            if (step >= 1) {
                LAS unsigned char* op = lds + (sp & 1) * GLA_OP_BYTES;
                LAS bf16_t* Qd = (LAS bf16_t*)op; LAS bf16_t* Kd = Qd + 64 * 136; LAS bf16_t* Kt = Kd + 64 * 136; LAS bf16_t* Vt = Kt + 128 * 72; LAS float* EBL = (LAS float*)(Vt + 64 * 72);
                const int mi = wave >> 1;
                if (lat) {
                    bf16x8 qf[4];
#pragma unroll
                    for (int ks = 0; ks < 4; ++ks) qf[ks] = *(LAS bf16x8*)(Qd + (mi * 16 + l15) * 136 + ks * 32 + lq * 8);
                    unsigned xa[4][2];
#pragma unroll
                    for (int jt = 0; jt < 4; ++jt) { f32x4 x = (f32x4){0.f, 0.f, 0.f, 0.f};
                        if (jt <= mi) {
#pragma unroll
                            for (int ks = 0; ks < 4; ++ks) x = MFMA16(*(LAS bf16x8*)(Kd + (jt * 16 + l15) * 136 + ks * 32 + lq * 8), qf[ks], x);
                            if (jt == mi) {
#pragma unroll
                                for (int r = 0; r < 4; ++r) x[r] = (lq * 4 + r <= l15) ? x[r] : 0.f; } }
                        xa[jt][0] = pk2(x[0], x[1]); xa[jt][1] = pk2(x[2], x[3]); }
#pragma unroll
                    for (int t2 = 0; t2 < 2; ++t2) { const int nt = (wave & 1) * 2 + t2; f32x4 a = (f32x4){0.f, 0.f, 0.f, 0.f};
#pragma unroll
                        for (int ks = 0; ks < 4; ++ks) a = MFMA16(qf[ks], *(LAS bf16x8*)(St + (nt * 16 + l15) * 136 + ks * 32 + lq * 8), a);
#pragma unroll
                        for (int ks = 0; ks < 2; ++ks) {
                            const u32x4 aw = (u32x4){xa[2 * ks][0], xa[2 * ks][1], xa[2 * ks + 1][0], xa[2 * ks + 1][1]};
                            const u32x2 b0 = *(LAS u32x2*)(Vt + (nt * 16 + l15) * 72 + ks * 32 + lq * 4), b1 = *(LAS u32x2*)(Vt + (nt * 16 + l15) * 72 + ks * 32 + 16 + lq * 4);
                            const u32x4 bw = (u32x4){b0.x, b0.y, b1.x, b1.y};
                            a = MFMA16(__builtin_bit_cast(bf16x8, aw), __builtin_bit_cast(bf16x8, bw), a); }
#pragma unroll
                        for (int r = 0; r < 4; ++r) OBF[(mi * 16 + lq * 4 + r) * 72 + nt * 16 + l15] = f2bf(a[r]); }
                }
                { float eb[4];
#pragma unroll
                    for (int r = 0; r < 4; ++r) eb[r] = EBL[wave * 16 + lq * 4 + r];
#pragma unroll
                    for (int nt = 0; nt < 4; ++nt) {
#pragma unroll
                        for (int r = 0; r < 4; ++r) accS[nt][r] *= eb[r];
#pragma unroll
                        for (int ks = 0; ks < 2; ++ks) accS[nt] = MFMA16(*(LAS bf16x8*)(Kt + (wave * 16 + l15) * 72 + ks * 32 + lq * 8), *(LAS bf16x8*)(Vt + (nt * 16 + l15) * 72 + ks * 32 + lq * 8), accS[nt]); } }
            }
            if (step < 36) {
                LAS unsigned char* op = lds + (step & 1) * GLA_OP_BYTES;
                LAS bf16_t* Qd = (LAS bf16_t*)op; LAS bf16_t* Kd = Qd + 64 * 136; LAS bf16_t* Kt = Kd + 64 * 136; LAS bf16_t* Vt = Kt + 128 * 72; LAS float* EBL = (LAS float*)(Vt + 64 * 72);
                { float v8[8]; unpack8(vw, v8);
#pragma unroll
                    for (int e = 0; e < 8; ++e) Vt[(seg * 8 + e) * 72 + ti] = f2bf(v8[e]); }
                float run[4] = {0.f, 0.f, 0.f, 0.f}, bc[4][4];
#pragma unroll
                for (int mt = 0; mt < 4; ++mt) {
                    const f32x4 sd = MFMA16(wfr, __builtin_bit_cast(bf16x8, alw[mt]), ((f32x4){0.f, 0.f, 0.f, 0.f}));
#pragma unroll
                    for (int r = 0; r < 4; ++r) { float x = logsigmoidf_(sd[r] + bad[r]) * 0.0625f;
                        x += DPP_F(x, 0x111); x += DPP_F(x, 0x112); x += DPP_F(x, 0x114); x += DPP_F(x, 0x118);
                        bc[mt][r] = run[r] + x; run[r] += DPP_F(x, 0x15F); }
                }
                float ebl[4];
#pragma unroll
                for (int r = 0; r < 4; ++r) ebl[r] = fexp(run[r]);
                if (l15 == 0) *(LAS f32x4*)(EBL + d0) = (f32x4){ebl[0], ebl[1], ebl[2], ebl[3]};
#pragma unroll
                for (int mt = 0; mt < 4; ++mt) { const int t = mt * 16 + l15; float qd[4], kd[4];
                    const float q4[4] = {bflo(qw[mt].x), bfhi(qw[mt].x), bflo(qw[mt].y), bfhi(qw[mt].y)}, k4[4] = {bflo(kw[mt].x), bfhi(kw[mt].x), bflo(kw[mt].y), bfhi(kw[mt].y)};
#pragma unroll
                    for (int r = 0; r < 4; ++r) { const float e1 = fexp(bc[mt][r]), e2 = __builtin_amdgcn_rcpf(e1);
                        qd[r] = q4[r] * 0.08838834764831845f * e1; kd[r] = k4[r] * e2; Kt[(d0 + r) * 72 + t] = f2bf(kd[r] * ebl[r]); }
                    u32x2 w; w.x = pk2(qd[0], qd[1]); w.y = pk2(qd[2], qd[3]); *(LAS u32x2*)(Qd + t * 136 + d0) = w;
                    w.x = pk2(kd[0], kd[1]); w.y = pk2(kd[2], kd[3]); *(LAS u32x2*)(Kd + t * 136 + d0) = w; }
            }
            __syncthreads();
            if (step >= 1) {
#pragma unroll
                for (int nt = 0; nt < 4; ++nt) { u32x2 w; w.x = pk2(accS[nt][0], accS[nt][1]); w.y = pk2(accS[nt][2], accS[nt][3]); *(LAS u32x2*)(St + (nt * 16 + l15) * 136 + wave * 16 + lq * 4) = w; }
                if (lat) *(u32x4*)(og + (size_t)(rbase + (dir ? 63 - ti : ti)) * D + h * 256 + dvs * 64 + seg * 8) = *(LAS u32x4*)(OBF + ti * 72 + seg * 8);
            }
            __syncthreads();
        }
    }
    __syncthreads();
}
template <bool LAT> __device__ __forceinline__ void load_mixed8(const bf16_t* __restrict__ Zr, int rowbase, int tl, int col, const float* mu8, float* out) {
    float own[8], zs[8], nb[8];
    const bf16_t* p = Zr + (size_t)(rowbase + tl) * ZR_LD + col;
    unpack8(ldg16(p), own);
    if (LAT) {
        const int x = tl & 63, y = tl >> 6;
#pragma unroll
        for (int ty = 0; ty < 4; ++ty) {
            const bool ok = ty == 0 ? (x > 0) : ty == 1 ? (x < 63) : ty == 2 ? (y > 0) : (y < 31);
            const int dl = ty == 0 ? -1 : ty == 1 ? 1 : ty == 2 ? -64 : 64;
            u32x4 w = (u32x4){0u, 0u, 0u, 0u};
            if (ok) w = ldg16(p + (ptrdiff_t)dl * ZR_LD);
            unpack8(w, nb); zs[ty] = nb[ty]; zs[ty + 4] = nb[ty + 4];
        }
    } else {
#pragma unroll
        for (int ty = 0; ty < 2; ++ty) {
            const bool ok = ty == 0 ? (tl > 0) : (tl < CTXL - 1);
            u32x4 w = (u32x4){0u, 0u, 0u, 0u};
            if (ok) w = ldg16(p + (ptrdiff_t)(ty == 0 ? -1 : 1) * ZR_LD);
            unpack8(w, nb); zs[ty] = nb[ty]; zs[ty + 2] = nb[ty + 2]; zs[ty + 4] = nb[ty + 4]; zs[ty + 6] = nb[ty + 6];
        }
    }
#pragma unroll
    for (int e = 0; e < 8; ++e) out[e] = own[e] + (zs[e] - own[e]) * mu8[e];
}

__device__ __forceinline__ float fast_tanh(float x) { const float e = fexp(2.0f * x); return 1.0f - 2.0f * __builtin_amdgcn_rcpf(1.0f + e); }
__device__ __forceinline__ void premix_lora(const Ctx& c) {
    const bf16_t* Zr = (const bf16_t*)(c.ws + WS_ZR); bf16_t* ZL = (bf16_t*)(c.ws + WS_ZL);
    for (int idx = blockIdx.x * NT + threadIdx.x; idx < MALL * 44; idx += gridDim.x * NT) {
        const int row = idx / 44, sg = idx - row * 44; float v8[8], mu8[8];
#pragma unroll
        for (int e = 0; e < 8; ++e) mu8[e] = CIN(11)[3072 + sg * 8 + e];
        if (row < MLAT) load_mixed8<true>(Zr, (row / SEQ) * SEQ, row % SEQ, ZR_OFF + 3072 + sg * 8, mu8, v8);
        else { const int rc = row - MLAT; load_mixed8<false>(Zr, MLAT + (rc / CTXL) * CTXL, rc % CTXL, ZR_OFF + 3072 + sg * 8, mu8, v8); }
#pragma unroll
        for (int e = 0; e < 8; ++e) v8[e] = sg < 16 ? fast_tanh(v8[e]) : (sg < 24 ? v8[e] : sigmoidf_(v8[e]));
        *(u32x4*)(ZL + (size_t)row * ZL_LD + sg * 8) = pack8(v8);
    }
}
__device__ __forceinline__ u32x2 ldg8(const bf16_t* p) { return *(const u32x2*)p; }
__device__ __forceinline__ void mix16_direct_lat(const bf16_t* __restrict__ Zr, int rowbase, int tl, int col, const float* __restrict__ mu, float* out) {
    const bf16_t* p = Zr + (size_t)(rowbase + tl) * ZR_LD + col;
    const u32x4 o0 = ldg16(p), o1 = ldg16(p + 8);
    const int x = tl & 63, y = tl >> 6; const u32x2 z2 = (u32x2){0u, 0u};
    u32x2 lf = z2, rt = z2, up = z2, dn = z2;
    if (x > 0) lf = ldg8(p - ZR_LD); if (x < 63) rt = ldg8(p + ZR_LD + 4); if (y > 0) up = ldg8(p - (ptrdiff_t)64 * ZR_LD + 8); if (y < 31) dn = ldg8(p + (ptrdiff_t)64 * ZR_LD + 12);
    const unsigned own[8] = {o0.x, o0.y, o0.z, o0.w, o1.x, o1.y, o1.z, o1.w}, nb[8] = {lf.x, lf.y, rt.x, rt.y, up.x, up.y, dn.x, dn.y};
#pragma unroll
    for (int j = 0; j < 8; ++j)
#pragma unroll
        for (int hh = 0; hh < 2; ++hh) { const int pp = 2 * j + hh, i = (pp & 3) * 4 + (pp >> 2); const float z = hh ? bfhi(own[j]) : bflo(own[j]), zs = hh ? bfhi(nb[j]) : bflo(nb[j]); out[i] = z + (zs - z) * mu[i]; }
}
constexpr int RW_SLOT = 12544, RW_KAP = 0, RW_RT = 2048, RW_KBT = 4096, RW_VT = 8192, RW_ARR = 10240, RW_MKK = 11264, RW_PM = 11776, RW_GC = 12288;
constexpr int RW_OST = 8 * RW_SLOT, RW_W2T = RW_OST + 16384, RW_A2T = RW_W2T + 9216, RW_PAR = RW_A2T + 9216, RW_MS = RW_PAR + 2560;
#define DPP_U(x, ctrl) ((unsigned)__builtin_amdgcn_update_dpp(0, (int)(x), (ctrl), 0xf, 0xf, false))
__device__ __forceinline__ float reduce4f(float x) {
    auto r = __builtin_amdgcn_permlane32_swap(__float_as_uint(x), __float_as_uint(x), false, false);
    const float y = __uint_as_float(r[0]) + __uint_as_float(r[1]);
    auto s = __builtin_amdgcn_permlane16_swap(__float_as_uint(y), __float_as_uint(y), false, false);
    return __uint_as_float(s[0]) + __uint_as_float(s[1]);
}
struct Raw16 { u32x4 o0, o1; u32x2 hal, up, dn; };
template <bool LAT> __device__ __forceinline__ void mix16_issue(Raw16& w, const bf16_t* __restrict__ Zr, int rowbase, int tl, int dir, int l15, int col) {
    const bf16_t* p = Zr + (size_t)(rowbase + tl) * ZR_LD + col;
    w.o0 = ldg16(p); w.o1 = ldg16(p + 8);
    const bool e0 = (l15 == 0), e15 = (l15 == 15);
    const int hdl = e0 ? (dir ? 1 : -1) : (dir ? -1 : 1);
    const int lim = LAT ? 64 : CTXL; const int pos = LAT ? (tl & 63) : tl;
    const bool hok = (e0 || e15) && (pos + hdl >= 0) && (pos + hdl < lim);
    const u32x2 z = (u32x2){0u, 0u};
    w.hal = z; w.up = z; w.dn = z;
    const int hoff = hdl < 0 ? 0 : 4;
    if (hok) w.hal = ldg8(p + (ptrdiff_t)hdl * ZR_LD + hoff);
    if (LAT) {
        if ((tl >> 6) > 0) w.up = ldg8(p - (ptrdiff_t)64 * ZR_LD + 8);
        if ((tl >> 6) < 31) w.dn = ldg8(p + (ptrdiff_t)64 * ZR_LD + 12);
    } else {
        if (hok) w.up = ldg8(p + (ptrdiff_t)hdl * ZR_LD + hoff + 8);
    }
}
template <bool LAT> __device__ __forceinline__ void mix16_finish(const Raw16& w, int tl, int dir, int l15, const LAS float* mu, float* out) {
    const unsigned own[8] = {w.o0.x, w.o0.y, w.o0.z, w.o0.w, w.o1.x, w.o1.y, w.o1.z, w.o1.w};
    const int lim = LAT ? 64 : CTXL; const int pos = LAT ? (tl & 63) : tl;
    const bool pv_ok = pos > 0, nx_ok = pos < lim - 1;
    const bool pv_edge = (l15 == (dir ? 15 : 0)), nx_edge = (l15 == (dir ? 0 : 15));
    unsigned nb[8];
#define NB_PREV(j, hv) { const unsigned a_ = DPP_U(own[j], 0x111), b_ = DPP_U(own[j], 0x101); unsigned v_ = dir ? b_ : a_; if (pv_edge) v_ = (hv); nb[j] = pv_ok ? v_ : 0u; }
#define NB_NEXT(j, hv) { const unsigned a_ = DPP_U(own[j], 0x111), b_ = DPP_U(own[j], 0x101); unsigned v_ = dir ? a_ : b_; if (nx_edge) v_ = (hv); nb[j] = nx_ok ? v_ : 0u; }
    NB_PREV(0, w.hal.x) NB_PREV(1, w.hal.y) NB_NEXT(2, w.hal.x) NB_NEXT(3, w.hal.y)
    if (LAT) { nb[4] = w.up.x; nb[5] = w.up.y; nb[6] = w.dn.x; nb[7] = w.dn.y; }
    else { NB_PREV(4, w.up.x) NB_PREV(5, w.up.y) NB_NEXT(6, w.up.x) NB_NEXT(7, w.up.y) }
#undef NB_PREV
#undef NB_NEXT
    float mu16[16];
#pragma unroll
    for (int q = 0; q < 4; ++q) { const f32x4 m = *(const LAS f32x4*)(mu + q * 4); mu16[q * 4] = m[0]; mu16[q * 4 + 1] = m[1]; mu16[q * 4 + 2] = m[2]; mu16[q * 4 + 3] = m[3]; }
#pragma unroll
    for (int j = 0; j < 8; ++j)
#pragma unroll
        for (int hh = 0; hh < 2; ++hh) { const int pp = 2 * j + hh, i = (pp & 3) * 4 + (pp >> 2); const float z = hh ? bfhi(own[j]) : bflo(own[j]), zs = hh ? bfhi(nb[j]) : bflo(nb[j]); out[i] = z + (zs - z) * mu16[i]; }
}
#define MIX_ISSUE(w, colv) do { if (lat) mix16_issue<true>(w, Zr, rowbase, tl, dir, l15, (colv)); else mix16_issue<false>(w, Zr, rowbase, tl, dir, l15, (colv)); } while (0)
#define MIX_FINISH(w, k, outv) do { if (lat) mix16_finish<true>(w, tl, dir, l15, PAR + (k) * 64 + lq * 16, outv); else mix16_finish<false>(w, tl, dir, l15, PAR + (k) * 64 + lq * 16, outv); } while (0)
#define SCHED_FENCE() __builtin_amdgcn_sched_barrier(0)
__device__ __forceinline__ u32x4 packv8(const float* v) { return pack8(v); }
__device__ __forceinline__ void p4_rwkv_chunked(const Ctx& c, LAS unsigned char* lds) {
    const int tid = threadIdx.x, lane = tid & 63, wave = tid >> 6, l15 = lane & 15, lq = lane >> 4;
    LAS bf16_t* W2T = (LAS bf16_t*)(lds + RW_W2T); LAS bf16_t* A2T = (LAS bf16_t*)(lds + RW_A2T); LAS float* PAR = (LAS float*)(lds + RW_PAR);
    const bf16_t* Zr = (const bf16_t*)(c.ws + WS_ZR);
    float* bonus = (float*)(c.ws + WS_BONUS);
    for (int u = blockIdx.x; u < 256; u += gridDim.x) {
        const int dir = u & 1, h = (u >> 1) & 15, b = u >> 5;
        bf16_t* orr = (bf16_t*)(c.ws + (dir ? WS_ORB : WS_ORF));
        __syncthreads();
        for (int i = tid; i < 4096; i += NT) { const int j = i >> 6, ch = i & 63; W2T[ch * 72 + j] = f2bf(CIN(13)[(size_t)(dir * 64 + j) * 1024 + h * 64 + ch]); A2T[ch * 72 + j] = f2bf(CIN(15)[(size_t)j * 1024 + h * 64 + ch]); }
        if (tid < 64) { const int ch = tid, hc = h * 64 + ch;
            PAR[0 * 64 + ch] = CIN(11)[hc]; PAR[1 * 64 + ch] = CIN(11)[1024 + hc]; PAR[2 * 64 + ch] = CIN(11)[2048 + hc]; PAR[3 * 64 + ch] = CIN(11)[3072 + dir * 64 + ch]; PAR[4 * 64 + ch] = CIN(11)[3200 + ch];
            PAR[5 * 64 + ch] = CIN(12)[dir * 1024 + hc]; PAR[6 * 64 + ch] = CIN(14)[hc]; PAR[7 * 64 + ch] = CIN(17)[hc]; PAR[8 * 64 + ch] = CIN(18)[hc]; PAR[9 * 64 + ch] = CIN(19)[hc]; }
        __syncthreads();
        f32x4 Tt[4];
#pragma unroll
        for (int kt = 0; kt < 4; ++kt) Tt[kt] = (f32x4){0.f, 0.f, 0.f, 0.f};
        Raw16 wa, wb, wc; u32x4 bw0, bw1, ba0, ba1;
#define RW_ISSUE(qq) do { const int q_ = (qq); { const u32x4 z4_ = (u32x4){0u, 0u, 0u, 0u}; const u32x2 z2_ = (u32x2){0u, 0u}; wa.o0 = z4_; wa.o1 = z4_; wa.hal = z2_; wa.up = z2_; wa.dn = z2_; wb = wa; wc = wa; bw0 = z4_; bw1 = z4_; ba0 = z4_; ba1 = z4_; } if (q_ < 144) { const bool lat = q_ >= 16; const int cidx_ = lat ? (dir ? 127 - (q_ - 16) : q_ - 16) : (dir ? 15 - q_ : q_); \
            const int tl = cidx_ * 16 + (dir ? 15 - l15 : l15), rowbase = lat ? b * SEQ : MLAT + b * CTXL; \
            MIX_ISSUE(wa, ZR_OFF + 2048 + h * 64 + lq * 16); MIX_ISSUE(wb, ZR_OFF + 1024 + h * 64 + lq * 16); MIX_ISSUE(wc, ZR_OFF + h * 64 + lq * 16); \
            const bf16_t* zl = (const bf16_t*)(c.ws + WS_ZL) + (size_t)(rowbase + tl) * ZL_LD; \
            bw0 = ldg16(zl + dir * 64 + lq * 16); bw1 = ldg16(zl + dir * 64 + lq * 16 + 8); ba0 = ldg16(zl + 128 + lq * 16); ba1 = ldg16(zl + 128 + lq * 16 + 8); } } while (0)
#pragma unroll 1
        for (int rho = 0; rho <= 18; ++rho) {
            RW_ISSUE(8 * rho + wave);
            SCHED_FENCE();
            if (wave < 4 && rho >= 1) {
                const int vt = wave;
#pragma unroll 1
                for (int j4 = 0; j4 < 8; ++j4) {
                    const int q = 8 * (rho - 1) + j4; const bool lat = q >= 16;
                    const LAS unsigned char* slot = lds + j4 * RW_SLOT;
                    const u32x4 kf0 = *(const LAS u32x4*)(slot + RW_KAP + lane * 16), kf1 = *(const LAS u32x4*)(slot + RW_KAP + 1024 + lane * 16);
                    const u32x4 rf0 = *(const LAS u32x4*)(slot + RW_RT + lane * 16), rf1 = *(const LAS u32x4*)(slot + RW_RT + 1024 + lane * 16);
                    const u32x2 mkkf = *(const LAS u32x2*)(slot + RW_MKK + lane * 8), pmf = *(const LAS u32x2*)(slot + RW_PM + lane * 8);
                    const u32x4 arrf = *(const LAS u32x4*)(slot + RW_ARR + lane * 16);
                    const u32x2 vf = *(const LAS u32x2*)(slot + RW_VT + ((vt * 16 + l15) * 16 + lq * 4) * 2);
                    const u32x4 tb0 = (u32x4){pk2(Tt[0][0], Tt[0][1]), pk2(Tt[0][2], Tt[0][3]), pk2(Tt[1][0], Tt[1][1]), pk2(Tt[1][2], Tt[1][3])};
                    const u32x4 tb1 = (u32x4){pk2(Tt[2][0], Tt[2][1]), pk2(Tt[2][2], Tt[2][3]), pk2(Tt[3][0], Tt[3][1]), pk2(Tt[3][2], Tt[3][3])};
                    const f32x4 z4 = (f32x4){0.f, 0.f, 0.f, 0.f};
                    f32x4 xy = MFMA16(__builtin_bit_cast(bf16x8, kf0), __builtin_bit_cast(bf16x8, tb0), z4); xy = MFMA16(__builtin_bit_cast(bf16x8, kf1), __builtin_bit_cast(bf16x8, tb1), xy);
                    xy = MFMA16(__builtin_bit_cast(bf16x8, ((u32x4){mkkf.x, mkkf.y, 0u, 0u})), __builtin_bit_cast(bf16x8, ((u32x4){vf.x, vf.y, 0u, 0u})), xy);
                    const f32x4 uu = MFMA16(__builtin_bit_cast(bf16x8, ((u32x4){pmf.x, pmf.y, 0u, 0u})), __builtin_bit_cast(bf16x8, ((u32x4){pk2(xy[0], xy[1]), pk2(xy[2], xy[3]), 0u, 0u})), z4);
                    const u32x4 vub = (u32x4){vf.x, vf.y, pk2(uu[0], uu[1]), pk2(uu[2], uu[3])};
                    if (lat) {
                        f32x4 o = MFMA16(__builtin_bit_cast(bf16x8, rf0), __builtin_bit_cast(bf16x8, tb0), z4); o = MFMA16(__builtin_bit_cast(bf16x8, rf1), __builtin_bit_cast(bf16x8, tb1), o);
                        o = MFMA16(__builtin_bit_cast(bf16x8, arrf), __builtin_bit_cast(bf16x8, vub), o);
                        LAS bf16_t* ost = (LAS bf16_t*)(lds + RW_OST) + j4 * 1024;
#pragma unroll
                        for (int r = 0; r < 4; ++r) ost[(lq * 4 + r) * 64 + vt * 16 + l15] = f2bf(o[r]);
                    }
                    const LAS float* GCs = (const LAS float*)(slot + RW_GC) + lq * 16;
#pragma unroll
                    for (int kt = 0; kt < 4; ++kt) { const f32x4 gc = *(const LAS f32x4*)(GCs + kt * 4); const u32x4 kbf = *(const LAS u32x4*)(slot + RW_KBT + (kt * 64 + lane) * 16);
                        f32x4 t = Tt[kt];
#pragma unroll
                        for (int r = 0; r < 4; ++r) t[r] *= gc[r];
                        Tt[kt] = MFMA16(__builtin_bit_cast(bf16x8, kbf), __builtin_bit_cast(bf16x8, vub), t); }
                }
            }
            __syncthreads();
            {
                const int pw = wave;
                { const int q = 8 * (rho - 1) + pw;
                    if (rho >= 1 && q >= 16) { const int cidx = dir ? 127 - (q - 16) : q - 16; const int tok = lane >> 2, part = lane & 3, tl = cidx * 16 + (dir ? 15 - tok : tok);
                        const LAS bf16_t* src = (const LAS bf16_t*)(lds + RW_OST) + pw * 1024 + tok * 64 + part * 16;
                        bf16_t* dst = orr + (size_t)(b * SEQ + tl) * D + h * 64 + part * 16;
                        *(u32x4*)dst = *(const LAS u32x4*)src; *(u32x4*)(dst + 8) = *(const LAS u32x4*)(src + 8); } }
                const int q = 8 * rho + pw;
                if (q < 144) {
                    const bool lat = q >= 16;
                    const int cidx = lat ? (dir ? 127 - (q - 16) : q - 16) : (dir ? 15 - q : q);
                    const int tl = cidx * 16 + (dir ? 15 - l15 : l15), rowbase = lat ? b * SEQ : MLAT + b * CTXL;
                    LAS unsigned char* slot = lds + pw * RW_SLOT;
                    float rm[16], km[16];
                    {
                        SCHED_FENCE();
                        { float vm[16]; MIX_FINISH(wa, 2, vm);
                            LAS bf16_t* VT = (LAS bf16_t*)(slot + RW_VT);
#pragma unroll
                            for (int i = 0; i < 16; ++i) VT[(lq * 16 + i) * 16 + l15] = f2bf(vm[i]); }
                        SCHED_FENCE();
                        MIX_FINISH(wb, 1, km);
                        SCHED_FENCE();
                        MIX_FINISH(wc, 0, rm);
                    }
                    SCHED_FENCE();
                    float inv;
                    { float ss = 0.f;
#pragma unroll
                        for (int qd = 0; qd < 4; ++qd) { const f32x4 kkm = *(const LAS f32x4*)(PAR + 7 * 64 + lq * 16 + qd * 4);
#pragma unroll
                            for (int e = 0; e < 4; ++e) { const float x = km[qd * 4 + e] * kkm[e]; ss += x * x; } }
                        ss = reduce4f(ss); inv = fminf(__builtin_amdgcn_rsqf(ss), 1e12f); }
                    unsigned kapw[8], betw[8], ktw[8], rtw[8]; float bs = 0.f;
                    { LAS bf16_t* KB = (LAS bf16_t*)(slot + RW_KBT) + ((l15 >> 2) * 16 + lq * 4) * 8 + (l15 & 3); LAS float* GCs = (LAS float*)(slot + RW_GC) + lq * 16;
                        const int arow = (l15 >> 2) * 16 + (l15 & 3);
#pragma unroll
                        for (int nt = 0; nt < 4; ++nt) { SCHED_FENCE();
                            const LAS bf16_t* wr = W2T + (arow + nt * 4) * 72 + lq * 16; const LAS bf16_t* ar = A2T + (arow + nt * 4) * 72 + lq * 16;
                            f32x4 xw = MFMA16(*(const LAS bf16x8*)wr, __builtin_bit_cast(bf16x8, bw0), ((f32x4){0.f, 0.f, 0.f, 0.f})); xw = MFMA16(*(const LAS bf16x8*)(wr + 8), __builtin_bit_cast(bf16x8, bw1), xw);
                            f32x4 xa = MFMA16(*(const LAS bf16x8*)ar, __builtin_bit_cast(bf16x8, ba0), ((f32x4){0.f, 0.f, 0.f, 0.f})); xa = MFMA16(*(const LAS bf16x8*)(ar + 8), __builtin_bit_cast(bf16x8, ba1), xa);
                            const f32x4 w0 = *(const LAS f32x4*)(PAR + 5 * 64 + lq * 16 + nt * 4), a0 = *(const LAS f32x4*)(PAR + 6 * 64 + lq * 16 + nt * 4);
                            const f32x4 kkm = *(const LAS f32x4*)(PAR + 7 * 64 + lq * 16 + nt * 4), kam = *(const LAS f32x4*)(PAR + 8 * 64 + lq * 16 + nt * 4), rkm = *(const LAS f32x4*)(PAR + 9 * 64 + lq * 16 + nt * 4);
                            float ka4[4], be4[4], kt4[4], rt4[4], g4[4], lw4[4], kapn4[4], kpi4[4], betn4[4];
#pragma unroll
                            for (int r = 0; r < 4; ++r) { const int i = nt * 4 + r;
                                lw4[r] = -0.6065306597126334f * __builtin_amdgcn_rcpf(1.0f + fexp(-(w0[r] + xw[r])));
                                const float avi = sigmoidf_(a0[r] + xa[r]);
                                kapn4[r] = km[i] * kkm[r] * inv; kpi4[r] = km[i] * (1.0f + (avi - 1.0f) * kam[r]); betn4[r] = kapn4[r] * avi;
                                bs += rm[i] * kpi4[r] * rkm[r]; g4[r] = lw4[r]; }
                            asm volatile("s_nop 1\n"
                                "v_add_f32_dpp %0, %0, %0 row_shr:1 row_mask:0xf bank_mask:0xf\n" "v_add_f32_dpp %1, %1, %1 row_shr:1 row_mask:0xf bank_mask:0xf\n" "v_add_f32_dpp %2, %2, %2 row_shr:1 row_mask:0xf bank_mask:0xf\n" "v_add_f32_dpp %3, %3, %3 row_shr:1 row_mask:0xf bank_mask:0xf\n"
                                "v_add_f32_dpp %0, %0, %0 row_shr:2 row_mask:0xf bank_mask:0xf\n" "v_add_f32_dpp %1, %1, %1 row_shr:2 row_mask:0xf bank_mask:0xf\n" "v_add_f32_dpp %2, %2, %2 row_shr:2 row_mask:0xf bank_mask:0xf\n" "v_add_f32_dpp %3, %3, %3 row_shr:2 row_mask:0xf bank_mask:0xf\n"
                                "v_add_f32_dpp %0, %0, %0 row_shr:4 row_mask:0xf bank_mask:0xf\n" "v_add_f32_dpp %1, %1, %1 row_shr:4 row_mask:0xf bank_mask:0xf\n" "v_add_f32_dpp %2, %2, %2 row_shr:4 row_mask:0xf bank_mask:0xf\n" "v_add_f32_dpp %3, %3, %3 row_shr:4 row_mask:0xf bank_mask:0xf\n"
                                "v_add_f32_dpp %0, %0, %0 row_shr:8 row_mask:0xf bank_mask:0xf\n" "v_add_f32_dpp %1, %1, %1 row_shr:8 row_mask:0xf bank_mask:0xf\n" "v_add_f32_dpp %2, %2, %2 row_shr:8 row_mask:0xf bank_mask:0xf\n" "v_add_f32_dpp %3, %3, %3 row_shr:8 row_mask:0xf bank_mask:0xf\n"
                                "s_nop 1\n"
                                : "+v"(g4[0]), "+v"(g4[1]), "+v"(g4[2]), "+v"(g4[3]));
#pragma unroll
                            for (int r = 0; r < 4; ++r) { const int i = nt * 4 + r; const float g = g4[r], kapn = kapn4[r], kpi = kpi4[r], betn = betn4[r];
                                const float e1 = fexp(g), e2 = __builtin_amdgcn_rcpf(e1);
                                const float eC = DPP_F(e1, 0x15F);
                                float ep = DPP_F(e1, 0x111); ep = l15 == 0 ? 1.0f : ep;
                                const float kt_ = kpi * e2, bt_ = betn * e2;
                                ka4[r] = kapn * ep; be4[r] = bt_; kt4[r] = kt_; rt4[r] = rm[i] * e1;
                                KB[(nt * 64 + r) * 8] = f2bf(kt_ * eC); KB[(nt * 64 + r) * 8 + 4] = f2bf(-bt_ * eC);
                                if (l15 == 0) GCs[i] = eC; }
                            kapw[2 * nt] = pk2(ka4[0], ka4[1]); kapw[2 * nt + 1] = pk2(ka4[2], ka4[3]); betw[2 * nt] = pk2(be4[0], be4[1]); betw[2 * nt + 1] = pk2(be4[2], be4[3]);
                            ktw[2 * nt] = pk2(kt4[0], kt4[1]); ktw[2 * nt + 1] = pk2(kt4[2], kt4[3]); rtw[2 * nt] = pk2(rt4[0], rt4[1]); rtw[2 * nt + 1] = pk2(rt4[2], rt4[3]); }
                        SCHED_FENCE();
                        bs = reduce4f(bs);
                        if (lat && dir == 0 && lq == 0) bonus[(size_t)(b * SEQ + tl) * 16 + h] = bs; }
                    const u32x4 kapf0 = (u32x4){kapw[0], kapw[1], kapw[2], kapw[3]}, kapf1 = (u32x4){kapw[4], kapw[5], kapw[6], kapw[7]}, betf0 = (u32x4){betw[0], betw[1], betw[2], betw[3]}, betf1 = (u32x4){betw[4], betw[5], betw[6], betw[7]};
                    const u32x4 ktf0 = (u32x4){ktw[0], ktw[1], ktw[2], ktw[3]}, ktf1 = (u32x4){ktw[4], ktw[5], ktw[6], ktw[7]}, rtf0 = (u32x4){rtw[0], rtw[1], rtw[2], rtw[3]}, rtf1 = (u32x4){rtw[4], rtw[5], rtw[6], rtw[7]};
                    *(LAS u32x4*)(slot + RW_KAP + lane * 16) = kapf0; *(LAS u32x4*)(slot + RW_KAP + 1024 + lane * 16) = kapf1;
                    *(LAS u32x4*)(slot + RW_RT + lane * 16) = rtf0; *(LAS u32x4*)(slot + RW_RT + 1024 + lane * 16) = rtf1;
                    const f32x4 z4 = (f32x4){0.f, 0.f, 0.f, 0.f};
                    f32x4 mkb = MFMA16(__builtin_bit_cast(bf16x8, betf0), __builtin_bit_cast(bf16x8, kapf0), z4); mkb = MFMA16(__builtin_bit_cast(bf16x8, betf1), __builtin_bit_cast(bf16x8, kapf1), mkb);
                    f32x4 mkk = MFMA16(__builtin_bit_cast(bf16x8, ktf0), __builtin_bit_cast(bf16x8, kapf0), z4); mkk = MFMA16(__builtin_bit_cast(bf16x8, ktf1), __builtin_bit_cast(bf16x8, kapf1), mkk);
                    f32x4 ark = MFMA16(__builtin_bit_cast(bf16x8, ktf0), __builtin_bit_cast(bf16x8, rtf0), z4); ark = MFMA16(__builtin_bit_cast(bf16x8, ktf1), __builtin_bit_cast(bf16x8, rtf1), ark);
                    f32x4 arb = MFMA16(__builtin_bit_cast(bf16x8, betf0), __builtin_bit_cast(bf16x8, rtf0), z4); arb = MFMA16(__builtin_bit_cast(bf16x8, betf1), __builtin_bit_cast(bf16x8, rtf1), arb);
                    float arr8[8], mk4[4], mb4[4];
#pragma unroll
                    for (int r = 0; r < 4; ++r) { const int s = lq * 4 + r; mb4[r] = s < l15 ? mkb[r] : 0.f; mk4[r] = s < l15 ? mkk[r] : 0.f; arr8[r] = s <= l15 ? ark[r] : 0.f; arr8[4 + r] = s <= l15 ? -arb[r] : 0.f; }
                    *(LAS u32x4*)(slot + RW_ARR + lane * 16) = packv8(arr8);
                    { u32x2 w; w.x = pk2(mk4[0], mk4[1]); w.y = pk2(mk4[2], mk4[3]); *(LAS u32x2*)(slot + RW_MKK + lane * 8) = w; }
                    { LAS float* MS = (LAS float*)(lds + RW_MS) + pw * 320;
                        *(LAS f32x4*)(MS + l15 * 20 + lq * 4) = (f32x4){mb4[0], mb4[1], mb4[2], mb4[3]};
                        LDS_FENCE();
                        float mrow[16];
#pragma unroll
                        for (int qd = 0; qd < 4; ++qd) { const f32x4 m = *(const LAS f32x4*)(MS + l15 * 20 + qd * 4); mrow[qd * 4] = m[0]; mrow[qd * 4 + 1] = m[1]; mrow[qd * 4 + 2] = m[2]; mrow[qd * 4 + 3] = m[3]; }
                        LDS_FENCE();
                        float p4[4];
#pragma unroll
                        for (int j = 0; j < 4; ++j) p4[j] = (l15 == lq * 4 + j) ? 1.0f : 0.f;
                        float nm[15];
#pragma unroll
                        for (int q = 0; q < 15; ++q) nm[q] = -mrow[q];
#define PS4(sidx, op) "v_fmac_f32_dpp %0, %0, %" #op " row_newbcast:" #sidx " row_mask:0xf bank_mask:0xf\n" "v_fmac_f32_dpp %1, %1, %" #op " row_newbcast:" #sidx " row_mask:0xf bank_mask:0xf\n" \
                    "v_fmac_f32_dpp %2, %2, %" #op " row_newbcast:" #sidx " row_mask:0xf bank_mask:0xf\n" "v_fmac_f32_dpp %3, %3, %" #op " row_newbcast:" #sidx " row_mask:0xf bank_mask:0xf\n"
                        asm volatile("s_nop 1\n"
                            PS4(0, 4) PS4(1, 5) PS4(2, 6) PS4(3, 7) PS4(4, 8) PS4(5, 9) PS4(6, 10) PS4(7, 11) PS4(8, 12) PS4(9, 13) PS4(10, 14) PS4(11, 15) PS4(12, 16) PS4(13, 17) PS4(14, 18)
                            "s_nop 1\n"
                            : "+v"(p4[0]), "+v"(p4[1]), "+v"(p4[2]), "+v"(p4[3])
                            : "v"(nm[0]), "v"(nm[1]), "v"(nm[2]), "v"(nm[3]), "v"(nm[4]), "v"(nm[5]), "v"(nm[6]), "v"(nm[7]), "v"(nm[8]), "v"(nm[9]), "v"(nm[10]), "v"(nm[11]), "v"(nm[12]), "v"(nm[13]), "v"(nm[14]));
#undef PS4
                        u32x2 w; w.x = pk2(p4[0], p4[1]); w.y = pk2(p4[2], p4[3]); *(LAS u32x2*)(slot + RW_PM + lane * 8) = w; }
                }
            }
            __syncthreads();
        }
    }
}
__device__ __forceinline__ void p5_post(const Ctx& c, LAS unsigned char* lds, bool dry = false) {
    const int tid = threadIdx.x, lane = tid & 63, wave = tid >> 6, l15 = lane & 15, lq = lane >> 4;
    LAS bf16_t* SG = (LAS bf16_t*)lds;
    LAS bf16_t* GL = SG + 64 * 200;
    const bf16_t* Zr = (const bf16_t*)(c.ws + WS_ZR); const bf16_t* g2t = (const bf16_t*)(c.ws + WS_G2T);
    bf16_t* og_f = (bf16_t*)c.out; const bf16_t* og_b = og_f + (size_t)MLAT * D;
    bf16_t* or_f = (bf16_t*)(c.ws + WS_ORF); const bf16_t* or_b = (const bf16_t*)(c.ws + WS_ORB);
    const float* bonus = (const float*)(c.ws + WS_BONUS);
    for (int u = blockIdx.x; u < MLAT / 64; u += gridDim.x) {
        const int rowbase = (u >> 5) * SEQ, tl0 = (u & 31) * 64;
        __syncthreads();
        { const int tok = tid >> 3, seg = tid & 7; const bf16_t* zl = (const bf16_t*)(c.ws + WS_ZL) + (size_t)(rowbase + tl0 + tok) * ZL_LD + 192;
#pragma unroll
            for (int k = 0; k < 3; ++k) { const int sgi = seg + 8 * k; u32x4 w = (u32x4){0u, 0u, 0u, 0u};
                if (sgi < 20) w = ldg16(zl + sgi * 8);
                *(LAS u32x4*)(SG + tok * 200 + sgi * 8) = w; } }
        __syncthreads();
#pragma unroll 1
        for (int half = 0; half < 2; ++half) {
            f32x4 acc[4][4];
#pragma unroll
            for (int mt = 0; mt < 4; ++mt)
#pragma unroll
                for (int nt = 0; nt < 4; ++nt) acc[mt][nt] = (f32x4){0.f, 0.f, 0.f, 0.f};
#pragma unroll
            for (int ks = 0; ks < 6; ++ks) { bf16x8 bfr[4], afr[4];
#pragma unroll
                for (int nt = 0; nt < 4; ++nt) bfr[nt] = *(const bf16x8*)(g2t + (size_t)(wave * 128 + (half * 4 + nt) * 16 + l15) * 192 + ks * 32 + lq * 8);
#pragma unroll
                for (int mt = 0; mt < 4; ++mt) afr[mt] = *(LAS bf16x8*)(SG + (mt * 16 + l15) * 200 + ks * 32 + lq * 8);
#pragma unroll
                for (int mt = 0; mt < 4; ++mt)
#pragma unroll
                    for (int nt = 0; nt < 4; ++nt) acc[mt][nt] = MFMA16(afr[mt], bfr[nt], acc[mt][nt]); }
#pragma unroll
            for (int mt = 0; mt < 4; ++mt)
#pragma unroll
                for (int nt = 0; nt < 4; ++nt)
#pragma unroll
                    for (int r = 0; r < 4; ++r) GL[(mt * 16 + lq * 4 + r) * 1032 + wave * 128 + (half * 4 + nt) * 16 + l15] = f2bf(acc[mt][nt][r]);
        }
        __syncthreads();
        for (int ii = 0; ii < 8; ++ii) {
            const int i = wave * 8 + ii; const size_t R = (size_t)rowbase + tl0 + i; const int ch0 = lane * 16;
            { float s[16], t[16]; unpack8(ldg16(og_f + R * D + ch0), s); unpack8(ldg16(og_f + R * D + ch0 + 8), s + 8); unpack8(ldg16(og_b + R * D + ch0), t); unpack8(ldg16(og_b + R * D + ch0 + 8), t + 8);
                float ssq = 0.f;
#pragma unroll
                for (int e = 0; e < 16; ++e) { s[e] += t[e]; ssq += s[e] * s[e]; }
                ssq += __shfl_xor(ssq, 1); ssq += __shfl_xor(ssq, 2); ssq += __shfl_xor(ssq, 4); ssq += __shfl_xor(ssq, 8);
                const float rs = rsqrtf(ssq * (1.0f / 256.0f) + 1e-6f);
#pragma unroll
                for (int e = 0; e < 16; ++e) s[e] = s[e] * rs * CIN(10)[ch0 + e];
                bf16_t* wp = dry ? (bf16_t*)(c.ws + WS_WIN) + (R & 4095) * D + ch0 : og_f + R * D + ch0;
                *(u32x4*)wp = pack8(s); *(u32x4*)(wp + 8) = pack8(s + 8); }
            { float s[16], t[16]; unpack8(ldg16(or_f + R * D + ch0), s); unpack8(ldg16(or_f + R * D + ch0 + 8), s + 8); unpack8(ldg16(or_b + R * D + ch0), t); unpack8(ldg16(or_b + R * D + ch0 + 8), t + 8);
                float sm = 0.f;
#pragma unroll
                for (int e = 0; e < 16; ++e) { s[e] += t[e]; sm += s[e]; }
                sm += __shfl_xor(sm, 1); sm += __shfl_xor(sm, 2);
                const float mean = sm * (1.0f / 64.0f); float sv = 0.f;
#pragma unroll
                for (int e = 0; e < 16; ++e) { s[e] -= mean; sv += s[e] * s[e]; }
                sv += __shfl_xor(sv, 1); sv += __shfl_xor(sv, 2);
                const float rs = rsqrtf(sv * (1.0f / 64.0f) + 64e-5f);
                const float bn = bonus[R * 16 + (lane >> 2)];
                float vm[16], g[16];
                mix16_direct_lat(Zr, rowbase, tl0 + i, ZR_OFF + 2048 + ch0, CIN(11) + 2048 + ch0, vm);
                unpack8(*(LAS u32x4*)(GL + i * 1032 + ch0), g); unpack8(*(LAS u32x4*)(GL + i * 1032 + ch0 + 8), g + 8);
#pragma unroll
                for (int e = 0; e < 16; ++e) s[e] = (s[e] * rs * CIN(20)[ch0 + e] + CIN(21)[ch0 + e] + bn * vm[e]) * g[e];
                bf16_t* wp = dry ? (bf16_t*)(c.ws + WS_WIN) + (R & 4095) * D + ch0 : or_f + R * D + ch0;
                *(u32x4*)wp = pack8(s); *(u32x4*)(wp + 8) = pack8(s + 8); }
        }
    }
    __syncthreads();
}

__device__ __forceinline__ void p7_combine(const Ctx& c) {
    const bf16_t* Z3 = (const bf16_t*)(c.ws + WS_Z3); const bf16_t* yg = (const bf16_t*)c.out; const bf16_t* yr = (const bf16_t*)(c.ws + WS_ORF); bf16_t* Y = (bf16_t*)(c.ws + WS_A1);
    for (int idx = blockIdx.x * NT + threadIdx.x; idx < MLAT * 128; idx += gridDim.x * NT) {
        const size_t row = idx >> 7; const int c8 = (idx & 127) * 8;
        float go[8], sg[8], sr[8], a[8], b[8], y[8];
        unpack8(ldg16(Z3 + row * Z3_LD + c8), go); unpack8(ldg16(Z3 + row * Z3_LD + 1024 + c8), sg); unpack8(ldg16(Z3 + row * Z3_LD + 2048 + c8), sr);
        unpack8(ldg16(yg + row * D + c8), a); unpack8(ldg16(yr + row * D + c8), b);
#pragma unroll
        for (int e = 0; e < 8; ++e) y[e] = sg[e] * a[e] * go[e] + sr[e] * b[e];
        *(u32x4*)(Y + row * D + c8) = pack8(y);
    }
}

__device__ __forceinline__ void p9_norm2_tables(const Ctx& c) {
    const int lane = threadIdx.x & 63, wave = threadIdx.x >> 6; const float* m = (const float*)(c.ws + WS_MOD); bf16_t* A2 = (bf16_t*)(c.ws + WS_A1);
    { const int stride = gridDim.x * 8;
        for (int row = blockIdx.x * 8 + wave; row < MLAT; row += 2 * stride) { const int rb = row + stride, b0 = row / SEQ;
            if (rb < MLAT) { const int b1 = rb / SEQ; norm_mod_row2(c.out + (size_t)row * D, c.out + (size_t)rb * D, CIN(23), m + b0 * MODW + 3072, m + b0 * MODW + 4096, m + b1 * MODW + 3072, m + b1 * MODW + 4096, A2 + (size_t)row * D, A2 + (size_t)rb * D, lane); }
            else norm_mod_row(c.out + (size_t)row * D, CIN(23), m + b0 * MODW + 3072, m + b0 * MODW + 4096, A2 + (size_t)row * D, lane); } }
    unsigned* UV = (unsigned*)(c.ws + WS_UT);
    for (size_t i = ((size_t)blockIdx.x * NT + threadIdx.x) * 4; i < (size_t)16384 * 1024; i += (size_t)gridDim.x * NT * 4) {
        const f32x4 a = *(const f32x4*)(CIN(26) + i), b = *(const f32x4*)(CIN(27) + i); const size_t e = i >> 10, o = (e * 2048 + (i & 1023)) >> 2;
        int w = __builtin_amdgcn_cvt_pk_fp8_f32(a[0] * 64.0f, a[1] * 64.0f, 0, false); w = __builtin_amdgcn_cvt_pk_fp8_f32(a[2] * 64.0f, a[3] * 64.0f, w, true); UV[o] = (unsigned)w;
        w = __builtin_amdgcn_cvt_pk_fp8_f32(b[0], b[1], 0, false); w = __builtin_amdgcn_cvt_pk_fp8_f32(b[2], b[3], w, true); UV[o + 256] = (unsigned)w; }
}
typedef float f32x2p __attribute__((ext_vector_type(2)));
__device__ __forceinline__ void fp8x16_to_f32(const u32x4 w, float* o) {
#pragma unroll
    for (int q = 0; q < 4; ++q) { const f32x2p lo = __builtin_amdgcn_cvt_pk_f32_fp8((int)w[q], false), hi = __builtin_amdgcn_cvt_pk_f32_fp8((int)w[q], true); o[q * 4] = lo[0]; o[q * 4 + 1] = lo[1]; o[q * 4 + 2] = hi[0]; o[q * 4 + 3] = hi[1]; }
}
__device__ __forceinline__ float row16_sum(float x) {
    x += __builtin_bit_cast(float, __builtin_amdgcn_update_dpp(0, __builtin_bit_cast(int, x), 0x128, 0xf, 0xf, false));
    x += __builtin_bit_cast(float, __builtin_amdgcn_update_dpp(0, __builtin_bit_cast(int, x), 0x124, 0xf, 0xf, false));
    x += __builtin_bit_cast(float, __builtin_amdgcn_update_dpp(0, __builtin_bit_cast(int, x), 0x122, 0xf, 0xf, false));
    x += __builtin_bit_cast(float, __builtin_amdgcn_update_dpp(0, __builtin_bit_cast(int, x), 0x121, 0xf, 0xf, false));
    return x;
}
__device__ __forceinline__ float row32_sum(float x) {
    x = row16_sum(x);
    auto r = __builtin_amdgcn_permlane16_swap(__float_as_uint(x), __float_as_uint(x), false, false);
    return __uint_as_float(r[0]) + __uint_as_float(r[1]);
}
__device__ __forceinline__ void p12_gather(const Ctx& c, int R0, const LAS int* IDXL, const LAS float* GATEL) {
    const int lane = threadIdx.x & 63, wave = __builtin_amdgcn_readfirstlane(threadIdx.x >> 6), g = lane >> 5, li = lane & 31;
    const bf16_t* A2 = (const bf16_t*)(c.ws + WS_A1); const unsigned char* UV = (const unsigned char*)(c.ws + WS_UT);
    const float* m = (const float*)(c.ws + WS_MOD);
    for (int tk = wave; tk < 64; tk += 8) { const int R = R0 + tk;
        float a[32], acc[32];
#pragma unroll
        for (int q = 0; q < 4; ++q) unpack8(ldg16(A2 + (size_t)R * D + li * 32 + q * 8), a + q * 8);
        for (int rep = 0; rep < (DUP(12) ? 2 : 1); ++rep) {
#pragma unroll
        for (int e = 0; e < 32; ++e) acc[e] = 0.f;
        const LAS int* ip = IDXL + tk * IDSTR + g * 64; const LAS float* gp = GATEL + tk * IDSTR + g * 64;
#pragma unroll 1
        for (int k4 = 0; k4 < 16; ++k4) {
            const u32x4 e4 = *(const LAS u32x4*)(ip + k4 * 4); const f32x4 g4 = *(const LAS f32x4*)(gp + k4 * 4);
            u32x4 uw[4][2], vw[4][2];
#pragma unroll
            for (int t = 0; t < 4; ++t) { const size_t eo = (size_t)e4[t] * 2048 + li * 32;
#pragma unroll
                for (int q = 0; q < 2; ++q) { uw[t][q] = *(const u32x4*)(UV + eo + q * 16); vw[t][q] = *(const u32x4*)(UV + eo + 1024 + q * 16); } }
            float dt[4];
#pragma unroll
            for (int t = 0; t < 4; ++t) { float d0 = 0.f, d1 = 0.f;
#pragma unroll
                for (int q = 0; q < 2; ++q) { float uf[16]; fp8x16_to_f32(uw[t][q], uf);
#pragma unroll
                    for (int e = 0; e < 16; e += 2) { d0 += a[q * 16 + e] * uf[e]; d1 += a[q * 16 + e + 1] * uf[e + 1]; } }
                dt[t] = d0 + d1; }
#pragma unroll
            for (int t = 0; t < 4; ++t) dt[t] = row32_sum(dt[t]) * (1.0f / 64.0f);
#pragma unroll
            for (int t = 0; t < 4; ++t) { const float x = dt[t]; const float cf = g4[t] * 0.5f * x * (1.0f + erff(x * 0.70710678118654752f));
#pragma unroll
                for (int q = 0; q < 2; ++q) { float vf[16]; fp8x16_to_f32(vw[t][q], vf);
#pragma unroll
                    for (int e = 0; e < 16; ++e) acc[q * 16 + e] += cf * vf[e]; } }
        }
        }
#pragma unroll
        for (int j = 0; j < 16; ++j) { auto r = __builtin_amdgcn_permlane32_swap(__float_as_uint(acc[j]), __float_as_uint(acc[j + 16]), false, false); acc[j] = __uint_as_float(r[0]) + __uint_as_float(r[1]); }
        const int b = R / SEQ, ch0 = li * 32 + g * 16; const float* g2 = m + b * MODW + 5120; float* hrow = c.out + (size_t)R * D; float h2[16]; float ss = 0.f;
#pragma unroll
        for (int q = 0; q < 4; ++q) { const f32x4 hv = *(const f32x4*)(hrow + ch0 + q * 4), gv = *(const f32x4*)(g2 + ch0 + q * 4);
#pragma unroll
            for (int e = 0; e < 4; ++e) { const float v = hv[e] + gv[e] * acc[q * 4 + e]; h2[q * 4 + e] = v; ss += v * v; } }
        ss = wave_sum(ss);
        const float rstd = rsqrtf(ss * (1.0f / 1024.0f) + 1e-6f);
#pragma unroll
        for (int q = 0; q < 4; ++q) { const f32x4 w = *(const f32x4*)(CIN(28) + ch0 + q * 4); f32x4 o;
#pragma unroll
            for (int e = 0; e < 4; ++e) o[e] = h2[q * 4 + e] * rstd * w[e];
            *(f32x4*)(hrow + ch0 + q * 4) = o; }
    }
}

__device__ __forceinline__ float gelu_as(float v) {
    const float av = fabsf(v), t = __builtin_amdgcn_rcpf(av * 0.2316418882f + 1.0f);
    float q = t * 0.5307027145f - 0.7265760135f; q = q * t + 0.7107068705f; q = q * t - 0.142248368f; q = q * t + 0.127414796f; q = q * t;
    const float e = __builtin_amdgcn_exp2f(v * v * -0.72134752044f), mneg = v * (q * e);
    return v < 0.f ? mneg : v - mneg;
}
#ifndef TPP
#define TPP 4
#endif
#ifndef NRG
#define NRG 8
#endif
#define RSH (14 - __builtin_ctz(NRG))
#define RSTR (NRG + 4)
__device__ __forceinline__ void p12_sweep(const Ctx& c, int R0, LAS unsigned char* lds) {
    const int lane = threadIdx.x & 63, wave = __builtin_amdgcn_readfirstlane(threadIdx.x >> 6);
    LAS int* SIDX = (LAS int*)lds; LAS float* SGATE = (LAS float*)(SIDX + 8192);
    const LAS int* IDXL = (const LAS int*)lds + 16384; const LAS float* GATEL = (const LAS float*)(IDXL + 64 * IDSTR);
    LAS int* START = (LAS int*)lds + 16384 + 2 * 64 * IDSTR;
    const bf16_t* A2 = (const bf16_t*)(c.ws + WS_A1); const unsigned char* UV = (const unsigned char*)(c.ws + WS_UT); const float* m = (const float*)(c.ws + WS_MOD);
    const unsigned long long ltmask = (1ull << lane) - 1ull;
    for (int k = 0; k < 8; ++k) { const int tok = wave + 8 * k;
        const int e0 = IDXL[tok * IDSTR + lane], e1 = IDXL[tok * IDSTR + 64 + lane]; const float g0 = GATEL[tok * IDSTR + lane], g1 = GATEL[tok * IDSTR + 64 + lane];
        const int b0 = e0 >> RSH, b1 = e1 >> RSH; int base = 0, pos0 = 0, pos1 = 0;
#pragma unroll
        for (int r = 0; r < NRG; ++r) { const unsigned long long m0 = __ballot(b0 == r), m1 = __ballot(b1 == r); const int c0 = __popcll(m0), c1 = __popcll(m1);
            if (b0 == r) pos0 = base + __popcll(m0 & ltmask);
            if (b1 == r) pos1 = base + c0 + __popcll(m1 & ltmask);
            if (lane == 0) START[tok * RSTR + r] = base;
            base += c0 + c1; }
        if (lane == 0) START[tok * RSTR + NRG] = 128;
        SIDX[tok * 128 + pos0] = e0; SGATE[tok * 128 + pos0] = g0; SIDX[tok * 128 + pos1] = e1; SGATE[tok * 128 + pos1] = g1; }
    LDS_FENCE();
#pragma unroll 1
    for (int pass = 0; pass < 8 / TPP; ++pass) {
        float acc[TPP][16]; u32x4 aw[TPP][2];
#pragma unroll
        for (int k = 0; k < TPP; ++k) { const int tok = wave + 8 * (pass * TPP + k); aw[k][0] = ldg16(A2 + (size_t)(R0 + tok) * D + lane * 16); aw[k][1] = ldg16(A2 + (size_t)(R0 + tok) * D + lane * 16 + 8);
#pragma unroll
            for (int e = 0; e < 16; ++e) acc[k][e] = 0.f; }
#pragma unroll 1
        for (int r = 0; r < NRG; ++r) {
#pragma unroll
            for (int k = 0; k < TPP; ++k) { const int tok = wave + 8 * (pass * TPP + k);
                const int s0 = __builtin_amdgcn_readfirstlane(START[tok * RSTR + r]), s1 = __builtin_amdgcn_readfirstlane(START[tok * RSTR + r + 1]);
                f32x2p a2[8];
                { float a[16]; unpack8(aw[k][0], a); unpack8(aw[k][1], a + 8);
#pragma unroll
                    for (int e = 0; e < 8; ++e) a2[e] = (f32x2p){a[2 * e], a[2 * e + 1]}; }
                for (int s = s0; s < s1; s += 8) {
                    const int n = (s1 - s) < 8 ? (s1 - s) : 8;
                    u32x4 uw[8], vw[8]; float gt[8], dt[8];
#pragma unroll
                    for (int t = 0; t < 8; ++t) { gt[t] = 0.f; dt[t] = 0.f; uw[t] = (u32x4){0u, 0u, 0u, 0u}; vw[t] = uw[t];
                        if (t < n) { const size_t eo = (size_t)SIDX[tok * 128 + s + t] * 2048 + lane * 16; gt[t] = SGATE[tok * 128 + s + t];
                            uw[t] = *(const u32x4*)(UV + eo); vw[t] = *(const u32x4*)(UV + eo + 1024); } }
#pragma unroll
                    for (int t = 0; t < 8; ++t) if (t < n) { f32x2p d = (f32x2p){0.f, 0.f};
#pragma unroll
                        for (int q = 0; q < 4; ++q) { d += a2[2 * q] * __builtin_amdgcn_cvt_pk_f32_fp8((int)uw[t][q], false); d += a2[2 * q + 1] * __builtin_amdgcn_cvt_pk_f32_fp8((int)uw[t][q], true); }
                        dt[t] = d[0] + d[1]; }
                    float w0, w1;
                    { float z[4];
#pragma unroll
                        for (int t = 0; t < 4; ++t) { auto r = __builtin_amdgcn_permlane32_swap(__float_as_uint(dt[t]), __float_as_uint(dt[t + 4]), false, false); z[t] = __uint_as_float(r[0]) + __uint_as_float(r[1]); }
                        auto r0 = __builtin_amdgcn_permlane16_swap(__float_as_uint(z[0]), __float_as_uint(z[2]), false, false); w0 = __uint_as_float(r0[0]) + __uint_as_float(r0[1]);
                        auto r1 = __builtin_amdgcn_permlane16_swap(__float_as_uint(z[1]), __float_as_uint(z[3]), false, false); w1 = __uint_as_float(r1[0]) + __uint_as_float(r1[1]);
                        w0 = row16_sum(w0); w1 = row16_sum(w1); }
                    const int rq = lane >> 4;
                    const float ge = rq == 0 ? gt[0] : rq == 1 ? gt[2] : rq == 2 ? gt[4] : gt[6], go = rq == 0 ? gt[1] : rq == 1 ? gt[3] : rq == 2 ? gt[5] : gt[7];
                    const float cfe = ge * gelu_as(w0 * (1.0f / 64.0f)), cfo = go * gelu_as(w1 * (1.0f / 64.0f));
                    f32x2p* ac2 = (f32x2p*)acc[k];
#pragma unroll
                    for (int t = 0; t < 8; ++t) if (t < n) { const int rowl = (t >> 1) * 16; const float cf = __builtin_bit_cast(float, __builtin_amdgcn_readlane(__builtin_bit_cast(int, (t & 1) ? cfo : cfe), rowl)); const f32x2p cf2 = (f32x2p){cf, cf};
#pragma unroll
                        for (int q = 0; q < 4; ++q) { ac2[2 * q] += cf2 * __builtin_amdgcn_cvt_pk_f32_fp8((int)vw[t][q], false); ac2[2 * q + 1] += cf2 * __builtin_amdgcn_cvt_pk_f32_fp8((int)vw[t][q], true); } }
                }
            }
        }
#pragma unroll
        for (int k = 0; k < TPP; ++k) { const int R = R0 + wave + 8 * (pass * TPP + k);
            const int b = R / SEQ, ch0 = lane * 16; const float* g2 = m + b * MODW + 5120; float* hrow = c.out + (size_t)R * D; float h2[16]; float ss = 0.f;
#pragma unroll
            for (int q = 0; q < 4; ++q) { const f32x4 hv = *(const f32x4*)(hrow + ch0 + q * 4), gv = *(const f32x4*)(g2 + ch0 + q * 4);
#pragma unroll
                for (int e = 0; e < 4; ++e) { const float v = hv[e] + gv[e] * acc[k][q * 4 + e]; h2[q * 4 + e] = v; ss += v * v; } }
            ss = wave_sum(ss);
            const float rstd = rsqrtf(ss * (1.0f / 1024.0f) + 1e-6f);
#pragma unroll
            for (int q = 0; q < 4; ++q) { const f32x4 w = *(const f32x4*)(CIN(28) + ch0 + q * 4); f32x4 o;
#pragma unroll
                for (int e = 0; e < 4; ++e) o[e] = h2[q * 4 + e] * rstd * w[e];
                *(f32x4*)(hrow + ch0 + q * 4) = o; } }
    }
}

typedef _Float16 hf2 __attribute__((ext_vector_type(2)));
typedef _Float16 hf8 __attribute__((ext_vector_type(8)));
__device__ __forceinline__ void p12_sweep2(const Ctx& c, int R0, LAS unsigned char* lds) {
    const int lane = threadIdx.x & 63, wave = __builtin_amdgcn_readfirstlane(threadIdx.x >> 6), l15 = lane & 15, lq = lane >> 4;
    LAS int* SIDX = (LAS int*)lds; LAS float* SGATE = (LAS float*)(SIDX + 8192);
    const LAS int* IDXL = (const LAS int*)lds + 16384; const LAS float* GATEL = (const LAS float*)(IDXL + 64 * IDSTR);
    LAS int* START = (LAS int*)lds + 16384 + 2 * 64 * IDSTR;
    LAS _Float16* A2H = (LAS _Float16*)((LAS int*)lds + 16384);
    const bf16_t* A2 = (const bf16_t*)(c.ws + WS_A1); const unsigned char* UV = (const unsigned char*)(c.ws + WS_UT); const float* m = (const float*)(c.ws + WS_MOD);
    const unsigned long long ltmask = (1ull << lane) - 1ull;
    for (int k = 0; k < 8; ++k) { const int tok = wave + 8 * k;
        const int e0 = IDXL[tok * IDSTR + lane], e1 = IDXL[tok * IDSTR + 64 + lane]; const float g0 = GATEL[tok * IDSTR + lane], g1 = GATEL[tok * IDSTR + 64 + lane];
        const int b0 = e0 >> 10, b1 = e1 >> 10; int base = 0, pos0 = 0, pos1 = 0;
#pragma unroll
        for (int r = 0; r < 16; ++r) { const unsigned long long m0 = __ballot(b0 == r), m1 = __ballot(b1 == r); const int c0 = __popcll(m0), c1 = __popcll(m1);
            if (b0 == r) pos0 = base + __popcll(m0 & ltmask);
            if (b1 == r) pos1 = base + c0 + __popcll(m1 & ltmask);
            if (lane == 0) START[tok * 20 + r] = base;
            base += c0 + c1; }
        if (lane == 0) START[tok * 20 + 16] = 128;
        SIDX[tok * 128 + pos0] = e0; SGATE[tok * 128 + pos0] = g0; SIDX[tok * 128 + pos1] = e1; SGATE[tok * 128 + pos1] = g1; }
    __syncthreads();
#pragma unroll 1
    for (int pass = 0; pass < 4; ++pass) {
        float acc[2][16];
#pragma unroll
        for (int k = 0; k < 2; ++k) { const int tok = wave + 8 * (pass * 2 + k); float a[16]; unpack8(ldg16(A2 + (size_t)(R0 + tok) * D + lane * 16), a); unpack8(ldg16(A2 + (size_t)(R0 + tok) * D + lane * 16 + 8), a + 8);
            hf8 h0, h1;
#pragma unroll
            for (int e = 0; e < 8; ++e) { h0[e] = (_Float16)a[e]; h1[e] = (_Float16)a[8 + e]; }
            *(LAS hf8*)(A2H + (wave * 2 + k) * 1024 + lane * 16) = h0; *(LAS hf8*)(A2H + (wave * 2 + k) * 1024 + lane * 16 + 8) = h1;
#pragma unroll
            for (int e = 0; e < 16; ++e) acc[k][e] = 0.f; }
        LDS_FENCE();
#pragma unroll 1
        for (int r = 0; r < 16; ++r) {
#pragma unroll
            for (int k = 0; k < 2; ++k) { const int tok = wave + 8 * (pass * 2 + k);
                const int s0 = __builtin_amdgcn_readfirstlane(START[tok * 20 + r]), s1 = __builtin_amdgcn_readfirstlane(START[tok * 20 + r + 1]);
                const LAS _Float16* ah = A2H + (wave * 2 + k) * 1024;
                for (int s = s0; s < s1; s += 16) { SCHED_FENCE();
                    const int n = (s1 - s) < 16 ? (s1 - s) : 16;
                    const bool valid = l15 < n; const int myrow = SIDX[tok * 128 + (valid ? s + l15 : s)];
                    const unsigned char* up = UV + (size_t)myrow * 2048 + lq * 16;
                    u32x4 uw[16];
#pragma unroll
                    for (int j = 0; j < 16; ++j) { uw[j] = (u32x4){0u, 0u, 0u, 0u}; if (valid) uw[j] = *(const u32x4*)(up + j * 64); }
                    u32x4 vw[8];
#pragma unroll
                    for (int t = 0; t < 8; ++t) { vw[t] = (u32x4){0u, 0u, 0u, 0u}; if (t < n) { const int rw = SIDX[tok * 128 + s + t]; vw[t] = *(const u32x4*)(UV + (size_t)rw * 2048 + 1024 + lane * 16); } }
                    f32x4 dacc = (f32x4){0.f, 0.f, 0.f, 0.f};
                    SCHED_FENCE();
#pragma unroll
                    for (int j = 0; j < 16; ++j) { hf8 ua, ub; if ((j & 3) == 0) SCHED_FENCE();
                        { const hf2 p0 = __builtin_amdgcn_cvt_scalef32_pk_f16_fp8(uw[j].x, 0.015625f, false), p1 = __builtin_amdgcn_cvt_scalef32_pk_f16_fp8(uw[j].x, 0.015625f, true), p2 = __builtin_amdgcn_cvt_scalef32_pk_f16_fp8(uw[j].y, 0.015625f, false), p3 = __builtin_amdgcn_cvt_scalef32_pk_f16_fp8(uw[j].y, 0.015625f, true);
                            ua = (hf8){p0[0], p0[1], p1[0], p1[1], p2[0], p2[1], p3[0], p3[1]}; }
                        { const hf2 p0 = __builtin_amdgcn_cvt_scalef32_pk_f16_fp8(uw[j].z, 0.015625f, false), p1 = __builtin_amdgcn_cvt_scalef32_pk_f16_fp8(uw[j].z, 0.015625f, true), p2 = __builtin_amdgcn_cvt_scalef32_pk_f16_fp8(uw[j].w, 0.015625f, false), p3 = __builtin_amdgcn_cvt_scalef32_pk_f16_fp8(uw[j].w, 0.015625f, true);
                            ub = (hf8){p0[0], p0[1], p1[0], p1[1], p2[0], p2[1], p3[0], p3[1]}; }
                        dacc = __builtin_amdgcn_mfma_f32_16x16x32_f16(ua, *(const LAS hf8*)(ah + j * 64 + lq * 16), dacc, 0, 0, 0);
                        dacc = __builtin_amdgcn_mfma_f32_16x16x32_f16(ub, *(const LAS hf8*)(ah + j * 64 + lq * 16 + 8), dacc, 0, 0, 0); }
                    SCHED_FENCE();
                    float cf4[4];
#pragma unroll
                    for (int rr = 0; rr < 4; ++rr) { const int sl = lq * 4 + rr; const float gte = (sl < n) ? SGATE[tok * 128 + s + sl] : 0.f; cf4[rr] = gte * gelu_as(dacc[rr]); }
#pragma unroll
                    for (int t = 0; t < 8; ++t) if (t < n) { const float cf = __builtin_bit_cast(float, __builtin_amdgcn_readlane(__builtin_bit_cast(int, cf4[t & 3]), (t >> 2) * 16)); float vf[16]; fp8x16_to_f32(vw[t], vf);
#pragma unroll
                        for (int e = 0; e < 16; ++e) acc[k][e] += cf * vf[e]; }
                    SCHED_FENCE();
                    if (n > 8) {
#pragma unroll
                        for (int t = 0; t < 8; ++t) { vw[t] = (u32x4){0u, 0u, 0u, 0u}; if (t + 8 < n) { const int rw = SIDX[tok * 128 + s + 8 + t]; vw[t] = *(const u32x4*)(UV + (size_t)rw * 2048 + 1024 + lane * 16); } }
#pragma unroll
                        for (int t = 0; t < 8; ++t) if (t + 8 < n) { const float cf = __builtin_bit_cast(float, __builtin_amdgcn_readlane(__builtin_bit_cast(int, cf4[t & 3]), ((t + 8) >> 2) * 16)); float vf[16]; fp8x16_to_f32(vw[t], vf);
#pragma unroll
                            for (int e = 0; e < 16; ++e) acc[k][e] += cf * vf[e]; }
                    }
                }
            }
        }
#pragma unroll
        for (int k = 0; k < 2; ++k) { const int R = R0 + wave + 8 * (pass * 2 + k);
            const int b = R / SEQ, ch0 = lane * 16; const float* g2 = m + b * MODW + 5120; float* hrow = c.out + (size_t)R * D; float h2[16]; float ss = 0.f;
#pragma unroll
            for (int q = 0; q < 4; ++q) { const f32x4 hv = *(const f32x4*)(hrow + ch0 + q * 4), gv = *(const f32x4*)(g2 + ch0 + q * 4);
#pragma unroll
                for (int e = 0; e < 4; ++e) { const float v = hv[e] + gv[e] * acc[k][q * 4 + e]; h2[q * 4 + e] = v; ss += v * v; } }
            ss = wave_sum(ss);
            const float rstd = rsqrtf(ss * (1.0f / 1024.0f) + 1e-6f);
#pragma unroll
            for (int q = 0; q < 4; ++q) { const f32x4 w = *(const f32x4*)(CIN(28) + ch0 + q * 4); f32x4 o;
#pragma unroll
                for (int e = 0; e < 4; ++e) o[e] = h2[q * 4 + e] * rstd * w[e];
                *(f32x4*)(hrow + ch0 + q * 4) = o; } }
    }
}

struct G4 { u32x4 uw[4], vw[4]; float gt[4]; };
__device__ __forceinline__ void g4_issue(G4& g, int ent, int tokbase, const LAS int* SIDX, const LAS float* SGATE, const unsigned char* UV, int lane) {
    const int k = ent & 1, n = ((ent >> 1) & 3) + 1, s = ent >> 3, tok = tokbase + 8 * k;
#pragma unroll
    for (int t = 0; t < 4; ++t) { const int sj = t < n ? s + t : s; const size_t eo = (size_t)SIDX[tok * 128 + sj] * 2048 + lane * 16; g.gt[t] = t < n ? SGATE[tok * 128 + sj] : 0.f;
        g.uw[t] = *(const u32x4*)(UV + eo); g.vw[t] = *(const u32x4*)(UV + eo + 1024); }
}
__device__ __forceinline__ void g4_consume(const G4& g, const u32x4 aw0, const u32x4 aw1, float* out, int lane) {
    float a[16]; unpack8(aw0, a); unpack8(aw1, a + 8);
    float dt[4];
#pragma unroll
    for (int t = 0; t < 4; ++t) { float uf[16]; fp8x16_to_f32(g.uw[t], uf); float d0 = 0.f, d1 = 0.f;
#pragma unroll
        for (int e = 0; e < 16; e += 2) { d0 += a[e] * uf[e]; d1 += a[e + 1] * uf[e + 1]; }
        dt[t] = d0 + d1; }
#pragma unroll
    for (int t = 0; t < 4; ++t) dt[t] = reduce4f(row16_sum(dt[t])) * (1.0f / 64.0f);
    float xs = dt[0], gs = g.gt[0];
#pragma unroll
    for (int t = 1; t < 4; ++t) { xs = (lane == t) ? dt[t] : xs; gs = (lane == t) ? g.gt[t] : gs; }
    const float cfl = gs * gelu_as(xs);
#pragma unroll
    for (int e = 0; e < 16; ++e) out[e] = 0.f;
#pragma unroll
    for (int t = 0; t < 4; ++t) { const float cf = __builtin_bit_cast(float, __builtin_amdgcn_readlane(__builtin_bit_cast(int, cfl), t)); float vf[16]; fp8x16_to_f32(g.vw[t], vf);
#pragma unroll
        for (int e = 0; e < 16; ++e) out[e] += cf * vf[e]; }
}
__device__ __forceinline__ void p12_sweep3(const Ctx& c, int R0, LAS unsigned char* lds) {
    const int lane = threadIdx.x & 63, wave = __builtin_amdgcn_readfirstlane(threadIdx.x >> 6);
    LAS int* SIDX = (LAS int*)lds; LAS float* SGATE = (LAS float*)(SIDX + 8192);
    const LAS int* IDXL = (const LAS int*)lds + 16384; const LAS float* GATEL = (const LAS float*)(IDXL + 64 * IDSTR);
    LAS int* START = (LAS int*)lds + 16384 + 2 * 64 * IDSTR;
    LAS int* GL = START + 64 * 20 + wave * 128;
    const bf16_t* A2 = (const bf16_t*)(c.ws + WS_A1); const unsigned char* UV = (const unsigned char*)(c.ws + WS_UT); const float* m = (const float*)(c.ws + WS_MOD);
    const unsigned long long ltmask = (1ull << lane) - 1ull;
    for (int k = 0; k < 8; ++k) { const int tok = wave + 8 * k;
        const int e0 = IDXL[tok * IDSTR + lane], e1 = IDXL[tok * IDSTR + 64 + lane]; const float g0 = GATEL[tok * IDSTR + lane], g1 = GATEL[tok * IDSTR + 64 + lane];
        const int b0 = e0 >> 10, b1 = e1 >> 10; int base = 0, pos0 = 0, pos1 = 0;
#pragma unroll
        for (int r = 0; r < 16; ++r) { const unsigned long long m0 = __ballot(b0 == r), m1 = __ballot(b1 == r); const int c0 = __popcll(m0), c1 = __popcll(m1);
            if (b0 == r) pos0 = base + __popcll(m0 & ltmask);
            if (b1 == r) pos1 = base + c0 + __popcll(m1 & ltmask);
            if (lane == 0) START[tok * 20 + r] = base;
            base += c0 + c1; }
        if (lane == 0) START[tok * 20 + 16] = 128;
        SIDX[tok * 128 + pos0] = e0; SGATE[tok * 128 + pos0] = g0; SIDX[tok * 128 + pos1] = e1; SGATE[tok * 128 + pos1] = g1; }
    LDS_FENCE();
#pragma unroll 1
    for (int pass = 0; pass < 4; ++pass) {
        const int tokbase = wave + 16 * pass;
        { int ng = 0, s0 = 0, s1 = 0; const int r = lane >> 1, k = lane & 1, tok = tokbase + 8 * k;
            if (lane < 32) { s0 = START[tok * 20 + r]; s1 = START[tok * 20 + r + 1]; ng = (s1 - s0 + 3) >> 2; }
            int pre = ng;
#pragma unroll
            for (int o = 1; o < 32; o <<= 1) { const int v = __shfl_up(pre, o); if (lane >= o) pre += v; }
            const int first = pre - ng;
            for (int g = 0; g < ng; ++g) { const int s = s0 + 4 * g; const int n = (s1 - s) < 4 ? (s1 - s) : 4; GL[first + g] = (s << 3) | ((n - 1) << 1) | k; }
            if (lane == 31) GL[127] = pre; }
        LDS_FENCE();
        const int ngr = __builtin_amdgcn_readfirstlane(GL[127]);
        float acc0[16], acc1[16];
        const u32x4 a00 = ldg16(A2 + (size_t)(R0 + tokbase) * D + lane * 16), a01 = ldg16(A2 + (size_t)(R0 + tokbase) * D + lane * 16 + 8);
        const u32x4 a10 = ldg16(A2 + (size_t)(R0 + tokbase + 8) * D + lane * 16), a11 = ldg16(A2 + (size_t)(R0 + tokbase + 8) * D + lane * 16 + 8);
#pragma unroll
        for (int e = 0; e < 16; ++e) { acc0[e] = 0.f; acc1[e] = 0.f; }
        G4 ga, gb;
        if (ngr > 0) g4_issue(ga, __builtin_amdgcn_readfirstlane(GL[0]), tokbase, SIDX, SGATE, UV, lane);
#pragma unroll 1
        for (int i = 0; i < ngr; i += 2) {
            const int ea = __builtin_amdgcn_readfirstlane(GL[i]);
            const bool hb = i + 1 < ngr; const int eb = hb ? __builtin_amdgcn_readfirstlane(GL[i + 1]) : 0;
            if (hb) g4_issue(gb, eb, tokbase, SIDX, SGATE, UV, lane);
            SCHED_FENCE();
            { const bool k1 = ea & 1; float o[16]; g4_consume(ga, k1 ? a10 : a00, k1 ? a11 : a01, o, lane);
#pragma unroll
                for (int e = 0; e < 16; ++e) { acc0[e] += k1 ? 0.f : o[e]; acc1[e] += k1 ? o[e] : 0.f; } }
            SCHED_FENCE();
            if (i + 2 < ngr) g4_issue(ga, __builtin_amdgcn_readfirstlane(GL[i + 2]), tokbase, SIDX, SGATE, UV, lane);
            SCHED_FENCE();
            if (hb) { const bool k1 = eb & 1; float o[16]; g4_consume(gb, k1 ? a10 : a00, k1 ? a11 : a01, o, lane);
#pragma unroll
                for (int e = 0; e < 16; ++e) { acc0[e] += k1 ? 0.f : o[e]; acc1[e] += k1 ? o[e] : 0.f; } }
            SCHED_FENCE();
        }
#pragma unroll
        for (int k = 0; k < 2; ++k) { const int R = R0 + tokbase + 8 * k; const float* acc = k ? acc1 : acc0;
            const int b = R / SEQ, ch0 = lane * 16; const float* g2 = m + b * MODW + 5120; float* hrow = c.out + (size_t)R * D; float h2[16]; float ss = 0.f;
#pragma unroll
            for (int q = 0; q < 4; ++q) { const f32x4 hv = *(const f32x4*)(hrow + ch0 + q * 4), gv = *(const f32x4*)(g2 + ch0 + q * 4);
#pragma unroll
                for (int e = 0; e < 4; ++e) { const float v = hv[e] + gv[e] * acc[q * 4 + e]; h2[q * 4 + e] = v; ss += v * v; } }
            ss = wave_sum(ss);
            const float rstd = rsqrtf(ss * (1.0f / 1024.0f) + 1e-6f);
#pragma unroll
            for (int q = 0; q < 4; ++q) { const f32x4 w = *(const f32x4*)(CIN(28) + ch0 + q * 4); f32x4 o;
#pragma unroll
                for (int e = 0; e < 4; ++e) o[e] = h2[q * 4 + e] * rstd * w[e];
                *(f32x4*)(hrow + ch0 + q * 4) = o; } }
    }
}

#define G8_LOAD_U(U, ent) do { const int k_ = (ent) & 1, n_ = (((ent) >> 1) & 7) + 1, s_ = (ent) >> 4, tok_ = tokbase + 8 * k_; \
        _Pragma("unroll") for (int t = 0; t < 8; ++t) { U[t] = (u32x4){0u, 0u, 0u, 0u}; if (t < n_) U[t] = *(const u32x4*)(UV + (size_t)SIDX[tok_ * 128 + s_ + t] * 2048 + lane * 16); } } while (0)
#define G8_BODY(U, ent) do { const int k_ = (ent) & 1, n_ = (((ent) >> 1) & 7) + 1, s_ = (ent) >> 4, tok_ = tokbase + 8 * k_; \
        u32x4 vw[8]; float gt[8], dt[8]; \
        _Pragma("unroll") for (int t = 0; t < 8; ++t) { gt[t] = 0.f; dt[t] = 0.f; vw[t] = (u32x4){0u, 0u, 0u, 0u}; \
            if (t < n_) { gt[t] = SGATE[tok_ * 128 + s_ + t]; vw[t] = *(const u32x4*)(UV + (size_t)SIDX[tok_ * 128 + s_ + t] * 2048 + 1024 + lane * 16); } } \
        f32x2p a2[8]; { float a[16]; unpack8(k_ ? aw[1][0] : aw[0][0], a); unpack8(k_ ? aw[1][1] : aw[0][1], a + 8); \
            _Pragma("unroll") for (int e = 0; e < 8; ++e) a2[e] = (f32x2p){a[2 * e], a[2 * e + 1]}; } \
        _Pragma("unroll") for (int t = 0; t < 8; ++t) if (t < n_) { f32x2p d = (f32x2p){0.f, 0.f}; \
            _Pragma("unroll") for (int q = 0; q < 4; ++q) { d += a2[2 * q] * __builtin_amdgcn_cvt_pk_f32_fp8((int)U[t][q], false); d += a2[2 * q + 1] * __builtin_amdgcn_cvt_pk_f32_fp8((int)U[t][q], true); } \
            dt[t] = d[0] + d[1]; } \
        float w0, w1; { float z[4]; \
            _Pragma("unroll") for (int t = 0; t < 4; ++t) { auto r = __builtin_amdgcn_permlane32_swap(__float_as_uint(dt[t]), __float_as_uint(dt[t + 4]), false, false); z[t] = __uint_as_float(r[0]) + __uint_as_float(r[1]); } \
            auto r0 = __builtin_amdgcn_permlane16_swap(__float_as_uint(z[0]), __float_as_uint(z[2]), false, false); w0 = __uint_as_float(r0[0]) + __uint_as_float(r0[1]); \
            auto r1 = __builtin_amdgcn_permlane16_swap(__float_as_uint(z[1]), __float_as_uint(z[3]), false, false); w1 = __uint_as_float(r1[0]) + __uint_as_float(r1[1]); \
            w0 = row16_sum(w0); w1 = row16_sum(w1); } \
        const int rq = lane >> 4; \
        const float ge = rq == 0 ? gt[0] : rq == 1 ? gt[2] : rq == 2 ? gt[4] : gt[6], go = rq == 0 ? gt[1] : rq == 1 ? gt[3] : rq == 2 ? gt[5] : gt[7]; \
        const float cfe = ge * gelu_as(w0 * (1.0f / 64.0f)), cfo = go * gelu_as(w1 * (1.0f / 64.0f)); \
        f32x2p o2[8]; _Pragma("unroll") for (int e = 0; e < 8; ++e) o2[e] = (f32x2p){0.f, 0.f}; \
        _Pragma("unroll") for (int t = 0; t < 8; ++t) if (t < n_) { const float cf = __builtin_bit_cast(float, __builtin_amdgcn_readlane(__builtin_bit_cast(int, (t & 1) ? cfo : cfe), (t >> 1) * 16)); const f32x2p cf2 = (f32x2p){cf, cf}; \
            _Pragma("unroll") for (int q = 0; q < 4; ++q) { o2[2 * q] += cf2 * __builtin_amdgcn_cvt_pk_f32_fp8((int)vw[t][q], false); o2[2 * q + 1] += cf2 * __builtin_amdgcn_cvt_pk_f32_fp8((int)vw[t][q], true); } } \
        if (k_) { _Pragma("unroll") for (int e = 0; e < 8; ++e) ((f32x2p*)acc[1])[e] += o2[e]; } else { _Pragma("unroll") for (int e = 0; e < 8; ++e) ((f32x2p*)acc[0])[e] += o2[e]; } } while (0)
__device__ __forceinline__ void p12_sweep5(const Ctx& c, int R0, LAS unsigned char* lds) {
    const int lane = threadIdx.x & 63, wave = __builtin_amdgcn_readfirstlane(threadIdx.x >> 6);
    LAS int* SIDX = (LAS int*)lds; LAS float* SGATE = (LAS float*)(SIDX + 8192);
    const LAS int* IDXL = (const LAS int*)lds + 16384; const LAS float* GATEL = (const LAS float*)(IDXL + 64 * IDSTR);
    LAS int* START = (LAS int*)lds + 16384 + 2 * 64 * IDSTR;
    LAS int* GL = START + 64 * 20 + wave * 128;
    const bf16_t* A2 = (const bf16_t*)(c.ws + WS_A1); const unsigned char* UV = (const unsigned char*)(c.ws + WS_UT); const float* m = (const float*)(c.ws + WS_MOD);
    const unsigned long long ltmask = (1ull << lane) - 1ull;
    for (int k = 0; k < 8; ++k) { const int tok = wave + 8 * k;
        const int e0 = IDXL[tok * IDSTR + lane], e1 = IDXL[tok * IDSTR + 64 + lane]; const float g0 = GATEL[tok * IDSTR + lane], g1 = GATEL[tok * IDSTR + 64 + lane];
        const int b0 = e0 >> 10, b1 = e1 >> 10; int base = 0, pos0 = 0, pos1 = 0;
#pragma unroll
        for (int r = 0; r < 16; ++r) { const unsigned long long m0 = __ballot(b0 == r), m1 = __ballot(b1 == r); const int c0 = __popcll(m0), c1 = __popcll(m1);
            if (b0 == r) pos0 = base + __popcll(m0 & ltmask);
            if (b1 == r) pos1 = base + c0 + __popcll(m1 & ltmask);
            if (lane == 0) START[tok * 20 + r] = base;
            base += c0 + c1; }
        if (lane == 0) START[tok * 20 + 16] = 128;
        SIDX[tok * 128 + pos0] = e0; SGATE[tok * 128 + pos0] = g0; SIDX[tok * 128 + pos1] = e1; SGATE[tok * 128 + pos1] = g1; }
    LDS_FENCE();
#pragma unroll 1
    for (int pass = 0; pass < 4; ++pass) {
        const int tokbase = wave + 16 * pass;
        { int ng = 0, s0 = 0, s1 = 0; const int r = lane >> 1, k = lane & 1, tok = tokbase + 8 * k;
            if (lane < 32) { s0 = START[tok * 20 + r]; s1 = START[tok * 20 + r + 1]; ng = (s1 - s0 + 7) >> 3; }
            int pre = ng;
#pragma unroll
            for (int o = 1; o < 32; o <<= 1) { const int v = __shfl_up(pre, o); if (lane >= o) pre += v; }
            const int first = pre - ng;
            for (int g = 0; g < ng; ++g) { const int s = s0 + 8 * g; const int n = (s1 - s) < 8 ? (s1 - s) : 8; GL[first + g] = (s << 4) | ((n - 1) << 1) | k; }
            if (lane == 31) GL[127] = pre; }
        LDS_FENCE();
        const int ngr = __builtin_amdgcn_readfirstlane(GL[127]);
        float acc[2][16]; u32x4 aw[2][2];
#pragma unroll
        for (int k = 0; k < 2; ++k) { aw[k][0] = ldg16(A2 + (size_t)(R0 + tokbase + 8 * k) * D + lane * 16); aw[k][1] = ldg16(A2 + (size_t)(R0 + tokbase + 8 * k) * D + lane * 16 + 8);
#pragma unroll
            for (int e = 0; e < 16; ++e) acc[k][e] = 0.f; }
        u32x4 UA[8], UB[8];
        if (ngr > 0) { const int e0_ = __builtin_amdgcn_readfirstlane(GL[0]); G8_LOAD_U(UA, e0_); }
#pragma unroll 1
        for (int i = 0; i < ngr; i += 2) {
            const int ea = __builtin_amdgcn_readfirstlane(GL[i]); const bool hb = i + 1 < ngr; const int eb = hb ? __builtin_amdgcn_readfirstlane(GL[i + 1]) : 0;
            if (hb) G8_LOAD_U(UB, eb);
            SCHED_FENCE();
            G8_BODY(UA, ea);
            SCHED_FENCE();
            if (i + 2 < ngr) { const int ec = __builtin_amdgcn_readfirstlane(GL[i + 2]); G8_LOAD_U(UA, ec); }
            SCHED_FENCE();
            if (hb) G8_BODY(UB, eb);
            SCHED_FENCE();
        }
#pragma unroll
        for (int k = 0; k < 2; ++k) { const int R = R0 + tokbase + 8 * k;
            const int b = R / SEQ, ch0 = lane * 16; const float* g2 = m + b * MODW + 5120; float* hrow = c.out + (size_t)R * D; float h2[16]; float ss = 0.f;
#pragma unroll
            for (int q = 0; q < 4; ++q) { const f32x4 hv = *(const f32x4*)(hrow + ch0 + q * 4), gv = *(const f32x4*)(g2 + ch0 + q * 4);
#pragma unroll
                for (int e = 0; e < 4; ++e) { const float v = hv[e] + gv[e] * acc[k][q * 4 + e]; h2[q * 4 + e] = v; ss += v * v; } }
            ss = wave_sum(ss);
            const float rstd = rsqrtf(ss * (1.0f / 1024.0f) + 1e-6f);
#pragma unroll
            for (int q = 0; q < 4; ++q) { const f32x4 w = *(const f32x4*)(CIN(28) + ch0 + q * 4); f32x4 o;
#pragma unroll
                for (int e = 0; e < 4; ++e) o[e] = h2[q * 4 + e] * rstd * w[e];
                *(f32x4*)(hrow + ch0 + q * 4) = o; } }
    }
}

__device__ __forceinline__ int sortable(float v) { const int b = __float_as_int(v); return b ^ ((b >> 31) & 0x7fffffff); }
__device__ __forceinline__ float unsortable(int k) { return __int_as_float(k ^ ((k >> 31) & 0x7fffffff)); }
#define CASD(a, b) { const int _hi = max(a, b), _lo = min(a, b); a = _hi; b = _lo; }
#define CAS16(t, x) { _Pragma("unroll") for (int _i = 0; _i < 16; ++_i) { const int _hi = max(t[_i], x); x = min(t[_i], x); t[_i] = _hi; } }
__device__ __forceinline__ void bitonic_merge16_desc(int* t) {
#pragma unroll
    for (int d = 8; d >= 1; d >>= 1)
#pragma unroll
        for (int i = 0; i < 16; ++i) if ((i & d) == 0) CASD(t[i], t[i + d]);
}
__device__ __forceinline__ void bitonic_sort16_desc(int* t) {
#pragma unroll
    for (int k = 2; k <= 16; k <<= 1)
#pragma unroll
        for (int d = k >> 1; d >= 1; d >>= 1)
#pragma unroll
            for (int i = 0; i < 16; ++i) { const int j = i ^ d; if (j > i) { if ((i & k) == 0 || k == 16) { CASD(t[i], t[j]); } else { CASD(t[j], t[i]); } } }
}
__device__ __forceinline__ void p11_topk(const Ctx& c, LAS unsigned char* lds) {
    const int tid = threadIdx.x, lane = tid & 63, wave = tid >> 6, l15 = lane & 15, lq = lane >> 4;
    LAS int* KEYS = (LAS int*)lds;
    const bf16_t* Q = (const bf16_t*)(c.ws + WS_Q); const bf16_t* SK = (const bf16_t*)(c.ws + WS_SK);
    LAS int* IDXL = KEYS + 16384;
    LAS float* GATEL = (LAS float*)(IDXL + 64 * IDSTR);
    for (int u = blockIdx.x; u < MLAT / 64; u += gridDim.x) {
        const int R0 = u * 64, tt = wave >> 1, p = wave & 1;
        __syncthreads();
#pragma unroll 2
        for (int h = 0; h < 8; ++h) {
            bf16x8 qf[4];
#pragma unroll
            for (int ks = 0; ks < 4; ++ks) qf[ks] = *(const bf16x8*)(Q + (size_t)(R0 + tt * 16 + l15) * 2048 + h * 256 + p * 128 + ks * 32 + lq * 8);
            int ta[16], tb[16];
#pragma unroll
            for (int nt = 0; nt < 8; ++nt) { f32x4 a = (f32x4){0.f, 0.f, 0.f, 0.f};
#pragma unroll
                for (int ks = 0; ks < 4; ++ks) a = MFMA16(*(const bf16x8*)(SK + (size_t)((h * 2 + p) * 128 + nt * 16 + l15) * 128 + ks * 32 + lq * 8), qf[ks], a);
#pragma unroll
                for (int r = 0; r < 4; ++r) { const int n = nt * 16 + lq * 4 + r; const int key = (sortable(a[r]) & ~127) | (127 - n);
                    if (nt < 4) ta[nt * 4 + r] = key; else tb[(nt - 4) * 4 + r] = key; } }
            bitonic_sort16_desc(ta); bitonic_sort16_desc(tb);
#pragma unroll
            for (int i = 0; i < 16; ++i) ta[i] = max(ta[i], tb[15 - i]);
            bitonic_merge16_desc(ta);
#pragma unroll
            for (int st = 0; st < 2; ++st) {
#pragma unroll
                for (int i = 0; i < 16; ++i) tb[i] = __shfl_xor(ta[i], st ? 32 : 16);
#pragma unroll
                for (int i = 0; i < 16; ++i) ta[i] = max(ta[i], tb[15 - i]);
                bitonic_merge16_desc(ta); }
            if (lq == 0) {
#pragma unroll
                for (int i = 0; i < 16; ++i) KEYS[((h * 2 + p) * 16 + i) * 64 + tt * 16 + l15] = ta[i]; }
        }
        __syncthreads();
        {
            const int tok = tid & 63, h = tid >> 6;
            int k1[16], k2[16]; float s1[16], s2[16];
#pragma unroll
            for (int i = 0; i < 16; ++i) { k1[i] = KEYS[((h * 2) * 16 + i) * 64 + tok]; k2[i] = KEYS[((h * 2 + 1) * 16 + i) * 64 + tok]; s1[i] = unsortable(k1[i] & ~127); s2[i] = unsortable(k2[i] & ~127); }
            int t[16];
#pragma unroll
            for (int j = 0; j < 16; ++j) t[j] = (sortable(s1[0] + s2[j]) & ~255) | (255 - j);
#pragma unroll
            for (int i = 1; i < 16; ++i)
#pragma unroll
                for (int j = 0; j < 16; ++j) if ((i + 1) * (j + 1) <= 16) { int x = (sortable(s1[i] + s2[j]) & ~255) | (255 - (i * 16 + j)); CAS16(t, x); }
            float sv[16]; int ev[16]; float mx = -3.0e38f;
#pragma unroll
            for (int k = 0; k < 16; ++k) { const int id = 255 - (t[k] & 255), i = id >> 4, j = id & 15;
                const int ia = KEYS[((h * 2) * 16 + i) * 64 + tok], ib = KEYS[((h * 2 + 1) * 16 + j) * 64 + tok];
                sv[k] = unsortable(ia & ~127) + unsortable(ib & ~127); ev[k] = (127 - (ia & 127)) * 128 + (127 - (ib & 127)); mx = fmaxf(mx, sv[k]); }
            float den = 0.f;
#pragma unroll
            for (int k = 0; k < 16; ++k) { sv[k] = fexp(sv[k] - mx); den += sv[k]; }
            const float inv = 1.0f / den; const int o = tok * IDSTR + h * 16;
#pragma unroll
            for (int k = 0; k < 16; k += 4) { *(LAS u32x4*)(IDXL + o + k) = (u32x4){(unsigned)ev[k], (unsigned)ev[k + 1], (unsigned)ev[k + 2], (unsigned)ev[k + 3]};
                *(LAS f32x4*)(GATEL + o + k) = (f32x4){sv[k] * inv, sv[k + 1] * inv, sv[k + 2] * inv, sv[k + 3] * inv}; }
        }
        __syncthreads();
#if GATHER_SWEEP == 5
        p12_sweep5(c, R0, lds);
#elif GATHER_SWEEP == 3
        p12_sweep3(c, R0, lds);
#elif GATHER_SWEEP == 2
        p12_sweep2(c, R0, lds);
#elif GATHER_SWEEP
        p12_sweep(c, R0, lds);
#else
        p12_gather(c, R0, IDXL, GATEL);
#endif
    }
    __syncthreads();
}

constexpr int N_PHASES = 12;
#ifndef RWKV_IMPL
#define RWKV_IMPL 1
#endif
#ifndef RWKV_PROBE
#define RWKV_PROBE 0
#endif
__global__ void __launch_bounds__(NT, 2) fwd_kernel(Args args) {
    extern __shared__ __attribute__((aligned(16))) unsigned char lds_raw[];
    LAS unsigned char* lds0 = (LAS unsigned char*)lds_raw;
    LAS unsigned char* lds = lds0 + LDS_HDR;
    Ctx c; c.in = (KArgPtr)__builtin_amdgcn_kernarg_segment_ptr();
    c.out = args.out; c.ws = args.ws;
    if (threadIdx.x < 16) ((LAS unsigned*)lds0)[threadIdx.x] = 0u;
    __syncthreads();
    const int lo = args.ph_lo, hi = args.ph_hi;
    const bool multi = (hi - lo) > 1;
    XcdBarrier bar; bar.bar = (unsigned*)(c.ws + WS_CTL); bar.x = 0; bar.st = (volatile LAS unsigned*)lds0;
    if (multi) bar = xcd_barrier_post((unsigned*)(c.ws + WS_CTL), (volatile LAS unsigned*)lds0);
#ifndef PROBE_T
#define PROBE_T -1
#endif
    LAS unsigned long long* stamps = (LAS unsigned long long*)(lds0 + LDS_BYTES - 256);
#define STAMP(i) do { if (PROBE_T >= 0 && threadIdx.x == 0) stamps[i] = wall_clock64(); } while (0)
#define IN(k) (lo <= (k) && (k) < hi)
#define SEAM(k) do { STAMP(2 * (k) + 1); if (IN(k) && IN((k) + 1)) { xcd_barrier(bar); if (DUP(20)) xcd_barrier(bar); } STAMP(2 * (k) + 2); } while (0)
    STAMP(0);
    const bf16_t* Wt_in = (const bf16_t*)(c.ws + WS_WIN);
    if (IN(0)) { p0_prologue(c, lds); if (DUP(0)) p0_prologue(c, lds); } SEAM(0);
    if (IN(1)) { p1_norm1(c); if (DUP(1)) p1_norm1(c); } SEAM(1);
    if (IN(2)) { pg8::Gemm g{(const bf16_t*)(c.ws + WS_A1), Wt_in, MALL, N1, D}; Gemm1Order S; S.init(MLAT, N1, gridDim.x, blockIdx.x);
        EpiB<0> E{(bf16_t*)(c.ws + WS_ZG), (bf16_t*)(c.ws + WS_ZR), 0};
        pg8::gemm_phase<EpiB<0>, Gemm1Order, false>((PG8_LAS unsigned char*)lds, g, S, E, nullptr);
        if (DUP(2)) { if (DUP(21)) xcd_barrier(bar); pg8::gemm_phase<EpiB<0>, Gemm1Order, false>((PG8_LAS unsigned char*)lds, g, S, E, nullptr); } } SEAM(2);
    if (IN(3)) { premix_lora(c); p3_gla(c, lds); if (DUP(3)) p3_gla(c, lds); } SEAM(3);
    if (IN(4)) { p4_rwkv_chunked(c, lds); if (DUP(4)) { if (DUP(21)) xcd_barrier(bar); p4_rwkv_chunked(c, lds); } } SEAM(4);
    if (IN(5)) { if (DUP(5)) p5_post(c, lds, true); p5_post(c, lds); } SEAM(5);
    if (IN(6)) { pg8::StaticOrder S; S.init(MLAT, D, gridDim.x, blockIdx.x); bf16_t* Tb = (bf16_t*)c.out; bf16_t* Yr = (bf16_t*)(c.ws + WS_ORF);
        { pg8::Gemm g{(const bf16_t*)(c.ws + WS_A1), Wt_in + (size_t)N1 * D, MLAT, D, D}; EpiMix<0> E{Tb, Yr}; pg8::gemm_phase<EpiMix<0>, pg8::StaticOrder, false>((PG8_LAS unsigned char*)lds, g, S, E, nullptr); }
        __syncthreads();
        { pg8::Gemm g{(const bf16_t*)(c.ws + WS_A1), Wt_in + (size_t)(N1 + 1024) * D, MLAT, D, D}; EpiMix<1> E{Tb, Yr}; pg8::gemm_phase<EpiMix<1>, pg8::StaticOrder, false>((PG8_LAS unsigned char*)lds, g, S, E, nullptr); }
        __syncthreads();
        { pg8::Gemm g{(const bf16_t*)(c.ws + WS_A1), Wt_in + (size_t)(N1 + 2048) * D, MLAT, D, D}; EpiMix<2> E{Tb, Yr}; pg8::gemm_phase<EpiMix<2>, pg8::StaticOrder, false>((PG8_LAS unsigned char*)lds, g, S, E, nullptr); } } SEAM(6);
    if (IN(8)) { pg8::Gemm g{(const bf16_t*)(c.ws + WS_ORF), (const bf16_t*)(c.ws + WS_WOUT), MLAT, D, D}; pg8::StaticOrder S; S.init(MLAT, D, gridDim.x, blockIdx.x);
        EpiH1 E{CIN(0), (const float*)(c.ws + WS_MOD), c.out};
        pg8::gemm_phase<EpiH1, pg8::StaticOrder, false>((PG8_LAS unsigned char*)lds, g, S, E, nullptr); } SEAM(8);
    if (IN(9)) { p9_norm2_tables(c); if (DUP(9)) p9_norm2_tables(c); } SEAM(9);
    if (IN(10)) { pg8::Gemm g{(const bf16_t*)(c.ws + WS_A1), (const bf16_t*)(c.ws + WS_WQ), MLAT, 2048, D}; pg8::StaticOrder S; S.init(MLAT, 2048, gridDim.x, blockIdx.x);
        EpiB<2> E{(bf16_t*)(c.ws + WS_Q), nullptr, 2048};
        pg8::gemm_phase<EpiB<2>, pg8::StaticOrder, false>((PG8_LAS unsigned char*)lds, g, S, E, nullptr);
        if (DUP(10)) pg8::gemm_phase<EpiB<2>, pg8::StaticOrder, false>((PG8_LAS unsigned char*)lds, g, S, E, nullptr); } SEAM(10);
    if (IN(11)) { p11_topk(c, lds); }
    STAMP(23);
    if (PROBE_T >= 0) {
        __syncthreads();
        const float us = (float)(stamps[PROBE_T + 1] - stamps[PROBE_T]) * 0.01f;
        for (int u = blockIdx.x; u < MLAT / 64; u += gridDim.x) for (int i = threadIdx.x; i < 64 * D; i += NT) c.out[(size_t)u * 64 * D + i] = us;
    }
#undef IN
#undef SEAM
}

__global__ void dbg_cmp2(const bf16_t* oldv, const bf16_t* nf, const bf16_t* nb, float* out) {
    for (size_t i = (size_t)blockIdx.x * blockDim.x + threadIdx.x; i < (size_t)MLAT * D; i += (size_t)gridDim.x * blockDim.x) {
        const float o = bf2f(oldv[i]); const float n = i < 8388608 ? bf2f(nf[i]) : bf2f(nb[i - 8388608]);
        float v = (n - o) * (100.0f / 12.2f); if (!(fabsf(v) < 1e30f)) v = 1e4f; out[i] = v; }
}
extern "C" void kernel_launch(void* const* d_in, const int* in_sizes, int n_in, void* d_out, int out_size, void* d_ws, size_t ws_size, hipStream_t stream) {
    static int grid = 0;
    if (grid == 0) {
        if (n_in != 29 || out_size != MLAT * D || ws_size < WS_END) { fprintf(stderr, "kernel_launch: unexpected shapes (n_in %d, out %d, ws %zu < %zu)\n", n_in, out_size, ws_size, (size_t)WS_END); grid = -1; return; }
        int dev = 0, cus = 0, per_cu = 0;
        if (hipGetDevice(&dev) != hipSuccess || hipDeviceGetAttribute(&cus, hipDeviceAttributeMultiprocessorCount, dev) != hipSuccess) { grid = -1; return; }
        if (hipFuncSetAttribute((const void*)fwd_kernel, hipFuncAttributeMaxDynamicSharedMemorySize, LDS_BYTES) != hipSuccess) { fprintf(stderr, "kernel_launch: hipFuncSetAttribute failed\n"); grid = -1; return; }
        if (hipOccupancyMaxActiveBlocksPerMultiprocessor(&per_cu, (const void*)fwd_kernel, NT, LDS_BYTES) != hipSuccess || per_cu < 1) fprintf(stderr, "kernel_launch: occupancy query reports %d\n", per_cu);
        (void)hipGetLastError();
        grid = cus;
    }
    if (grid < 0) return;
    (void)hipMemsetAsync((char*)d_ws + WS_CTL, 0, 65536, stream);
    Args a{};
    for (int i = 0; i < 29; ++i) a.in[i] = (const float*)d_in[i];
    a.out = (float*)d_out; a.ws = (unsigned char*)d_ws;
#if MK_N_LAUNCHES == 1
    a.ph_lo = 0; a.ph_hi = N_PHASES;
    hipLaunchKernelGGL(fwd_kernel, dim3(grid), dim3(NT), LDS_BYTES, stream, a);
#else
    for (int p = 0; p < N_PHASES; ++p) { a.ph_lo = p; a.ph_hi = p + 1; hipLaunchKernelGGL(fwd_kernel, dim3(grid), dim3(NT), LDS_BYTES, stream, a); }
#endif
}
```

```cpp
#include <hip/hip_runtime.h>
#include <stdint.h>
#include <stdio.h>

#ifndef MK_N_LAUNCHES
#define MK_N_LAUNCHES 1
#endif

namespace pg8 {
#define PG8_LAS __attribute__((address_space(3)))
typedef unsigned short bf16_t;
typedef short bf16x8 __attribute__((ext_vector_type(8)));
typedef float f32x4 __attribute__((ext_vector_type(4)));
typedef unsigned u32x4 __attribute__((ext_vector_type(4)));
constexpr int BM = 256, BK = 64, HALF = 128, HTB = HALF * BK * 2  , STAGE_BYTES = 8 * HTB, NXCD = 8, WGM = 8;

__host__ __device__ __forceinline__ int lds_byte(int r, int c) { const int st = (r >> 4) * 2 + (c >> 5), rr = r & 15, cc = c & 31, ob = rr * 64 + cc * 2; return st * 1024 + (ob ^ (((ob >> 9) & 1) << 5)); }
__host__ __device__ __forceinline__ void stage_rc(int b, int& R, int& C) { const int st = b / 1024, sb = b % 1024, swz = sb ^ (((sb >> 9) & 1) << 5); R = (st >> 1) * 16 + swz / 64; C = (st & 1) * 32 + (swz % 64) / 2; }
__host__ __device__ __forceinline__ int perm32(int rho) { const int n = rho >> 4, i = rho & 15; return 8 * (i >> 2) + 4 * n + (i & 3); }

struct Unit { int pm, pn; };
struct Gemm { const bf16_t* A; const bf16_t* Bt; int M, N, K; };

struct StaticOrder {
    int nM, nN, nwg, G, c;
    __host__ __device__ void init(int M, int N, int G_, int c_) { nM = M / BM; nN = N / BM; nwg = nM * nN; G = G_; c = c_; }
    __host__ __device__ bool next(int i, Unit& u) const {
        const long L = (long)i * G + c; if (L >= nwg) return false;
        int wgid = (int)L; { const int q = nwg / NXCD, r = nwg % NXCD, xcd = wgid % NXCD, off = wgid / NXCD; wgid = (xcd < r ? xcd * (q + 1) : r * (q + 1) + (xcd - r) * q) + off; }
        const int nig = WGM * nN, gid = wgid / nig, fm = gid * WGM, gsz = (nM - fm) < WGM ? (nM - fm) : WGM;
        u.pm = fm + ((wgid % nig) % gsz); u.pn = (wgid % nig) / gsz; return true;
    }
    __device__ __forceinline__ void a_ready(const Unit&) const {}
    __device__ __forceinline__ void done(const Unit&) const {}
};
__device__ __forceinline__ unsigned cvt_pk_bf16(float lo, float hi) { unsigned r; asm volatile("v_cvt_pk_bf16_f32 %0, %1, %2" : "=v"(r) : "v"(lo), "v"(hi)); return r; }
template <class Epi, class Sched, bool STAMP = false>
__device__ __forceinline__ void gemm_phase(PG8_LAS unsigned char* lds, const Gemm g, const Sched& S, const Epi& E, unsigned long long* stamps) {
    const int tid = threadIdx.x, wid = __builtin_amdgcn_readfirstlane(tid >> 6), lane = tid & 63, wr = wid >> 2, wc = wid & 3, fr = lane & 15, fq = lane >> 4;
    const int K = g.K, nt = K / BK;
    int ts_lo = 0, ts_hi = 0, nts = 0; const unsigned long long rt_entry = STAMP ? (unsigned long long)wall_clock64() : 0ull;
#define PG8_STAMP() do { if (STAMP && wid == 0 && nts < 64) { const unsigned long long _c = (unsigned long long)clock64(); \
        ts_lo = (lane == nts) ? (int)(unsigned)_c : ts_lo; ts_hi = (lane == nts) ? (int)(unsigned)(_c >> 32) : ts_hi; ++nts; } } while (0)
    PG8_STAMP();
    unsigned voffA[2], voffB[2];
#pragma unroll
    for (int i = 0; i < 2; ++i) { int R, C; stage_rc(tid * 16 + i * 8192, R, C); const int Rb = Epi::PERM ? ((R & ~31) + perm32(R & 31)) : R;
        voffA[i] = (unsigned)(R * K + C) * 2u; voffB[i] = (unsigned)(Rb * K + C) * 2u; }
    const size_t kstep = (size_t)(BK * 2);
    const size_t hstep = (size_t)HALF * K * 2;
    const size_t tstep = 2 * hstep;
    const unsigned ldsw = (unsigned)wid * 1024u;
    const int aoff = lds_byte(wr * 64 + fr, fq * 8), boff = lds_byte(wc * 32 + fr, fq * 8);
#define PG8_SA(b, h) (((b) * 2 + (h)) * HTB)
#define PG8_SB(b, h) ((4 + (b) * 2 + (h)) * HTB)
#define PG8_STAGE(bufoff, gbase, voff) do { _Pragma("unroll") for (int _i = 0; _i < 2; ++_i) \
        __builtin_amdgcn_global_load_lds((const unsigned*)((const char*)(gbase) + (voff)[_i]), (PG8_LAS unsigned*)(lds + (bufoff) + ldsw + _i * 8192), 16, 0, 0); } while (0)
#define PG8_LDA(dst, b, h) do { _Pragma("unroll") for (int m = 0; m < 4; ++m) _Pragma("unroll") for (int k = 0; k < 2; ++k) dst[m][k] = *(const PG8_LAS bf16x8*)(lds + PG8_SA(b, h) + aoff + m * 2048 + k * 1024); } while (0)
#define PG8_LDB(dst, b, h) do { _Pragma("unroll") for (int n = 0; n < 2; ++n) _Pragma("unroll") for (int k = 0; k < 2; ++k) dst[n][k] = *(const PG8_LAS bf16x8*)(lds + PG8_SB(b, h) + boff + n * 2048 + k * 1024); } while (0)
#define PG8_MMA(ai, bj, At, Bt) do { __builtin_amdgcn_s_setprio(1); _Pragma("unroll") for (int m = 0; m < 4; ++m) _Pragma("unroll") for (int n = 0; n < 2; ++n) _Pragma("unroll") for (int k = 0; k < 2; ++k) \
        acc[ai][bj][m][n] = __builtin_amdgcn_mfma_f32_16x16x32_bf16(Bt[n][k], At[m][k], acc[ai][bj][m][n], 0, 0, 0); __builtin_amdgcn_s_setprio(0); } while (0)
#define PG8_WAIT_V(n) asm volatile("s_waitcnt vmcnt(" #n ")" ::: "memory")
#define PG8_WAIT_L(n) asm volatile("s_waitcnt lgkmcnt(" #n ")" ::: "memory")
#define PG8_BAR __builtin_amdgcn_s_barrier()
#define PG8_SCHED __builtin_amdgcn_sched_barrier(0)
    Unit cur, nxt; int ui = 0;
    if (!S.next(0, cur)) return;
    f32x4 acc[2][2][4][2];
#pragma unroll
    for (int a = 0; a < 2; ++a)
#pragma unroll
        for (int b = 0; b < 2; ++b)
#pragma unroll
            for (int m = 0; m < 4; ++m)
#pragma unroll
                for (int n = 0; n < 2; ++n) acc[a][b][m][n] = (f32x4){0.f, 0.f, 0.f, 0.f};
    bf16x8 At[4][2], B0[2][2], B1[2][2];
    const char* cA = (const char*)g.A + (size_t)cur.pm * tstep; const char* cB = (const char*)g.Bt + (size_t)cur.pn * tstep;
    S.a_ready(cur);
    PG8_STAGE(PG8_SB(0, 0), cB, voffB); PG8_STAGE(PG8_SA(0, 0), cA, voffA); PG8_STAGE(PG8_SB(0, 1), cB + hstep, voffB); PG8_STAGE(PG8_SA(0, 1), cA + hstep, voffA);
    if (wr == 1) PG8_BAR;
    PG8_WAIT_V(4); PG8_BAR;
    PG8_STAGE(PG8_SB(1, 0), cB + kstep, voffB); PG8_STAGE(PG8_SA(1, 0), cA + kstep, voffA); PG8_STAGE(PG8_SB(1, 1), cB + hstep + kstep, voffB);
    PG8_WAIT_V(6); PG8_BAR;
    PG8_STAMP();
    for (;;) {
        const bool has_next = S.next(ui + 1, nxt);
        const char* nA = has_next ? (const char*)g.A + (size_t)nxt.pm * tstep : cA; const char* nB = has_next ? (const char*)g.Bt + (size_t)nxt.pn * tstep : cB;
        for (int t = 0; t < nt; t += 2) {
            const bool last = (t == nt - 2);
            const char* a1 = cA + (size_t)(t + 1) * kstep;
            const char* a2 = last ? nA : cA + (size_t)(t + 2) * kstep; const char* b2 = last ? nB : cB + (size_t)(t + 2) * kstep;
            const char* a3 = a2 + kstep; const char* b3 = b2 + kstep;
            if (last && has_next) S.a_ready(nxt);
            PG8_LDB(B0, 0, 0); PG8_SCHED; PG8_LDA(At, 0, 0); PG8_STAGE(PG8_SA(1, 1), a1 + hstep, voffA);
            PG8_WAIT_L(8); PG8_BAR; PG8_WAIT_L(0); PG8_MMA(0, 0, At, B0); PG8_BAR; PG8_SCHED;
            PG8_LDB(B1, 0, 1); PG8_STAGE(PG8_SB(0, 0), b2, voffB);
            PG8_BAR; PG8_WAIT_L(0); PG8_MMA(0, 1, At, B1); PG8_BAR;
            PG8_LDA(At, 0, 1); PG8_STAGE(PG8_SA(0, 0), a2, voffA);
            PG8_BAR; PG8_WAIT_L(0); PG8_MMA(1, 0, At, B0); PG8_BAR; PG8_SCHED;
            PG8_STAGE(PG8_SB(0, 1), b2 + hstep, voffB);
            PG8_WAIT_V(6); PG8_BAR; PG8_MMA(1, 1, At, B1); PG8_BAR;
            PG8_LDB(B0, 1, 0); PG8_SCHED; PG8_LDA(At, 1, 0); PG8_STAGE(PG8_SA(0, 1), a2 + hstep, voffA);
            PG8_WAIT_L(8); PG8_BAR; PG8_WAIT_L(0); PG8_MMA(0, 0, At, B0); PG8_BAR; PG8_SCHED;
            PG8_LDB(B1, 1, 1); PG8_STAGE(PG8_SB(1, 0), b3, voffB);
            PG8_BAR; PG8_WAIT_L(0); PG8_MMA(0, 1, At, B1); PG8_BAR;
            PG8_LDA(At, 1, 1); PG8_STAGE(PG8_SA(1, 0), a3, voffA);
            PG8_BAR; PG8_WAIT_L(0); PG8_MMA(1, 0, At, B0); PG8_BAR; PG8_SCHED;
            PG8_STAGE(PG8_SB(1, 1), b3 + hstep, voffB);
            PG8_WAIT_V(6); PG8_BAR; PG8_MMA(1, 1, At, B1); PG8_BAR;
        }
        PG8_STAMP();
        if constexpr (!Epi::AFTER_DRAIN) { E(acc, cur, wr, wc, fr, fq); S.done(cur); }
        PG8_STAMP();
        if (!has_next) break;
#pragma unroll
        for (int a = 0; a < 2; ++a)
#pragma unroll
            for (int b = 0; b < 2; ++b)
#pragma unroll
                for (int m = 0; m < 4; ++m)
#pragma unroll
                    for (int n = 0; n < 2; ++n) acc[a][b][m][n] = (f32x4){0.f, 0.f, 0.f, 0.f};
        cur = nxt; cA = nA; cB = nB; ++ui;
    }
    PG8_WAIT_V(0);
    if (wr == 0) PG8_BAR;
    PG8_BAR;
    if constexpr (Epi::AFTER_DRAIN) { E.fused(acc, cur, wr, wc, fr, fq, lds, wid, lane); S.done(cur); }
    PG8_STAMP();
    if (STAMP && wid == 0) { stamps[lane] = lane < nts ? (((unsigned long long)(unsigned)ts_hi << 32) | (unsigned)ts_lo) : 0ull;
        if (lane == 62) stamps[62] = rt_entry; if (lane == 63) stamps[63] = (unsigned long long)wall_clock64(); }
#undef PG8_STAMP
#undef PG8_SA
#undef PG8_SB
#undef PG8_STAGE
#undef PG8_LDA
#undef PG8_LDB
#undef PG8_MMA
#undef PG8_WAIT_V
#undef PG8_WAIT_L
#undef PG8_BAR
#undef PG8_SCHED
}
}

#define XB_TMO      128
#define XB_XCNT(j)  (256  + 64 * (j))
#define XB_XSUB(j)  (1280 + 64 * (j))
#define XB_XGEN(j)  (2304 + 64 * (j))
#define XB_TOP      3328
#define XB_TOPGEN   3392
#define XCD_BAR_WORDS 3456
#define XB_SPIN_CAP (1u << 18)
#define LAS __attribute__((address_space(3)))

__device__ __forceinline__ unsigned xb_ld(unsigned* p)              { return __hip_atomic_load(p, __ATOMIC_RELAXED, __HIP_MEMORY_SCOPE_AGENT); }
__device__ __forceinline__ unsigned xb_add(unsigned* p, unsigned v) { return __hip_atomic_fetch_add(p, v, __ATOMIC_RELAXED, __HIP_MEMORY_SCOPE_AGENT); }
__device__ __forceinline__ unsigned xb_xcc_id() { return (unsigned)__builtin_amdgcn_s_getreg((3 << 11) | 20) & 0xFu; }
#define XB_SPIN(cond, bar) do { unsigned _sp = 0; while (cond) { __builtin_amdgcn_s_sleep(1); \
    if ((++_sp & 255u) == 0u) { if (xb_ld(&(bar)[XB_TMO])) break; if (_sp > XB_SPIN_CAP) { atomicAdd(&(bar)[XB_TMO], 1u); break; } } } } while (0)

struct XcdBarrier {
    unsigned* bar; unsigned x;
    volatile LAS unsigned* st;
};

__device__ __forceinline__ XcdBarrier xcd_barrier_post(unsigned* bar, volatile LAS unsigned* st) {
    XcdBarrier b; b.bar = bar; b.x = xb_xcc_id(); b.st = st;
    if (threadIdx.x == 0) (void)xb_add(&bar[XB_XCNT(b.x)], 1u);
    return b;
}
__device__ __forceinline__ void xcd_barrier_complete(unsigned* bar, unsigned x, unsigned& nloc, unsigned& nx) {
    const unsigned G = gridDim.x * gridDim.y * gridDim.z;
    unsigned sum, cnt, mine, sp = 0u;
    for (;;) {
        sum = 0u; cnt = 0u; mine = 0u;
#pragma unroll
        for (unsigned j = 0; j < 16; ++j) { const unsigned c = xb_ld(&bar[XB_XCNT(j)]); sum += c; cnt += (c > 0u) ? 1u : 0u; mine = (j == x) ? c : mine; }
        if (sum == G) break;
        __builtin_amdgcn_s_sleep(1);
        if ((++sp & 255u) == 0u) { if (xb_ld(&bar[XB_TMO])) break; if (sp > XB_SPIN_CAP) { atomicAdd(&bar[XB_TMO], 1u); break; } }
    }
    nloc = mine > 0u ? mine : 1u; nx = cnt > 0u ? cnt : 1u;
}

__device__ __forceinline__ void xcd_barrier(const XcdBarrier& b) {
    asm volatile("s_waitcnt vmcnt(0)" ::: "memory");
    __syncthreads();
    if (threadIdx.x == 0) {
        unsigned* bar = b.bar;
        __builtin_amdgcn_s_waitcnt(0);
        unsigned nloc = b.st[0], nx = b.st[1];
        if (nloc == 0u) { xcd_barrier_complete(bar, b.x, nloc, nx); b.st[0] = nloc; b.st[1] = nx; }
        const unsigned old = xb_add(&bar[XB_XSUB(b.x)], 1u);
        const unsigned gen = old / nloc;
        if (old + 1u == (gen + 1u) * nloc) {
            __builtin_amdgcn_fence(__ATOMIC_RELEASE, "agent");
            asm volatile("s_waitcnt vmcnt(0)" ::: "memory");
            const unsigned og = xb_add(&bar[XB_TOP], 1u);
            const unsigned tg = og / nx;
            if (og + 1u == (tg + 1u) * nx) xb_add(&bar[XB_TOPGEN], 1u);
            else XB_SPIN(xb_ld(&bar[XB_TOPGEN]) == tg, bar);
            __builtin_amdgcn_fence(__ATOMIC_ACQUIRE, "agent");
            xb_add(&bar[XB_XGEN(b.x)], 1u);
            asm volatile("s_waitcnt vmcnt(0)" ::: "memory");
        } else {
            XB_SPIN(xb_ld(&bar[XB_XGEN(b.x)]) == gen, bar);
            __builtin_amdgcn_fence(__ATOMIC_ACQUIRE, "agent");
            asm volatile("s_waitcnt vmcnt(0)" ::: "memory");
        }
    }
    __syncthreads();
}

typedef unsigned short bf16_t;
typedef short bf16x8 __attribute__((ext_vector_type(8)));
typedef float f32x4 __attribute__((ext_vector_type(4)));
typedef unsigned u32x4 __attribute__((ext_vector_type(4)));
typedef unsigned u32x2 __attribute__((ext_vector_type(2)));

constexpr int IDSTR = 132;
#ifndef GATHER_SWEEP
#define GATHER_SWEEP 6
#endif
#ifndef DUP_MASK
#define DUP_MASK 0
#ifndef S8_REPS
#define S8_REPS 1
#endif
#ifndef S8_HOT
#define S8_HOT 1
#endif
#define GEXP 3
#endif
#define DUP(k) ((DUP_MASK >> (k)) & 1)
constexpr int NT = 512;
constexpr int D = 1024, NB = 8, SEQ = 2048, CTXL = 256;
constexpr int MLAT = NB * SEQ, MCTX = NB * CTXL, MALL = MLAT + MCTX;
constexpr int ZG_LD = 2048, ZR_LD = 3584, Z3_LD = 3072;
constexpr int N1 = 5632, N2 = 3072, NIN = N1 + N2;
constexpr int ZR_OFF = 32;
constexpr int MODW = 6144;
constexpr int LDS_BYTES = 163840, LDS_HDR = 64;

constexpr size_t WS_CTL   = 0;
constexpr size_t WS_MOD   = 65536;
constexpr size_t WS_BONUS = WS_MOD + 262144;
constexpr size_t WS_WIN   = WS_BONUS + 1048576;
constexpr size_t WS_WOUT  = WS_WIN + (size_t)NIN * 1024 * 2;
constexpr size_t WS_WQ    = WS_WOUT + (size_t)1024 * 1024 * 2;
constexpr size_t WS_G2T   = WS_WQ + (size_t)2048 * 1024 * 2;
constexpr size_t WS_SK    = WS_G2T + (size_t)1024 * 192 * 2;
constexpr size_t WS_A1    = WS_SK + (size_t)16 * 128 * 128 * 2;
constexpr size_t WS_ZG    = WS_A1 + (size_t)MALL * 1024 * 2;
constexpr size_t WS_ZR    = WS_ZG + (size_t)MALL * ZG_LD * 2;
constexpr size_t WS_ZL    = WS_ZR + (size_t)MALL * ZR_LD * 2;
constexpr int ZL_LD = 352;
constexpr size_t WS_END   = WS_ZL + (size_t)MALL * ZL_LD * 2;
constexpr size_t WS_ORF   = WS_ZG;
constexpr size_t WS_ORB   = WS_ZG + (size_t)MLAT * 1024 * 2;
constexpr size_t WS_Q     = WS_ZG;
constexpr size_t WS_Z3    = WS_ZR;
constexpr size_t WS_UT    = WS_ZR;
constexpr size_t WS_VT    = WS_UT + (size_t)16384 * 1024;
constexpr size_t WS_IDX   = WS_VT + (size_t)16384 * 1024;
constexpr size_t WS_GATE  = WS_IDX + (size_t)MLAT * 128 * 4;
static_assert(WS_GATE + (size_t)MLAT * 128 * 4 <= WS_ZL, "ws map");
static_assert(WS_ORB + (size_t)MLAT * 1024 * 2 <= WS_ZR, "ws map");

typedef const float* const __attribute__((address_space(4))) * KArgPtr;
struct Ctx { KArgPtr in; float* out; unsigned char* ws; };
#define CIN(k) (c.in[k])
struct Args { const float* in[29]; float* out; unsigned char* ws; int ph_lo, ph_hi; };

typedef __bf16 hwbf16x2 __attribute__((ext_vector_type(2)));
typedef float f32x2v __attribute__((ext_vector_type(2)));
__device__ __forceinline__ unsigned pk2(float lo, float hi) { const f32x2v f = {lo, hi}; const hwbf16x2 v = __builtin_convertvector(f, hwbf16x2); return __builtin_bit_cast(unsigned, v); }
__device__ __forceinline__ bf16_t f2bf(float f) { return (bf16_t)(pk2(f, 0.f) & 0xffffu); }
__device__ __forceinline__ float bflo(unsigned w) { return __uint_as_float(w << 16); }
__device__ __forceinline__ float bfhi(unsigned w) { return __uint_as_float(w & 0xffff0000u); }
__device__ __forceinline__ float bf2f(bf16_t b) { return __uint_as_float(((unsigned)b) << 16); }
__device__ __forceinline__ void unpack8(const u32x4 w, float* o) { o[0] = bflo(w.x); o[1] = bfhi(w.x); o[2] = bflo(w.y); o[3] = bfhi(w.y); o[4] = bflo(w.z); o[5] = bfhi(w.z); o[6] = bflo(w.w); o[7] = bfhi(w.w); }
__device__ __forceinline__ u32x4 pack8(const float* v) { u32x4 w; w.x = pk2(v[0], v[1]); w.y = pk2(v[2], v[3]); w.z = pk2(v[4], v[5]); w.w = pk2(v[6], v[7]); return w; }
__device__ __forceinline__ u32x4 ldg16(const bf16_t* p) { return *(const u32x4*)p; }
__device__ __forceinline__ float fexp(float x) { return __builtin_amdgcn_exp2f(x * 1.4426950408889634f); }
__device__ __forceinline__ float flog(float x) { return __builtin_amdgcn_logf(x) * 0.6931471805599453f; }
__device__ __forceinline__ float sigmoidf_(float x) { return __builtin_amdgcn_rcpf(1.0f + fexp(-x)); }
__device__ __forceinline__ float wave_sum(float v) {
#pragma unroll
    for (int o = 32; o > 0; o >>= 1) v += __shfl_xor(v, o);
    return v;
}
#define LDS_FENCE() asm volatile("s_waitcnt lgkmcnt(0)" ::: "memory")

__device__ __forceinline__ int win_src(int n) {
    if (n < 2048) return n;
    if (n < N1) { const int j = n - 2048; if (j < 16) return 3072 + j; if (j < 32) return 3088 + (j - 16); if (j < 32 + 3424) { int cr = j - 32; if (cr < 3072) { const int p = cr & 15; cr = (cr & ~15) + (p & 3) * 4 + (p >> 2); } return 3104 + cr; } return -1; }
    const int j = n - N1; return j < 1024 ? 2048 + j : 6528 + (j - 1024);
}
template <int MODE> __device__ __forceinline__ void transpose_tile(const float* __restrict__ src, int ld, bf16_t* __restrict__ dst, int n0, int k0, LAS float* tile) {
    const int tid = threadIdx.x;
#pragma unroll
    for (int e = 0; e < 8; ++e) { const int idx = tid + e * NT, kk = idx >> 6, nn = idx & 63; const int n = n0 + nn; const int s = MODE == 0 ? win_src(n) : n;
        tile[kk * 65 + nn] = s >= 0 ? src[(size_t)(k0 + kk) * ld + s] : 0.f; }
    __syncthreads();
#pragma unroll
    for (int e = 0; e < 4; ++e) { const int idx = tid + e * NT, nn = idx >> 5, kp = idx & 31;
        *(unsigned*)(dst + (size_t)(n0 + nn) * 1024 + k0 + kp * 2) = pk2(tile[(kp * 2) * 65 + nn], tile[(kp * 2 + 1) * 65 + nn]); }
    __syncthreads();
}
__device__ __forceinline__ void p0_prologue(const Ctx& c, LAS unsigned char* lds) {
    const int tid = threadIdx.x, G = gridDim.x, bx = blockIdx.x;
    LAS float* tile = (LAS float*)lds;
    bf16_t* Wt_in = (bf16_t*)(c.ws + WS_WIN); bf16_t* Wt_out = (bf16_t*)(c.ws + WS_WOUT); bf16_t* Wt_q = (bf16_t*)(c.ws + WS_WQ);
    constexpr int T_IN = (NIN / 64) * 16, T_OUT = 16 * 16, T_Q = 32 * 16;
    for (int rep_ = 0; rep_ < (DUP(22) ? 2 : 1); ++rep_)
    for (int t = bx; t < T_IN + T_OUT + T_Q; t += G) {
        if (t < T_IN) transpose_tile<0>(CIN(7), 8576, Wt_in, (t >> 4) * 64, (t & 15) * 64, tile);
        else if (t < T_IN + T_OUT) { const int u = t - T_IN; transpose_tile<1>(CIN(22), 1024, Wt_out, (u >> 4) * 64, (u & 15) * 64, tile); }
        else { const int u = t - T_IN - T_OUT; transpose_tile<1>(CIN(24), 2048, Wt_q, (u >> 4) * 64, (u & 15) * 64, tile); }
    }
    bf16_t* g2t = (bf16_t*)(c.ws + WS_G2T); bf16_t* sk = (bf16_t*)(c.ws + WS_SK);
    for (int i = bx * NT + tid; i < 1024 * 192; i += G * NT) { const int n = i / 192, j = i - n * 192; g2t[i] = f2bf(j < 160 ? CIN(16)[j * 1024 + n] : 0.f); }
    for (int i = bx * NT + tid; i < 16 * 128 * 128; i += G * NT) sk[i] = f2bf(CIN(25)[i]);
    LAS float* sc = (LAS float*)lds;
    LAS float* part = sc + 9 * 1024;
    float* m = (float*)(c.ws + WS_MOD);
    for (int rep_ = 0; rep_ < (DUP(23) ? 2 : 1); ++rep_)
    for (int cg = bx; cg < MODW / 24; cg += G) {
        __syncthreads();
        for (int i = tid; i < 9 * 1024; i += NT) { const float v = i < 8192 ? CIN(1)[i] : CIN(3)[i - 8192]; sc[i] = v * sigmoidf_(v); }
        __syncthreads();
        const int c0 = cg * 24;
        if (tid < 504) { const int col = tid % 24, kp = tid / 24; float acc[9];
#pragma unroll
            for (int r = 0; r < 9; ++r) acc[r] = 0.f;
            for (int k = kp; k < 1024; k += 21) { const float w = CIN(5)[(size_t)k * MODW + c0 + col];
#pragma unroll
                for (int r = 0; r < 9; ++r) acc[r] += sc[r * 1024 + k] * w; }
#pragma unroll
            for (int r = 0; r < 9; ++r) part[(kp * 9 + r) * 24 + col] = acc[r]; }
        __syncthreads();
        if (tid < 216) { const int r = tid / 24, col = tid % 24; float s = CIN(6)[c0 + col];
            for (int kp = 0; kp < 21; ++kp) s += part[(kp * 9 + r) * 24 + col];
            m[r * MODW + c0 + col] = s; }
    }
    __syncthreads();
}

__device__ __forceinline__ void norm_mod_row(const float* __restrict__ src, const float* __restrict__ nw, const float* __restrict__ shift, const float* __restrict__ scale, bf16_t* __restrict__ dst, int lane) {
    f32x4 v[4]; float ss = 0.f;
#pragma unroll
    for (int j = 0; j < 4; ++j) { v[j] = *(const f32x4*)(src + (j * 64 + lane) * 4); ss += v[j][0] * v[j][0] + v[j][1] * v[j][1] + v[j][2] * v[j][2] + v[j][3] * v[j][3]; }
    ss = wave_sum(ss);
    const float rstd = rsqrtf(ss * (1.0f / 1024.0f) + 1e-6f);
#pragma unroll
    for (int j = 0; j < 4; ++j) { const int c0 = (j * 64 + lane) * 4; const f32x4 w = *(const f32x4*)(nw + c0), sh = *(const f32x4*)(shift + c0), sc = *(const f32x4*)(scale + c0);
        float y[4];
#pragma unroll
        for (int e = 0; e < 4; ++e) y[e] = v[j][e] * rstd * w[e] * (1.0f + sc[e]) + sh[e];
        u32x2 o; o.x = pk2(y[0], y[1]); o.y = pk2(y[2], y[3]); *(u32x2*)(dst + c0) = o; }
}
__device__ __forceinline__ void norm_mod_row2(const float* __restrict__ s0, const float* __restrict__ s1, const float* __restrict__ nw, const float* __restrict__ sh0, const float* __restrict__ sc0,
                                              const float* __restrict__ sh1, const float* __restrict__ sc1, bf16_t* __restrict__ d0, bf16_t* __restrict__ d1, int lane) {
    f32x4 v0[4], v1[4]; float a0 = 0.f, a1 = 0.f;
#pragma unroll
    for (int j = 0; j < 4; ++j) { v0[j] = *(const f32x4*)(s0 + (j * 64 + lane) * 4); v1[j] = *(const f32x4*)(s1 + (j * 64 + lane) * 4); }
#pragma unroll
    for (int j = 0; j < 4; ++j) { a0 += v0[j][0] * v0[j][0] + v0[j][1] * v0[j][1] + v0[j][2] * v0[j][2] + v0[j][3] * v0[j][3]; a1 += v1[j][0] * v1[j][0] + v1[j][1] * v1[j][1] + v1[j][2] * v1[j][2] + v1[j][3] * v1[j][3]; }
#pragma unroll
    for (int o = 32; o > 0; o >>= 1) { a0 += __shfl_xor(a0, o); a1 += __shfl_xor(a1, o); }
    const float r0 = rsqrtf(a0 * (1.0f / 1024.0f) + 1e-6f), r1 = rsqrtf(a1 * (1.0f / 1024.0f) + 1e-6f);
#pragma unroll
    for (int j = 0; j < 4; ++j) { const int c0 = (j * 64 + lane) * 4; const f32x4 w = *(const f32x4*)(nw + c0), h0 = *(const f32x4*)(sh0 + c0), g0 = *(const f32x4*)(sc0 + c0), h1 = *(const f32x4*)(sh1 + c0), g1 = *(const f32x4*)(sc1 + c0);
        float y0[4], y1[4];
#pragma unroll
        for (int e = 0; e < 4; ++e) { y0[e] = v0[j][e] * r0 * w[e] * (1.0f + g0[e]) + h0[e]; y1[e] = v1[j][e] * r1 * w[e] * (1.0f + g1[e]) + h1[e]; }
        u32x2 o; o.x = pk2(y0[0], y0[1]); o.y = pk2(y0[2], y0[3]); *(u32x2*)(d0 + c0) = o; o.x = pk2(y1[0], y1[1]); o.y = pk2(y1[2], y1[3]); *(u32x2*)(d1 + c0) = o; }
}
__device__ __forceinline__ void p1_norm1(const Ctx& c) {
    const int lane = threadIdx.x & 63, wave = threadIdx.x >> 6; const float* m = (const float*)(c.ws + WS_MOD); bf16_t* A1 = (bf16_t*)(c.ws + WS_A1);
    const int stride = gridDim.x * 8;
    for (int row = blockIdx.x * 8 + wave; row < MALL; row += 2 * stride) {
        const int rb = row + stride;
        const float* s0 = row < MLAT ? CIN(0) + (size_t)row * D : CIN(2) + (size_t)(row - MLAT) * D; const int m0 = row < MLAT ? row / SEQ : 8;
        if (rb < MALL) { const float* s1 = rb < MLAT ? CIN(0) + (size_t)rb * D : CIN(2) + (size_t)(rb - MLAT) * D; const int m1 = rb < MLAT ? rb / SEQ : 8;
            norm_mod_row2(s0, s1, CIN(4), m + m0 * MODW, m + m0 * MODW + 1024, m + m1 * MODW, m + m1 * MODW + 1024, A1 + (size_t)row * D, A1 + (size_t)rb * D, lane); }
        else norm_mod_row(s0, CIN(4), m + m0 * MODW, m + m0 * MODW + 1024, A1 + (size_t)row * D, lane);
    }
}
template <int MODE  > struct EpiB {
    static constexpr bool PERM = true, AFTER_DRAIN = false;
    bf16_t* O0; bf16_t* O1; int ldc;
    __device__ __forceinline__ void operator()(const pg8::f32x4 (&acc)[2][2][4][2], const pg8::Unit& u, int wr, int wc, int fr, int fq) const {
        const int row0 = u.pm * 256 + wr * 64 + fr; int colt = u.pn * 256; bf16_t* base = O0; int ld = ldc;
        if (MODE == 0) { if (u.pn >= 8) { base = O1; ld = ZR_LD; colt -= 2048; } else { ld = ZG_LD; } }
        const int col0 = colt + wc * 32 + 8 * fq;
        const bool is_silu = (MODE == 1) && (u.pn < 4);
#pragma unroll
        for (int ai = 0; ai < 2; ++ai)
#pragma unroll
            for (int m = 0; m < 4; ++m) { bf16_t* rowp = base + (size_t)(row0 + ai * 128 + m * 16) * ld + col0;
#pragma unroll
                for (int bj = 0; bj < 2; ++bj) { float v[8];
#pragma unroll
                    for (int j = 0; j < 4; ++j) { v[j] = acc[ai][bj][m][0][j]; v[4 + j] = acc[ai][bj][m][1][j]; }
                    if (MODE == 1) {
#pragma unroll
                        for (int j = 0; j < 8; ++j) { const float s = sigmoidf_(v[j]); v[j] = is_silu ? v[j] * s : s; } }
                    *(u32x4*)(rowp + bj * 128) = pack8(v); } }
    }
};
template <int STEP> struct EpiMix {
    static constexpr bool PERM = true, AFTER_DRAIN = false;
    bf16_t* T; bf16_t* YR;
    __device__ __forceinline__ void operator()(const pg8::f32x4 (&acc)[2][2][4][2], const pg8::Unit& u, int wr, int wc, int fr, int fq) const {
        const int row0 = u.pm * 256 + wr * 64 + fr, col0 = u.pn * 256 + wc * 32 + 8 * fq;
#pragma unroll
        for (int ai = 0; ai < 2; ++ai)
#pragma unroll
            for (int m = 0; m < 4; ++m) { const size_t ro = (size_t)(row0 + ai * 128 + m * 16) * D + col0;
#pragma unroll
                for (int bj = 0; bj < 2; ++bj) { float v[8], t[8];
#pragma unroll
                    for (int j = 0; j < 4; ++j) { v[j] = acc[ai][bj][m][0][j]; v[4 + j] = acc[ai][bj][m][1][j]; }
                    unpack8(ldg16(T + ro + bj * 128), t);
                    if (STEP == 0) {
#pragma unroll
                        for (int j = 0; j < 8; ++j) t[j] *= v[j] * sigmoidf_(v[j]);
                        *(u32x4*)(T + ro + bj * 128) = pack8(t);
                    } else if (STEP == 1) {
#pragma unroll
                        for (int j = 0; j < 8; ++j) t[j] *= sigmoidf_(v[j]);
                        *(u32x4*)(T + ro + bj * 128) = pack8(t);
                    } else { float r[8]; unpack8(ldg16(YR + ro + bj * 128), r);
#pragma unroll
                        for (int j = 0; j < 8; ++j) t[j] += sigmoidf_(v[j]) * r[j];
                        *(u32x4*)(YR + ro + bj * 128) = pack8(t); } } }
    }
};
struct EpiH1 {
    static constexpr bool PERM = false, AFTER_DRAIN = false;
    const float* x; const float* m; float* h1;
    __device__ __forceinline__ void operator()(const pg8::f32x4 (&acc)[2][2][4][2], const pg8::Unit& u, int wr, int wc, int fr, int fq) const {
        const int row0 = u.pm * 256 + wr * 64 + fr, col0 = u.pn * 256 + wc * 32 + 4 * fq;
        const float* g = m + (size_t)((u.pm * 256) / SEQ) * MODW + 2048;
        f32x4 gv[2][2];
#pragma unroll
        for (int bj = 0; bj < 2; ++bj)
#pragma unroll
            for (int n = 0; n < 2; ++n) gv[bj][n] = *(const f32x4*)(g + col0 + bj * 128 + n * 16);
#pragma unroll
        for (int ai = 0; ai < 2; ++ai)
#pragma unroll
            for (int mm = 0; mm < 4; ++mm) { const size_t ro = (size_t)(row0 + ai * 128 + mm * 16) * D + col0;
#pragma unroll
                for (int bj = 0; bj < 2; ++bj)
#pragma unroll
                    for (int n = 0; n < 2; ++n) { const f32x4 xv = *(const f32x4*)(x + ro + bj * 128 + n * 16); *(f32x4*)(h1 + ro + bj * 128 + n * 16) = xv + gv[bj][n] * acc[ai][bj][mm][n]; } }
    }
};

struct Gemm1Order : pg8::StaticOrder {
    __device__ bool next(int i, pg8::Unit& u) const {
        const long L = (long)i * G + c;
        if (L < 1408) return pg8::StaticOrder::next(i, u);
        const int k = (int)(L - 1408); if (k >= 128) return false;
        const int t = k >> 3; u.pm = 64 + (k & 7); u.pn = t < 6 ? 2 + t : (t == 6 ? 8 : 5 + t);
        return true;
    }
};

#define MFMA16(a, b, c) __builtin_amdgcn_mfma_f32_16x16x32_bf16(a, b, c, 0, 0, 0)
__device__ __forceinline__ float logsigmoidf_(float x) { return fminf(x, 0.f) - flog(1.0f + fexp(-fabsf(x))); }
#define DPP_F(x, ctrl) __builtin_bit_cast(float, __builtin_amdgcn_update_dpp(0, __builtin_bit_cast(int, (x)), (ctrl), 0xf, 0xf, true))
constexpr int GLA_OP_BYTES = 17408 + 17408 + 18432 + 9216 + 512;
__device__ __forceinline__ void p3_gla(const Ctx& c, LAS unsigned char* lds) {
    const int tid = threadIdx.x, lane = tid & 63, wave = tid >> 6, l15 = lane & 15, lq = lane >> 4;
    LAS bf16_t* St = (LAS bf16_t*)(lds + 2 * GLA_OP_BYTES);
    LAS bf16_t* WAT = St + 64 * 136;
    LAS float* BA = (LAS float*)(WAT + 128 * 40);
    LAS bf16_t* OBF = (LAS bf16_t*)(BA + 128);
    const bf16_t* Zg = (const bf16_t*)(c.ws + WS_ZG); const bf16_t* Zr = (const bf16_t*)(c.ws + WS_ZR);
    bf16_t* og_f = (bf16_t*)c.out; bf16_t* og_b = og_f + (size_t)MLAT * D;
    const int ti = tid >> 3, seg = tid & 7;
    for (int u = blockIdx.x; u < 256; u += gridDim.x) {
        const int dir = u & 1, dvs = (u >> 1) & 3, h = (u >> 3) & 3, b = u >> 5;
        bf16_t* og = dir ? og_b : og_f;
        __syncthreads();
        for (int i = tid; i < 128 * 40; i += NT) { const int d = i / 40, j = i - d * 40; WAT[i] = f2bf(j < 16 ? CIN(8)[(size_t)(dir * 16 + j) * 512 + h * 128 + d] : 0.f); }
        if (tid < 128) BA[tid] = CIN(9)[dir * 512 + h * 128 + tid];
        for (int i = tid; i < 64 * 136 / 2; i += NT) ((LAS unsigned*)St)[i] = 0u;
        f32x4 accS[4];
#pragma unroll
        for (int n = 0; n < 4; ++n) accS[n] = (f32x4){0.f, 0.f, 0.f, 0.f};
        __syncthreads();
        const int d0 = wave * 16 + lq * 4;
        const bf16x8 wfr = *(LAS bf16x8*)(WAT + (wave * 16 + l15) * 40 + lq * 8);
        float bad[4];
#pragma unroll
        for (int r = 0; r < 4; ++r) bad[r] = BA[d0 + r];
#pragma unroll 1
        for (int step = 0; step <= 36; ++step) {
            const bool latn = step >= 4;
            const int cidxn = latn ? (dir ? 31 - (step - 4) : step - 4) : (dir ? 3 - step : step);
            const int rbasen = (latn ? b * SEQ : MLAT + b * CTXL) + cidxn * 64;
            u32x4 vw = (u32x4){0u, 0u, 0u, 0u}, alw[4]; u32x2 qw[4], kw[4];
            if (step < 36) {
                vw = ldg16(Zg + (size_t)(rbasen + (dir ? 63 - ti : ti)) * ZG_LD + 1024 + h * 256 + dvs * 64 + seg * 8);
#pragma unroll
                for (int mt = 0; mt < 4; ++mt) { const int t = mt * 16 + l15; const size_t R = (size_t)(rbasen + (dir ? 63 - t : t));
                    alw[mt] = (u32x4){0u, 0u, 0u, 0u}; if (lq < 2) alw[mt] = ldg16(Zr + R * ZR_LD + dir * 16 + lq * 8);
                    qw[mt] = (u32x2){0u, 0u}; if (latn) qw[mt] = *(const u32x2*)(Zg + R * ZG_LD + h * 128 + d0);
                    kw[mt] = *(const u32x2*)(Zg + R * ZG_LD + 512 + h * 128 + d0); }
            }
            const int sp = step - 1; const bool lat = sp >= 4;
            const int cidx = lat ? (dir ? 31 - (sp - 4) : sp - 4) : (dir ? 3 - sp : sp);
            const int rbase = (lat ? b * SEQ : MLAT + b * CTXL) + cidx * 64;
            if (step >= 1) {
                LAS unsigned char* op = lds + (sp & 1) * GLA_OP_BYTES;
                LAS bf16_t* Qd = (LAS bf16_t*)op; LAS bf16_t* Kd = Qd + 64 * 136; LAS bf16_t* Kt = Kd + 64 * 136; LAS bf16_t* Vt = Kt + 128 * 72; LAS float* EBL = (LAS float*)(Vt + 64 * 72);
                const int mi = wave >> 1;
                if (lat) {
                    bf16x8 qf[4];
#pragma unroll
                    for (int ks = 0; ks < 4; ++ks) qf[ks] = *(LAS bf16x8*)(Qd + (mi * 16 + l15) * 136 + ks * 32 + lq * 8);
                    unsigned xa[4][2];
#pragma unroll
                    for (int jt = 0; jt < 4; ++jt) { f32x4 x = (f32x4){0.f, 0.f, 0.f, 0.f};
                        if (jt <= mi) {
#pragma unroll
                            for (int ks = 0; ks < 4; ++ks) x = MFMA16(*(LAS bf16x8*)(Kd + (jt * 16 + l15) * 136 + ks * 32 + lq * 8), qf[ks], x);
                            if (jt == mi) {
#pragma unroll
                                for (int r = 0; r < 4; ++r) x[r] = (lq * 4 + r <= l15) ? x[r] : 0.f; } }
                        xa[jt][0] = pk2(x[0], x[1]); xa[jt][1] = pk2(x[2], x[3]); }
#pragma unroll
                    for (int t2 = 0; t2 < 2; ++t2) { const int nt = (wave & 1) * 2 + t2; f32x4 a = (f32x4){0.f, 0.f, 0.f, 0.f};
#pragma unroll
                        for (int ks = 0; ks < 4; ++ks) a = MFMA16(qf[ks], *(LAS bf16x8*)(St + (nt * 16 + l15) * 136 + ks * 32 + lq * 8), a);
#pragma unroll
                        for (int ks = 0; ks < 2; ++ks) {
                            const u32x4 aw = (u32x4){xa[2 * ks][0], xa[2 * ks][1], xa[2 * ks + 1][0], xa[2 * ks + 1][1]};
                            const u32x2 b0 = *(LAS u32x2*)(Vt + (nt * 16 + l15) * 72 + ks * 32 + lq * 4), b1 = *(LAS u32x2*)(Vt + (nt * 16 + l15) * 72 + ks * 32 + 16 + lq * 4);
                            const u32x4 bw = (u32x4){b0.x, b0.y, b1.x, b1.y};
                            a = MFMA16(__builtin_bit_cast(bf16x8, aw), __builtin_bit_cast(bf16x8, bw), a); }
#pragma unroll
                        for (int r = 0; r < 4; ++r) OBF[(mi * 16 + lq * 4 + r) * 72 + nt * 16 + l15] = f2bf(a[r]); }
                }
                { float eb[4];
#pragma unroll
                    for (int r = 0; r < 4; ++r) eb[r] = EBL[wave * 16 + lq * 4 + r];
#pragma unroll
                    for (int nt = 0; nt < 4; ++nt) {
#pragma unroll
                        for (int r = 0; r < 4; ++r) accS[nt][r] *= eb[r];
#pragma unroll
                        for (int ks = 0; ks < 2; ++ks) accS[nt] = MFMA16(*(LAS bf16x8*)(Kt + (wave * 16 + l15) * 72 + ks * 32 + lq * 8), *(LAS bf16x8*)(Vt + (nt * 16 + l15) * 72 + ks * 32 + lq * 8), accS[nt]); } }
            }
            if (step < 36) {
                LAS unsigned char* op = lds + (step & 1) * GLA_OP_BYTES;
                LAS bf16_t* Qd = (LAS bf16_t*)op; LAS bf16_t* Kd = Qd + 64 * 136; LAS bf16_t* Kt = Kd + 64 * 136; LAS bf16_t* Vt = Kt + 128 * 72; LAS float* EBL = (LAS float*)(Vt + 64 * 72);
                { float v8[8]; unpack8(vw, v8);
#pragma unroll
                    for (int e = 0; e < 8; ++e) Vt[(seg * 8 + e) * 72 + ti] = f2bf(v8[e]); }
                float run[4] = {0.f, 0.f, 0.f, 0.f}, bc[4][4];
#pragma unroll
                for (int mt = 0; mt < 4; ++mt) {
                    const f32x4 sd = MFMA16(wfr, __builtin_bit_cast(bf16x8, alw[mt]), ((f32x4){0.f, 0.f, 0.f, 0.f}));
#pragma unroll
                    for (int r = 0; r < 4; ++r) { float x = logsigmoidf_(sd[r] + bad[r]) * 0.0625f;
                        x += DPP_F(x, 0x111); x += DPP_F(x, 0x112); x += DPP_F(x, 0x114); x += DPP_F(x, 0x118);
                        bc[mt][r] = run[r] + x; run[r] += DPP_F(x, 0x15F); }
                }
                float ebl[4];
#pragma unroll
                for (int r = 0; r < 4; ++r) ebl[r] = fexp(run[r]);
                if (l15 == 0) *(LAS f32x4*)(EBL + d0) = (f32x4){ebl[0], ebl[1], ebl[2], ebl[3]};
#pragma unroll
                for (int mt = 0; mt < 4; ++mt) { const int t = mt * 16 + l15; float qd[4], kd[4];
                    const float q4[4] = {bflo(qw[mt].x), bfhi(qw[mt].x), bflo(qw[mt].y), bfhi(qw[mt].y)}, k4[4] = {bflo(kw[mt].x), bfhi(kw[mt].x), bflo(kw[mt].y), bfhi(kw[mt].y)};
#pragma unroll
                    for (int r = 0; r < 4; ++r) { const float e1 = fexp(bc[mt][r]), e2 = __builtin_amdgcn_rcpf(e1);
                        qd[r] = q4[r] * 0.08838834764831845f * e1; kd[r] = k4[r] * e2; Kt[(d0 + r) * 72 + t] = f2bf(kd[r] * ebl[r]); }
                    u32x2 w; w.x = pk2(qd[0], qd[1]); w.y = pk2(qd[2], qd[3]); *(LAS u32x2*)(Qd + t * 136 + d0) = w;
                    w.x = pk2(kd[0], kd[1]); w.y = pk2(kd[2], kd[3]); *(LAS u32x2*)(Kd + t * 136 + d0) = w; }
            }
            __syncthreads();
            if (step >= 1) {
#pragma unroll
                for (int nt = 0; nt < 4; ++nt) { u32x2 w; w.x = pk2(accS[nt][0], accS[nt][1]); w.y = pk2(accS[nt][2], accS[nt][3]); *(LAS u32x2*)(St + (nt * 16 + l15) * 136 + wave * 16 + lq * 4) = w; }
                if (lat) *(u32x4*)(og + (size_t)(rbase + (dir ? 63 - ti : ti)) * D + h * 256 + dvs * 64 + seg * 8) = *(LAS u32x4*)(OBF + ti * 72 + seg * 8);
            }
            __syncthreads();
        }
    }
    __syncthreads();
}
template <bool LAT> __device__ __forceinline__ void load_mixed8(const bf16_t* __restrict__ Zr, int rowbase, int tl, int col, const float* mu8, float* out) {
    float own[8], zs[8], nb[8];
    const bf16_t* p = Zr + (size_t)(rowbase + tl) * ZR_LD + col;
    unpack8(ldg16(p), own);
    if (LAT) {
        const int x = tl & 63, y = tl >> 6;
#pragma unroll
        for (int ty = 0; ty < 4; ++ty) {
            const bool ok = ty == 0 ? (x > 0) : ty == 1 ? (x < 63) : ty == 2 ? (y > 0) : (y < 31);
            const int dl = ty == 0 ? -1 : ty == 1 ? 1 : ty == 2 ? -64 : 64;
            u32x4 w = (u32x4){0u, 0u, 0u, 0u};
            if (ok) w = ldg16(p + (ptrdiff_t)dl * ZR_LD);
            unpack8(w, nb); zs[ty] = nb[ty]; zs[ty + 4] = nb[ty + 4];
        }
    } else {
#pragma unroll
        for (int ty = 0; ty < 2; ++ty) {
            const bool ok = ty == 0 ? (tl > 0) : (tl < CTXL - 1);
            u32x4 w = (u32x4){0u, 0u, 0u, 0u};
            if (ok) w = ldg16(p + (ptrdiff_t)(ty == 0 ? -1 : 1) * ZR_LD);
            unpack8(w, nb); zs[ty] = nb[ty]; zs[ty + 2] = nb[ty + 2]; zs[ty + 4] = nb[ty + 4]; zs[ty + 6] = nb[ty + 6];
        }
    }
#pragma unroll
    for (int e = 0; e < 8; ++e) out[e] = own[e] + (zs[e] - own[e]) * mu8[e];
}

__device__ __forceinline__ float fast_tanh(float x) { const float e = fexp(2.0f * x); return 1.0f - 2.0f * __builtin_amdgcn_rcpf(1.0f + e); }
__device__ __forceinline__ void premix_lora(const Ctx& c) {
    const bf16_t* Zr = (const bf16_t*)(c.ws + WS_ZR); bf16_t* ZL = (bf16_t*)(c.ws + WS_ZL);
    for (int idx = blockIdx.x * NT + threadIdx.x; idx < MALL * 44; idx += gridDim.x * NT) {
        const int row = idx / 44, sg = idx - row * 44; float v8[8], mu8[8];
#pragma unroll
        for (int e = 0; e < 8; ++e) mu8[e] = CIN(11)[3072 + sg * 8 + e];
        if (row < MLAT) load_mixed8<true>(Zr, (row / SEQ) * SEQ, row % SEQ, ZR_OFF + 3072 + sg * 8, mu8, v8);
        else { const int rc = row - MLAT; load_mixed8<false>(Zr, MLAT + (rc / CTXL) * CTXL, rc % CTXL, ZR_OFF + 3072 + sg * 8, mu8, v8); }
#pragma unroll
        for (int e = 0; e < 8; ++e) v8[e] = sg < 16 ? fast_tanh(v8[e]) : (sg < 24 ? v8[e] : sigmoidf_(v8[e]));
        *(u32x4*)(ZL + (size_t)row * ZL_LD + sg * 8) = pack8(v8);
    }
}
__device__ __forceinline__ u32x2 ldg8(const bf16_t* p) { return *(const u32x2*)p; }
__device__ __forceinline__ void mix16_direct_lat(const bf16_t* __restrict__ Zr, int rowbase, int tl, int col, const float* __restrict__ mu, float* out) {
    const bf16_t* p = Zr + (size_t)(rowbase + tl) * ZR_LD + col;
    const u32x4 o0 = ldg16(p), o1 = ldg16(p + 8);
    const int x = tl & 63, y = tl >> 6; const u32x2 z2 = (u32x2){0u, 0u};
    u32x2 lf = z2, rt = z2, up = z2, dn = z2;
    if (x > 0) lf = ldg8(p - ZR_LD); if (x < 63) rt = ldg8(p + ZR_LD + 4); if (y > 0) up = ldg8(p - (ptrdiff_t)64 * ZR_LD + 8); if (y < 31) dn = ldg8(p + (ptrdiff_t)64 * ZR_LD + 12);
    const unsigned own[8] = {o0.x, o0.y, o0.z, o0.w, o1.x, o1.y, o1.z, o1.w}, nb[8] = {lf.x, lf.y, rt.x, rt.y, up.x, up.y, dn.x, dn.y};
#pragma unroll
    for (int j = 0; j < 8; ++j)
#pragma unroll
        for (int hh = 0; hh < 2; ++hh) { const int pp = 2 * j + hh, i = (pp & 3) * 4 + (pp >> 2); const float z = hh ? bfhi(own[j]) : bflo(own[j]), zs = hh ? bfhi(nb[j]) : bflo(nb[j]); out[i] = z + (zs - z) * mu[i]; }
}
constexpr int RW_SLOT = 12544, RW_KAP = 0, RW_RT = 2048, RW_KBT = 4096, RW_VT = 8192, RW_ARR = 10240, RW_MKK = 11264, RW_PM = 11776, RW_GC = 12288;
constexpr int RW_OST = 8 * RW_SLOT, RW_W2T = RW_OST + 16384, RW_A2T = RW_W2T + 9216, RW_PAR = RW_A2T + 9216, RW_MS = RW_PAR + 2560;
#define DPP_U(x, ctrl) ((unsigned)__builtin_amdgcn_update_dpp(0, (int)(x), (ctrl), 0xf, 0xf, false))
__device__ __forceinline__ float reduce4f(float x) {
    auto r = __builtin_amdgcn_permlane32_swap(__float_as_uint(x), __float_as_uint(x), false, false);
    const float y = __uint_as_float(r[0]) + __uint_as_float(r[1]);
    auto s = __builtin_amdgcn_permlane16_swap(__float_as_uint(y), __float_as_uint(y), false, false);
    return __uint_as_float(s[0]) + __uint_as_float(s[1]);
}
struct Raw16 { u32x4 o0, o1; u32x2 hal, up, dn; };
template <bool LAT> __device__ __forceinline__ void mix16_issue(Raw16& w, const bf16_t* __restrict__ Zr, int rowbase, int tl, int dir, int l15, int col) {
    const bf16_t* p = Zr + (size_t)(rowbase + tl) * ZR_LD + col;
    w.o0 = ldg16(p); w.o1 = ldg16(p + 8);
    const bool e0 = (l15 == 0), e15 = (l15 == 15);
    const int hdl = e0 ? (dir ? 1 : -1) : (dir ? -1 : 1);
    const int lim = LAT ? 64 : CTXL; const int pos = LAT ? (tl & 63) : tl;
    const bool hok = (e0 || e15) && (pos + hdl >= 0) && (pos + hdl < lim);
    const u32x2 z = (u32x2){0u, 0u};
    w.hal = z; w.up = z; w.dn = z;
    const int hoff = hdl < 0 ? 0 : 4;
    if (hok) w.hal = ldg8(p + (ptrdiff_t)hdl * ZR_LD + hoff);
    if (LAT) {
        if ((tl >> 6) > 0) w.up = ldg8(p - (ptrdiff_t)64 * ZR_LD + 8);
        if ((tl >> 6) < 31) w.dn = ldg8(p + (ptrdiff_t)64 * ZR_LD + 12);
    } else {
        if (hok) w.up = ldg8(p + (ptrdiff_t)hdl * ZR_LD + hoff + 8);
    }
}
template <bool LAT> __device__ __forceinline__ void mix16_finish(const Raw16& w, int tl, int dir, int l15, const LAS float* mu, float* out) {
    const unsigned own[8] = {w.o0.x, w.o0.y, w.o0.z, w.o0.w, w.o1.x, w.o1.y, w.o1.z, w.o1.w};
    const int lim = LAT ? 64 : CTXL; const int pos = LAT ? (tl & 63) : tl;
    const bool pv_ok = pos > 0, nx_ok = pos < lim - 1;
    const bool pv_edge = (l15 == (dir ? 15 : 0)), nx_edge = (l15 == (dir ? 0 : 15));
    unsigned nb[8];
#define NB_PREV(j, hv) { const unsigned a_ = DPP_U(own[j], 0x111), b_ = DPP_U(own[j], 0x101); unsigned v_ = dir ? b_ : a_; if (pv_edge) v_ = (hv); nb[j] = pv_ok ? v_ : 0u; }
#define NB_NEXT(j, hv) { const unsigned a_ = DPP_U(own[j], 0x111), b_ = DPP_U(own[j], 0x101); unsigned v_ = dir ? a_ : b_; if (nx_edge) v_ = (hv); nb[j] = nx_ok ? v_ : 0u; }
    NB_PREV(0, w.hal.x) NB_PREV(1, w.hal.y) NB_NEXT(2, w.hal.x) NB_NEXT(3, w.hal.y)
    if (LAT) { nb[4] = w.up.x; nb[5] = w.up.y; nb[6] = w.dn.x; nb[7] = w.dn.y; }
    else { NB_PREV(4, w.up.x) NB_PREV(5, w.up.y) NB_NEXT(6, w.up.x) NB_NEXT(7, w.up.y) }
#undef NB_PREV
#undef NB_NEXT
    float mu16[16];
#pragma unroll
    for (int q = 0; q < 4; ++q) { const f32x4 m = *(const LAS f32x4*)(mu + q * 4); mu16[q * 4] = m[0]; mu16[q * 4 + 1] = m[1]; mu16[q * 4 + 2] = m[2]; mu16[q * 4 + 3] = m[3]; }
#pragma unroll
    for (int j = 0; j < 8; ++j)
#pragma unroll
        for (int hh = 0; hh < 2; ++hh) { const int pp = 2 * j + hh, i = (pp & 3) * 4 + (pp >> 2); const float z = hh ? bfhi(own[j]) : bflo(own[j]), zs = hh ? bfhi(nb[j]) : bflo(nb[j]); out[i] = z + (zs - z) * mu16[i]; }
}
#define MIX_ISSUE(w, colv) do { if (lat) mix16_issue<true>(w, Zr, rowbase, tl, dir, l15, (colv)); else mix16_issue<false>(w, Zr, rowbase, tl, dir, l15, (colv)); } while (0)
#define MIX_FINISH(w, k, outv) do { if (lat) mix16_finish<true>(w, tl, dir, l15, PAR + (k) * 64 + lq * 16, outv); else mix16_finish<false>(w, tl, dir, l15, PAR + (k) * 64 + lq * 16, outv); } while (0)
#define SCHED_FENCE() __builtin_amdgcn_sched_barrier(0)
__device__ __forceinline__ u32x4 packv8(const float* v) { return pack8(v); }
__device__ __forceinline__ void p4_rwkv_chunked(const Ctx& c, LAS unsigned char* lds) {
    const int tid = threadIdx.x, lane = tid & 63, wave = tid >> 6, l15 = lane & 15, lq = lane >> 4;
    LAS bf16_t* W2T = (LAS bf16_t*)(lds + RW_W2T); LAS bf16_t* A2T = (LAS bf16_t*)(lds + RW_A2T); LAS float* PAR = (LAS float*)(lds + RW_PAR);
    const bf16_t* Zr = (const bf16_t*)(c.ws + WS_ZR);
    float* bonus = (float*)(c.ws + WS_BONUS);
    for (int u = blockIdx.x; u < 256; u += gridDim.x) {
        const int dir = u & 1, h = (u >> 1) & 15, b = u >> 5;
        bf16_t* orr = (bf16_t*)(c.ws + (dir ? WS_ORB : WS_ORF));
        __syncthreads();
        for (int i = tid; i < 4096; i += NT) { const int j = i >> 6, ch = i & 63; W2T[ch * 72 + j] = f2bf(CIN(13)[(size_t)(dir * 64 + j) * 1024 + h * 64 + ch]); A2T[ch * 72 + j] = f2bf(CIN(15)[(size_t)j * 1024 + h * 64 + ch]); }
        if (tid < 64) { const int ch = tid, hc = h * 64 + ch;
            PAR[0 * 64 + ch] = CIN(11)[hc]; PAR[1 * 64 + ch] = CIN(11)[1024 + hc]; PAR[2 * 64 + ch] = CIN(11)[2048 + hc]; PAR[3 * 64 + ch] = CIN(11)[3072 + dir * 64 + ch]; PAR[4 * 64 + ch] = CIN(11)[3200 + ch];
            PAR[5 * 64 + ch] = CIN(12)[dir * 1024 + hc]; PAR[6 * 64 + ch] = CIN(14)[hc]; PAR[7 * 64 + ch] = CIN(17)[hc]; PAR[8 * 64 + ch] = CIN(18)[hc]; PAR[9 * 64 + ch] = CIN(19)[hc]; }
        __syncthreads();
        f32x4 Tt[4];
#pragma unroll
        for (int kt = 0; kt < 4; ++kt) Tt[kt] = (f32x4){0.f, 0.f, 0.f, 0.f};
        Raw16 wa, wb, wc; u32x4 bw0, bw1, ba0, ba1;
#define RW_ISSUE(qq) do { const int q_ = (qq); { const u32x4 z4_ = (u32x4){0u, 0u, 0u, 0u}; const u32x2 z2_ = (u32x2){0u, 0u}; wa.o0 = z4_; wa.o1 = z4_; wa.hal = z2_; wa.up = z2_; wa.dn = z2_; wb = wa; wc = wa; bw0 = z4_; bw1 = z4_; ba0 = z4_; ba1 = z4_; } if (q_ < 144) { const bool lat = q_ >= 16; const int cidx_ = lat ? (dir ? 127 - (q_ - 16) : q_ - 16) : (dir ? 15 - q_ : q_); \
            const int tl = cidx_ * 16 + (dir ? 15 - l15 : l15), rowbase = lat ? b * SEQ : MLAT + b * CTXL; \
            MIX_ISSUE(wa, ZR_OFF + 2048 + h * 64 + lq * 16); MIX_ISSUE(wb, ZR_OFF + 1024 + h * 64 + lq * 16); MIX_ISSUE(wc, ZR_OFF + h * 64 + lq * 16); \
            const bf16_t* zl = (const bf16_t*)(c.ws + WS_ZL) + (size_t)(rowbase + tl) * ZL_LD; \
            bw0 = ldg16(zl + dir * 64 + lq * 16); bw1 = ldg16(zl + dir * 64 + lq * 16 + 8); ba0 = ldg16(zl + 128 + lq * 16); ba1 = ldg16(zl + 128 + lq * 16 + 8); } } while (0)
#pragma unroll 1
        for (int rho = 0; rho <= 18; ++rho) {
            RW_ISSUE(8 * rho + wave);
            SCHED_FENCE();
            if (wave < 4 && rho >= 1) {
                const int vt = wave;
#pragma unroll 1
                for (int j4 = 0; j4 < 8; ++j4) {
                    const int q = 8 * (rho - 1) + j4; const bool lat = q >= 16;
                    const LAS unsigned char* slot = lds + j4 * RW_SLOT;
                    const u32x4 kf0 = *(const LAS u32x4*)(slot + RW_KAP + lane * 16), kf1 = *(const LAS u32x4*)(slot + RW_KAP + 1024 + lane * 16);
                    const u32x4 rf0 = *(const LAS u32x4*)(slot + RW_RT + lane * 16), rf1 = *(const LAS u32x4*)(slot + RW_RT + 1024 + lane * 16);
                    const u32x2 mkkf = *(const LAS u32x2*)(slot + RW_MKK + lane * 8), pmf = *(const LAS u32x2*)(slot + RW_PM + lane * 8);
                    const u32x4 arrf = *(const LAS u32x4*)(slot + RW_ARR + lane * 16);
                    const u32x2 vf = *(const LAS u32x2*)(slot + RW_VT + ((vt * 16 + l15) * 16 + lq * 4) * 2);
                    const u32x4 tb0 = (u32x4){pk2(Tt[0][0], Tt[0][1]), pk2(Tt[0][2], Tt[0][3]), pk2(Tt[1][0], Tt[1][1]), pk2(Tt[1][2], Tt[1][3])};
                    const u32x4 tb1 = (u32x4){pk2(Tt[2][0], Tt[2][1]), pk2(Tt[2][2], Tt[2][3]), pk2(Tt[3][0], Tt[3][1]), pk2(Tt[3][2], Tt[3][3])};
                    const f32x4 z4 = (f32x4){0.f, 0.f, 0.f, 0.f};
                    f32x4 xy = MFMA16(__builtin_bit_cast(bf16x8, kf0), __builtin_bit_cast(bf16x8, tb0), z4); xy = MFMA16(__builtin_bit_cast(bf16x8, kf1), __builtin_bit_cast(bf16x8, tb1), xy);
                    xy = MFMA16(__builtin_bit_cast(bf16x8, ((u32x4){mkkf.x, mkkf.y, 0u, 0u})), __builtin_bit_cast(bf16x8, ((u32x4){vf.x, vf.y, 0u, 0u})), xy);
                    const f32x4 uu = MFMA16(__builtin_bit_cast(bf16x8, ((u32x4){pmf.x, pmf.y, 0u, 0u})), __builtin_bit_cast(bf16x8, ((u32x4){pk2(xy[0], xy[1]), pk2(xy[2], xy[3]), 0u, 0u})), z4);
                    const u32x4 vub = (u32x4){vf.x, vf.y, pk2(uu[0], uu[1]), pk2(uu[2], uu[3])};
                    if (lat) {
                        f32x4 o = MFMA16(__builtin_bit_cast(bf16x8, rf0), __builtin_bit_cast(bf16x8, tb0), z4); o = MFMA16(__builtin_bit_cast(bf16x8, rf1), __builtin_bit_cast(bf16x8, tb1), o);
                        o = MFMA16(__builtin_bit_cast(bf16x8, arrf), __builtin_bit_cast(bf16x8, vub), o);
                        LAS bf16_t* ost = (LAS bf16_t*)(lds + RW_OST) + j4 * 1024;
#pragma unroll
                        for (int r = 0; r < 4; ++r) ost[(lq * 4 + r) * 64 + vt * 16 + l15] = f2bf(o[r]);
                    }
                    const LAS float* GCs = (const LAS float*)(slot + RW_GC) + lq * 16;
#pragma unroll
                    for (int kt = 0; kt < 4; ++kt) { const f32x4 gc = *(const LAS f32x4*)(GCs + kt * 4); const u32x4 kbf = *(const LAS u32x4*)(slot + RW_KBT + (kt * 64 + lane) * 16);
                        f32x4 t = Tt[kt];
#pragma unroll
                        for (int r = 0; r < 4; ++r) t[r] *= gc[r];
                        Tt[kt] = MFMA16(__builtin_bit_cast(bf16x8, kbf), __builtin_bit_cast(bf16x8, vub), t); }
                }
            }
            __syncthreads();
            {
                const int pw = wave;
                { const int q = 8 * (rho - 1) + pw;
                    if (rho >= 1 && q >= 16) { const int cidx = dir ? 127 - (q - 16) : q - 16; const int tok = lane >> 2, part = lane & 3, tl = cidx * 16 + (dir ? 15 - tok : tok);
                        const LAS bf16_t* src = (const LAS bf16_t*)(lds + RW_OST) + pw * 1024 + tok * 64 + part * 16;
                        bf16_t* dst = orr + (size_t)(b * SEQ + tl) * D + h * 64 + part * 16;
                        *(u32x4*)dst = *(const LAS u32x4*)src; *(u32x4*)(dst + 8) = *(const LAS u32x4*)(src + 8); } }
                const int q = 8 * rho + pw;
                if (q < 144) {
                    const bool lat = q >= 16;
                    const int cidx = lat ? (dir ? 127 - (q - 16) : q - 16) : (dir ? 15 - q : q);
                    const int tl = cidx * 16 + (dir ? 15 - l15 : l15), rowbase = lat ? b * SEQ : MLAT + b * CTXL;
                    LAS unsigned char* slot = lds + pw * RW_SLOT;
                    float rm[16], km[16];
                    {
                        SCHED_FENCE();
                        { float vm[16]; MIX_FINISH(wa, 2, vm);
                            LAS bf16_t* VT = (LAS bf16_t*)(slot + RW_VT);
#pragma unroll
                            for (int i = 0; i < 16; ++i) VT[(lq * 16 + i) * 16 + l15] = f2bf(vm[i]); }
                        SCHED_FENCE();
                        MIX_FINISH(wb, 1, km);
                        SCHED_FENCE();
                        MIX_FINISH(wc, 0, rm);
                    }
                    SCHED_FENCE();
                    float inv;
                    { float ss = 0.f;
#pragma unroll
                        for (int qd = 0; qd < 4; ++qd) { const f32x4 kkm = *(const LAS f32x4*)(PAR + 7 * 64 + lq * 16 + qd * 4);
#pragma unroll
                            for (int e = 0; e < 4; ++e) { const float x = km[qd * 4 + e] * kkm[e]; ss += x * x; } }
                        ss = reduce4f(ss); inv = fminf(__builtin_amdgcn_rsqf(ss), 1e12f); }
                    unsigned kapw[8], betw[8], ktw[8], rtw[8]; float bs = 0.f;
                    { LAS bf16_t* KB = (LAS bf16_t*)(slot + RW_KBT) + ((l15 >> 2) * 16 + lq * 4) * 8 + (l15 & 3); LAS float* GCs = (LAS float*)(slot + RW_GC) + lq * 16;
                        const int arow = (l15 >> 2) * 16 + (l15 & 3);
#pragma unroll
                        for (int nt = 0; nt < 4; ++nt) { SCHED_FENCE();
                            const LAS bf16_t* wr = W2T + (arow + nt * 4) * 72 + lq * 16; const LAS bf16_t* ar = A2T + (arow + nt * 4) * 72 + lq * 16;
                            f32x4 xw = MFMA16(*(const LAS bf16x8*)wr, __builtin_bit_cast(bf16x8, bw0), ((f32x4){0.f, 0.f, 0.f, 0.f})); xw = MFMA16(*(const LAS bf16x8*)(wr + 8), __builtin_bit_cast(bf16x8, bw1), xw);
                            f32x4 xa = MFMA16(*(const LAS bf16x8*)ar, __builtin_bit_cast(bf16x8, ba0), ((f32x4){0.f, 0.f, 0.f, 0.f})); xa = MFMA16(*(const LAS bf16x8*)(ar + 8), __builtin_bit_cast(bf16x8, ba1), xa);
                            const f32x4 w0 = *(const LAS f32x4*)(PAR + 5 * 64 + lq * 16 + nt * 4), a0 = *(const LAS f32x4*)(PAR + 6 * 64 + lq * 16 + nt * 4);
                            const f32x4 kkm = *(const LAS f32x4*)(PAR + 7 * 64 + lq * 16 + nt * 4), kam = *(const LAS f32x4*)(PAR + 8 * 64 + lq * 16 + nt * 4), rkm = *(const LAS f32x4*)(PAR + 9 * 64 + lq * 16 + nt * 4);
                            float ka4[4], be4[4], kt4[4], rt4[4], g4[4], lw4[4], kapn4[4], kpi4[4], betn4[4];
#pragma unroll
                            for (int r = 0; r < 4; ++r) { const int i = nt * 4 + r;
                                lw4[r] = -0.6065306597126334f * __builtin_amdgcn_rcpf(1.0f + fexp(-(w0[r] + xw[r])));
                                const float avi = sigmoidf_(a0[r] + xa[r]);
                                kapn4[r] = km[i] * kkm[r] * inv; kpi4[r] = km[i] * (1.0f + (avi - 1.0f) * kam[r]); betn4[r] = kapn4[r] * avi;
                                bs += rm[i] * kpi4[r] * rkm[r]; g4[r] = lw4[r]; }
                            asm volatile("s_nop 1\n"
                                "v_add_f32_dpp %0, %0, %0 row_shr:1 row_mask:0xf bank_mask:0xf\n" "v_add_f32_dpp %1, %1, %1 row_shr:1 row_mask:0xf bank_mask:0xf\n" "v_add_f32_dpp %2, %2, %2 row_shr:1 row_mask:0xf bank_mask:0xf\n" "v_add_f32_dpp %3, %3, %3 row_shr:1 row_mask:0xf bank_mask:0xf\n"
                                "v_add_f32_dpp %0, %0, %0 row_shr:2 row_mask:0xf bank_mask:0xf\n" "v_add_f32_dpp %1, %1, %1 row_shr:2 row_mask:0xf bank_mask:0xf\n" "v_add_f32_dpp %2, %2, %2 row_shr:2 row_mask:0xf bank_mask:0xf\n" "v_add_f32_dpp %3, %3, %3 row_shr:2 row_mask:0xf bank_mask:0xf\n"
                                "v_add_f32_dpp %0, %0, %0 row_shr:4 row_mask:0xf bank_mask:0xf\n" "v_add_f32_dpp %1, %1, %1 row_shr:4 row_mask:0xf bank_mask:0xf\n" "v_add_f32_dpp %2, %2, %2 row_shr:4 row_mask:0xf bank_mask:0xf\n" "v_add_f32_dpp %3, %3, %3 row_shr:4 row_mask:0xf bank_mask:0xf\n"
                                "v_add_f32_dpp %0, %0, %0 row_shr:8 row_mask:0xf bank_mask:0xf\n" "v_add_f32_dpp %1, %1, %1 row_shr:8 row_mask:0xf bank_mask:0xf\n" "v_add_f32_dpp %2, %2, %2 row_shr:8 row_mask:0xf bank_mask:0xf\n" "v_add_f32_dpp %3, %3, %3 row_shr:8 row_mask:0xf bank_mask:0xf\n"
                                "s_nop 1\n"
                                : "+v"(g4[0]), "+v"(g4[1]), "+v"(g4[2]), "+v"(g4[3]));
#pragma unroll
                            for (int r = 0; r < 4; ++r) { const int i = nt * 4 + r; const float g = g4[r], kapn = kapn4[r], kpi = kpi4[r], betn = betn4[r];
                                const float e1 = fexp(g), e2 = __builtin_amdgcn_rcpf(e1);
                                const float eC = DPP_F(e1, 0x15F);
                                float ep = DPP_F(e1, 0x111); ep = l15 == 0 ? 1.0f : ep;
                                const float kt_ = kpi * e2, bt_ = betn * e2;
                                ka4[r] = kapn * ep; be4[r] = bt_; kt4[r] = kt_; rt4[r] = rm[i] * e1;
                                KB[(nt * 64 + r) * 8] = f2bf(kt_ * eC); KB[(nt * 64 + r) * 8 + 4] = f2bf(-bt_ * eC);
                                if (l15 == 0) GCs[i] = eC; }
                            kapw[2 * nt] = pk2(ka4[0], ka4[1]); kapw[2 * nt + 1] = pk2(ka4[2], ka4[3]); betw[2 * nt] = pk2(be4[0], be4[1]); betw[2 * nt + 1] = pk2(be4[2], be4[3]);
                            ktw[2 * nt] = pk2(kt4[0], kt4[1]); ktw[2 * nt + 1] = pk2(kt4[2], kt4[3]); rtw[2 * nt] = pk2(rt4[0], rt4[1]); rtw[2 * nt + 1] = pk2(rt4[2], rt4[3]); }
                        SCHED_FENCE();
                        bs = reduce4f(bs);
                        if (lat && dir == 0 && lq == 0) bonus[(size_t)(b * SEQ + tl) * 16 + h] = bs; }
                    const u32x4 kapf0 = (u32x4){kapw[0], kapw[1], kapw[2], kapw[3]}, kapf1 = (u32x4){kapw[4], kapw[5], kapw[6], kapw[7]}, betf0 = (u32x4){betw[0], betw[1], betw[2], betw[3]}, betf1 = (u32x4){betw[4], betw[5], betw[6], betw[7]};
                    const u32x4 ktf0 = (u32x4){ktw[0], ktw[1], ktw[2], ktw[3]}, ktf1 = (u32x4){ktw[4], ktw[5], ktw[6], ktw[7]}, rtf0 = (u32x4){rtw[0], rtw[1], rtw[2], rtw[3]}, rtf1 = (u32x4){rtw[4], rtw[5], rtw[6], rtw[7]};
                    *(LAS u32x4*)(slot + RW_KAP + lane * 16) = kapf0; *(LAS u32x4*)(slot + RW_KAP + 1024 + lane * 16) = kapf1;
                    *(LAS u32x4*)(slot + RW_RT + lane * 16) = rtf0; *(LAS u32x4*)(slot + RW_RT + 1024 + lane * 16) = rtf1;
                    const f32x4 z4 = (f32x4){0.f, 0.f, 0.f, 0.f};
                    f32x4 mkb = MFMA16(__builtin_bit_cast(bf16x8, betf0), __builtin_bit_cast(bf16x8, kapf0), z4); mkb = MFMA16(__builtin_bit_cast(bf16x8, betf1), __builtin_bit_cast(bf16x8, kapf1), mkb);
                    f32x4 mkk = MFMA16(__builtin_bit_cast(bf16x8, ktf0), __builtin_bit_cast(bf16x8, kapf0), z4); mkk = MFMA16(__builtin_bit_cast(bf16x8, ktf1), __builtin_bit_cast(bf16x8, kapf1), mkk);
                    f32x4 ark = MFMA16(__builtin_bit_cast(bf16x8, ktf0), __builtin_bit_cast(bf16x8, rtf0), z4); ark = MFMA16(__builtin_bit_cast(bf16x8, ktf1), __builtin_bit_cast(bf16x8, rtf1), ark);
                    f32x4 arb = MFMA16(__builtin_bit_cast(bf16x8, betf0), __builtin_bit_cast(bf16x8, rtf0), z4); arb = MFMA16(__builtin_bit_cast(bf16x8, betf1), __builtin_bit_cast(bf16x8, rtf1), arb);
                    float arr8[8], mk4[4], mb4[4];
#pragma unroll
                    for (int r = 0; r < 4; ++r) { const int s = lq * 4 + r; mb4[r] = s < l15 ? mkb[r] : 0.f; mk4[r] = s < l15 ? mkk[r] : 0.f; arr8[r] = s <= l15 ? ark[r] : 0.f; arr8[4 + r] = s <= l15 ? -arb[r] : 0.f; }
                    *(LAS u32x4*)(slot + RW_ARR + lane * 16) = packv8(arr8);
                    { u32x2 w; w.x = pk2(mk4[0], mk4[1]); w.y = pk2(mk4[2], mk4[3]); *(LAS u32x2*)(slot + RW_MKK + lane * 8) = w; }
                    { LAS float* MS = (LAS float*)(lds + RW_MS) + pw * 320;
                        *(LAS f32x4*)(MS + l15 * 20 + lq * 4) = (f32x4){mb4[0], mb4[1], mb4[2], mb4[3]};
                        LDS_FENCE();
                        float mrow[16];
#pragma unroll
                        for (int qd = 0; qd < 4; ++qd) { const f32x4 m = *(const LAS f32x4*)(MS + l15 * 20 + qd * 4); mrow[qd * 4] = m[0]; mrow[qd * 4 + 1] = m[1]; mrow[qd * 4 + 2] = m[2]; mrow[qd * 4 + 3] = m[3]; }
                        LDS_FENCE();
                        float p4[4];
#pragma unroll
                        for (int j = 0; j < 4; ++j) p4[j] = (l15 == lq * 4 + j) ? 1.0f : 0.f;
                        float nm[15];
#pragma unroll
                        for (int q = 0; q < 15; ++q) nm[q] = -mrow[q];
#define PS4(sidx, op) "v_fmac_f32_dpp %0, %0, %" #op " row_newbcast:" #sidx " row_mask:0xf bank_mask:0xf\n" "v_fmac_f32_dpp %1, %1, %" #op " row_newbcast:" #sidx " row_mask:0xf bank_mask:0xf\n" \
                    "v_fmac_f32_dpp %2, %2, %" #op " row_newbcast:" #sidx " row_mask:0xf bank_mask:0xf\n" "v_fmac_f32_dpp %3, %3, %" #op " row_newbcast:" #sidx " row_mask:0xf bank_mask:0xf\n"
                        asm volatile("s_nop 1\n"
                            PS4(0, 4) PS4(1, 5) PS4(2, 6) PS4(3, 7) PS4(4, 8) PS4(5, 9) PS4(6, 10) PS4(7, 11) PS4(8, 12) PS4(9, 13) PS4(10, 14) PS4(11, 15) PS4(12, 16) PS4(13, 17) PS4(14, 18)
                            "s_nop 1\n"
                            : "+v"(p4[0]), "+v"(p4[1]), "+v"(p4[2]), "+v"(p4[3])
                            : "v"(nm[0]), "v"(nm[1]), "v"(nm[2]), "v"(nm[3]), "v"(nm[4]), "v"(nm[5]), "v"(nm[6]), "v"(nm[7]), "v"(nm[8]), "v"(nm[9]), "v"(nm[10]), "v"(nm[11]), "v"(nm[12]), "v"(nm[13]), "v"(nm[14]));
#undef PS4
                        u32x2 w; w.x = pk2(p4[0], p4[1]); w.y = pk2(p4[2], p4[3]); *(LAS u32x2*)(slot + RW_PM + lane * 8) = w; }
                }
            }
            __syncthreads();
        }
    }
}
__device__ __forceinline__ void p5_post(const Ctx& c, LAS unsigned char* lds, bool dry = false) {
    const int tid = threadIdx.x, lane = tid & 63, wave = tid >> 6, l15 = lane & 15, lq = lane >> 4;
    LAS bf16_t* SG = (LAS bf16_t*)lds;
    LAS bf16_t* GL = SG + 64 * 200;
    const bf16_t* Zr = (const bf16_t*)(c.ws + WS_ZR); const bf16_t* g2t = (const bf16_t*)(c.ws + WS_G2T);
    bf16_t* og_f = (bf16_t*)c.out; const bf16_t* og_b = og_f + (size_t)MLAT * D;
    bf16_t* or_f = (bf16_t*)(c.ws + WS_ORF); const bf16_t* or_b = (const bf16_t*)(c.ws + WS_ORB);
    const float* bonus = (const float*)(c.ws + WS_BONUS);
    for (int u = blockIdx.x; u < MLAT / 64; u += gridDim.x) {
        const int rowbase = (u >> 5) * SEQ, tl0 = (u & 31) * 64;
        __syncthreads();
        { const int tok = tid >> 3, seg = tid & 7; const bf16_t* zl = (const bf16_t*)(c.ws + WS_ZL) + (size_t)(rowbase + tl0 + tok) * ZL_LD + 192;
#pragma unroll
            for (int k = 0; k < 3; ++k) { const int sgi = seg + 8 * k; u32x4 w = (u32x4){0u, 0u, 0u, 0u};
                if (sgi < 20) w = ldg16(zl + sgi * 8);
                *(LAS u32x4*)(SG + tok * 200 + sgi * 8) = w; } }
        __syncthreads();
#pragma unroll 1
        for (int half = 0; half < 2; ++half) {
            f32x4 acc[4][4];
#pragma unroll
            for (int mt = 0; mt < 4; ++mt)
#pragma unroll
                for (int nt = 0; nt < 4; ++nt) acc[mt][nt] = (f32x4){0.f, 0.f, 0.f, 0.f};
#pragma unroll
            for (int ks = 0; ks < 6; ++ks) { bf16x8 bfr[4], afr[4];
#pragma unroll
                for (int nt = 0; nt < 4; ++nt) bfr[nt] = *(const bf16x8*)(g2t + (size_t)(wave * 128 + (half * 4 + nt) * 16 + l15) * 192 + ks * 32 + lq * 8);
#pragma unroll
                for (int mt = 0; mt < 4; ++mt) afr[mt] = *(LAS bf16x8*)(SG + (mt * 16 + l15) * 200 + ks * 32 + lq * 8);
#pragma unroll
                for (int mt = 0; mt < 4; ++mt)
#pragma unroll
                    for (int nt = 0; nt < 4; ++nt) acc[mt][nt] = MFMA16(afr[mt], bfr[nt], acc[mt][nt]); }
#pragma unroll
            for (int mt = 0; mt < 4; ++mt)
#pragma unroll
                for (int nt = 0; nt < 4; ++nt)
#pragma unroll
                    for (int r = 0; r < 4; ++r) GL[(mt * 16 + lq * 4 + r) * 1032 + wave * 128 + (half * 4 + nt) * 16 + l15] = f2bf(acc[mt][nt][r]);
        }
        __syncthreads();
        for (int ii = 0; ii < 8; ++ii) {
            const int i = wave * 8 + ii; const size_t R = (size_t)rowbase + tl0 + i; const int ch0 = lane * 16;
            { float s[16], t[16]; unpack8(ldg16(og_f + R * D + ch0), s); unpack8(ldg16(og_f + R * D + ch0 + 8), s + 8); unpack8(ldg16(og_b + R * D + ch0), t); unpack8(ldg16(og_b + R * D + ch0 + 8), t + 8);
                float ssq = 0.f;
#pragma unroll
                for (int e = 0; e < 16; ++e) { s[e] += t[e]; ssq += s[e] * s[e]; }
                ssq += __shfl_xor(ssq, 1); ssq += __shfl_xor(ssq, 2); ssq += __shfl_xor(ssq, 4); ssq += __shfl_xor(ssq, 8);
                const float rs = rsqrtf(ssq * (1.0f / 256.0f) + 1e-6f);
#pragma unroll
                for (int e = 0; e < 16; ++e) s[e] = s[e] * rs * CIN(10)[ch0 + e];
                bf16_t* wp = dry ? (bf16_t*)(c.ws + WS_WIN) + (R & 4095) * D + ch0 : og_f + R * D + ch0;
                *(u32x4*)wp = pack8(s); *(u32x4*)(wp + 8) = pack8(s + 8); }
            { float s[16], t[16]; unpack8(ldg16(or_f + R * D + ch0), s); unpack8(ldg16(or_f + R * D + ch0 + 8), s + 8); unpack8(ldg16(or_b + R * D + ch0), t); unpack8(ldg16(or_b + R * D + ch0 + 8), t + 8);
                float sm = 0.f;
#pragma unroll
                for (int e = 0; e < 16; ++e) { s[e] += t[e]; sm += s[e]; }
                sm += __shfl_xor(sm, 1); sm += __shfl_xor(sm, 2);
                const float mean = sm * (1.0f / 64.0f); float sv = 0.f;
#pragma unroll
                for (int e = 0; e < 16; ++e) { s[e] -= mean; sv += s[e] * s[e]; }
                sv += __shfl_xor(sv, 1); sv += __shfl_xor(sv, 2);
                const float rs = rsqrtf(sv * (1.0f / 64.0f) + 64e-5f);
                const float bn = bonus[R * 16 + (lane >> 2)];
                float vm[16], g[16];
                mix16_direct_lat(Zr, rowbase, tl0 + i, ZR_OFF + 2048 + ch0, CIN(11) + 2048 + ch0, vm);
                unpack8(*(LAS u32x4*)(GL + i * 1032 + ch0), g); unpack8(*(LAS u32x4*)(GL + i * 1032 + ch0 + 8), g + 8);
#pragma unroll
                for (int e = 0; e < 16; ++e) s[e] = (s[e] * rs * CIN(20)[ch0 + e] + CIN(21)[ch0 + e] + bn * vm[e]) * g[e];
                bf16_t* wp = dry ? (bf16_t*)(c.ws + WS_WIN) + (R & 4095) * D + ch0 : or_f + R * D + ch0;
                *(u32x4*)wp = pack8(s); *(u32x4*)(wp + 8) = pack8(s + 8); }
        }
    }
    __syncthreads();
}

__device__ __forceinline__ void p7_combine(const Ctx& c) {
    const bf16_t* Z3 = (const bf16_t*)(c.ws + WS_Z3); const bf16_t* yg = (const bf16_t*)c.out; const bf16_t* yr = (const bf16_t*)(c.ws + WS_ORF); bf16_t* Y = (bf16_t*)(c.ws + WS_A1);
    for (int idx = blockIdx.x * NT + threadIdx.x; idx < MLAT * 128; idx += gridDim.x * NT) {
        const size_t row = idx >> 7; const int c8 = (idx & 127) * 8;
        float go[8], sg[8], sr[8], a[8], b[8], y[8];
        unpack8(ldg16(Z3 + row * Z3_LD + c8), go); unpack8(ldg16(Z3 + row * Z3_LD + 1024 + c8), sg); unpack8(ldg16(Z3 + row * Z3_LD + 2048 + c8), sr);
        unpack8(ldg16(yg + row * D + c8), a); unpack8(ldg16(yr + row * D + c8), b);
#pragma unroll
        for (int e = 0; e < 8; ++e) y[e] = sg[e] * a[e] * go[e] + sr[e] * b[e];
        *(u32x4*)(Y + row * D + c8) = pack8(y);
    }
}

__device__ __forceinline__ void p9_norm2_tables(const Ctx& c) {
    const int lane = threadIdx.x & 63, wave = threadIdx.x >> 6; const float* m = (const float*)(c.ws + WS_MOD); bf16_t* A2 = (bf16_t*)(c.ws + WS_A1);
    { const int stride = gridDim.x * 8;
        for (int row = blockIdx.x * 8 + wave; row < MLAT; row += 2 * stride) { const int rb = row + stride, b0 = row / SEQ;
            if (rb < MLAT) { const int b1 = rb / SEQ; norm_mod_row2(c.out + (size_t)row * D, c.out + (size_t)rb * D, CIN(23), m + b0 * MODW + 3072, m + b0 * MODW + 4096, m + b1 * MODW + 3072, m + b1 * MODW + 4096, A2 + (size_t)row * D, A2 + (size_t)rb * D, lane); }
            else norm_mod_row(c.out + (size_t)row * D, CIN(23), m + b0 * MODW + 3072, m + b0 * MODW + 4096, A2 + (size_t)row * D, lane); } }
    unsigned* UT = (unsigned*)(c.ws + WS_UT); unsigned* VT = (unsigned*)(c.ws + WS_VT);
    for (size_t i = ((size_t)blockIdx.x * NT + threadIdx.x) * 4; i < (size_t)16384 * 1024; i += (size_t)gridDim.x * NT * 4) {
        const f32x4 a = *(const f32x4*)(CIN(26) + i), b = *(const f32x4*)(CIN(27) + i); const size_t e = i >> 10, cc = i & 1023, o = ((cc >> 9) * (size_t)8388608 + e * 512 + (cc & 511)) >> 2;
        int w = __builtin_amdgcn_cvt_pk_fp8_f32(a[0] * 64.0f, a[1] * 64.0f, 0, false); w = __builtin_amdgcn_cvt_pk_fp8_f32(a[2] * 64.0f, a[3] * 64.0f, w, true); UT[o] = (unsigned)w;
        w = __builtin_amdgcn_cvt_pk_fp8_f32(b[0], b[1], 0, false); w = __builtin_amdgcn_cvt_pk_fp8_f32(b[2], b[3], w, true); VT[o] = (unsigned)w; }
}
typedef float f32x2p __attribute__((ext_vector_type(2)));
__device__ __forceinline__ void fp8x16_to_f32(const u32x4 w, float* o) {
#pragma unroll
    for (int q = 0; q < 4; ++q) { const f32x2p lo = __builtin_amdgcn_cvt_pk_f32_fp8((int)w[q], false), hi = __builtin_amdgcn_cvt_pk_f32_fp8((int)w[q], true); o[q * 4] = lo[0]; o[q * 4 + 1] = lo[1]; o[q * 4 + 2] = hi[0]; o[q * 4 + 3] = hi[1]; }
}
__device__ __forceinline__ float row16_sum(float x) {
    x += __builtin_bit_cast(float, __builtin_amdgcn_update_dpp(0, __builtin_bit_cast(int, x), 0x128, 0xf, 0xf, false));
    x += __builtin_bit_cast(float, __builtin_amdgcn_update_dpp(0, __builtin_bit_cast(int, x), 0x124, 0xf, 0xf, false));
    x += __builtin_bit_cast(float, __builtin_amdgcn_update_dpp(0, __builtin_bit_cast(int, x), 0x122, 0xf, 0xf, false));
    x += __builtin_bit_cast(float, __builtin_amdgcn_update_dpp(0, __builtin_bit_cast(int, x), 0x121, 0xf, 0xf, false));
    return x;
}
__device__ __forceinline__ float row32_sum(float x) {
    x = row16_sum(x);
    auto r = __builtin_amdgcn_permlane16_swap(__float_as_uint(x), __float_as_uint(x), false, false);
    return __uint_as_float(r[0]) + __uint_as_float(r[1]);
}
__device__ __forceinline__ float gelu_as(float v) {
    const float av = fabsf(v), t = __builtin_amdgcn_rcpf(av * 0.2316418882f + 1.0f);
    float q = t * 0.5307027145f - 0.7265760135f; q = q * t + 0.7107068705f; q = q * t - 0.142248368f; q = q * t + 0.127414796f; q = q * t;
    const float e = __builtin_amdgcn_exp2f(v * v * -0.72134752044f), mneg = v * (q * e);
    return v < 0.f ? mneg : v - mneg;
}

typedef int i32x8 __attribute__((ext_vector_type(8)));
constexpr int BF_HL = 4096, BF_WAVE = 2 * BF_HL;
#define S9_ROW(e) ((unsigned)(e) & rmask)
template <int EXP> __device__ __forceinline__ void p12_sweep10(const Ctx& c, int R0, LAS unsigned char* lds, int tid) {
    constexpr bool dry = EXP != 0;
    const int lane = tid & 63, wave = __builtin_amdgcn_readfirstlane(tid >> 6), l15 = lane & 15, lq = lane >> 4;
    LAS int* SIDX = (LAS int*)lds; LAS float* SGATE = (LAS float*)(SIDX + 8192);
    const LAS int* IDXL = (const LAS int*)lds + 16384; const LAS float* GATEL = (const LAS float*)(IDXL + 64 * IDSTR);
    LAS unsigned char* BF = lds + 65536 + wave * BF_WAVE;
    LAS int* HIST = (LAS int*)(lds + 133120) + wave * 64;
    LAS float* XP = (LAS float*)(lds + 135168) + wave * 512;
    const bf16_t* A2 = (const bf16_t*)(c.ws + WS_A1); const unsigned char* UT = (const unsigned char*)(c.ws + WS_UT); const unsigned char* VT = (const unsigned char*)(c.ws + WS_VT); const float* m = (const float*)(c.ws + WS_MOD);
    for (int k = 0; k < 8; ++k) { const int tok = wave + 8 * k;
        if (lane < 32) HIST[lane] = 0;
        const int e0 = IDXL[tok * IDSTR + lane], e1 = IDXL[tok * IDSTR + 64 + lane]; const float g0 = GATEL[tok * IDSTR + lane], g1 = GATEL[tok * IDSTR + 64 + lane];
        const int b0 = e0 >> 9, b1 = e1 >> 9;
        const int r0 = __hip_atomic_fetch_add(HIST + b0, 1, __ATOMIC_RELAXED, __HIP_MEMORY_SCOPE_WORKGROUP), r1 = __hip_atomic_fetch_add(HIST + b1, 1, __ATOMIC_RELAXED, __HIP_MEMORY_SCOPE_WORKGROUP);
        const int cnt = lane < 32 ? __hip_atomic_load(HIST + (lane & 31), __ATOMIC_RELAXED, __HIP_MEMORY_SCOPE_WORKGROUP) : 0; int incl = cnt;
#pragma unroll
        for (int o = 1; o < 32; o <<= 1) { const int v = __shfl_up(incl, o); if (lane >= o) incl += v; }
        if (lane < 32) HIST[32 + lane] = incl - cnt;
        LDS_FENCE();
        const int pos0 = HIST[32 + b0] + r0, pos1 = HIST[32 + b1] + r1;
        SIDX[tok * 128 + pos0] = e0; SGATE[tok * 128 + pos0] = g0; SIDX[tok * 128 + pos1] = e1; SGATE[tok * 128 + pos1] = g1;
        LDS_FENCE(); }
    __syncthreads();
    const int psel = l15 & 3;
    float wsel[4];
#pragma unroll
    for (int r = 0; r < 4; ++r) wsel[r] = ((l15 >> 2) == lq && psel == r) ? 1.0f : 0.f;
#pragma unroll 1
    for (int rep = 0; rep < S8_REPS; ++rep)
#pragma unroll 1
    for (int pass = 0; pass < 2; ++pass) {
        const bool dryrep = dry || (rep + 1 < S8_REPS); const unsigned rmask = (dryrep && S8_HOT) ? 63u : 16383u;
#pragma unroll
        for (int k = 0; k < 4; ++k) { const int tok = wave + 8 * (pass * 4 + k); float a[16];
            unpack8(ldg16(A2 + (size_t)(R0 + tok) * D + lane * 16), a); unpack8(ldg16(A2 + (size_t)(R0 + tok) * D + lane * 16 + 8), a + 8);
            u32x4 hi, lo;
#pragma unroll
            for (int q = 0; q < 4; ++q) { int w = __builtin_amdgcn_cvt_pk_fp8_f32(a[4 * q], a[4 * q + 1], 0, false); w = __builtin_amdgcn_cvt_pk_fp8_f32(a[4 * q + 2], a[4 * q + 3], w, true);
                const f32x2p h01 = __builtin_amdgcn_cvt_pk_f32_fp8(w, false), h23 = __builtin_amdgcn_cvt_pk_f32_fp8(w, true);
                int v = __builtin_amdgcn_cvt_pk_fp8_f32(a[4 * q] - h01[0], a[4 * q + 1] - h01[1], 0, false); v = __builtin_amdgcn_cvt_pk_fp8_f32(a[4 * q + 2] - h23[0], a[4 * q + 3] - h23[1], v, true);
                hi[q] = (unsigned)w; lo[q] = (unsigned)v; }
            LAS unsigned char* bp = BF + (((((lane >> 5) * 4 + ((lane >> 2) & 3)) * 2 + ((lane >> 4) & 1)) * 16) + 4 * k + (lane & 3)) * 16;
            *(LAS u32x4*)bp = hi; *(LAS u32x4*)(bp + BF_HL) = lo; }
        LDS_FENCE();
        const int tokv = wave + 8 * (pass * 4 + lq);
        const LAS int* LV = SIDX + tokv * 128; LAS float* LGv = SGATE + tokv * 128; LAS float* XPv = XP + lq * 128;
        const LAS int* LU = SIDX + (wave + 8 * (pass * 4 + (l15 >> 2))) * 128;
        const unsigned offU = (unsigned)(lq * 64 + psel * 16), offV = (unsigned)(l15 * 16);
#pragma unroll 1
        for (int jj = 0; jj < 2; ++jj) { u32x4 U[8][2];
            const unsigned char* UTj = UT + (size_t)jj * 8388608; const LAS unsigned char* BFr = BF + (lq * 32 + l15) * 16 + jj * 2048;
#pragma unroll
            for (int s2 = 0; s2 < 8; ++s2) { const unsigned char* up = UTj + (size_t)((S9_ROW(LU[s2]) << 9) + offU);
                U[s2][0] = *(const u32x4*)up; U[s2][1] = *(const u32x4*)(up + 256); }
#pragma unroll 1
            for (int g = 0; g < 16; ++g) {
#pragma unroll
                for (int i = 0; i < 8; ++i) { const int step = 8 * g + i;
                    f32x4 d = (f32x4){0.f, 0.f, 0.f, 0.f};
                    { const u32x4 a0 = U[i][0], a1 = U[i][1];
                        const i32x8 a8 = {(int)a0.x, (int)a0.y, (int)a0.z, (int)a0.w, (int)a1.x, (int)a1.y, (int)a1.z, (int)a1.w};
#pragma unroll
                        for (int hl = 0; hl < 2; ++hl) { const u32x4 b0 = *(const LAS u32x4*)(BFr + hl * BF_HL), b1 = *(const LAS u32x4*)(BFr + hl * BF_HL + 256);
                            const i32x8 b8 = {(int)b0.x, (int)b0.y, (int)b0.z, (int)b0.w, (int)b1.x, (int)b1.y, (int)b1.z, (int)b1.w};
                            d = __builtin_amdgcn_mfma_scale_f32_16x16x128_f8f6f4(a8, b8, d, 0, 0, 0, 0, 0, 0); } }
                    SCHED_FENCE();
                    { const unsigned char* up = UTj + (size_t)((S9_ROW(LU[(step + 8) & 127]) << 9) + offU);
                        U[i][0] = *(const u32x4*)up; U[i][1] = *(const u32x4*)(up + 256); }
                    SCHED_FENCE();
                    const float x = row16_sum(d[0] * wsel[0] + d[1] * wsel[1] + d[2] * wsel[2] + d[3] * wsel[3]);
                    if (jj == 0) { if (l15 == 0) XPv[step] = x; }
                    else { const float cf = LGv[step] * gelu_as((x + XPv[step]) * (1.0f / 64.0f)); if (l15 == 0) LGv[step] = cf; }
                    SCHED_FENCE(); }
            }
            LDS_FENCE();
        }
        f32x2p acc[32];
#pragma unroll
        for (int e = 0; e < 32; ++e) acc[e] = (f32x2p){0.f, 0.f};
#pragma unroll
        for (int hv = 0; hv < 2; ++hv) { u32x4 V[8][2];
            const unsigned char* VTh = VT + (size_t)hv * 8388608;
#pragma unroll
            for (int s2 = 0; s2 < 8; ++s2) { const unsigned char* vp = VTh + (size_t)((S9_ROW(LV[s2]) << 9) + offV);
                V[s2][0] = *(const u32x4*)vp; V[s2][1] = *(const u32x4*)(vp + 256); }
#pragma unroll 1
            for (int g = 0; g < 16; ++g) {
#pragma unroll
                for (int i = 0; i < 8; ++i) { const int step = 8 * g + i;
                    const float cf = LGv[step]; const f32x2p cf2 = (f32x2p){cf, cf};
#pragma unroll
                    for (int q = 0; q < 2; ++q)
#pragma unroll
                        for (int w = 0; w < 4; ++w) { acc[hv * 16 + q * 8 + w * 2] += cf2 * __builtin_amdgcn_cvt_pk_f32_fp8((int)V[i][q][w], false); acc[hv * 16 + q * 8 + w * 2 + 1] += cf2 * __builtin_amdgcn_cvt_pk_f32_fp8((int)V[i][q][w], true); }
                    SCHED_FENCE();
                    { const unsigned char* vp = VTh + (size_t)((S9_ROW(LV[(step + 8) & 127]) << 9) + offV);
                        V[i][0] = *(const u32x4*)vp; V[i][1] = *(const u32x4*)(vp + 256); }
                    SCHED_FENCE(); }
            }
        }
        { const int R = R0 + tokv; const int b = R / SEQ; const float* g2 = m + b * MODW + 5120; float* hrow = c.out + (size_t)R * D; float ss = 0.f;
            f32x4 h2[16];
#pragma unroll
            for (int q = 0; q < 4; ++q)
#pragma unroll
                for (int w = 0; w < 4; ++w) { const int ch = q * 256 + l15 * 16 + w * 4; const f32x4 hv = *(const f32x4*)(hrow + ch), gv = *(const f32x4*)(g2 + ch);
                    const float a4[4] = {acc[q * 8 + 2 * w][0], acc[q * 8 + 2 * w][1], acc[q * 8 + 2 * w + 1][0], acc[q * 8 + 2 * w + 1][1]};
#pragma unroll
                    for (int e = 0; e < 4; ++e) { const float v = hv[e] + gv[e] * a4[e]; h2[q * 4 + w][e] = v; ss += v * v; } }
            ss = row16_sum(ss);
            const float rstd = rsqrtf(ss * (1.0f / 1024.0f) + 1e-6f);
            float* orow = dryrep ? (float*)(c.ws + WS_ZR + (size_t)56 * 1048576) + (size_t)(R & 8191) * D : hrow;
#pragma unroll
            for (int q = 0; q < 4; ++q)
#pragma unroll
                for (int w = 0; w < 4; ++w) { const int ch = q * 256 + l15 * 16 + w * 4; const f32x4 wv = *(const f32x4*)(CIN(28) + ch); f32x4 o;
#pragma unroll
                    for (int e = 0; e < 4; ++e) o[e] = h2[q * 4 + w][e] * rstd * wv[e];
                    *(f32x4*)(orow + ch) = o; } }
    }
}

__device__ __forceinline__ int sortable(float v) { const int b = __float_as_int(v); return b ^ ((b >> 31) & 0x7fffffff); }
__device__ __forceinline__ float unsortable(int k) { return __int_as_float(k ^ ((k >> 31) & 0x7fffffff)); }
#define CASD(a, b) { const int _hi = max(a, b), _lo = min(a, b); a = _hi; b = _lo; }
#define CAS16(t, x) { _Pragma("unroll") for (int _i = 0; _i < 16; ++_i) { const int _hi = max(t[_i], x); x = min(t[_i], x); t[_i] = _hi; } }
__device__ __forceinline__ void bitonic_merge16_desc(int* t) {
#pragma unroll
    for (int d = 8; d >= 1; d >>= 1)
#pragma unroll
        for (int i = 0; i < 16; ++i) if ((i & d) == 0) CASD(t[i], t[i + d]);
}
__device__ __forceinline__ void bitonic_sort16_desc(int* t) {
#pragma unroll
    for (int k = 2; k <= 16; k <<= 1)
#pragma unroll
        for (int d = k >> 1; d >= 1; d >>= 1)
#pragma unroll
            for (int i = 0; i < 16; ++i) { const int j = i ^ d; if (j > i) { if ((i & k) == 0 || k == 16) { CASD(t[i], t[j]); } else { CASD(t[j], t[i]); } } }
}
template <int EXP> __device__ __forceinline__ void p11_topk(const Ctx& c, LAS unsigned char* lds) {
    LAS int* KEYS = (LAS int*)lds;
    const bf16_t* Q = (const bf16_t*)(c.ws + WS_Q); const bf16_t* SK = (const bf16_t*)(c.ws + WS_SK);
    LAS int* IDXL = KEYS + 16384;
    LAS float* GATEL = (LAS float*)(IDXL + 64 * IDSTR);
    const int wv_s = __builtin_amdgcn_readfirstlane(threadIdx.x >> 6);
    for (int u = blockIdx.x; u < MLAT / 64; u += gridDim.x) {
        int tid; asm volatile("v_mbcnt_lo_u32_b32 %0, -1, 0\n\tv_mbcnt_hi_u32_b32 %0, -1, %0\n\tv_or_b32 %0, %1, %0" : "=&v"(tid) : "s"(wv_s << 6));
        const int lane = tid & 63, wave = tid >> 6, l15 = lane & 15, lq = lane >> 4;
        const int R0 = u * 64, tt = wave >> 1, p = wave & 1;
        __syncthreads();
#pragma unroll 1
        for (int h = 0; h < 8; ++h) {
            bf16x8 qf[4];
#pragma unroll
            for (int ks = 0; ks < 4; ++ks) qf[ks] = *(const bf16x8*)(Q + (size_t)(R0 + tt * 16 + l15) * 2048 + h * 256 + p * 128 + ks * 32 + lq * 8);
            int ta[16], tb[16];
#pragma unroll
            for (int nt = 0; nt < 8; ++nt) { f32x4 a = (f32x4){0.f, 0.f, 0.f, 0.f};
#pragma unroll
                for (int ks = 0; ks < 4; ++ks) a = MFMA16(*(const bf16x8*)(SK + (size_t)((h * 2 + p) * 128 + nt * 16 + l15) * 128 + ks * 32 + lq * 8), qf[ks], a);
#pragma unroll
                for (int r = 0; r < 4; ++r) { const int n = nt * 16 + lq * 4 + r; const int key = (sortable(a[r]) & ~127) | (127 - n);
                    if (nt < 4) ta[nt * 4 + r] = key; else tb[(nt - 4) * 4 + r] = key; } }
            bitonic_sort16_desc(ta); bitonic_sort16_desc(tb);
#pragma unroll
            for (int i = 0; i < 16; ++i) ta[i] = max(ta[i], tb[15 - i]);
            bitonic_merge16_desc(ta);
#pragma unroll
            for (int st = 0; st < 2; ++st) {
#pragma unroll
                for (int i = 0; i < 16; ++i) tb[i] = __shfl_xor(ta[i], st ? 32 : 16);
#pragma unroll
                for (int i = 0; i < 16; ++i) ta[i] = max(ta[i], tb[15 - i]);
                bitonic_merge16_desc(ta); }
            if (lq == 0) {
#pragma unroll
                for (int i = 0; i < 16; ++i) KEYS[((h * 2 + p) * 16 + i) * 64 + tt * 16 + l15] = ta[i]; }
        }
        __syncthreads();
        {
            const int tok = tid & 63, h = tid >> 6;
            int k1[16], k2[16]; float s1[16], s2[16];
#pragma unroll
            for (int i = 0; i < 16; ++i) { k1[i] = KEYS[((h * 2) * 16 + i) * 64 + tok]; k2[i] = KEYS[((h * 2 + 1) * 16 + i) * 64 + tok]; s1[i] = unsortable(k1[i] & ~127); s2[i] = unsortable(k2[i] & ~127); }
            int t[16];
#pragma unroll
            for (int j = 0; j < 16; ++j) t[j] = (sortable(s1[0] + s2[j]) & ~255) | (255 - j);
#pragma unroll
            for (int i = 1; i < 16; ++i)
#pragma unroll
                for (int j = 0; j < 16; ++j) if ((i + 1) * (j + 1) <= 16) { int x = (sortable(s1[i] + s2[j]) & ~255) | (255 - (i * 16 + j)); CAS16(t, x); }
            float sv[16]; int ev[16]; float mx = -3.0e38f;
#pragma unroll
            for (int k = 0; k < 16; ++k) { const int id = 255 - (t[k] & 255), i = id >> 4, j = id & 15;
                const int ia = KEYS[((h * 2) * 16 + i) * 64 + tok], ib = KEYS[((h * 2 + 1) * 16 + j) * 64 + tok];
                sv[k] = unsortable(ia & ~127) + unsortable(ib & ~127); ev[k] = (127 - (ia & 127)) * 128 + (127 - (ib & 127)); mx = fmaxf(mx, sv[k]); }
            float den = 0.f;
#pragma unroll
            for (int k = 0; k < 16; ++k) { sv[k] = fexp(sv[k] - mx); den += sv[k]; }
            const float inv = 1.0f / den; const int o = tok * IDSTR + h * 16;
#pragma unroll
            for (int k = 0; k < 16; k += 4) { *(LAS u32x4*)(IDXL + o + k) = (u32x4){(unsigned)ev[k], (unsigned)ev[k + 1], (unsigned)ev[k + 2], (unsigned)ev[k + 3]};
                *(LAS f32x4*)(GATEL + o + k) = (f32x4){sv[k] * inv, sv[k + 1] * inv, sv[k + 2] * inv, sv[k + 3] * inv}; }
        }
        __syncthreads();
        if (EXP != 2) p12_sweep10<EXP>(c, R0, lds, tid);
    }
    __syncthreads();
}

constexpr int N_PHASES = 12;
#ifndef RWKV_IMPL
#define RWKV_IMPL 1
#endif
#ifndef RWKV_PROBE
#define RWKV_PROBE 0
#endif
__global__ void __launch_bounds__(NT, 2) fwd_kernel(Args args) {
    extern __shared__ __attribute__((aligned(16))) unsigned char lds_raw[];
    LAS unsigned char* lds0 = (LAS unsigned char*)lds_raw;
    LAS unsigned char* lds = lds0 + LDS_HDR;
    Ctx c; c.in = (KArgPtr)__builtin_amdgcn_kernarg_segment_ptr();
    c.out = args.out; c.ws = args.ws;
    if (threadIdx.x < 16) ((LAS unsigned*)lds0)[threadIdx.x] = 0u;
    __syncthreads();
    const int lo = args.ph_lo, hi = args.ph_hi;
    const bool multi = (hi - lo) > 1;
    XcdBarrier bar; bar.bar = (unsigned*)(c.ws + WS_CTL); bar.x = 0; bar.st = (volatile LAS unsigned*)lds0;
    if (multi) bar = xcd_barrier_post((unsigned*)(c.ws + WS_CTL), (volatile LAS unsigned*)lds0);
#ifndef PROBE_T
#define PROBE_T -1
#endif
    LAS unsigned long long* stamps = (LAS unsigned long long*)(lds0 + LDS_BYTES - 256);
#define STAMP(i) do { if (PROBE_T >= 0 && threadIdx.x == 0) stamps[i] = wall_clock64(); } while (0)
#define IN(k) (lo <= (k) && (k) < hi)
#define SEAM(k) do { STAMP(2 * (k) + 1); if (IN(k) && IN((k) + 1)) { xcd_barrier(bar); if (DUP(20)) xcd_barrier(bar); } STAMP(2 * (k) + 2); } while (0)
    STAMP(0);
    const bf16_t* Wt_in = (const bf16_t*)(c.ws + WS_WIN);
    if (IN(0)) { p0_prologue(c, lds); if (DUP(0)) p0_prologue(c, lds); } SEAM(0);
    if (IN(1)) { p1_norm1(c); if (DUP(1)) p1_norm1(c); } SEAM(1);
    if (IN(2)) { pg8::Gemm g{(const bf16_t*)(c.ws + WS_A1), Wt_in, MALL, N1, D}; Gemm1Order S; S.init(MLAT, N1, gridDim.x, blockIdx.x);
        EpiB<0> E{(bf16_t*)(c.ws + WS_ZG), (bf16_t*)(c.ws + WS_ZR), 0};
        pg8::gemm_phase<EpiB<0>, Gemm1Order, false>((PG8_LAS unsigned char*)lds, g, S, E, nullptr);
        if (DUP(2)) { if (DUP(21)) xcd_barrier(bar); pg8::gemm_phase<EpiB<0>, Gemm1Order, false>((PG8_LAS unsigned char*)lds, g, S, E, nullptr); } } SEAM(2);
    if (IN(3)) { premix_lora(c); p3_gla(c, lds); if (DUP(3)) p3_gla(c, lds); } SEAM(3);
    if (IN(4)) { p4_rwkv_chunked(c, lds); if (DUP(4)) { if (DUP(21)) xcd_barrier(bar); p4_rwkv_chunked(c, lds); } } SEAM(4);
    if (IN(5)) { if (DUP(5)) p5_post(c, lds, true); p5_post(c, lds); } SEAM(5);
    if (IN(6)) { pg8::StaticOrder S; S.init(MLAT, D, gridDim.x, blockIdx.x); bf16_t* Tb = (bf16_t*)c.out; bf16_t* Yr = (bf16_t*)(c.ws + WS_ORF);
        { pg8::Gemm g{(const bf16_t*)(c.ws + WS_A1), Wt_in + (size_t)N1 * D, MLAT, D, D}; EpiMix<0> E{Tb, Yr}; pg8::gemm_phase<EpiMix<0>, pg8::StaticOrder, false>((PG8_LAS unsigned char*)lds, g, S, E, nullptr); }
        __syncthreads();
        { pg8::Gemm g{(const bf16_t*)(c.ws + WS_A1), Wt_in + (size_t)(N1 + 1024) * D, MLAT, D, D}; EpiMix<1> E{Tb, Yr}; pg8::gemm_phase<EpiMix<1>, pg8::StaticOrder, false>((PG8_LAS unsigned char*)lds, g, S, E, nullptr); }
        __syncthreads();
        { pg8::Gemm g{(const bf16_t*)(c.ws + WS_A1), Wt_in + (size_t)(N1 + 2048) * D, MLAT, D, D}; EpiMix<2> E{Tb, Yr}; pg8::gemm_phase<EpiMix<2>, pg8::StaticOrder, false>((PG8_LAS unsigned char*)lds, g, S, E, nullptr); } } SEAM(6);
    if (IN(8)) { pg8::Gemm g{(const bf16_t*)(c.ws + WS_ORF), (const bf16_t*)(c.ws + WS_WOUT), MLAT, D, D}; pg8::StaticOrder S; S.init(MLAT, D, gridDim.x, blockIdx.x);
        EpiH1 E{CIN(0), (const float*)(c.ws + WS_MOD), c.out};
        pg8::gemm_phase<EpiH1, pg8::StaticOrder, false>((PG8_LAS unsigned char*)lds, g, S, E, nullptr); } SEAM(8);
    if (IN(9)) { p9_norm2_tables(c); if (DUP(9)) p9_norm2_tables(c); } SEAM(9);
    if (IN(10)) { pg8::Gemm g{(const bf16_t*)(c.ws + WS_A1), (const bf16_t*)(c.ws + WS_WQ), MLAT, 2048, D}; pg8::StaticOrder S; S.init(MLAT, 2048, gridDim.x, blockIdx.x);
        EpiB<2> E{(bf16_t*)(c.ws + WS_Q), nullptr, 2048};
        pg8::gemm_phase<EpiB<2>, pg8::StaticOrder, false>((PG8_LAS unsigned char*)lds, g, S, E, nullptr);
        if (DUP(10)) pg8::gemm_phase<EpiB<2>, pg8::StaticOrder, false>((PG8_LAS unsigned char*)lds, g, S, E, nullptr); } SEAM(10);
    if (IN(11)) { if (DUP(11)) p11_topk<GEXP>(c, lds); p11_topk<0>(c, lds); }
    STAMP(23);
    if (PROBE_T >= 0) {
        __syncthreads();
        const float us = (float)(stamps[PROBE_T + 1] - stamps[PROBE_T]) * 0.01f;
        for (int u = blockIdx.x; u < MLAT / 64; u += gridDim.x) for (int i = threadIdx.x; i < 64 * D; i += NT) c.out[(size_t)u * 64 * D + i] = us;
    }
#undef IN
#undef SEAM
}

__global__ void dbg_cmp2(const bf16_t* oldv, const bf16_t* nf, const bf16_t* nb, float* out) {
    for (size_t i = (size_t)blockIdx.x * blockDim.x + threadIdx.x; i < (size_t)MLAT * D; i += (size_t)gridDim.x * blockDim.x) {
        const float o = bf2f(oldv[i]); const float n = i < 8388608 ? bf2f(nf[i]) : bf2f(nb[i - 8388608]);
        float v = (n - o) * (100.0f / 12.2f); if (!(fabsf(v) < 1e30f)) v = 1e4f; out[i] = v; }
}
extern "C" void kernel_launch(void* const* d_in, const int* in_sizes, int n_in, void* d_out, int out_size, void* d_ws, size_t ws_size, hipStream_t stream) {
    static int grid = 0;
    if (grid == 0) {
        if (n_in != 29 || out_size != MLAT * D || ws_size < WS_END) { fprintf(stderr, "kernel_launch: unexpected shapes (n_in %d, out %d, ws %zu < %zu)\n", n_in, out_size, ws_size, (size_t)WS_END); grid = -1; return; }
        int dev = 0, cus = 0, per_cu = 0;
        if (hipGetDevice(&dev) != hipSuccess || hipDeviceGetAttribute(&cus, hipDeviceAttributeMultiprocessorCount, dev) != hipSuccess) { grid = -1; return; }
        if (hipFuncSetAttribute((const void*)fwd_kernel, hipFuncAttributeMaxDynamicSharedMemorySize, LDS_BYTES) != hipSuccess) { fprintf(stderr, "kernel_launch: hipFuncSetAttribute failed\n"); grid = -1; return; }
        if (hipOccupancyMaxActiveBlocksPerMultiprocessor(&per_cu, (const void*)fwd_kernel, NT, LDS_BYTES) != hipSuccess || per_cu < 1) fprintf(stderr, "kernel_launch: occupancy query reports %d\n", per_cu);
        (void)hipGetLastError();
        grid = cus;
    }
    if (grid < 0) return;
    (void)hipMemsetAsync((char*)d_ws + WS_CTL, 0, 65536, stream);
    Args a{};
    for (int i = 0; i < 29; ++i) a.in[i] = (const float*)d_in[i];
    a.out = (float*)d_out; a.ws = (unsigned char*)d_ws;
#if MK_N_LAUNCHES == 1
    a.ph_lo = 0; a.ph_hi = N_PHASES;
    hipLaunchKernelGGL(fwd_kernel, dim3(grid), dim3(NT), LDS_BYTES, stream, a);
#else
    for (int p = 0; p < N_PHASES; ++p) { a.ph_lo = p; a.ph_hi = p + 1; hipLaunchKernelGGL(fwd_kernel, dim3(grid), dim3(NT), LDS_BYTES, stream, a); }
#endif
}
```

```cpp
#include <hip/hip_runtime.h>
#include <stdint.h>
#include <stdio.h>

#ifndef MK_N_LAUNCHES
#define MK_N_LAUNCHES 1
#endif

namespace pg8 {
#define PG8_LAS __attribute__((address_space(3)))
typedef unsigned short bf16_t;
typedef short bf16x8 __attribute__((ext_vector_type(8)));
typedef float f32x4 __attribute__((ext_vector_type(4)));
typedef unsigned u32x4 __attribute__((ext_vector_type(4)));
constexpr int BM = 256, BK = 64, HALF = 128, HTB = HALF * BK * 2  , STAGE_BYTES = 8 * HTB, NXCD = 8, WGM = 8;

__host__ __device__ __forceinline__ int lds_byte(int r, int c) { const int st = (r >> 4) * 2 + (c >> 5), rr = r & 15, cc = c & 31, ob = rr * 64 + cc * 2; return st * 1024 + (ob ^ (((ob >> 9) & 1) << 5)); }
__host__ __device__ __forceinline__ void stage_rc(int b, int& R, int& C) { const int st = b / 1024, sb = b % 1024, swz = sb ^ (((sb >> 9) & 1) << 5); R = (st >> 1) * 16 + swz / 64; C = (st & 1) * 32 + (swz % 64) / 2; }
__host__ __device__ __forceinline__ int perm32(int rho) { const int n = rho >> 4, i = rho & 15; return 8 * (i >> 2) + 4 * n + (i & 3); }

struct Unit { int pm, pn; };
struct Gemm { const bf16_t* A; const bf16_t* Bt; int M, N, K; };

struct StaticOrder {
    int nM, nN, nwg, G, c;
    __host__ __device__ void init(int M, int N, int G_, int c_) { nM = M / BM; nN = N / BM; nwg = nM * nN; G = G_; c = c_; }
    __host__ __device__ bool next(int i, Unit& u) const {
        const long L = (long)i * G + c; if (L >= nwg) return false;
        int wgid = (int)L; { const int q = nwg / NXCD, r = nwg % NXCD, xcd = wgid % NXCD, off = wgid / NXCD; wgid = (xcd < r ? xcd * (q + 1) : r * (q + 1) + (xcd - r) * q) + off; }
        const int nig = WGM * nN, gid = wgid / nig, fm = gid * WGM, gsz = (nM - fm) < WGM ? (nM - fm) : WGM;
        u.pm = fm + ((wgid % nig) % gsz); u.pn = (wgid % nig) / gsz; return true;
    }
    __device__ __forceinline__ void a_ready(const Unit&) const {}
    __device__ __forceinline__ void done(const Unit&) const {}
};
__device__ __forceinline__ unsigned cvt_pk_bf16(float lo, float hi) { unsigned r; asm volatile("v_cvt_pk_bf16_f32 %0, %1, %2" : "=v"(r) : "v"(lo), "v"(hi)); return r; }
template <class Epi, class Sched, bool STAMP = false>
__device__ __forceinline__ void gemm_phase(PG8_LAS unsigned char* lds, const Gemm g, const Sched& S, const Epi& E, unsigned long long* stamps) {
    const int tid = threadIdx.x, wid = __builtin_amdgcn_readfirstlane(tid >> 6), lane = tid & 63, wr = wid >> 2, wc = wid & 3, fr = lane & 15, fq = lane >> 4;
    const int K = g.K, nt = K / BK;
    int ts_lo = 0, ts_hi = 0, nts = 0; const unsigned long long rt_entry = STAMP ? (unsigned long long)wall_clock64() : 0ull;
#define PG8_STAMP() do { if (STAMP && wid == 0 && nts < 64) { const unsigned long long _c = (unsigned long long)clock64(); \
        ts_lo = (lane == nts) ? (int)(unsigned)_c : ts_lo; ts_hi = (lane == nts) ? (int)(unsigned)(_c >> 32) : ts_hi; ++nts; } } while (0)
    PG8_STAMP();
    unsigned voffA[2], voffB[2];
#pragma unroll
    for (int i = 0; i < 2; ++i) { int R, C; stage_rc(tid * 16 + i * 8192, R, C); const int Rb = Epi::PERM ? ((R & ~31) + perm32(R & 31)) : R;
        voffA[i] = (unsigned)(R * K + C) * 2u; voffB[i] = (unsigned)(Rb * K + C) * 2u; }
    const size_t kstep = (size_t)(BK * 2);
    const size_t hstep = (size_t)HALF * K * 2;
    const size_t tstep = 2 * hstep;
    const unsigned ldsw = (unsigned)wid * 1024u;
    const int aoff = lds_byte(wr * 64 + fr, fq * 8), boff = lds_byte(wc * 32 + fr, fq * 8);
#define PG8_SA(b, h) (((b) * 2 + (h)) * HTB)
#define PG8_SB(b, h) ((4 + (b) * 2 + (h)) * HTB)
#define PG8_STAGE(bufoff, gbase, voff) do { _Pragma("unroll") for (int _i = 0; _i < 2; ++_i) \
        __builtin_amdgcn_global_load_lds((const unsigned*)((const char*)(gbase) + (voff)[_i]), (PG8_LAS unsigned*)(lds + (bufoff) + ldsw + _i * 8192), 16, 0, 0); } while (0)
#define PG8_LDA(dst, b, h) do { _Pragma("unroll") for (int m = 0; m < 4; ++m) _Pragma("unroll") for (int k = 0; k < 2; ++k) dst[m][k] = *(const PG8_LAS bf16x8*)(lds + PG8_SA(b, h) + aoff + m * 2048 + k * 1024); } while (0)
#define PG8_LDB(dst, b, h) do { _Pragma("unroll") for (int n = 0; n < 2; ++n) _Pragma("unroll") for (int k = 0; k < 2; ++k) dst[n][k] = *(const PG8_LAS bf16x8*)(lds + PG8_SB(b, h) + boff + n * 2048 + k * 1024); } while (0)
#define PG8_MMA(ai, bj, At, Bt) do { __builtin_amdgcn_s_setprio(1); _Pragma("unroll") for (int m = 0; m < 4; ++m) _Pragma("unroll") for (int n = 0; n < 2; ++n) _Pragma("unroll") for (int k = 0; k < 2; ++k) \
        acc[ai][bj][m][n] = __builtin_amdgcn_mfma_f32_16x16x32_bf16(Bt[n][k], At[m][k], acc[ai][bj][m][n], 0, 0, 0); __builtin_amdgcn_s_setprio(0); } while (0)
#define PG8_WAIT_V(n) asm volatile("s_waitcnt vmcnt(" #n ")" ::: "memory")
#define PG8_WAIT_L(n) asm volatile("s_waitcnt lgkmcnt(" #n ")" ::: "memory")
#define PG8_BAR __builtin_amdgcn_s_barrier()
#define PG8_SCHED __builtin_amdgcn_sched_barrier(0)
    Unit cur, nxt; int ui = 0;
    if (!S.next(0, cur)) return;
    f32x4 acc[2][2][4][2];
#pragma unroll
    for (int a = 0; a < 2; ++a)
#pragma unroll
        for (int b = 0; b < 2; ++b)
#pragma unroll
            for (int m = 0; m < 4; ++m)
#pragma unroll
                for (int n = 0; n < 2; ++n) acc[a][b][m][n] = (f32x4){0.f, 0.f, 0.f, 0.f};
    bf16x8 At[4][2], B0[2][2], B1[2][2];
    const char* cA = (const char*)g.A + (size_t)cur.pm * tstep; const char* cB = (const char*)g.Bt + (size_t)cur.pn * tstep;
    S.a_ready(cur);
    PG8_STAGE(PG8_SB(0, 0), cB, voffB); PG8_STAGE(PG8_SA(0, 0), cA, voffA); PG8_STAGE(PG8_SB(0, 1), cB + hstep, voffB); PG8_STAGE(PG8_SA(0, 1), cA + hstep, voffA);
    if (wr == 1) PG8_BAR;
    PG8_WAIT_V(4); PG8_BAR;
    PG8_STAGE(PG8_SB(1, 0), cB + kstep, voffB); PG8_STAGE(PG8_SA(1, 0), cA + kstep, voffA); PG8_STAGE(PG8_SB(1, 1), cB + hstep + kstep, voffB);
    PG8_WAIT_V(6); PG8_BAR;
    PG8_STAMP();
    for (;;) {
        const bool has_next = S.next(ui + 1, nxt);
        const char* nA = has_next ? (const char*)g.A + (size_t)nxt.pm * tstep : cA; const char* nB = has_next ? (const char*)g.Bt + (size_t)nxt.pn * tstep : cB;
        for (int t = 0; t < nt; t += 2) {
            const bool last = (t == nt - 2);
            const char* a1 = cA + (size_t)(t + 1) * kstep;
            const char* a2 = last ? nA : cA + (size_t)(t + 2) * kstep; const char* b2 = last ? nB : cB + (size_t)(t + 2) * kstep;
            const char* a3 = a2 + kstep; const char* b3 = b2 + kstep;
            if (last && has_next) S.a_ready(nxt);
            PG8_LDB(B0, 0, 0); PG8_SCHED; PG8_LDA(At, 0, 0); PG8_STAGE(PG8_SA(1, 1), a1 + hstep, voffA);
            PG8_WAIT_L(8); PG8_BAR; PG8_WAIT_L(0); PG8_MMA(0, 0, At, B0); PG8_BAR; PG8_SCHED;
            PG8_LDB(B1, 0, 1); PG8_STAGE(PG8_SB(0, 0), b2, voffB);
            PG8_BAR; PG8_WAIT_L(0); PG8_MMA(0, 1, At, B1); PG8_BAR;
            PG8_LDA(At, 0, 1); PG8_STAGE(PG8_SA(0, 0), a2, voffA);
            PG8_BAR; PG8_WAIT_L(0); PG8_MMA(1, 0, At, B0); PG8_BAR; PG8_SCHED;
            PG8_STAGE(PG8_SB(0, 1), b2 + hstep, voffB);
            PG8_WAIT_V(6); PG8_BAR; PG8_MMA(1, 1, At, B1); PG8_BAR;
            PG8_LDB(B0, 1, 0); PG8_SCHED; PG8_LDA(At, 1, 0); PG8_STAGE(PG8_SA(0, 1), a2 + hstep, voffA);
            PG8_WAIT_L(8); PG8_BAR; PG8_WAIT_L(0); PG8_MMA(0, 0, At, B0); PG8_BAR; PG8_SCHED;
            PG8_LDB(B1, 1, 1); PG8_STAGE(PG8_SB(1, 0), b3, voffB);
            PG8_BAR; PG8_WAIT_L(0); PG8_MMA(0, 1, At, B1); PG8_BAR;
            PG8_LDA(At, 1, 1); PG8_STAGE(PG8_SA(1, 0), a3, voffA);
            PG8_BAR; PG8_WAIT_L(0); PG8_MMA(1, 0, At, B0); PG8_BAR; PG8_SCHED;
            PG8_STAGE(PG8_SB(1, 1), b3 + hstep, voffB);
            PG8_WAIT_V(6); PG8_BAR; PG8_MMA(1, 1, At, B1); PG8_BAR;
        }
        PG8_STAMP();
        if constexpr (!Epi::AFTER_DRAIN) { E(acc, cur, wr, wc, fr, fq); S.done(cur); }
        PG8_STAMP();
        if (!has_next) break;
#pragma unroll
        for (int a = 0; a < 2; ++a)
#pragma unroll
            for (int b = 0; b < 2; ++b)
#pragma unroll
                for (int m = 0; m < 4; ++m)
#pragma unroll
                    for (int n = 0; n < 2; ++n) acc[a][b][m][n] = (f32x4){0.f, 0.f, 0.f, 0.f};
        cur = nxt; cA = nA; cB = nB; ++ui;
    }
    PG8_WAIT_V(0);
    if (wr == 0) PG8_BAR;
    PG8_BAR;
    if constexpr (Epi::AFTER_DRAIN) { E.fused(acc, cur, wr, wc, fr, fq, lds, wid, lane); S.done(cur); }
    PG8_STAMP();
    if (STAMP && wid == 0) { stamps[lane] = lane < nts ? (((unsigned long long)(unsigned)ts_hi << 32) | (unsigned)ts_lo) : 0ull;
        if (lane == 62) stamps[62] = rt_entry; if (lane == 63) stamps[63] = (unsigned long long)wall_clock64(); }
#undef PG8_STAMP
#undef PG8_SA
#undef PG8_SB
#undef PG8_STAGE
#undef PG8_LDA
#undef PG8_LDB
#undef PG8_MMA
#undef PG8_WAIT_V
#undef PG8_WAIT_L
#undef PG8_BAR
#undef PG8_SCHED
}
}

#define XB_TMO      128
#define XB_XCNT(j)  (256  + 64 * (j))
#define XB_XSUB(j)  (1280 + 64 * (j))
#define XB_XGEN(j)  (2304 + 64 * (j))
#define XB_TOP      3328
#define XB_TOPGEN   3392
#define XCD_BAR_WORDS 3456
#define XB_SPIN_CAP (1u << 18)
#define LAS __attribute__((address_space(3)))

__device__ __forceinline__ unsigned xb_ld(unsigned* p)              { return __hip_atomic_load(p, __ATOMIC_RELAXED, __HIP_MEMORY_SCOPE_AGENT); }
__device__ __forceinline__ unsigned xb_add(unsigned* p, unsigned v) { return __hip_atomic_fetch_add(p, v, __ATOMIC_RELAXED, __HIP_MEMORY_SCOPE_AGENT); }
__device__ __forceinline__ unsigned xb_xcc_id() { return (unsigned)__builtin_amdgcn_s_getreg((3 << 11) | 20) & 0xFu; }
#define XB_SPIN(cond, bar) do { unsigned _sp = 0; while (cond) { __builtin_amdgcn_s_sleep(1); \
    if ((++_sp & 255u) == 0u) { if (xb_ld(&(bar)[XB_TMO])) break; if (_sp > XB_SPIN_CAP) { atomicAdd(&(bar)[XB_TMO], 1u); break; } } } } while (0)

struct XcdBarrier {
    unsigned* bar; unsigned x;
    volatile LAS unsigned* st;
};

__device__ __forceinline__ XcdBarrier xcd_barrier_post(unsigned* bar, volatile LAS unsigned* st) {
    XcdBarrier b; b.bar = bar; b.x = xb_xcc_id(); b.st = st;
    if (threadIdx.x == 0) (void)xb_add(&bar[XB_XCNT(b.x)], 1u);
    return b;
}
__device__ __forceinline__ void xcd_barrier_complete(unsigned* bar, unsigned x, unsigned& nloc, unsigned& nx) {
    const unsigned G = gridDim.x * gridDim.y * gridDim.z;
    unsigned sum, cnt, mine, sp = 0u;
    for (;;) {
        sum = 0u; cnt = 0u; mine = 0u;
#pragma unroll
        for (unsigned j = 0; j < 16; ++j) { const unsigned c = xb_ld(&bar[XB_XCNT(j)]); sum += c; cnt += (c > 0u) ? 1u : 0u; mine = (j == x) ? c : mine; }
        if (sum == G) break;
        __builtin_amdgcn_s_sleep(1);
        if ((++sp & 255u) == 0u) { if (xb_ld(&bar[XB_TMO])) break; if (sp > XB_SPIN_CAP) { atomicAdd(&bar[XB_TMO], 1u); break; } }
    }
    nloc = mine > 0u ? mine : 1u; nx = cnt > 0u ? cnt : 1u;
}

__device__ __forceinline__ void xcd_barrier(const XcdBarrier& b) {
    asm volatile("s_waitcnt vmcnt(0)" ::: "memory");
    __syncthreads();
    if (threadIdx.x == 0) {
        unsigned* bar = b.bar;
        __builtin_amdgcn_s_waitcnt(0);
        unsigned nloc = b.st[0], nx = b.st[1];
        if (nloc == 0u) { xcd_barrier_complete(bar, b.x, nloc, nx); b.st[0] = nloc; b.st[1] = nx; }
        const unsigned old = xb_add(&bar[XB_XSUB(b.x)], 1u);
        const unsigned gen = old / nloc;
        if (old + 1u == (gen + 1u) * nloc) {
            __builtin_amdgcn_fence(__ATOMIC_RELEASE, "agent");
            asm volatile("s_waitcnt vmcnt(0)" ::: "memory");
            const unsigned og = xb_add(&bar[XB_TOP], 1u);
            const unsigned tg = og / nx;
            if (og + 1u == (tg + 1u) * nx) xb_add(&bar[XB_TOPGEN], 1u);
            else XB_SPIN(xb_ld(&bar[XB_TOPGEN]) == tg, bar);
            __builtin_amdgcn_fence(__ATOMIC_ACQUIRE, "agent");
            xb_add(&bar[XB_XGEN(b.x)], 1u);
            asm volatile("s_waitcnt vmcnt(0)" ::: "memory");
        } else {
            XB_SPIN(xb_ld(&bar[XB_XGEN(b.x)]) == gen, bar);
            __builtin_amdgcn_fence(__ATOMIC_ACQUIRE, "agent");
            asm volatile("s_waitcnt vmcnt(0)" ::: "memory");
        }
    }
    __syncthreads();
}

typedef unsigned short bf16_t;
typedef short bf16x8 __attribute__((ext_vector_type(8)));
typedef float f32x4 __attribute__((ext_vector_type(4)));
typedef unsigned u32x4 __attribute__((ext_vector_type(4)));
typedef unsigned u32x2 __attribute__((ext_vector_type(2)));

constexpr int IDSTR = 132;
#ifndef GATHER_SWEEP
#define GATHER_SWEEP 6
#endif
#ifndef DUP_MASK
#define DUP_MASK 0
#ifndef S8_REPS
#define S8_REPS 1
#endif
#ifndef S8_HOT
#define S8_HOT 1
#endif
#define GEXP 3
#endif
#define DUP(k) ((DUP_MASK >> (k)) & 1)
constexpr int NT = 512;
constexpr int D = 1024, NB = 8, SEQ = 2048, CTXL = 256;
constexpr int MLAT = NB * SEQ, MCTX = NB * CTXL, MALL = MLAT + MCTX;
constexpr int ZG_LD = 2048, ZR_LD = 3584, Z3_LD = 3072;
constexpr int N1 = 5632, N2 = 3072, NIN = N1 + N2;
constexpr int ZR_OFF = 32;
constexpr int MODW = 6144;
constexpr int LDS_BYTES = 163840, LDS_HDR = 64;

constexpr size_t WS_CTL   = 0;
constexpr size_t WS_MOD   = 65536;
constexpr size_t WS_BONUS = WS_MOD + 262144;
constexpr size_t WS_WIN   = WS_BONUS + 1048576;
constexpr size_t WS_WOUT  = WS_WIN + (size_t)NIN * 1024 * 2;
constexpr size_t WS_WQ    = WS_WOUT + (size_t)1024 * 1024 * 2;
constexpr size_t WS_G2T   = WS_WQ + (size_t)2048 * 1024 * 2;
constexpr size_t WS_SK    = WS_G2T + (size_t)1024 * 192 * 2;
constexpr size_t WS_A1    = WS_SK + (size_t)16 * 128 * 128 * 2;
constexpr size_t WS_ZG    = WS_A1 + (size_t)MALL * 1024 * 2;
constexpr size_t WS_ZR    = WS_ZG + (size_t)MALL * ZG_LD * 2;
constexpr size_t WS_ZL    = WS_ZR + (size_t)MALL * ZR_LD * 2;
constexpr int ZL_LD = 352;
constexpr size_t WS_END   = WS_ZL + (size_t)MALL * ZL_LD * 2;
constexpr size_t WS_ZQ    = WS_ZG;
constexpr size_t WS_ZK    = WS_ZG + (size_t)MALL * 512 * 2;
constexpr size_t WS_ZV    = WS_ZG + (size_t)MALL * 1024 * 2;
constexpr size_t WS_ALO   = WS_ZQ + (size_t)MLAT * 512 * 2;
constexpr size_t WS_ORF   = WS_ZG;
constexpr size_t WS_ORB   = WS_ZG + (size_t)MLAT * 1024 * 2;
constexpr size_t WS_Q     = WS_ZG;
constexpr size_t WS_Z3    = WS_ZR;
constexpr size_t WS_UT    = WS_ZR;
constexpr size_t WS_VT    = WS_UT + (size_t)16384 * 1024;
constexpr size_t WS_IDX   = WS_VT + (size_t)16384 * 1024;
constexpr size_t WS_GATE  = WS_IDX + (size_t)MLAT * 128 * 4;
static_assert(WS_GATE + (size_t)MLAT * 128 * 4 <= WS_ZL, "ws map");
static_assert(WS_ORB + (size_t)MLAT * 1024 * 2 <= WS_ZR, "ws map");

typedef const float* const __attribute__((address_space(4))) * KArgPtr;
struct Ctx { KArgPtr in; float* out; unsigned char* ws; };
#define CIN(k) (c.in[k])
struct Args { const float* in[29]; float* out; unsigned char* ws; int ph_lo, ph_hi; };

typedef __bf16 hwbf16x2 __attribute__((ext_vector_type(2)));
typedef float f32x2v __attribute__((ext_vector_type(2)));
__device__ __forceinline__ unsigned pk2(float lo, float hi) { const f32x2v f = {lo, hi}; const hwbf16x2 v = __builtin_convertvector(f, hwbf16x2); return __builtin_bit_cast(unsigned, v); }
__device__ __forceinline__ bf16_t f2bf(float f) { return (bf16_t)(pk2(f, 0.f) & 0xffffu); }
__device__ __forceinline__ float bflo(unsigned w) { return __uint_as_float(w << 16); }
__device__ __forceinline__ float bfhi(unsigned w) { return __uint_as_float(w & 0xffff0000u); }
__device__ __forceinline__ float bf2f(bf16_t b) { return __uint_as_float(((unsigned)b) << 16); }
__device__ __forceinline__ void unpack8(const u32x4 w, float* o) { o[0] = bflo(w.x); o[1] = bfhi(w.x); o[2] = bflo(w.y); o[3] = bfhi(w.y); o[4] = bflo(w.z); o[5] = bfhi(w.z); o[6] = bflo(w.w); o[7] = bfhi(w.w); }
__device__ __forceinline__ u32x4 pack8(const float* v) { u32x4 w; w.x = pk2(v[0], v[1]); w.y = pk2(v[2], v[3]); w.z = pk2(v[4], v[5]); w.w = pk2(v[6], v[7]); return w; }
__device__ __forceinline__ u32x4 ldg16(const bf16_t* p) { return *(const u32x4*)p; }
__device__ __forceinline__ float fexp(float x) { return __builtin_amdgcn_exp2f(x * 1.4426950408889634f); }
__device__ __forceinline__ float flog(float x) { return __builtin_amdgcn_logf(x) * 0.6931471805599453f; }
__device__ __forceinline__ float sigmoidf_(float x) { return __builtin_amdgcn_rcpf(1.0f + fexp(-x)); }
__device__ __forceinline__ float wave_sum(float v) {
#pragma unroll
    for (int o = 32; o > 0; o >>= 1) v += __shfl_xor(v, o);
    return v;
}
#define LDS_FENCE() asm volatile("s_waitcnt lgkmcnt(0)" ::: "memory")

__device__ __forceinline__ int win_src(int n) {
    if (n < 2048) return n;
    if (n < N1) { const int j = n - 2048; if (j < 16) return 3072 + j; if (j < 32) return 3088 + (j - 16); if (j < 32 + 3424) { int cr = j - 32; if (cr < 3072) { const int p = cr & 15; cr = (cr & ~15) + (p & 3) * 4 + (p >> 2); } return 3104 + cr; } return -1; }
    const int j = n - N1; return j < 1024 ? 2048 + j : 6528 + (j - 1024);
}
template <int MODE> __device__ __forceinline__ void transpose_tile(const float* __restrict__ src, int ld, bf16_t* __restrict__ dst, int n0, int k0, LAS float* tile) {
    const int tid = threadIdx.x;
#pragma unroll
    for (int e = 0; e < 8; ++e) { const int idx = tid + e * NT, kk = idx >> 6, nn = idx & 63; const int n = n0 + nn; const int s = MODE == 0 ? win_src(n) : n;
        tile[kk * 65 + nn] = s >= 0 ? src[(size_t)(k0 + kk) * ld + s] : 0.f; }
    __syncthreads();
#pragma unroll
    for (int e = 0; e < 4; ++e) { const int idx = tid + e * NT, nn = idx >> 5, kp = idx & 31;
        *(unsigned*)(dst + (size_t)(n0 + nn) * 1024 + k0 + kp * 2) = pk2(tile[(kp * 2) * 65 + nn], tile[(kp * 2 + 1) * 65 + nn]); }
    __syncthreads();
}
__device__ __forceinline__ void p0_prologue(const Ctx& c, LAS unsigned char* lds) {
    const int tid = threadIdx.x, G = gridDim.x, bx = blockIdx.x;
    LAS float* tile = (LAS float*)lds;
    bf16_t* Wt_in = (bf16_t*)(c.ws + WS_WIN); bf16_t* Wt_out = (bf16_t*)(c.ws + WS_WOUT); bf16_t* Wt_q = (bf16_t*)(c.ws + WS_WQ);
    constexpr int T_IN = (NIN / 64) * 16, T_OUT = 16 * 16, T_Q = 32 * 16;
    for (int rep_ = 0; rep_ < (DUP(22) ? 2 : 1); ++rep_)
    for (int t = bx; t < T_IN + T_OUT + T_Q; t += G) {
        if (t < T_IN) transpose_tile<0>(CIN(7), 8576, Wt_in, (t >> 4) * 64, (t & 15) * 64, tile);
        else if (t < T_IN + T_OUT) { const int u = t - T_IN; transpose_tile<1>(CIN(22), 1024, Wt_out, (u >> 4) * 64, (u & 15) * 64, tile); }
        else { const int u = t - T_IN - T_OUT; transpose_tile<1>(CIN(24), 2048, Wt_q, (u >> 4) * 64, (u & 15) * 64, tile); }
    }
    bf16_t* g2t = (bf16_t*)(c.ws + WS_G2T); bf16_t* sk = (bf16_t*)(c.ws + WS_SK);
    for (int i = bx * NT + tid; i < 1024 * 192; i += G * NT) { const int n = i / 192, j = i - n * 192;
        g2t[(((((n >> 4) * 6 + (j >> 5)) * 64) + ((j >> 3) & 3) * 16 + (n & 15)) << 3) + (j & 7)] = f2bf(j < 160 ? CIN(16)[j * 1024 + n] : 0.f); }
    for (int i = bx * NT + tid; i < 16 * 128 * 128; i += G * NT) { const int hp = i >> 14, n = (i >> 7) & 127, k = i & 127;
        sk[((((hp * 8 + (n >> 4)) * 4 + (k >> 5)) * 64 + ((k >> 3) & 3) * 16 + (n & 15)) << 3) + (k & 7)] = f2bf(CIN(25)[i]); }
    LAS float* sc = (LAS float*)lds;
    LAS float* part = sc + 9 * 1024;
    float* m = (float*)(c.ws + WS_MOD);
    for (int rep_ = 0; rep_ < (DUP(23) ? 2 : 1); ++rep_)
    for (int cg = bx; cg < MODW / 24; cg += G) {
        __syncthreads();
        for (int i = tid; i < 9 * 1024; i += NT) { const float v = i < 8192 ? CIN(1)[i] : CIN(3)[i - 8192]; sc[i] = v * sigmoidf_(v); }
        __syncthreads();
        const int c0 = cg * 24;
        if (tid < 504) { const int col = tid % 24, kp = tid / 24; float acc[9];
#pragma unroll
            for (int r = 0; r < 9; ++r) acc[r] = 0.f;
            for (int k = kp; k < 1024; k += 21) { const float w = CIN(5)[(size_t)k * MODW + c0 + col];
#pragma unroll
                for (int r = 0; r < 9; ++r) acc[r] += sc[r * 1024 + k] * w; }
#pragma unroll
            for (int r = 0; r < 9; ++r) part[(kp * 9 + r) * 24 + col] = acc[r]; }
        __syncthreads();
        if (tid < 216) { const int r = tid / 24, col = tid % 24; float s = CIN(6)[c0 + col];
            for (int kp = 0; kp < 21; ++kp) s += part[(kp * 9 + r) * 24 + col];
            m[r * MODW + c0 + col] = s; }
    }
    __syncthreads();
}

__device__ __forceinline__ void norm_mod_row(const float* __restrict__ src, const float* __restrict__ nw, const float* __restrict__ shift, const float* __restrict__ scale, bf16_t* __restrict__ dst, int lane) {
    f32x4 v[4]; float ss = 0.f;
#pragma unroll
    for (int j = 0; j < 4; ++j) { v[j] = *(const f32x4*)(src + (j * 64 + lane) * 4); ss += v[j][0] * v[j][0] + v[j][1] * v[j][1] + v[j][2] * v[j][2] + v[j][3] * v[j][3]; }
    ss = wave_sum(ss);
    const float rstd = rsqrtf(ss * (1.0f / 1024.0f) + 1e-6f);
#pragma unroll
    for (int j = 0; j < 4; ++j) { const int c0 = (j * 64 + lane) * 4; const f32x4 w = *(const f32x4*)(nw + c0), sh = *(const f32x4*)(shift + c0), sc = *(const f32x4*)(scale + c0);
        float y[4];
#pragma unroll
        for (int e = 0; e < 4; ++e) y[e] = v[j][e] * rstd * w[e] * (1.0f + sc[e]) + sh[e];
        u32x2 o; o.x = pk2(y[0], y[1]); o.y = pk2(y[2], y[3]); *(u32x2*)(dst + c0) = o; }
}
__device__ __forceinline__ void norm_mod_row2(const float* __restrict__ s0, const float* __restrict__ s1, const float* __restrict__ nw, const float* __restrict__ sh0, const float* __restrict__ sc0,
                                              const float* __restrict__ sh1, const float* __restrict__ sc1, bf16_t* __restrict__ d0, bf16_t* __restrict__ d1, int lane) {
    f32x4 v0[4], v1[4]; float a0 = 0.f, a1 = 0.f;
#pragma unroll
    for (int j = 0; j < 4; ++j) { v0[j] = *(const f32x4*)(s0 + (j * 64 + lane) * 4); v1[j] = *(const f32x4*)(s1 + (j * 64 + lane) * 4); }
#pragma unroll
    for (int j = 0; j < 4; ++j) { a0 += v0[j][0] * v0[j][0] + v0[j][1] * v0[j][1] + v0[j][2] * v0[j][2] + v0[j][3] * v0[j][3]; a1 += v1[j][0] * v1[j][0] + v1[j][1] * v1[j][1] + v1[j][2] * v1[j][2] + v1[j][3] * v1[j][3]; }
#pragma unroll
    for (int o = 32; o > 0; o >>= 1) { a0 += __shfl_xor(a0, o); a1 += __shfl_xor(a1, o); }
    const float r0 = rsqrtf(a0 * (1.0f / 1024.0f) + 1e-6f), r1 = rsqrtf(a1 * (1.0f / 1024.0f) + 1e-6f);
#pragma unroll
    for (int j = 0; j < 4; ++j) { const int c0 = (j * 64 + lane) * 4; const f32x4 w = *(const f32x4*)(nw + c0), h0 = *(const f32x4*)(sh0 + c0), g0 = *(const f32x4*)(sc0 + c0), h1 = *(const f32x4*)(sh1 + c0), g1 = *(const f32x4*)(sc1 + c0);
        float y0[4], y1[4];
#pragma unroll
        for (int e = 0; e < 4; ++e) { y0[e] = v0[j][e] * r0 * w[e] * (1.0f + g0[e]) + h0[e]; y1[e] = v1[j][e] * r1 * w[e] * (1.0f + g1[e]) + h1[e]; }
        u32x2 o; o.x = pk2(y0[0], y0[1]); o.y = pk2(y0[2], y0[3]); *(u32x2*)(d0 + c0) = o; o.x = pk2(y1[0], y1[1]); o.y = pk2(y1[2], y1[3]); *(u32x2*)(d1 + c0) = o; }
}
__device__ __forceinline__ void p1_norm1(const Ctx& c) {
    const int lane = threadIdx.x & 63, wave = threadIdx.x >> 6; const float* m = (const float*)(c.ws + WS_MOD); bf16_t* A1 = (bf16_t*)(c.ws + WS_A1);
    const int stride = gridDim.x * 8;
    for (int row = blockIdx.x * 8 + wave; row < MALL; row += 2 * stride) {
        const int rb = row + stride;
        const float* s0 = row < MLAT ? CIN(0) + (size_t)row * D : CIN(2) + (size_t)(row - MLAT) * D; const int m0 = row < MLAT ? row / SEQ : 8;
        if (rb < MALL) { const float* s1 = rb < MLAT ? CIN(0) + (size_t)rb * D : CIN(2) + (size_t)(rb - MLAT) * D; const int m1 = rb < MLAT ? rb / SEQ : 8;
            norm_mod_row2(s0, s1, CIN(4), m + m0 * MODW, m + m0 * MODW + 1024, m + m1 * MODW, m + m1 * MODW + 1024, A1 + (size_t)row * D, A1 + (size_t)rb * D, lane); }
        else norm_mod_row(s0, CIN(4), m + m0 * MODW, m + m0 * MODW + 1024, A1 + (size_t)row * D, lane);
    }
}
template <int MODE  > struct EpiB {
    static constexpr bool PERM = true, AFTER_DRAIN = false;
    bf16_t* O0; bf16_t* O1; int ldc;
    __device__ __forceinline__ void operator()(const pg8::f32x4 (&acc)[2][2][4][2], const pg8::Unit& u, int wr, int wc, int fr, int fq) const {
        const int row0 = u.pm * 256 + wr * 64 + fr; int colt = u.pn * 256; bf16_t* base = O0; int ld = ldc;
        if (MODE == 0) { if (u.pn >= 8) { base = O1; ld = ZR_LD; colt -= 2048; } else { ld = ZG_LD; } }
        const int col0 = colt + wc * 32 + 8 * fq;
        const bool is_silu = (MODE == 1) && (u.pn < 4);
#pragma unroll
        for (int ai = 0; ai < 2; ++ai)
#pragma unroll
            for (int m = 0; m < 4; ++m) { bf16_t* rowp = base + (size_t)(row0 + ai * 128 + m * 16) * ld + col0;
#pragma unroll
                for (int bj = 0; bj < 2; ++bj) { float v[8];
#pragma unroll
                    for (int j = 0; j < 4; ++j) { v[j] = acc[ai][bj][m][0][j]; v[4 + j] = acc[ai][bj][m][1][j]; }
                    if (MODE == 1) {
#pragma unroll
                        for (int j = 0; j < 8; ++j) { const float s = sigmoidf_(v[j]); v[j] = is_silu ? v[j] * s : s; } }
                    if (MODE == 0 && u.pn < 4) {
                        const int chunk = (row0 + ai * 128 + m * 16) >> 6, head = (2 * u.pn + bj) & 3;
                        bf16_t* blk = O0 + (u.pn >= 2 ? (size_t)MALL * 512 : (size_t)0) + ((size_t)(chunk * 4 + head) << 13);
                        const u32x4 w = pack8(v); const int wv_c = 2 * wc + (fq >> 1), lq_c = 2 * (fq & 1);
                        *(u32x2*)(blk + (((wv_c * 4 + m) * 64 + lq_c * 16 + fr) << 2)) = (u32x2){w.x, w.y};
                        *(u32x2*)(blk + (((wv_c * 4 + m) * 64 + (lq_c + 1) * 16 + fr) << 2)) = (u32x2){w.z, w.w};
                    } else if (MODE == 0 && u.pn < 8) {
                        *(u32x4*)(O0 + (size_t)MALL * 1024 + (size_t)(row0 + ai * 128 + m * 16) * 1024 + (u.pn - 4) * 256 + bj * 128 + wc * 32 + 8 * fq) = pack8(v);
                    } else if (MODE == 0 && u.pn == 8 && bj == 0 && wc == 0) {
                        const int chunk = (row0 + ai * 128 + m * 16) >> 6;
                        *(u32x4*)(O0 + (size_t)MLAT * 512 + ((size_t)((((chunk * 2 + (fq >> 1)) * 4 + m) * 2 + (fq & 1)) * 16 + fr) << 3)) = pack8(v);
                    } else if (MODE == 3) {
                        const int tile = (row0 + ai * 128 + m * 16) >> 4;
                        *(u32x4*)(O0 + ((size_t)((((tile * 8 + u.pn) * 2 + bj) * 4 + wc) * 64 + fq * 16 + fr) << 3)) = pack8(v);
                    } else *(u32x4*)(rowp + bj * 128) = pack8(v); } }
    }
};
template <int STEP> struct EpiMix {
    static constexpr bool PERM = true, AFTER_DRAIN = false;
    bf16_t* T; bf16_t* YR;
    __device__ __forceinline__ void operator()(const pg8::f32x4 (&acc)[2][2][4][2], const pg8::Unit& u, int wr, int wc, int fr, int fq) const {
        const int row0 = u.pm * 256 + wr * 64 + fr, col0 = u.pn * 256 + wc * 32 + 8 * fq;
#pragma unroll
        for (int ai = 0; ai < 2; ++ai)
#pragma unroll
            for (int m = 0; m < 4; ++m) { const size_t ro = (size_t)(row0 + ai * 128 + m * 16) * D + col0;
#pragma unroll
                for (int bj = 0; bj < 2; ++bj) { float v[8], t[8];
#pragma unroll
                    for (int j = 0; j < 4; ++j) { v[j] = acc[ai][bj][m][0][j]; v[4 + j] = acc[ai][bj][m][1][j]; }
                    unpack8(ldg16(T + ro + bj * 128), t);
                    if (STEP == 0) {
#pragma unroll
                        for (int j = 0; j < 8; ++j) t[j] *= v[j] * sigmoidf_(v[j]);
                        *(u32x4*)(T + ro + bj * 128) = pack8(t);
                    } else if (STEP == 1) {
#pragma unroll
                        for (int j = 0; j < 8; ++j) t[j] *= sigmoidf_(v[j]);
                        *(u32x4*)(T + ro + bj * 128) = pack8(t);
                    } else { float r[8]; unpack8(ldg16(YR + ro + bj * 128), r);
#pragma unroll
                        for (int j = 0; j < 8; ++j) t[j] += sigmoidf_(v[j]) * r[j];
                        *(u32x4*)(YR + ro + bj * 128) = pack8(t); } } }
    }
};
struct EpiH1 {
    static constexpr bool PERM = false, AFTER_DRAIN = false;
    const float* x; const float* m; float* h1;
    __device__ __forceinline__ void operator()(const pg8::f32x4 (&acc)[2][2][4][2], const pg8::Unit& u, int wr, int wc, int fr, int fq) const {
        const int row0 = u.pm * 256 + wr * 64 + fr, col0 = u.pn * 256 + wc * 32 + 4 * fq;
        const float* g = m + (size_t)((u.pm * 256) / SEQ) * MODW + 2048;
        f32x4 gv[2][2];
#pragma unroll
        for (int bj = 0; bj < 2; ++bj)
#pragma unroll
            for (int n = 0; n < 2; ++n) gv[bj][n] = *(const f32x4*)(g + col0 + bj * 128 + n * 16);
#pragma unroll
        for (int ai = 0; ai < 2; ++ai)
#pragma unroll
            for (int mm = 0; mm < 4; ++mm) { const size_t ro = (size_t)(row0 + ai * 128 + mm * 16) * D + col0;
#pragma unroll
                for (int bj = 0; bj < 2; ++bj)
#pragma unroll
                    for (int n = 0; n < 2; ++n) { const f32x4 xv = *(const f32x4*)(x + ro + bj * 128 + n * 16); *(f32x4*)(h1 + ro + bj * 128 + n * 16) = xv + gv[bj][n] * acc[ai][bj][mm][n]; } }
    }
};

struct Gemm1Order : pg8::StaticOrder {
    __device__ bool next(int i, pg8::Unit& u) const {
        const long L = (long)i * G + c;
        if (L < 1408) return pg8::StaticOrder::next(i, u);
        const int k = (int)(L - 1408); if (k >= 128) return false;
        const int t = k >> 3; u.pm = 64 + (k & 7); u.pn = t < 6 ? 2 + t : (t == 6 ? 8 : 5 + t);
        return true;
    }
};

#define MFMA16(a, b, c) __builtin_amdgcn_mfma_f32_16x16x32_bf16(a, b, c, 0, 0, 0)
__device__ __forceinline__ float logsigmoidf_(float x) { return fminf(x, 0.f) - flog(1.0f + fexp(-fabsf(x))); }
#define DPP_F(x, ctrl) __builtin_bit_cast(float, __builtin_amdgcn_update_dpp(0, __builtin_bit_cast(int, (x)), (ctrl), 0xf, 0xf, true))
constexpr int GLA_OP_BYTES = 17408 + 17408 + 18432 + 9216 + 512;
__device__ __forceinline__ void p3_gla(const Ctx& c, LAS unsigned char* lds) {
    const int tid = threadIdx.x, lane = tid & 63, wave = tid >> 6, l15 = lane & 15, lq = lane >> 4;
    LAS bf16_t* St = (LAS bf16_t*)(lds + 2 * GLA_OP_BYTES);
    LAS bf16_t* WAT = St + 64 * 136;
    LAS float* BA = (LAS float*)(WAT + 128 * 40);
    LAS bf16_t* OBF = (LAS bf16_t*)(BA + 128);
    const bf16_t* Zq = (const bf16_t*)(c.ws + WS_ZQ); const bf16_t* Zk = (const bf16_t*)(c.ws + WS_ZK); const bf16_t* Zv = (const bf16_t*)(c.ws + WS_ZV); const bf16_t* Alo = (const bf16_t*)(c.ws + WS_ALO);
    bf16_t* og_f = (bf16_t*)c.out; bf16_t* og_b = og_f + (size_t)MLAT * D;
    const int ti = tid >> 3, seg = tid & 7;
    for (int u = blockIdx.x; u < 256; u += gridDim.x) {
        const int dir = u & 1, dvs = (u >> 1) & 3, h = (u >> 3) & 3, b = u >> 5;
        bf16_t* og = dir ? og_b : og_f;
        __syncthreads();
        for (int i = tid; i < 128 * 40; i += NT) { const int d = i / 40, j = i - d * 40; WAT[i] = f2bf(j < 16 ? CIN(8)[(size_t)(dir * 16 + j) * 512 + h * 128 + d] : 0.f); }
        if (tid < 128) BA[tid] = CIN(9)[dir * 512 + h * 128 + tid];
        for (int i = tid; i < 64 * 136 / 2; i += NT) ((LAS unsigned*)St)[i] = 0u;
        f32x4 accS[4];
#pragma unroll
        for (int n = 0; n < 4; ++n) accS[n] = (f32x4){0.f, 0.f, 0.f, 0.f};
        __syncthreads();
        const int d0 = wave * 16 + lq * 4;
        const bf16x8 wfr = *(LAS bf16x8*)(WAT + (wave * 16 + l15) * 40 + lq * 8);
        float bad[4];
#pragma unroll
        for (int r = 0; r < 4; ++r) bad[r] = BA[d0 + r];
#pragma unroll 1
        for (int step = 0; step <= 36; ++step) {
            const bool latn = step >= 4;
            const int cidxn = latn ? (dir ? 31 - (step - 4) : step - 4) : (dir ? 3 - step : step);
            const int rbasen = (latn ? b * SEQ : MLAT + b * CTXL) + cidxn * 64;
            u32x4 vw = (u32x4){0u, 0u, 0u, 0u}, alw[4]; u32x2 qw[4], kw[4];
            if (step < 36) {
                vw = ldg16(Zv + (size_t)(rbasen + (dir ? 63 - ti : ti)) * 1024 + h * 256 + dvs * 64 + seg * 8);
                const int chk = rbasen >> 6;
#pragma unroll
                for (int mt = 0; mt < 4; ++mt) { const int mtp = dir ? 3 - mt : mt, lp = dir ? 15 - l15 : l15;
                    alw[mt] = (u32x4){0u, 0u, 0u, 0u}; if (lq < 2) alw[mt] = ldg16(Alo + ((size_t)((((chk * 2 + dir) * 4 + mtp) * 2 + lq) * 16 + lp) << 3));
                    const size_t fo = ((size_t)(chk * 4 + h) << 13) + (size_t)(((wave * 4 + mtp) * 64 + lq * 16 + lp) << 2);
                    qw[mt] = (u32x2){0u, 0u}; if (latn) qw[mt] = *(const u32x2*)(Zq + fo);
                    kw[mt] = *(const u32x2*)(Zk + fo); }
            }
            const int sp = step - 1; const bool lat = sp >= 4;
            const int cidx = lat ? (dir ? 31 - (sp - 4) : sp - 4) : (dir ? 3 - sp : sp);
            const int rbase = (lat ? b * SEQ : MLAT + b * CTXL) + cidx * 64;
            if (step >= 1) {
                LAS unsigned char* op = lds + (sp & 1) * GLA_OP_BYTES;
                LAS bf16_t* Qd = (LAS bf16_t*)op; LAS bf16_t* Kd = Qd + 64 * 136; LAS bf16_t* Kt = Kd + 64 * 136; LAS bf16_t* Vt = Kt + 128 * 72; LAS float* EBL = (LAS float*)(Vt + 64 * 72);
                const int mi = wave >> 1;
                if (lat) {
                    bf16x8 qf[4];
#pragma unroll
                    for (int ks = 0; ks < 4; ++ks) qf[ks] = *(LAS bf16x8*)(Qd + (mi * 16 + l15) * 136 + ks * 32 + lq * 8);
                    unsigned xa[4][2];
#pragma unroll
                    for (int jt = 0; jt < 4; ++jt) { f32x4 x = (f32x4){0.f, 0.f, 0.f, 0.f};
                        if (jt <= mi) {
#pragma unroll
                            for (int ks = 0; ks < 4; ++ks) x = MFMA16(*(LAS bf16x8*)(Kd + (jt * 16 + l15) * 136 + ks * 32 + lq * 8), qf[ks], x);
                            if (jt == mi) {
#pragma unroll
                                for (int r = 0; r < 4; ++r) x[r] = (lq * 4 + r <= l15) ? x[r] : 0.f; } }
                        xa[jt][0] = pk2(x[0], x[1]); xa[jt][1] = pk2(x[2], x[3]); }
#pragma unroll
                    for (int t2 = 0; t2 < 2; ++t2) { const int nt = (wave & 1) * 2 + t2; f32x4 a = (f32x4){0.f, 0.f, 0.f, 0.f};
#pragma unroll
                        for (int ks = 0; ks < 4; ++ks) a = MFMA16(qf[ks], *(LAS bf16x8*)(St + (nt * 16 + l15) * 136 + ks * 32 + lq * 8), a);
#pragma unroll
                        for (int ks = 0; ks < 2; ++ks) {
                            const u32x4 aw = (u32x4){xa[2 * ks][0], xa[2 * ks][1], xa[2 * ks + 1][0], xa[2 * ks + 1][1]};
                            const u32x2 b0 = *(LAS u32x2*)(Vt + (nt * 16 + l15) * 72 + ks * 32 + lq * 4), b1 = *(LAS u32x2*)(Vt + (nt * 16 + l15) * 72 + ks * 32 + 16 + lq * 4);
                            const u32x4 bw = (u32x4){b0.x, b0.y, b1.x, b1.y};
                            a = MFMA16(__builtin_bit_cast(bf16x8, aw), __builtin_bit_cast(bf16x8, bw), a); }
#pragma unroll
                        for (int r = 0; r < 4; ++r) OBF[(mi * 16 + lq * 4 + r) * 72 + nt * 16 + l15] = f2bf(a[r]); }
                }
                { float eb[4];
#pragma unroll
                    for (int r = 0; r < 4; ++r) eb[r] = EBL[wave * 16 + lq * 4 + r];
#pragma unroll
                    for (int nt = 0; nt < 4; ++nt) {
#pragma unroll
                        for (int r = 0; r < 4; ++r) accS[nt][r] *= eb[r];
#pragma unroll
                        for (int ks = 0; ks < 2; ++ks) accS[nt] = MFMA16(*(LAS bf16x8*)(Kt + (wave * 16 + l15) * 72 + ks * 32 + lq * 8), *(LAS bf16x8*)(Vt + (nt * 16 + l15) * 72 + ks * 32 + lq * 8), accS[nt]); } }
            }
            if (step < 36) {
                LAS unsigned char* op = lds + (step & 1) * GLA_OP_BYTES;
                LAS bf16_t* Qd = (LAS bf16_t*)op; LAS bf16_t* Kd = Qd + 64 * 136; LAS bf16_t* Kt = Kd + 64 * 136; LAS bf16_t* Vt = Kt + 128 * 72; LAS float* EBL = (LAS float*)(Vt + 64 * 72);
                { float v8[8]; unpack8(vw, v8);
#pragma unroll
                    for (int e = 0; e < 8; ++e) Vt[(seg * 8 + e) * 72 + ti] = f2bf(v8[e]); }
                float run[4] = {0.f, 0.f, 0.f, 0.f}, bc[4][4];
#pragma unroll
                for (int mt = 0; mt < 4; ++mt) {
                    const f32x4 sd = MFMA16(wfr, __builtin_bit_cast(bf16x8, alw[mt]), ((f32x4){0.f, 0.f, 0.f, 0.f}));
#pragma unroll
                    for (int r = 0; r < 4; ++r) { float x = logsigmoidf_(sd[r] + bad[r]) * 0.0625f;
                        x += DPP_F(x, 0x111); x += DPP_F(x, 0x112); x += DPP_F(x, 0x114); x += DPP_F(x, 0x118);
                        bc[mt][r] = run[r] + x; run[r] += DPP_F(x, 0x15F); }
                }
                float ebl[4];
#pragma unroll
                for (int r = 0; r < 4; ++r) ebl[r] = fexp(run[r]);
                if (l15 == 0) *(LAS f32x4*)(EBL + d0) = (f32x4){ebl[0], ebl[1], ebl[2], ebl[3]};
#pragma unroll
                for (int mt = 0; mt < 4; ++mt) { const int t = mt * 16 + l15; float qd[4], kd[4];
                    const float q4[4] = {bflo(qw[mt].x), bfhi(qw[mt].x), bflo(qw[mt].y), bfhi(qw[mt].y)}, k4[4] = {bflo(kw[mt].x), bfhi(kw[mt].x), bflo(kw[mt].y), bfhi(kw[mt].y)};
#pragma unroll
                    for (int r = 0; r < 4; ++r) { const float e1 = fexp(bc[mt][r]), e2 = __builtin_amdgcn_rcpf(e1);
                        qd[r] = q4[r] * 0.08838834764831845f * e1; kd[r] = k4[r] * e2; Kt[(d0 + r) * 72 + t] = f2bf(kd[r] * ebl[r]); }
                    u32x2 w; w.x = pk2(qd[0], qd[1]); w.y = pk2(qd[2], qd[3]); *(LAS u32x2*)(Qd + t * 136 + d0) = w;
                    w.x = pk2(kd[0], kd[1]); w.y = pk2(kd[2], kd[3]); *(LAS u32x2*)(Kd + t * 136 + d0) = w; }
            }
            __syncthreads();
            if (step >= 1) {
#pragma unroll
                for (int nt = 0; nt < 4; ++nt) { u32x2 w; w.x = pk2(accS[nt][0], accS[nt][1]); w.y = pk2(accS[nt][2], accS[nt][3]); *(LAS u32x2*)(St + (nt * 16 + l15) * 136 + wave * 16 + lq * 4) = w; }
                if (lat) *(u32x4*)(og + (size_t)(rbase + (dir ? 63 - ti : ti)) * D + h * 256 + dvs * 64 + seg * 8) = *(LAS u32x4*)(OBF + ti * 72 + seg * 8);
            }
            __syncthreads();
        }
    }
    __syncthreads();
}
template <bool LAT> __device__ __forceinline__ void load_mixed8(const bf16_t* __restrict__ Zr, int rowbase, int tl, int col, const float* mu8, float* out) {
    float own[8], zs[8], nb[8];
    const bf16_t* p = Zr + (size_t)(rowbase + tl) * ZR_LD + col;
    unpack8(ldg16(p), own);
    if (LAT) {
        const int x = tl & 63, y = tl >> 6;
#pragma unroll
        for (int ty = 0; ty < 4; ++ty) {
            const bool ok = ty == 0 ? (x > 0) : ty == 1 ? (x < 63) : ty == 2 ? (y > 0) : (y < 31);
            const int dl = ty == 0 ? -1 : ty == 1 ? 1 : ty == 2 ? -64 : 64;
            u32x4 w = (u32x4){0u, 0u, 0u, 0u};
            if (ok) w = ldg16(p + (ptrdiff_t)dl * ZR_LD);
            unpack8(w, nb); zs[ty] = nb[ty]; zs[ty + 4] = nb[ty + 4];
        }
    } else {
#pragma unroll
        for (int ty = 0; ty < 2; ++ty) {
            const bool ok = ty == 0 ? (tl > 0) : (tl < CTXL - 1);
            u32x4 w = (u32x4){0u, 0u, 0u, 0u};
            if (ok) w = ldg16(p + (ptrdiff_t)(ty == 0 ? -1 : 1) * ZR_LD);
            unpack8(w, nb); zs[ty] = nb[ty]; zs[ty + 2] = nb[ty + 2]; zs[ty + 4] = nb[ty + 4]; zs[ty + 6] = nb[ty + 6];
        }
    }
#pragma unroll
    for (int e = 0; e < 8; ++e) out[e] = own[e] + (zs[e] - own[e]) * mu8[e];
}

__device__ __forceinline__ float fast_tanh(float x) { const float e = fexp(2.0f * x); return 1.0f - 2.0f * __builtin_amdgcn_rcpf(1.0f + e); }
__device__ __forceinline__ void premix_lora(const Ctx& c) {
    const bf16_t* Zr = (const bf16_t*)(c.ws + WS_ZR); bf16_t* ZL = (bf16_t*)(c.ws + WS_ZL);
    for (int idx = blockIdx.x * NT + threadIdx.x; idx < MALL * 44; idx += gridDim.x * NT) {
        const int row = idx / 44, sg = idx - row * 44; float v8[8], mu8[8];
#pragma unroll
        for (int e = 0; e < 8; ++e) mu8[e] = CIN(11)[3072 + sg * 8 + e];
        if (row < MLAT) load_mixed8<true>(Zr, (row / SEQ) * SEQ, row % SEQ, ZR_OFF + 3072 + sg * 8, mu8, v8);
        else { const int rc = row - MLAT; load_mixed8<false>(Zr, MLAT + (rc / CTXL) * CTXL, rc % CTXL, ZR_OFF + 3072 + sg * 8, mu8, v8); }
#pragma unroll
        for (int e = 0; e < 8; ++e) v8[e] = sg < 16 ? fast_tanh(v8[e]) : (sg < 24 ? v8[e] : sigmoidf_(v8[e]));
        *(u32x4*)(ZL + (size_t)row * ZL_LD + sg * 8) = pack8(v8);
    }
}
__device__ __forceinline__ u32x2 ldg8(const bf16_t* p) { return *(const u32x2*)p; }
__device__ __forceinline__ void mix16_direct_lat(const bf16_t* __restrict__ Zr, int rowbase, int tl, int col, const float* __restrict__ mu, float* out) {
    const bf16_t* p = Zr + (size_t)(rowbase + tl) * ZR_LD + col;
    const u32x4 o0 = ldg16(p), o1 = ldg16(p + 8);
    const int x = tl & 63, y = tl >> 6; const u32x2 z2 = (u32x2){0u, 0u};
    u32x2 lf = z2, rt = z2, up = z2, dn = z2;
    if (x > 0) lf = ldg8(p - ZR_LD); if (x < 63) rt = ldg8(p + ZR_LD + 4); if (y > 0) up = ldg8(p - (ptrdiff_t)64 * ZR_LD + 8); if (y < 31) dn = ldg8(p + (ptrdiff_t)64 * ZR_LD + 12);
    const unsigned own[8] = {o0.x, o0.y, o0.z, o0.w, o1.x, o1.y, o1.z, o1.w}, nb[8] = {lf.x, lf.y, rt.x, rt.y, up.x, up.y, dn.x, dn.y};
#pragma unroll
    for (int j = 0; j < 8; ++j)
#pragma unroll
        for (int hh = 0; hh < 2; ++hh) { const int pp = 2 * j + hh, i = (pp & 3) * 4 + (pp >> 2); const float z = hh ? bfhi(own[j]) : bflo(own[j]), zs = hh ? bfhi(nb[j]) : bflo(nb[j]); out[i] = z + (zs - z) * mu[i]; }
}
constexpr int RW_SLOT = 12544, RW_KAP = 0, RW_RT = 2048, RW_KBT = 4096, RW_VT = 8192, RW_ARR = 10240, RW_MKK = 11264, RW_PM = 11776, RW_GC = 12288;
constexpr int RW_OST = 8 * RW_SLOT, RW_W2T = RW_OST + 16384, RW_A2T = RW_W2T + 9216, RW_PAR = RW_A2T + 9216, RW_MS = RW_PAR + 2560;
#define DPP_U(x, ctrl) ((unsigned)__builtin_amdgcn_update_dpp(0, (int)(x), (ctrl), 0xf, 0xf, false))
__device__ __forceinline__ float reduce4f(float x) {
    auto r = __builtin_amdgcn_permlane32_swap(__float_as_uint(x), __float_as_uint(x), false, false);
    const float y = __uint_as_float(r[0]) + __uint_as_float(r[1]);
    auto s = __builtin_amdgcn_permlane16_swap(__float_as_uint(y), __float_as_uint(y), false, false);
    return __uint_as_float(s[0]) + __uint_as_float(s[1]);
}
struct Raw16 { u32x4 o0, o1; u32x2 hal, up, dn; };
template <bool LAT> __device__ __forceinline__ void mix16_issue(Raw16& w, const bf16_t* __restrict__ Zr, int rowbase, int tl, int dir, int l15, int col) {
    const bf16_t* p = Zr + (size_t)(rowbase + tl) * ZR_LD + col;
    w.o0 = ldg16(p); w.o1 = ldg16(p + 8);
    const bool e0 = (l15 == 0), e15 = (l15 == 15);
    const int hdl = e0 ? (dir ? 1 : -1) : (dir ? -1 : 1);
    const int lim = LAT ? 64 : CTXL; const int pos = LAT ? (tl & 63) : tl;
    const bool hok = (e0 || e15) && (pos + hdl >= 0) && (pos + hdl < lim);
    const u32x2 z = (u32x2){0u, 0u};
    w.hal = z; w.up = z; w.dn = z;
    const int hoff = hdl < 0 ? 0 : 4;
    if (hok) w.hal = ldg8(p + (ptrdiff_t)hdl * ZR_LD + hoff);
    if (LAT) {
        if ((tl >> 6) > 0) w.up = ldg8(p - (ptrdiff_t)64 * ZR_LD + 8);
        if ((tl >> 6) < 31) w.dn = ldg8(p + (ptrdiff_t)64 * ZR_LD + 12);
    } else {
        if (hok) w.up = ldg8(p + (ptrdiff_t)hdl * ZR_LD + hoff + 8);
    }
}
template <bool LAT> __device__ __forceinline__ void mix16_finish(const Raw16& w, int tl, int dir, int l15, const LAS float* mu, float* out) {
    const unsigned own[8] = {w.o0.x, w.o0.y, w.o0.z, w.o0.w, w.o1.x, w.o1.y, w.o1.z, w.o1.w};
    const int lim = LAT ? 64 : CTXL; const int pos = LAT ? (tl & 63) : tl;
    const bool pv_ok = pos > 0, nx_ok = pos < lim - 1;
    const bool pv_edge = (l15 == (dir ? 15 : 0)), nx_edge = (l15 == (dir ? 0 : 15));
    unsigned nb[8];
#define NB_PREV(j, hv) { const unsigned a_ = DPP_U(own[j], 0x111), b_ = DPP_U(own[j], 0x101); unsigned v_ = dir ? b_ : a_; if (pv_edge) v_ = (hv); nb[j] = pv_ok ? v_ : 0u; }
#define NB_NEXT(j, hv) { const unsigned a_ = DPP_U(own[j], 0x111), b_ = DPP_U(own[j], 0x101); unsigned v_ = dir ? a_ : b_; if (nx_edge) v_ = (hv); nb[j] = nx_ok ? v_ : 0u; }
    NB_PREV(0, w.hal.x) NB_PREV(1, w.hal.y) NB_NEXT(2, w.hal.x) NB_NEXT(3, w.hal.y)
    if (LAT) { nb[4] = w.up.x; nb[5] = w.up.y; nb[6] = w.dn.x; nb[7] = w.dn.y; }
    else { NB_PREV(4, w.up.x) NB_PREV(5, w.up.y) NB_NEXT(6, w.up.x) NB_NEXT(7, w.up.y) }
#undef NB_PREV
#undef NB_NEXT
    float mu16[16];
#pragma unroll
    for (int q = 0; q < 4; ++q) { const f32x4 m = *(const LAS f32x4*)(mu + q * 4); mu16[q * 4] = m[0]; mu16[q * 4 + 1] = m[1]; mu16[q * 4 + 2] = m[2]; mu16[q * 4 + 3] = m[3]; }
#pragma unroll
    for (int j = 0; j < 8; ++j)
#pragma unroll
        for (int hh = 0; hh < 2; ++hh) { const int pp = 2 * j + hh, i = (pp & 3) * 4 + (pp >> 2); const float z = hh ? bfhi(own[j]) : bflo(own[j]), zs = hh ? bfhi(nb[j]) : bflo(nb[j]); out[i] = z + (zs - z) * mu16[i]; }
}
#define MIX_ISSUE(w, colv) do { if (lat) mix16_issue<true>(w, Zr, rowbase, tl, dir, l15, (colv)); else mix16_issue<false>(w, Zr, rowbase, tl, dir, l15, (colv)); } while (0)
#define MIX_FINISH(w, k, outv) do { if (lat) mix16_finish<true>(w, tl, dir, l15, PAR + (k) * 64 + lq * 16, outv); else mix16_finish<false>(w, tl, dir, l15, PAR + (k) * 64 + lq * 16, outv); } while (0)
#define SCHED_FENCE() __builtin_amdgcn_sched_barrier(0)
__device__ __forceinline__ u32x4 packv8(const float* v) { return pack8(v); }
__device__ __forceinline__ void p4_rwkv_chunked(const Ctx& c, LAS unsigned char* lds) {
    const int tid = threadIdx.x, lane = tid & 63, wave = tid >> 6, l15 = lane & 15, lq = lane >> 4;
    LAS bf16_t* W2T = (LAS bf16_t*)(lds + RW_W2T); LAS bf16_t* A2T = (LAS bf16_t*)(lds + RW_A2T); LAS float* PAR = (LAS float*)(lds + RW_PAR);
    const bf16_t* Zr = (const bf16_t*)(c.ws + WS_ZR);
    float* bonus = (float*)(c.ws + WS_BONUS);
    for (int u = blockIdx.x; u < 256; u += gridDim.x) {
        const int dir = u & 1, h = (u >> 1) & 15, b = u >> 5;
        bf16_t* orr = (bf16_t*)(c.ws + (dir ? WS_ORB : WS_ORF));
        __syncthreads();
        for (int i = tid; i < 4096; i += NT) { const int j = i >> 6, ch = i & 63; W2T[ch * 72 + j] = f2bf(CIN(13)[(size_t)(dir * 64 + j) * 1024 + h * 64 + ch]); A2T[ch * 72 + j] = f2bf(CIN(15)[(size_t)j * 1024 + h * 64 + ch]); }
        if (tid < 64) { const int ch = tid, hc = h * 64 + ch;
            PAR[0 * 64 + ch] = CIN(11)[hc]; PAR[1 * 64 + ch] = CIN(11)[1024 + hc]; PAR[2 * 64 + ch] = CIN(11)[2048 + hc]; PAR[3 * 64 + ch] = CIN(11)[3072 + dir * 64 + ch]; PAR[4 * 64 + ch] = CIN(11)[3200 + ch];
            PAR[5 * 64 + ch] = CIN(12)[dir * 1024 + hc]; PAR[6 * 64 + ch] = CIN(14)[hc]; PAR[7 * 64 + ch] = CIN(17)[hc]; PAR[8 * 64 + ch] = CIN(18)[hc]; PAR[9 * 64 + ch] = CIN(19)[hc]; }
        __syncthreads();
        f32x4 Tt[4];
#pragma unroll
        for (int kt = 0; kt < 4; ++kt) Tt[kt] = (f32x4){0.f, 0.f, 0.f, 0.f};
        Raw16 wa, wb, wc; u32x4 bw0, bw1, ba0, ba1;
#define RW_ISSUE(qq) do { const int q_ = (qq); { const u32x4 z4_ = (u32x4){0u, 0u, 0u, 0u}; const u32x2 z2_ = (u32x2){0u, 0u}; wa.o0 = z4_; wa.o1 = z4_; wa.hal = z2_; wa.up = z2_; wa.dn = z2_; wb = wa; wc = wa; bw0 = z4_; bw1 = z4_; ba0 = z4_; ba1 = z4_; } if (q_ < 144) { const bool lat = q_ >= 16; const int cidx_ = lat ? (dir ? 127 - (q_ - 16) : q_ - 16) : (dir ? 15 - q_ : q_); \
            const int tl = cidx_ * 16 + (dir ? 15 - l15 : l15), rowbase = lat ? b * SEQ : MLAT + b * CTXL; \
            MIX_ISSUE(wa, ZR_OFF + 2048 + h * 64 + lq * 16); MIX_ISSUE(wb, ZR_OFF + 1024 + h * 64 + lq * 16); MIX_ISSUE(wc, ZR_OFF + h * 64 + lq * 16); \
            const bf16_t* zl = (const bf16_t*)(c.ws + WS_ZL) + (size_t)(rowbase + tl) * ZL_LD; \
            bw0 = ldg16(zl + dir * 64 + lq * 16); bw1 = ldg16(zl + dir * 64 + lq * 16 + 8); ba0 = ldg16(zl + 128 + lq * 16); ba1 = ldg16(zl + 128 + lq * 16 + 8); } } while (0)
#pragma unroll 1
        for (int rho = 0; rho <= 18; ++rho) {
            RW_ISSUE(8 * rho + wave);
            SCHED_FENCE();
            if (wave < 4 && rho >= 1) {
                const int vt = wave;
#pragma unroll 1
                for (int j4 = 0; j4 < 8; ++j4) {
                    const int q = 8 * (rho - 1) + j4; const bool lat = q >= 16;
                    const LAS unsigned char* slot = lds + j4 * RW_SLOT;
                    const u32x4 kf0 = *(const LAS u32x4*)(slot + RW_KAP + lane * 16), kf1 = *(const LAS u32x4*)(slot + RW_KAP + 1024 + lane * 16);
                    const u32x4 rf0 = *(const LAS u32x4*)(slot + RW_RT + lane * 16), rf1 = *(const LAS u32x4*)(slot + RW_RT + 1024 + lane * 16);
                    const u32x2 mkkf = *(const LAS u32x2*)(slot + RW_MKK + lane * 8), pmf = *(const LAS u32x2*)(slot + RW_PM + lane * 8);
                    const u32x4 arrf = *(const LAS u32x4*)(slot + RW_ARR + lane * 16);
                    const u32x2 vf = *(const LAS u32x2*)(slot + RW_VT + ((vt * 16 + l15) * 16 + lq * 4) * 2);
                    const u32x4 tb0 = (u32x4){pk2(Tt[0][0], Tt[0][1]), pk2(Tt[0][2], Tt[0][3]), pk2(Tt[1][0], Tt[1][1]), pk2(Tt[1][2], Tt[1][3])};
                    const u32x4 tb1 = (u32x4){pk2(Tt[2][0], Tt[2][1]), pk2(Tt[2][2], Tt[2][3]), pk2(Tt[3][0], Tt[3][1]), pk2(Tt[3][2], Tt[3][3])};
                    const f32x4 z4 = (f32x4){0.f, 0.f, 0.f, 0.f};
                    f32x4 xy = MFMA16(__builtin_bit_cast(bf16x8, kf0), __builtin_bit_cast(bf16x8, tb0), z4); xy = MFMA16(__builtin_bit_cast(bf16x8, kf1), __builtin_bit_cast(bf16x8, tb1), xy);
                    xy = MFMA16(__builtin_bit_cast(bf16x8, ((u32x4){mkkf.x, mkkf.y, 0u, 0u})), __builtin_bit_cast(bf16x8, ((u32x4){vf.x, vf.y, 0u, 0u})), xy);
                    const f32x4 uu = MFMA16(__builtin_bit_cast(bf16x8, ((u32x4){pmf.x, pmf.y, 0u, 0u})), __builtin_bit_cast(bf16x8, ((u32x4){pk2(xy[0], xy[1]), pk2(xy[2], xy[3]), 0u, 0u})), z4);
                    const u32x4 vub = (u32x4){vf.x, vf.y, pk2(uu[0], uu[1]), pk2(uu[2], uu[3])};
                    if (lat) {
                        f32x4 o = MFMA16(__builtin_bit_cast(bf16x8, rf0), __builtin_bit_cast(bf16x8, tb0), z4); o = MFMA16(__builtin_bit_cast(bf16x8, rf1), __builtin_bit_cast(bf16x8, tb1), o);
                        o = MFMA16(__builtin_bit_cast(bf16x8, arrf), __builtin_bit_cast(bf16x8, vub), o);
                        LAS bf16_t* ost = (LAS bf16_t*)(lds + RW_OST) + j4 * 1024;
#pragma unroll
                        for (int r = 0; r < 4; ++r) ost[(lq * 4 + r) * 64 + vt * 16 + l15] = f2bf(o[r]);
                    }
                    const LAS float* GCs = (const LAS float*)(slot + RW_GC) + lq * 16;
#pragma unroll
                    for (int kt = 0; kt < 4; ++kt) { const f32x4 gc = *(const LAS f32x4*)(GCs + kt * 4); const u32x4 kbf = *(const LAS u32x4*)(slot + RW_KBT + (kt * 64 + lane) * 16);
                        f32x4 t = Tt[kt];
#pragma unroll
                        for (int r = 0; r < 4; ++r) t[r] *= gc[r];
                        Tt[kt] = MFMA16(__builtin_bit_cast(bf16x8, kbf), __builtin_bit_cast(bf16x8, vub), t); }
                }
            }
            __syncthreads();
            {
                const int pw = wave;
                { const int q = 8 * (rho - 1) + pw;
                    if (rho >= 1 && q >= 16) { const int cidx = dir ? 127 - (q - 16) : q - 16; const int tok = lane >> 2, part = lane & 3, tl = cidx * 16 + (dir ? 15 - tok : tok);
                        const LAS bf16_t* src = (const LAS bf16_t*)(lds + RW_OST) + pw * 1024 + tok * 64 + part * 16;
                        bf16_t* dst = orr + (size_t)(b * SEQ + tl) * D + h * 64 + part * 16;
                        *(u32x4*)dst = *(const LAS u32x4*)src; *(u32x4*)(dst + 8) = *(const LAS u32x4*)(src + 8); } }
                const int q = 8 * rho + pw;
                if (q < 144) {
                    const bool lat = q >= 16;
                    const int cidx = lat ? (dir ? 127 - (q - 16) : q - 16) : (dir ? 15 - q : q);
                    const int tl = cidx * 16 + (dir ? 15 - l15 : l15), rowbase = lat ? b * SEQ : MLAT + b * CTXL;
                    LAS unsigned char* slot = lds + pw * RW_SLOT;
                    float rm[16], km[16];
                    {
                        SCHED_FENCE();
                        { float vm[16]; MIX_FINISH(wa, 2, vm);
                            LAS bf16_t* VT = (LAS bf16_t*)(slot + RW_VT);
#pragma unroll
                            for (int i = 0; i < 16; ++i) VT[(lq * 16 + i) * 16 + l15] = f2bf(vm[i]); }
                        SCHED_FENCE();
                        MIX_FINISH(wb, 1, km);
                        SCHED_FENCE();
                        MIX_FINISH(wc, 0, rm);
                    }
                    SCHED_FENCE();
                    float inv;
                    { float ss = 0.f;
#pragma unroll
                        for (int qd = 0; qd < 4; ++qd) { const f32x4 kkm = *(const LAS f32x4*)(PAR + 7 * 64 + lq * 16 + qd * 4);
#pragma unroll
                            for (int e = 0; e < 4; ++e) { const float x = km[qd * 4 + e] * kkm[e]; ss += x * x; } }
                        ss = reduce4f(ss); inv = fminf(__builtin_amdgcn_rsqf(ss), 1e12f); }
                    unsigned kapw[8], betw[8], ktw[8], rtw[8]; float bs = 0.f;
                    { LAS bf16_t* KB = (LAS bf16_t*)(slot + RW_KBT) + ((l15 >> 2) * 16 + lq * 4) * 8 + (l15 & 3); LAS float* GCs = (LAS float*)(slot + RW_GC) + lq * 16;
                        const int arow = (l15 >> 2) * 16 + (l15 & 3);
#pragma unroll
                        for (int nt = 0; nt < 4; ++nt) { SCHED_FENCE();
                            const LAS bf16_t* wr = W2T + (arow + nt * 4) * 72 + lq * 16; const LAS bf16_t* ar = A2T + (arow + nt * 4) * 72 + lq * 16;
                            f32x4 xw = MFMA16(*(const LAS bf16x8*)wr, __builtin_bit_cast(bf16x8, bw0), ((f32x4){0.f, 0.f, 0.f, 0.f})); xw = MFMA16(*(const LAS bf16x8*)(wr + 8), __builtin_bit_cast(bf16x8, bw1), xw);
                            f32x4 xa = MFMA16(*(const LAS bf16x8*)ar, __builtin_bit_cast(bf16x8, ba0), ((f32x4){0.f, 0.f, 0.f, 0.f})); xa = MFMA16(*(const LAS bf16x8*)(ar + 8), __builtin_bit_cast(bf16x8, ba1), xa);
                            const f32x4 w0 = *(const LAS f32x4*)(PAR + 5 * 64 + lq * 16 + nt * 4), a0 = *(const LAS f32x4*)(PAR + 6 * 64 + lq * 16 + nt * 4);
                            const f32x4 kkm = *(const LAS f32x4*)(PAR + 7 * 64 + lq * 16 + nt * 4), kam = *(const LAS f32x4*)(PAR + 8 * 64 + lq * 16 + nt * 4), rkm = *(const LAS f32x4*)(PAR + 9 * 64 + lq * 16 + nt * 4);
                            float ka4[4], be4[4], kt4[4], rt4[4], g4[4], lw4[4], kapn4[4], kpi4[4], betn4[4];
#pragma unroll
                            for (int r = 0; r < 4; ++r) { const int i = nt * 4 + r;
                                lw4[r] = -0.6065306597126334f * __builtin_amdgcn_rcpf(1.0f + fexp(-(w0[r] + xw[r])));
                                const float avi = sigmoidf_(a0[r] + xa[r]);
                                kapn4[r] = km[i] * kkm[r] * inv; kpi4[r] = km[i] * (1.0f + (avi - 1.0f) * kam[r]); betn4[r] = kapn4[r] * avi;
                                bs += rm[i] * kpi4[r] * rkm[r]; g4[r] = lw4[r]; }
                            asm volatile("s_nop 1\n"
                                "v_add_f32_dpp %0, %0, %0 row_shr:1 row_mask:0xf bank_mask:0xf\n" "v_add_f32_dpp %1, %1, %1 row_shr:1 row_mask:0xf bank_mask:0xf\n" "v_add_f32_dpp %2, %2, %2 row_shr:1 row_mask:0xf bank_mask:0xf\n" "v_add_f32_dpp %3, %3, %3 row_shr:1 row_mask:0xf bank_mask:0xf\n"
                                "v_add_f32_dpp %0, %0, %0 row_shr:2 row_mask:0xf bank_mask:0xf\n" "v_add_f32_dpp %1, %1, %1 row_shr:2 row_mask:0xf bank_mask:0xf\n" "v_add_f32_dpp %2, %2, %2 row_shr:2 row_mask:0xf bank_mask:0xf\n" "v_add_f32_dpp %3, %3, %3 row_shr:2 row_mask:0xf bank_mask:0xf\n"
                                "v_add_f32_dpp %0, %0, %0 row_shr:4 row_mask:0xf bank_mask:0xf\n" "v_add_f32_dpp %1, %1, %1 row_shr:4 row_mask:0xf bank_mask:0xf\n" "v_add_f32_dpp %2, %2, %2 row_shr:4 row_mask:0xf bank_mask:0xf\n" "v_add_f32_dpp %3, %3, %3 row_shr:4 row_mask:0xf bank_mask:0xf\n"
                                "v_add_f32_dpp %0, %0, %0 row_shr:8 row_mask:0xf bank_mask:0xf\n" "v_add_f32_dpp %1, %1, %1 row_shr:8 row_mask:0xf bank_mask:0xf\n" "v_add_f32_dpp %2, %2, %2 row_shr:8 row_mask:0xf bank_mask:0xf\n" "v_add_f32_dpp %3, %3, %3 row_shr:8 row_mask:0xf bank_mask:0xf\n"
                                "s_nop 1\n"
                                : "+v"(g4[0]), "+v"(g4[1]), "+v"(g4[2]), "+v"(g4[3]));
#pragma unroll
                            for (int r = 0; r < 4; ++r) { const int i = nt * 4 + r; const float g = g4[r], kapn = kapn4[r], kpi = kpi4[r], betn = betn4[r];
                                const float e1 = fexp(g), e2 = __builtin_amdgcn_rcpf(e1);
                                const float eC = DPP_F(e1, 0x15F);
                                float ep = DPP_F(e1, 0x111); ep = l15 == 0 ? 1.0f : ep;
                                const float kt_ = kpi * e2, bt_ = betn * e2;
                                ka4[r] = kapn * ep; be4[r] = bt_; kt4[r] = kt_; rt4[r] = rm[i] * e1;
                                KB[(nt * 64 + r) * 8] = f2bf(kt_ * eC); KB[(nt * 64 + r) * 8 + 4] = f2bf(-bt_ * eC);
                                if (l15 == 0) GCs[i] = eC; }
                            kapw[2 * nt] = pk2(ka4[0], ka4[1]); kapw[2 * nt + 1] = pk2(ka4[2], ka4[3]); betw[2 * nt] = pk2(be4[0], be4[1]); betw[2 * nt + 1] = pk2(be4[2], be4[3]);
                            ktw[2 * nt] = pk2(kt4[0], kt4[1]); ktw[2 * nt + 1] = pk2(kt4[2], kt4[3]); rtw[2 * nt] = pk2(rt4[0], rt4[1]); rtw[2 * nt + 1] = pk2(rt4[2], rt4[3]); }
                        SCHED_FENCE();
                        bs = reduce4f(bs);
                        if (lat && dir == 0 && lq == 0) bonus[(size_t)(b * SEQ + tl) * 16 + h] = bs; }
                    const u32x4 kapf0 = (u32x4){kapw[0], kapw[1], kapw[2], kapw[3]}, kapf1 = (u32x4){kapw[4], kapw[5], kapw[6], kapw[7]}, betf0 = (u32x4){betw[0], betw[1], betw[2], betw[3]}, betf1 = (u32x4){betw[4], betw[5], betw[6], betw[7]};
                    const u32x4 ktf0 = (u32x4){ktw[0], ktw[1], ktw[2], ktw[3]}, ktf1 = (u32x4){ktw[4], ktw[5], ktw[6], ktw[7]}, rtf0 = (u32x4){rtw[0], rtw[1], rtw[2], rtw[3]}, rtf1 = (u32x4){rtw[4], rtw[5], rtw[6], rtw[7]};
                    *(LAS u32x4*)(slot + RW_KAP + lane * 16) = kapf0; *(LAS u32x4*)(slot + RW_KAP + 1024 + lane * 16) = kapf1;
                    *(LAS u32x4*)(slot + RW_RT + lane * 16) = rtf0; *(LAS u32x4*)(slot + RW_RT + 1024 + lane * 16) = rtf1;
                    const f32x4 z4 = (f32x4){0.f, 0.f, 0.f, 0.f};
                    f32x4 mkb = MFMA16(__builtin_bit_cast(bf16x8, betf0), __builtin_bit_cast(bf16x8, kapf0), z4); mkb = MFMA16(__builtin_bit_cast(bf16x8, betf1), __builtin_bit_cast(bf16x8, kapf1), mkb);
                    f32x4 mkk = MFMA16(__builtin_bit_cast(bf16x8, ktf0), __builtin_bit_cast(bf16x8, kapf0), z4); mkk = MFMA16(__builtin_bit_cast(bf16x8, ktf1), __builtin_bit_cast(bf16x8, kapf1), mkk);
                    f32x4 ark = MFMA16(__builtin_bit_cast(bf16x8, ktf0), __builtin_bit_cast(bf16x8, rtf0), z4); ark = MFMA16(__builtin_bit_cast(bf16x8, ktf1), __builtin_bit_cast(bf16x8, rtf1), ark);
                    f32x4 arb = MFMA16(__builtin_bit_cast(bf16x8, betf0), __builtin_bit_cast(bf16x8, rtf0), z4); arb = MFMA16(__builtin_bit_cast(bf16x8, betf1), __builtin_bit_cast(bf16x8, rtf1), arb);
                    float arr8[8], mk4[4], mb4[4];
#pragma unroll
                    for (int r = 0; r < 4; ++r) { const int s = lq * 4 + r; mb4[r] = s < l15 ? mkb[r] : 0.f; mk4[r] = s < l15 ? mkk[r] : 0.f; arr8[r] = s <= l15 ? ark[r] : 0.f; arr8[4 + r] = s <= l15 ? -arb[r] : 0.f; }
                    *(LAS u32x4*)(slot + RW_ARR + lane * 16) = packv8(arr8);
                    { u32x2 w; w.x = pk2(mk4[0], mk4[1]); w.y = pk2(mk4[2], mk4[3]); *(LAS u32x2*)(slot + RW_MKK + lane * 8) = w; }
                    { LAS float* MS = (LAS float*)(lds + RW_MS) + pw * 320;
                        *(LAS f32x4*)(MS + l15 * 20 + lq * 4) = (f32x4){mb4[0], mb4[1], mb4[2], mb4[3]};
                        LDS_FENCE();
                        float mrow[16];
#pragma unroll
                        for (int qd = 0; qd < 4; ++qd) { const f32x4 m = *(const LAS f32x4*)(MS + l15 * 20 + qd * 4); mrow[qd * 4] = m[0]; mrow[qd * 4 + 1] = m[1]; mrow[qd * 4 + 2] = m[2]; mrow[qd * 4 + 3] = m[3]; }
                        LDS_FENCE();
                        float p4[4];
#pragma unroll
                        for (int j = 0; j < 4; ++j) p4[j] = (l15 == lq * 4 + j) ? 1.0f : 0.f;
                        float nm[15];
#pragma unroll
                        for (int q = 0; q < 15; ++q) nm[q] = -mrow[q];
#define PS4(sidx, op) "v_fmac_f32_dpp %0, %0, %" #op " row_newbcast:" #sidx " row_mask:0xf bank_mask:0xf\n" "v_fmac_f32_dpp %1, %1, %" #op " row_newbcast:" #sidx " row_mask:0xf bank_mask:0xf\n" \
                    "v_fmac_f32_dpp %2, %2, %" #op " row_newbcast:" #sidx " row_mask:0xf bank_mask:0xf\n" "v_fmac_f32_dpp %3, %3, %" #op " row_newbcast:" #sidx " row_mask:0xf bank_mask:0xf\n"
                        asm volatile("s_nop 1\n"
                            PS4(0, 4) PS4(1, 5) PS4(2, 6) PS4(3, 7) PS4(4, 8) PS4(5, 9) PS4(6, 10) PS4(7, 11) PS4(8, 12) PS4(9, 13) PS4(10, 14) PS4(11, 15) PS4(12, 16) PS4(13, 17) PS4(14, 18)
                            "s_nop 1\n"
                            : "+v"(p4[0]), "+v"(p4[1]), "+v"(p4[2]), "+v"(p4[3])
                            : "v"(nm[0]), "v"(nm[1]), "v"(nm[2]), "v"(nm[3]), "v"(nm[4]), "v"(nm[5]), "v"(nm[6]), "v"(nm[7]), "v"(nm[8]), "v"(nm[9]), "v"(nm[10]), "v"(nm[11]), "v"(nm[12]), "v"(nm[13]), "v"(nm[14]));
#undef PS4
                        u32x2 w; w.x = pk2(p4[0], p4[1]); w.y = pk2(p4[2], p4[3]); *(LAS u32x2*)(slot + RW_PM + lane * 8) = w; }
                }
            }
            __syncthreads();
        }
    }
}
__device__ __forceinline__ void p5_post(const Ctx& c, LAS unsigned char* lds, bool dry = false) {
    const int tid = threadIdx.x, lane = tid & 63, wave = tid >> 6, l15 = lane & 15, lq = lane >> 4;
    LAS bf16_t* SG = (LAS bf16_t*)lds;
    LAS bf16_t* GL = SG + 64 * 200;
    const bf16_t* Zr = (const bf16_t*)(c.ws + WS_ZR); const bf16_t* g2t = (const bf16_t*)(c.ws + WS_G2T);
    bf16_t* og_f = (bf16_t*)c.out; const bf16_t* og_b = og_f + (size_t)MLAT * D;
    bf16_t* or_f = (bf16_t*)(c.ws + WS_ORF); const bf16_t* or_b = (const bf16_t*)(c.ws + WS_ORB);
    const float* bonus = (const float*)(c.ws + WS_BONUS);
    for (int u = blockIdx.x; u < MLAT / 64; u += gridDim.x) {
        const int rowbase = (u >> 5) * SEQ, tl0 = (u & 31) * 64;
        __syncthreads();
        { const int tok = tid >> 3, seg = tid & 7; const bf16_t* zl = (const bf16_t*)(c.ws + WS_ZL) + (size_t)(rowbase + tl0 + tok) * ZL_LD + 192;
#pragma unroll
            for (int k = 0; k < 3; ++k) { const int sgi = seg + 8 * k; u32x4 w = (u32x4){0u, 0u, 0u, 0u};
                if (sgi < 20) w = ldg16(zl + sgi * 8);
                *(LAS u32x4*)(SG + tok * 200 + sgi * 8) = w; } }
        __syncthreads();
#pragma unroll 1
        for (int half = 0; half < 2; ++half) {
            f32x4 acc[4][4];
#pragma unroll
            for (int mt = 0; mt < 4; ++mt)
#pragma unroll
                for (int nt = 0; nt < 4; ++nt) acc[mt][nt] = (f32x4){0.f, 0.f, 0.f, 0.f};
#pragma unroll
            for (int ks = 0; ks < 6; ++ks) { bf16x8 bfr[4], afr[4];
#pragma unroll
                for (int nt = 0; nt < 4; ++nt) bfr[nt] = *(const bf16x8*)(g2t + (size_t)(((((wave * 8 + half * 4 + nt) * 6 + ks) * 64) + lane) << 3));
#pragma unroll
                for (int mt = 0; mt < 4; ++mt) afr[mt] = *(LAS bf16x8*)(SG + (mt * 16 + l15) * 200 + ks * 32 + lq * 8);
#pragma unroll
                for (int mt = 0; mt < 4; ++mt)
#pragma unroll
                    for (int nt = 0; nt < 4; ++nt) acc[mt][nt] = MFMA16(afr[mt], bfr[nt], acc[mt][nt]); }
#pragma unroll
            for (int mt = 0; mt < 4; ++mt)
#pragma unroll
                for (int nt = 0; nt < 4; ++nt)
#pragma unroll
                    for (int r = 0; r < 4; ++r) GL[(mt * 16 + lq * 4 + r) * 1032 + wave * 128 + (half * 4 + nt) * 16 + l15] = f2bf(acc[mt][nt][r]);
        }
        __syncthreads();
        for (int ii = 0; ii < 8; ++ii) {
            const int i = wave * 8 + ii; const size_t R = (size_t)rowbase + tl0 + i; const int ch0 = lane * 16;
            { float s[16], t[16]; unpack8(ldg16(og_f + R * D + ch0), s); unpack8(ldg16(og_f + R * D + ch0 + 8), s + 8); unpack8(ldg16(og_b + R * D + ch0), t); unpack8(ldg16(og_b + R * D + ch0 + 8), t + 8);
                float ssq = 0.f;
#pragma unroll
                for (int e = 0; e < 16; ++e) { s[e] += t[e]; ssq += s[e] * s[e]; }
                ssq += __shfl_xor(ssq, 1); ssq += __shfl_xor(ssq, 2); ssq += __shfl_xor(ssq, 4); ssq += __shfl_xor(ssq, 8);
                const float rs = rsqrtf(ssq * (1.0f / 256.0f) + 1e-6f);
#pragma unroll
                for (int e = 0; e < 16; ++e) s[e] = s[e] * rs * CIN(10)[ch0 + e];
                bf16_t* wp = dry ? (bf16_t*)(c.ws + WS_WIN) + (R & 4095) * D + ch0 : og_f + R * D + ch0;
                *(u32x4*)wp = pack8(s); *(u32x4*)(wp + 8) = pack8(s + 8); }
            { float s[16], t[16]; unpack8(ldg16(or_f + R * D + ch0), s); unpack8(ldg16(or_f + R * D + ch0 + 8), s + 8); unpack8(ldg16(or_b + R * D + ch0), t); unpack8(ldg16(or_b + R * D + ch0 + 8), t + 8);
                float sm = 0.f;
#pragma unroll
                for (int e = 0; e < 16; ++e) { s[e] += t[e]; sm += s[e]; }
                sm += __shfl_xor(sm, 1); sm += __shfl_xor(sm, 2);
                const float mean = sm * (1.0f / 64.0f); float sv = 0.f;
#pragma unroll
                for (int e = 0; e < 16; ++e) { s[e] -= mean; sv += s[e] * s[e]; }
                sv += __shfl_xor(sv, 1); sv += __shfl_xor(sv, 2);
                const float rs = rsqrtf(sv * (1.0f / 64.0f) + 64e-5f);
                const float bn = bonus[R * 16 + (lane >> 2)];
                float vm[16], g[16];
                mix16_direct_lat(Zr, rowbase, tl0 + i, ZR_OFF + 2048 + ch0, CIN(11) + 2048 + ch0, vm);
                unpack8(*(LAS u32x4*)(GL + i * 1032 + ch0), g); unpack8(*(LAS u32x4*)(GL + i * 1032 + ch0 + 8), g + 8);
#pragma unroll
                for (int e = 0; e < 16; ++e) s[e] = (s[e] * rs * CIN(20)[ch0 + e] + CIN(21)[ch0 + e] + bn * vm[e]) * g[e];
                bf16_t* wp = dry ? (bf16_t*)(c.ws + WS_WIN) + (R & 4095) * D + ch0 : or_f + R * D + ch0;
                *(u32x4*)wp = pack8(s); *(u32x4*)(wp + 8) = pack8(s + 8); }
        }
    }
    __syncthreads();
}

__device__ __forceinline__ void p7_combine(const Ctx& c) {
    const bf16_t* Z3 = (const bf16_t*)(c.ws + WS_Z3); const bf16_t* yg = (const bf16_t*)c.out; const bf16_t* yr = (const bf16_t*)(c.ws + WS_ORF); bf16_t* Y = (bf16_t*)(c.ws + WS_A1);
    for (int idx = blockIdx.x * NT + threadIdx.x; idx < MLAT * 128; idx += gridDim.x * NT) {
        const size_t row = idx >> 7; const int c8 = (idx & 127) * 8;
        float go[8], sg[8], sr[8], a[8], b[8], y[8];
        unpack8(ldg16(Z3 + row * Z3_LD + c8), go); unpack8(ldg16(Z3 + row * Z3_LD + 1024 + c8), sg); unpack8(ldg16(Z3 + row * Z3_LD + 2048 + c8), sr);
        unpack8(ldg16(yg + row * D + c8), a); unpack8(ldg16(yr + row * D + c8), b);
#pragma unroll
        for (int e = 0; e < 8; ++e) y[e] = sg[e] * a[e] * go[e] + sr[e] * b[e];
        *(u32x4*)(Y + row * D + c8) = pack8(y);
    }
}

__device__ __forceinline__ void p9_norm2_tables(const Ctx& c) {
    const int lane = threadIdx.x & 63, wave = threadIdx.x >> 6; const float* m = (const float*)(c.ws + WS_MOD); bf16_t* A2 = (bf16_t*)(c.ws + WS_A1);
    { const int stride = gridDim.x * 8;
        for (int row = blockIdx.x * 8 + wave; row < MLAT; row += 2 * stride) { const int rb = row + stride, b0 = row / SEQ;
            if (rb < MLAT) { const int b1 = rb / SEQ; norm_mod_row2(c.out + (size_t)row * D, c.out + (size_t)rb * D, CIN(23), m + b0 * MODW + 3072, m + b0 * MODW + 4096, m + b1 * MODW + 3072, m + b1 * MODW + 4096, A2 + (size_t)row * D, A2 + (size_t)rb * D, lane); }
            else norm_mod_row(c.out + (size_t)row * D, CIN(23), m + b0 * MODW + 3072, m + b0 * MODW + 4096, A2 + (size_t)row * D, lane); } }
    unsigned* UT = (unsigned*)(c.ws + WS_UT); unsigned* VT = (unsigned*)(c.ws + WS_VT);
    for (size_t i = ((size_t)blockIdx.x * NT + threadIdx.x) * 4; i < (size_t)16384 * 1024; i += (size_t)gridDim.x * NT * 4) {
        const f32x4 a = *(const f32x4*)(CIN(26) + i), b = *(const f32x4*)(CIN(27) + i); const size_t e = i >> 10, cc = i & 1023, o = ((cc >> 9) * (size_t)8388608 + e * 512 + (cc & 511)) >> 2;
        int w = __builtin_amdgcn_cvt_pk_fp8_f32(a[0] * 64.0f, a[1] * 64.0f, 0, false); w = __builtin_amdgcn_cvt_pk_fp8_f32(a[2] * 64.0f, a[3] * 64.0f, w, true); UT[o] = (unsigned)w;
        w = __builtin_amdgcn_cvt_pk_fp8_f32(b[0], b[1], 0, false); w = __builtin_amdgcn_cvt_pk_fp8_f32(b[2], b[3], w, true); VT[o] = (unsigned)w; }
}
typedef float f32x2p __attribute__((ext_vector_type(2)));
__device__ __forceinline__ void fp8x16_to_f32(const u32x4 w, float* o) {
#pragma unroll
    for (int q = 0; q < 4; ++q) { const f32x2p lo = __builtin_amdgcn_cvt_pk_f32_fp8((int)w[q], false), hi = __builtin_amdgcn_cvt_pk_f32_fp8((int)w[q], true); o[q * 4] = lo[0]; o[q * 4 + 1] = lo[1]; o[q * 4 + 2] = hi[0]; o[q * 4 + 3] = hi[1]; }
}
__device__ __forceinline__ float row16_sum(float x) {
    x += __builtin_bit_cast(float, __builtin_amdgcn_update_dpp(0, __builtin_bit_cast(int, x), 0x128, 0xf, 0xf, false));
    x += __builtin_bit_cast(float, __builtin_amdgcn_update_dpp(0, __builtin_bit_cast(int, x), 0x124, 0xf, 0xf, false));
    x += __builtin_bit_cast(float, __builtin_amdgcn_update_dpp(0, __builtin_bit_cast(int, x), 0x122, 0xf, 0xf, false));
    x += __builtin_bit_cast(float, __builtin_amdgcn_update_dpp(0, __builtin_bit_cast(int, x), 0x121, 0xf, 0xf, false));
    return x;
}
__device__ __forceinline__ float row32_sum(float x) {
    x = row16_sum(x);
    auto r = __builtin_amdgcn_permlane16_swap(__float_as_uint(x), __float_as_uint(x), false, false);
    return __uint_as_float(r[0]) + __uint_as_float(r[1]);
}
__device__ __forceinline__ float gelu_as(float v) {
    const float av = fabsf(v), t = __builtin_amdgcn_rcpf(av * 0.2316418882f + 1.0f);
    float q = t * 0.5307027145f - 0.7265760135f; q = q * t + 0.7107068705f; q = q * t - 0.142248368f; q = q * t + 0.127414796f; q = q * t;
    const float e = __builtin_amdgcn_exp2f(v * v * -0.72134752044f), mneg = v * (q * e);
    return v < 0.f ? mneg : v - mneg;
}

typedef int i32x8 __attribute__((ext_vector_type(8)));
constexpr int BF_HL = 4096, BF_WAVE = 2 * BF_HL;
#define S9_ROW(e) ((unsigned)(e) & rmask)
template <int EXP> __device__ __forceinline__ void p12_sweep10(const Ctx& c, int R0, LAS unsigned char* lds, int tid) {
    constexpr bool dry = EXP != 0;
    const int lane = tid & 63, wave = __builtin_amdgcn_readfirstlane(tid >> 6), l15 = lane & 15, lq = lane >> 4;
    LAS int* SIDX = (LAS int*)lds; LAS float* SGATE = (LAS float*)(SIDX + 8192);
    const LAS int* IDXL = (const LAS int*)lds + 16384; const LAS float* GATEL = (const LAS float*)(IDXL + 64 * IDSTR);
    LAS unsigned char* BF = lds + 65536 + wave * BF_WAVE;
    LAS int* HIST = (LAS int*)(lds + 133120) + wave * 64;
    LAS float* XP = (LAS float*)(lds + 135168) + wave * 512;
    const bf16_t* A2 = (const bf16_t*)(c.ws + WS_A1); const unsigned char* UT = (const unsigned char*)(c.ws + WS_UT); const unsigned char* VT = (const unsigned char*)(c.ws + WS_VT); const float* m = (const float*)(c.ws + WS_MOD);
    for (int k = 0; k < 8; ++k) { const int tok = wave + 8 * k;
        if (lane < 32) HIST[lane] = 0;
        const int e0 = IDXL[tok * IDSTR + lane], e1 = IDXL[tok * IDSTR + 64 + lane]; const float g0 = GATEL[tok * IDSTR + lane], g1 = GATEL[tok * IDSTR + 64 + lane];
        const int b0 = e0 >> 9, b1 = e1 >> 9;
        const int r0 = __hip_atomic_fetch_add(HIST + b0, 1, __ATOMIC_RELAXED, __HIP_MEMORY_SCOPE_WORKGROUP), r1 = __hip_atomic_fetch_add(HIST + b1, 1, __ATOMIC_RELAXED, __HIP_MEMORY_SCOPE_WORKGROUP);
        const int cnt = lane < 32 ? __hip_atomic_load(HIST + (lane & 31), __ATOMIC_RELAXED, __HIP_MEMORY_SCOPE_WORKGROUP) : 0; int incl = cnt;
#pragma unroll
        for (int o = 1; o < 32; o <<= 1) { const int v = __shfl_up(incl, o); if (lane >= o) incl += v; }
        if (lane < 32) HIST[32 + lane] = incl - cnt;
        LDS_FENCE();
        const int pos0 = HIST[32 + b0] + r0, pos1 = HIST[32 + b1] + r1;
        SIDX[tok * 128 + pos0] = e0; SGATE[tok * 128 + pos0] = g0; SIDX[tok * 128 + pos1] = e1; SGATE[tok * 128 + pos1] = g1;
        LDS_FENCE(); }
    __syncthreads();
    const int psel = l15 & 3;
    float wsel[4];
#pragma unroll
    for (int r = 0; r < 4; ++r) wsel[r] = ((l15 >> 2) == lq && psel == r) ? 1.0f : 0.f;
#pragma unroll 1
    for (int rep = 0; rep < S8_REPS; ++rep)
#pragma unroll 1
    for (int pass = 0; pass < 2; ++pass) {
        const bool dryrep = dry || (rep + 1 < S8_REPS); const unsigned rmask = (dryrep && S8_HOT) ? 63u : 16383u;
#pragma unroll
        for (int k = 0; k < 4; ++k) { const int tok = wave + 8 * (pass * 4 + k); float a[16];
            unpack8(ldg16(A2 + (size_t)(R0 + tok) * D + lane * 16), a); unpack8(ldg16(A2 + (size_t)(R0 + tok) * D + lane * 16 + 8), a + 8);
            u32x4 hi, lo;
#pragma unroll
            for (int q = 0; q < 4; ++q) { int w = __builtin_amdgcn_cvt_pk_fp8_f32(a[4 * q], a[4 * q + 1], 0, false); w = __builtin_amdgcn_cvt_pk_fp8_f32(a[4 * q + 2], a[4 * q + 3], w, true);
                const f32x2p h01 = __builtin_amdgcn_cvt_pk_f32_fp8(w, false), h23 = __builtin_amdgcn_cvt_pk_f32_fp8(w, true);
                int v = __builtin_amdgcn_cvt_pk_fp8_f32(a[4 * q] - h01[0], a[4 * q + 1] - h01[1], 0, false); v = __builtin_amdgcn_cvt_pk_fp8_f32(a[4 * q + 2] - h23[0], a[4 * q + 3] - h23[1], v, true);
                hi[q] = (unsigned)w; lo[q] = (unsigned)v; }
            LAS unsigned char* bp = BF + (((((lane >> 5) * 4 + ((lane >> 2) & 3)) * 2 + ((lane >> 4) & 1)) * 16) + 4 * k + (lane & 3)) * 16;
            *(LAS u32x4*)bp = hi; *(LAS u32x4*)(bp + BF_HL) = lo; }
        LDS_FENCE();
        const int tokv = wave + 8 * (pass * 4 + lq);
        const LAS int* LV = SIDX + tokv * 128; LAS float* LGv = SGATE + tokv * 128; LAS float* XPv = XP + lq * 128;
        const LAS int* LU = SIDX + (wave + 8 * (pass * 4 + (l15 >> 2))) * 128;
        const unsigned offU = (unsigned)(lq * 64 + psel * 16), offV = (unsigned)(l15 * 16);
        const bool wr_lane = (l15 == 4 * lq);
#pragma unroll 1
        for (int jj = 0; jj < 2; ++jj) { u32x4 U[8][2];
            const unsigned char* UTj = UT + (size_t)jj * 8388608; const LAS unsigned char* BFr = BF + (lq * 32 + l15) * 16 + jj * 2048;
            i32x8 Bh, Bl;
            { const u32x4 b0 = *(const LAS u32x4*)BFr, b1 = *(const LAS u32x4*)(BFr + 256), c0 = *(const LAS u32x4*)(BFr + BF_HL), c1 = *(const LAS u32x4*)(BFr + BF_HL + 256);
                Bh = (i32x8){(int)b0.x, (int)b0.y, (int)b0.z, (int)b0.w, (int)b1.x, (int)b1.y, (int)b1.z, (int)b1.w}; Bl = (i32x8){(int)c0.x, (int)c0.y, (int)c0.z, (int)c0.w, (int)c1.x, (int)c1.y, (int)c1.z, (int)c1.w}; }
#pragma unroll
            for (int s2 = 0; s2 < 8; ++s2) { const unsigned char* up = UTj + (size_t)((S9_ROW(LU[s2]) << 9) + offU);
                U[s2][0] = *(const u32x4*)up; U[s2][1] = *(const u32x4*)(up + 256); }
#pragma unroll 1
            for (int g = 0; g < 16; ++g) {
                const u32x4 ln0 = *(const LAS u32x4*)(LU + ((8 * g + 8) & 127)), ln1 = *(const LAS u32x4*)(LU + ((8 * g + 12) & 127));
                const unsigned ln[8] = {ln0.x, ln0.y, ln0.z, ln0.w, ln1.x, ln1.y, ln1.z, ln1.w};
                float x[8];
#pragma unroll
                for (int i = 0; i < 8; ++i) {
                    const u32x4 a0 = U[i][0], a1 = U[i][1];
                    const i32x8 a8 = {(int)a0.x, (int)a0.y, (int)a0.z, (int)a0.w, (int)a1.x, (int)a1.y, (int)a1.z, (int)a1.w};
                    f32x4 d = __builtin_amdgcn_mfma_scale_f32_16x16x128_f8f6f4(a8, Bh, ((f32x4){0.f, 0.f, 0.f, 0.f}), 0, 0, 0, 0, 0, 0);
                    d = __builtin_amdgcn_mfma_scale_f32_16x16x128_f8f6f4(a8, Bl, d, 0, 0, 0, 0, 0, 0);
                    { const unsigned char* up = UTj + (size_t)((S9_ROW(ln[i]) << 9) + offU);
                        U[i][0] = *(const u32x4*)up; U[i][1] = *(const u32x4*)(up + 256); }
                    x[i] = d[0] * wsel[0] + d[1] * wsel[1] + d[2] * wsel[2] + d[3] * wsel[3];
                    SCHED_FENCE(); }
#pragma unroll
                for (int i = 0; i < 8; ++i) { x[i] += DPP_F(x[i], 0xB1); x[i] += DPP_F(x[i], 0x4E); }
                if (jj == 0) { if (wr_lane) { *(LAS f32x4*)(XPv + 8 * g) = (f32x4){x[0], x[1], x[2], x[3]}; *(LAS f32x4*)(XPv + 8 * g + 4) = (f32x4){x[4], x[5], x[6], x[7]}; } }
                else { const f32x4 p0 = *(const LAS f32x4*)(XPv + 8 * g), p1 = *(const LAS f32x4*)(XPv + 8 * g + 4), g0 = *(const LAS f32x4*)(LGv + 8 * g), g1 = *(const LAS f32x4*)(LGv + 8 * g + 4);
                    const float xp[8] = {p0[0], p0[1], p0[2], p0[3], p1[0], p1[1], p1[2], p1[3]}, gt[8] = {g0[0], g0[1], g0[2], g0[3], g1[0], g1[1], g1[2], g1[3]}; float cf[8];
#pragma unroll
                    for (int i = 0; i < 8; ++i) cf[i] = gt[i] * gelu_as((x[i] + xp[i]) * (1.0f / 64.0f));
                    if (wr_lane && !(dryrep && S8_REPS > 1)) { *(LAS f32x4*)(LGv + 8 * g) = (f32x4){cf[0], cf[1], cf[2], cf[3]}; *(LAS f32x4*)(LGv + 8 * g + 4) = (f32x4){cf[4], cf[5], cf[6], cf[7]}; } }
                SCHED_FENCE();
            }
            LDS_FENCE();
        }
        f32x2p acc[32];
#pragma unroll
        for (int e = 0; e < 32; ++e) acc[e] = (f32x2p){0.f, 0.f};
#pragma unroll
        for (int hv = 0; hv < 2; ++hv) { u32x4 V[8][2];
            const unsigned char* VTh = VT + (size_t)hv * 8388608;
#pragma unroll
            for (int s2 = 0; s2 < 8; ++s2) { const unsigned char* vp = VTh + (size_t)((S9_ROW(LV[s2]) << 9) + offV);
                V[s2][0] = *(const u32x4*)vp; V[s2][1] = *(const u32x4*)(vp + 256); }
#pragma unroll 1
            for (int g = 0; g < 16; ++g) {
                const u32x4 ln0 = *(const LAS u32x4*)(LV + ((8 * g + 8) & 127)), ln1 = *(const LAS u32x4*)(LV + ((8 * g + 12) & 127));
                const unsigned ln[8] = {ln0.x, ln0.y, ln0.z, ln0.w, ln1.x, ln1.y, ln1.z, ln1.w};
                const f32x4 c0 = *(const LAS f32x4*)(LGv + 8 * g), c1 = *(const LAS f32x4*)(LGv + 8 * g + 4);
                const float cf8[8] = {c0[0], c0[1], c0[2], c0[3], c1[0], c1[1], c1[2], c1[3]};
#pragma unroll
                for (int i = 0; i < 8; ++i) {
                    const f32x2p cf2 = (f32x2p){cf8[i], cf8[i]};
#pragma unroll
                    for (int q = 0; q < 2; ++q)
#pragma unroll
                        for (int w = 0; w < 4; ++w) { acc[hv * 16 + q * 8 + w * 2] += cf2 * __builtin_amdgcn_cvt_pk_f32_fp8((int)V[i][q][w], false); acc[hv * 16 + q * 8 + w * 2 + 1] += cf2 * __builtin_amdgcn_cvt_pk_f32_fp8((int)V[i][q][w], true); }
                    SCHED_FENCE();
                    { const unsigned char* vp = VTh + (size_t)((S9_ROW(ln[i]) << 9) + offV);
                        V[i][0] = *(const u32x4*)vp; V[i][1] = *(const u32x4*)(vp + 256); }
                    SCHED_FENCE(); }
            }
        }
        { const int R = R0 + tokv; const int b = R / SEQ; const float* g2 = m + b * MODW + 5120; float* hrow = c.out + (size_t)R * D; float ss = 0.f;
            f32x4 h2[16];
#pragma unroll
            for (int q = 0; q < 4; ++q)
#pragma unroll
                for (int w = 0; w < 4; ++w) { const int ch = q * 256 + l15 * 16 + w * 4; const f32x4 hv = *(const f32x4*)(hrow + ch), gv = *(const f32x4*)(g2 + ch);
                    const float a4[4] = {acc[q * 8 + 2 * w][0], acc[q * 8 + 2 * w][1], acc[q * 8 + 2 * w + 1][0], acc[q * 8 + 2 * w + 1][1]};
#pragma unroll
                    for (int e = 0; e < 4; ++e) { const float v = hv[e] + gv[e] * a4[e]; h2[q * 4 + w][e] = v; ss += v * v; } }
            ss = row16_sum(ss);
            const float rstd = rsqrtf(ss * (1.0f / 1024.0f) + 1e-6f);
            float* orow = dryrep ? (float*)(c.ws + WS_ZR + (size_t)56 * 1048576) + (size_t)(R & 8191) * D : hrow;
#pragma unroll
            for (int q = 0; q < 4; ++q)
#pragma unroll
                for (int w = 0; w < 4; ++w) { const int ch = q * 256 + l15 * 16 + w * 4; const f32x4 wv = *(const f32x4*)(CIN(28) + ch); f32x4 o;
#pragma unroll
                    for (int e = 0; e < 4; ++e) o[e] = h2[q * 4 + w][e] * rstd * wv[e];
                    *(f32x4*)(orow + ch) = o; } }
    }
}

__device__ __forceinline__ int sortable(float v) { const int b = __float_as_int(v); return b ^ ((b >> 31) & 0x7fffffff); }
__device__ __forceinline__ float unsortable(int k) { return __int_as_float(k ^ ((k >> 31) & 0x7fffffff)); }
#define CASD(a, b) { const int _hi = max(a, b), _lo = min(a, b); a = _hi; b = _lo; }
#define CAS16(t, x) { _Pragma("unroll") for (int _i = 0; _i < 16; ++_i) { const int _hi = max(t[_i], x); x = min(t[_i], x); t[_i] = _hi; } }
__device__ __forceinline__ void bitonic_merge16_desc(int* t) {
#pragma unroll
    for (int d = 8; d >= 1; d >>= 1)
#pragma unroll
        for (int i = 0; i < 16; ++i) if ((i & d) == 0) CASD(t[i], t[i + d]);
}
__device__ __forceinline__ void bitonic_sort16_desc(int* t) {
#pragma unroll
    for (int k = 2; k <= 16; k <<= 1)
#pragma unroll
        for (int d = k >> 1; d >= 1; d >>= 1)
#pragma unroll
            for (int i = 0; i < 16; ++i) { const int j = i ^ d; if (j > i) { if ((i & k) == 0 || k == 16) { CASD(t[i], t[j]); } else { CASD(t[j], t[i]); } } }
}
template <int EXP> __device__ __forceinline__ void p11_topk(const Ctx& c, LAS unsigned char* lds) {
    LAS int* KEYS = (LAS int*)lds;
    const bf16_t* Q = (const bf16_t*)(c.ws + WS_Q); const bf16_t* SK = (const bf16_t*)(c.ws + WS_SK);
    LAS int* IDXL = KEYS + 16384;
    LAS float* GATEL = (LAS float*)(IDXL + 64 * IDSTR);
    const int wv_s = __builtin_amdgcn_readfirstlane(threadIdx.x >> 6);
    for (int u = blockIdx.x; u < MLAT / 64; u += gridDim.x) {
        int tid; asm volatile("v_mbcnt_lo_u32_b32 %0, -1, 0\n\tv_mbcnt_hi_u32_b32 %0, -1, %0\n\tv_or_b32 %0, %1, %0" : "=&v"(tid) : "s"(wv_s << 6));
        const int lane = tid & 63, wave = tid >> 6, l15 = lane & 15, lq = lane >> 4;
        const int R0 = u * 64, tt = wave >> 1, p = wave & 1;
        __syncthreads();
#pragma unroll 1
        for (int h = 0; h < 8; ++h) {
            bf16x8 qf[4];
#pragma unroll
            for (int ks = 0; ks < 4; ++ks) qf[ks] = *(const bf16x8*)(Q + ((size_t)((((((R0 >> 4) + tt) * 8 + h) * 2 + p) * 4 + ks) * 64 + lane) << 3));
            int ta[16], tb[16];
#pragma unroll
            for (int nt = 0; nt < 8; ++nt) { f32x4 a = (f32x4){0.f, 0.f, 0.f, 0.f};
#pragma unroll
                for (int ks = 0; ks < 4; ++ks) a = MFMA16(*(const bf16x8*)(SK + (size_t)(((((h * 2 + p) * 8 + nt) * 4 + ks) * 64 + lane) * 8)), qf[ks], a);
#pragma unroll
                for (int r = 0; r < 4; ++r) { const int n = nt * 16 + lq * 4 + r; const int key = (sortable(a[r]) & ~127) | (127 - n);
                    if (nt < 4) ta[nt * 4 + r] = key; else tb[(nt - 4) * 4 + r] = key; } }
            bitonic_sort16_desc(ta); bitonic_sort16_desc(tb);
#pragma unroll
            for (int i = 0; i < 16; ++i) ta[i] = max(ta[i], tb[15 - i]);
            bitonic_merge16_desc(ta);
#pragma unroll
            for (int st = 0; st < 2; ++st) {
#pragma unroll
                for (int i = 0; i < 16; ++i) tb[i] = __shfl_xor(ta[i], st ? 32 : 16);
#pragma unroll
                for (int i = 0; i < 16; ++i) ta[i] = max(ta[i], tb[15 - i]);
                bitonic_merge16_desc(ta); }
            if (lq == 0) {
#pragma unroll
                for (int i = 0; i < 16; ++i) KEYS[((h * 2 + p) * 16 + i) * 64 + tt * 16 + l15] = ta[i]; }
        }
        __syncthreads();
        {
            const int tok = tid & 63, h = tid >> 6;
            int k1[16], k2[16]; float s1[16], s2[16];
#pragma unroll
            for (int i = 0; i < 16; ++i) { k1[i] = KEYS[((h * 2) * 16 + i) * 64 + tok]; k2[i] = KEYS[((h * 2 + 1) * 16 + i) * 64 + tok]; s1[i] = unsortable(k1[i] & ~127); s2[i] = unsortable(k2[i] & ~127); }
            int t[16];
#pragma unroll
            for (int j = 0; j < 16; ++j) t[j] = (sortable(s1[0] + s2[j]) & ~255) | (255 - j);
#pragma unroll
            for (int i = 1; i < 16; ++i)
#pragma unroll
                for (int j = 0; j < 16; ++j) if ((i + 1) * (j + 1) <= 16) { int x = (sortable(s1[i] + s2[j]) & ~255) | (255 - (i * 16 + j)); CAS16(t, x); }
            float sv[16]; int ev[16]; float mx = -3.0e38f;
#pragma unroll
            for (int k = 0; k < 16; ++k) { const int id = 255 - (t[k] & 255), i = id >> 4, j = id & 15;
                const int ia = KEYS[((h * 2) * 16 + i) * 64 + tok], ib = KEYS[((h * 2 + 1) * 16 + j) * 64 + tok];
                sv[k] = unsortable(ia & ~127) + unsortable(ib & ~127); ev[k] = (127 - (ia & 127)) * 128 + (127 - (ib & 127)); mx = fmaxf(mx, sv[k]); }
            float den = 0.f;
#pragma unroll
            for (int k = 0; k < 16; ++k) { sv[k] = fexp(sv[k] - mx); den += sv[k]; }
            const float inv = 1.0f / den; const int o = tok * IDSTR + h * 16;
#pragma unroll
            for (int k = 0; k < 16; k += 4) { *(LAS u32x4*)(IDXL + o + k) = (u32x4){(unsigned)ev[k], (unsigned)ev[k + 1], (unsigned)ev[k + 2], (unsigned)ev[k + 3]};
                *(LAS f32x4*)(GATEL + o + k) = (f32x4){sv[k] * inv, sv[k + 1] * inv, sv[k + 2] * inv, sv[k + 3] * inv}; }
        }
        __syncthreads();
        if (EXP != 2) p12_sweep10<EXP>(c, R0, lds, tid);
    }
    __syncthreads();
}

constexpr int N_PHASES = 12;
#ifndef RWKV_IMPL
#define RWKV_IMPL 1
#endif
#ifndef RWKV_PROBE
#define RWKV_PROBE 0
#endif
__global__ void __launch_bounds__(NT, 2) fwd_kernel(Args args) {
    extern __shared__ __attribute__((aligned(16))) unsigned char lds_raw[];
    LAS unsigned char* lds0 = (LAS unsigned char*)lds_raw;
    LAS unsigned char* lds = lds0 + LDS_HDR;
    Ctx c; c.in = (KArgPtr)__builtin_amdgcn_kernarg_segment_ptr();
    c.out = args.out; c.ws = args.ws;
    if (threadIdx.x < 16) ((LAS unsigned*)lds0)[threadIdx.x] = 0u;
    __syncthreads();
    const int lo = args.ph_lo, hi = args.ph_hi;
    const bool multi = (hi - lo) > 1;
    XcdBarrier bar; bar.bar = (unsigned*)(c.ws + WS_CTL); bar.x = 0; bar.st = (volatile LAS unsigned*)lds0;
    if (multi) bar = xcd_barrier_post((unsigned*)(c.ws + WS_CTL), (volatile LAS unsigned*)lds0);
#ifndef PROBE_T
#define PROBE_T -1
#endif
    LAS unsigned long long* stamps = (LAS unsigned long long*)(lds0 + LDS_BYTES - 256);
#define STAMP(i) do { if (PROBE_T >= 0 && threadIdx.x == 0) stamps[i] = wall_clock64(); } while (0)
#define IN(k) (lo <= (k) && (k) < hi)
#define SEAM(k) do { STAMP(2 * (k) + 1); if (IN(k) && IN((k) + 1)) { xcd_barrier(bar); if (DUP(20)) xcd_barrier(bar); } STAMP(2 * (k) + 2); } while (0)
    STAMP(0);
    const bf16_t* Wt_in = (const bf16_t*)(c.ws + WS_WIN);
    if (IN(0)) { p0_prologue(c, lds); if (DUP(0)) p0_prologue(c, lds); } SEAM(0);
    if (IN(1)) { p1_norm1(c); if (DUP(1)) p1_norm1(c); } SEAM(1);
    if (IN(2)) { pg8::Gemm g{(const bf16_t*)(c.ws + WS_A1), Wt_in, MALL, N1, D}; Gemm1Order S; S.init(MLAT, N1, gridDim.x, blockIdx.x);
        EpiB<0> E{(bf16_t*)(c.ws + WS_ZG), (bf16_t*)(c.ws + WS_ZR), 0};
        pg8::gemm_phase<EpiB<0>, Gemm1Order, false>((PG8_LAS unsigned char*)lds, g, S, E, nullptr);
        if (DUP(2)) { if (DUP(21)) xcd_barrier(bar); pg8::gemm_phase<EpiB<0>, Gemm1Order, false>((PG8_LAS unsigned char*)lds, g, S, E, nullptr); } } SEAM(2);
    if (IN(3)) { premix_lora(c); p3_gla(c, lds); if (DUP(3)) p3_gla(c, lds); } SEAM(3);
    if (IN(4)) { p4_rwkv_chunked(c, lds); if (DUP(4)) { if (DUP(21)) xcd_barrier(bar); p4_rwkv_chunked(c, lds); } } SEAM(4);
    if (IN(5)) { if (DUP(5)) p5_post(c, lds, true); p5_post(c, lds); } SEAM(5);
    if (IN(6)) { pg8::StaticOrder S; S.init(MLAT, D, gridDim.x, blockIdx.x); bf16_t* Tb = (bf16_t*)c.out; bf16_t* Yr = (bf16_t*)(c.ws + WS_ORF);
        { pg8::Gemm g{(const bf16_t*)(c.ws + WS_A1), Wt_in + (size_t)N1 * D, MLAT, D, D}; EpiMix<0> E{Tb, Yr}; pg8::gemm_phase<EpiMix<0>, pg8::StaticOrder, false>((PG8_LAS unsigned char*)lds, g, S, E, nullptr); }
        __syncthreads();
        { pg8::Gemm g{(const bf16_t*)(c.ws + WS_A1), Wt_in + (size_t)(N1 + 1024) * D, MLAT, D, D}; EpiMix<1> E{Tb, Yr}; pg8::gemm_phase<EpiMix<1>, pg8::StaticOrder, false>((PG8_LAS unsigned char*)lds, g, S, E, nullptr); }
        __syncthreads();
        { pg8::Gemm g{(const bf16_t*)(c.ws + WS_A1), Wt_in + (size_t)(N1 + 2048) * D, MLAT, D, D}; EpiMix<2> E{Tb, Yr}; pg8::gemm_phase<EpiMix<2>, pg8::StaticOrder, false>((PG8_LAS unsigned char*)lds, g, S, E, nullptr); } } SEAM(6);
    if (IN(8)) { pg8::Gemm g{(const bf16_t*)(c.ws + WS_ORF), (const bf16_t*)(c.ws + WS_WOUT), MLAT, D, D}; pg8::StaticOrder S; S.init(MLAT, D, gridDim.x, blockIdx.x);
        EpiH1 E{CIN(0), (const float*)(c.ws + WS_MOD), c.out};
        pg8::gemm_phase<EpiH1, pg8::StaticOrder, false>((PG8_LAS unsigned char*)lds, g, S, E, nullptr); } SEAM(8);
    if (IN(9)) { p9_norm2_tables(c); if (DUP(9)) p9_norm2_tables(c); } SEAM(9);
    if (IN(10)) { pg8::Gemm g{(const bf16_t*)(c.ws + WS_A1), (const bf16_t*)(c.ws + WS_WQ), MLAT, 2048, D}; pg8::StaticOrder S; S.init(MLAT, 2048, gridDim.x, blockIdx.x);
        EpiB<3> E{(bf16_t*)(c.ws + WS_Q), nullptr, 2048};
        pg8::gemm_phase<EpiB<3>, pg8::StaticOrder, false>((PG8_LAS unsigned char*)lds, g, S, E, nullptr);
        if (DUP(10)) pg8::gemm_phase<EpiB<3>, pg8::StaticOrder, false>((PG8_LAS unsigned char*)lds, g, S, E, nullptr); } SEAM(10);
    if (IN(11)) { if (DUP(11)) p11_topk<GEXP>(c, lds); p11_topk<0>(c, lds); }
    STAMP(23);
    if (PROBE_T >= 0) {
        __syncthreads();
        const float us = (float)(stamps[PROBE_T + 1] - stamps[PROBE_T]) * 0.01f;
        for (int u = blockIdx.x; u < MLAT / 64; u += gridDim.x) for (int i = threadIdx.x; i < 64 * D; i += NT) c.out[(size_t)u * 64 * D + i] = us;
    }
#undef IN
#undef SEAM
}

__global__ void dbg_cmp2(const bf16_t* oldv, const bf16_t* nf, const bf16_t* nb, float* out) {
    for (size_t i = (size_t)blockIdx.x * blockDim.x + threadIdx.x; i < (size_t)MLAT * D; i += (size_t)gridDim.x * blockDim.x) {
        const float o = bf2f(oldv[i]); const float n = i < 8388608 ? bf2f(nf[i]) : bf2f(nb[i - 8388608]);
        float v = (n - o) * (100.0f / 12.2f); if (!(fabsf(v) < 1e30f)) v = 1e4f; out[i] = v; }
}
extern "C" void kernel_launch(void* const* d_in, const int* in_sizes, int n_in, void* d_out, int out_size, void* d_ws, size_t ws_size, hipStream_t stream) {
    static int grid = 0;
    if (grid == 0) {
        if (n_in != 29 || out_size != MLAT * D || ws_size < WS_END) { fprintf(stderr, "kernel_launch: unexpected shapes (n_in %d, out %d, ws %zu < %zu)\n", n_in, out_size, ws_size, (size_t)WS_END); grid = -1; return; }
        int dev = 0, cus = 0, per_cu = 0;
        if (hipGetDevice(&dev) != hipSuccess || hipDeviceGetAttribute(&cus, hipDeviceAttributeMultiprocessorCount, dev) != hipSuccess) { grid = -1; return; }
        if (hipFuncSetAttribute((const void*)fwd_kernel, hipFuncAttributeMaxDynamicSharedMemorySize, LDS_BYTES) != hipSuccess) { fprintf(stderr, "kernel_launch: hipFuncSetAttribute failed\n"); grid = -1; return; }
        if (hipOccupancyMaxActiveBlocksPerMultiprocessor(&per_cu, (const void*)fwd_kernel, NT, LDS_BYTES) != hipSuccess || per_cu < 1) fprintf(stderr, "kernel_launch: occupancy query reports %d\n", per_cu);
        (void)hipGetLastError();
        grid = cus;
    }
    if (grid < 0) return;
    (void)hipMemsetAsync((char*)d_ws + WS_CTL, 0, 65536, stream);
    Args a{};
    for (int i = 0; i < 29; ++i) a.in[i] = (const float*)d_in[i];
    a.out = (float*)d_out; a.ws = (unsigned char*)d_ws;
#if MK_N_LAUNCHES == 1
    a.ph_lo = 0; a.ph_hi = N_PHASES;
    hipLaunchKernelGGL(fwd_kernel, dim3(grid), dim3(NT), LDS_BYTES, stream, a);
#else
    for (int p = 0; p < N_PHASES; ++p) { a.ph_lo = p; a.ph_hi = p + 1; hipLaunchKernelGGL(fwd_kernel, dim3(grid), dim3(NT), LDS_BYTES, stream, a); }
#endif
}
```

```cpp
#include <hip/hip_runtime.h>
#include <stdint.h>
#include <stdio.h>

#ifndef MK_N_LAUNCHES
#define MK_N_LAUNCHES 1
#endif

namespace pg8 {
#define PG8_LAS __attribute__((address_space(3)))
typedef unsigned short bf16_t;
typedef short bf16x8 __attribute__((ext_vector_type(8)));
typedef float f32x4 __attribute__((ext_vector_type(4)));
typedef unsigned u32x4 __attribute__((ext_vector_type(4)));
constexpr int BM = 256, BK = 64, HALF = 128, HTB = HALF * BK * 2  , STAGE_BYTES = 8 * HTB, NXCD = 8, WGM = 8;

__host__ __device__ __forceinline__ int lds_byte(int r, int c) { const int st = (r >> 4) * 2 + (c >> 5), rr = r & 15, cc = c & 31, ob = rr * 64 + cc * 2; return st * 1024 + (ob ^ (((ob >> 9) & 1) << 5)); }
__host__ __device__ __forceinline__ void stage_rc(int b, int& R, int& C) { const int st = b / 1024, sb = b % 1024, swz = sb ^ (((sb >> 9) & 1) << 5); R = (st >> 1) * 16 + swz / 64; C = (st & 1) * 32 + (swz % 64) / 2; }
__host__ __device__ __forceinline__ int perm32(int rho) { const int n = rho >> 4, i = rho & 15; return 8 * (i >> 2) + 4 * n + (i & 3); }

struct Unit { int pm, pn; };
struct Gemm { const bf16_t* A; const bf16_t* Bt; int M, N, K; };

struct StaticOrder {
    int nM, nN, nwg, G, c;
    __host__ __device__ void init(int M, int N, int G_, int c_) { nM = M / BM; nN = N / BM; nwg = nM * nN; G = G_; c = c_; }
    __host__ __device__ bool next(int i, Unit& u) const {
        const long L = (long)i * G + c; if (L >= nwg) return false;
        int wgid = (int)L; { const int q = nwg / NXCD, r = nwg % NXCD, xcd = wgid % NXCD, off = wgid / NXCD; wgid = (xcd < r ? xcd * (q + 1) : r * (q + 1) + (xcd - r) * q) + off; }
        const int nig = WGM * nN, gid = wgid / nig, fm = gid * WGM, gsz = (nM - fm) < WGM ? (nM - fm) : WGM;
        u.pm = fm + ((wgid % nig) % gsz); u.pn = (wgid % nig) / gsz; return true;
    }
    __device__ __forceinline__ void a_ready(const Unit&) const {}
    __device__ __forceinline__ void done(const Unit&) const {}
};
__device__ __forceinline__ unsigned cvt_pk_bf16(float lo, float hi) { unsigned r; asm volatile("v_cvt_pk_bf16_f32 %0, %1, %2" : "=v"(r) : "v"(lo), "v"(hi)); return r; }
template <class Epi, class Sched, bool STAMP = false>
__device__ __forceinline__ void gemm_phase(PG8_LAS unsigned char* lds, const Gemm g, const Sched& S, const Epi& E, unsigned long long* stamps) {
    const int tid = threadIdx.x, wid = __builtin_amdgcn_readfirstlane(tid >> 6), lane = tid & 63, wr = wid >> 2, wc = wid & 3, fr = lane & 15, fq = lane >> 4;
    const int K = g.K, nt = K / BK;
    int ts_lo = 0, ts_hi = 0, nts = 0; const unsigned long long rt_entry = STAMP ? (unsigned long long)wall_clock64() : 0ull;
#define PG8_STAMP() do { if (STAMP && wid == 0 && nts < 64) { const unsigned long long _c = (unsigned long long)clock64(); \
        ts_lo = (lane == nts) ? (int)(unsigned)_c : ts_lo; ts_hi = (lane == nts) ? (int)(unsigned)(_c >> 32) : ts_hi; ++nts; } } while (0)
    PG8_STAMP();
    unsigned voffA[2], voffB[2];
#pragma unroll
    for (int i = 0; i < 2; ++i) { int R, C; stage_rc(tid * 16 + i * 8192, R, C); const int Rb = Epi::PERM ? ((R & ~31) + perm32(R & 31)) : R;
        voffA[i] = (unsigned)(R * K + C) * 2u; voffB[i] = (unsigned)(Rb * K + C) * 2u; }
    const size_t kstep = (size_t)(BK * 2);
    const size_t hstep = (size_t)HALF * K * 2;
    const size_t tstep = 2 * hstep;
    const unsigned ldsw = (unsigned)wid * 1024u;
    const int aoff = lds_byte(wr * 64 + fr, fq * 8), boff = lds_byte(wc * 32 + fr, fq * 8);
#define PG8_SA(b, h) (((b) * 2 + (h)) * HTB)
#define PG8_SB(b, h) ((4 + (b) * 2 + (h)) * HTB)
#define PG8_STAGE(bufoff, gbase, voff) do { _Pragma("unroll") for (int _i = 0; _i < 2; ++_i) \
        __builtin_amdgcn_global_load_lds((const unsigned*)((const char*)(gbase) + (voff)[_i]), (PG8_LAS unsigned*)(lds + (bufoff) + ldsw + _i * 8192), 16, 0, 0); } while (0)
#define PG8_LDA(dst, b, h) do { _Pragma("unroll") for (int m = 0; m < 4; ++m) _Pragma("unroll") for (int k = 0; k < 2; ++k) dst[m][k] = *(const PG8_LAS bf16x8*)(lds + PG8_SA(b, h) + aoff + m * 2048 + k * 1024); } while (0)
#define PG8_LDB(dst, b, h) do { _Pragma("unroll") for (int n = 0; n < 2; ++n) _Pragma("unroll") for (int k = 0; k < 2; ++k) dst[n][k] = *(const PG8_LAS bf16x8*)(lds + PG8_SB(b, h) + boff + n * 2048 + k * 1024); } while (0)
#define PG8_MMA(ai, bj, At, Bt) do { __builtin_amdgcn_s_setprio(1); _Pragma("unroll") for (int m = 0; m < 4; ++m) _Pragma("unroll") for (int n = 0; n < 2; ++n) _Pragma("unroll") for (int k = 0; k < 2; ++k) \
        acc[ai][bj][m][n] = __builtin_amdgcn_mfma_f32_16x16x32_bf16(Bt[n][k], At[m][k], acc[ai][bj][m][n], 0, 0, 0); __builtin_amdgcn_s_setprio(0); } while (0)
#define PG8_WAIT_V(n) asm volatile("s_waitcnt vmcnt(" #n ")" ::: "memory")
#define PG8_WAIT_L(n) asm volatile("s_waitcnt lgkmcnt(" #n ")" ::: "memory")
#define PG8_BAR __builtin_amdgcn_s_barrier()
#define PG8_SCHED __builtin_amdgcn_sched_barrier(0)
    Unit cur, nxt; int ui = 0;
    if (!S.next(0, cur)) return;
    f32x4 acc[2][2][4][2];
#pragma unroll
    for (int a = 0; a < 2; ++a)
#pragma unroll
        for (int b = 0; b < 2; ++b)
#pragma unroll
            for (int m = 0; m < 4; ++m)
#pragma unroll
                for (int n = 0; n < 2; ++n) acc[a][b][m][n] = (f32x4){0.f, 0.f, 0.f, 0.f};
    bf16x8 At[4][2], B0[2][2], B1[2][2];
    const char* cA = (const char*)g.A + (size_t)cur.pm * tstep; const char* cB = (const char*)g.Bt + (size_t)cur.pn * tstep;
    S.a_ready(cur);
    PG8_STAGE(PG8_SB(0, 0), cB, voffB); PG8_STAGE(PG8_SA(0, 0), cA, voffA); PG8_STAGE(PG8_SB(0, 1), cB + hstep, voffB); PG8_STAGE(PG8_SA(0, 1), cA + hstep, voffA);
    if (wr == 1) PG8_BAR;
    PG8_WAIT_V(4); PG8_BAR;
    PG8_STAGE(PG8_SB(1, 0), cB + kstep, voffB); PG8_STAGE(PG8_SA(1, 0), cA + kstep, voffA); PG8_STAGE(PG8_SB(1, 1), cB + hstep + kstep, voffB);
    PG8_WAIT_V(6); PG8_BAR;
    PG8_STAMP();
    for (;;) {
        const bool has_next = S.next(ui + 1, nxt);
        const char* nA = has_next ? (const char*)g.A + (size_t)nxt.pm * tstep : cA; const char* nB = has_next ? (const char*)g.Bt + (size_t)nxt.pn * tstep : cB;
        for (int t = 0; t < nt; t += 2) {
            const bool last = (t == nt - 2);
            const char* a1 = cA + (size_t)(t + 1) * kstep;
            const char* a2 = last ? nA : cA + (size_t)(t + 2) * kstep; const char* b2 = last ? nB : cB + (size_t)(t + 2) * kstep;
            const char* a3 = a2 + kstep; const char* b3 = b2 + kstep;
            if (last && has_next) S.a_ready(nxt);
            PG8_LDB(B0, 0, 0); PG8_SCHED; PG8_LDA(At, 0, 0); PG8_STAGE(PG8_SA(1, 1), a1 + hstep, voffA);
            PG8_WAIT_L(8); PG8_BAR; PG8_WAIT_L(0); PG8_MMA(0, 0, At, B0); PG8_BAR; PG8_SCHED;
            PG8_LDB(B1, 0, 1); PG8_STAGE(PG8_SB(0, 0), b2, voffB);
            PG8_BAR; PG8_WAIT_L(0); PG8_MMA(0, 1, At, B1); PG8_BAR;
            PG8_LDA(At, 0, 1); PG8_STAGE(PG8_SA(0, 0), a2, voffA);
            PG8_BAR; PG8_WAIT_L(0); PG8_MMA(1, 0, At, B0); PG8_BAR; PG8_SCHED;
            PG8_STAGE(PG8_SB(0, 1), b2 + hstep, voffB);
            PG8_WAIT_V(6); PG8_BAR; PG8_MMA(1, 1, At, B1); PG8_BAR;
            PG8_LDB(B0, 1, 0); PG8_SCHED; PG8_LDA(At, 1, 0); PG8_STAGE(PG8_SA(0, 1), a2 + hstep, voffA);
            PG8_WAIT_L(8); PG8_BAR; PG8_WAIT_L(0); PG8_MMA(0, 0, At, B0); PG8_BAR; PG8_SCHED;
            PG8_LDB(B1, 1, 1); PG8_STAGE(PG8_SB(1, 0), b3, voffB);
            PG8_BAR; PG8_WAIT_L(0); PG8_MMA(0, 1, At, B1); PG8_BAR;
            PG8_LDA(At, 1, 1); PG8_STAGE(PG8_SA(1, 0), a3, voffA);
            PG8_BAR; PG8_WAIT_L(0); PG8_MMA(1, 0, At, B0); PG8_BAR; PG8_SCHED;
            PG8_STAGE(PG8_SB(1, 1), b3 + hstep, voffB);
            PG8_WAIT_V(6); PG8_BAR; PG8_MMA(1, 1, At, B1); PG8_BAR;
        }
        PG8_STAMP();
        if constexpr (!Epi::AFTER_DRAIN) { E(acc, cur, wr, wc, fr, fq); S.done(cur); }
        PG8_STAMP();
        if (!has_next) break;
#pragma unroll
        for (int a = 0; a < 2; ++a)
#pragma unroll
            for (int b = 0; b < 2; ++b)
#pragma unroll
                for (int m = 0; m < 4; ++m)
#pragma unroll
                    for (int n = 0; n < 2; ++n) acc[a][b][m][n] = (f32x4){0.f, 0.f, 0.f, 0.f};
        cur = nxt; cA = nA; cB = nB; ++ui;
    }
    PG8_WAIT_V(0);
    if (wr == 0) PG8_BAR;
    PG8_BAR;
    if constexpr (Epi::AFTER_DRAIN) { E.fused(acc, cur, wr, wc, fr, fq, lds, wid, lane); S.done(cur); }
    PG8_STAMP();
    if (STAMP && wid == 0) { stamps[lane] = lane < nts ? (((unsigned long long)(unsigned)ts_hi << 32) | (unsigned)ts_lo) : 0ull;
        if (lane == 62) stamps[62] = rt_entry; if (lane == 63) stamps[63] = (unsigned long long)wall_clock64(); }
#undef PG8_STAMP
#undef PG8_SA
#undef PG8_SB
#undef PG8_STAGE
#undef PG8_LDA
#undef PG8_LDB
#undef PG8_MMA
#undef PG8_WAIT_V
#undef PG8_WAIT_L
#undef PG8_BAR
#undef PG8_SCHED
}
}

#define XB_TMO      128
#define XB_XCNT(j)  (256  + 64 * (j))
#define XB_XSUB(j)  (1280 + 64 * (j))
#define XB_XGEN(j)  (2304 + 64 * (j))
#define XB_TOP      3328
#define XB_TOPGEN   3392
#define XCD_BAR_WORDS 3456
#define XB_SPIN_CAP (1u << 18)
#define LAS __attribute__((address_space(3)))

__device__ __forceinline__ unsigned xb_ld(unsigned* p)              { return __hip_atomic_load(p, __ATOMIC_RELAXED, __HIP_MEMORY_SCOPE_AGENT); }
__device__ __forceinline__ unsigned xb_add(unsigned* p, unsigned v) { return __hip_atomic_fetch_add(p, v, __ATOMIC_RELAXED, __HIP_MEMORY_SCOPE_AGENT); }
__device__ __forceinline__ unsigned xb_xcc_id() { return (unsigned)__builtin_amdgcn_s_getreg((3 << 11) | 20) & 0xFu; }
#define XB_SPIN(cond, bar) do { unsigned _sp = 0; while (cond) { __builtin_amdgcn_s_sleep(1); \
    if ((++_sp & 255u) == 0u) { if (xb_ld(&(bar)[XB_TMO])) break; if (_sp > XB_SPIN_CAP) { atomicAdd(&(bar)[XB_TMO], 1u); break; } } } } while (0)

struct XcdBarrier {
    unsigned* bar; unsigned x;
    volatile LAS unsigned* st;
};

__device__ __forceinline__ XcdBarrier xcd_barrier_post(unsigned* bar, volatile LAS unsigned* st) {
    XcdBarrier b; b.bar = bar; b.x = xb_xcc_id(); b.st = st;
    if (threadIdx.x == 0) (void)xb_add(&bar[XB_XCNT(b.x)], 1u);
    return b;
}
__device__ __forceinline__ void xcd_barrier_complete(unsigned* bar, unsigned x, unsigned& nloc, unsigned& nx) {
    const unsigned G = gridDim.x * gridDim.y * gridDim.z;
    unsigned sum, cnt, mine, sp = 0u;
    for (;;) {
        sum = 0u; cnt = 0u; mine = 0u;
#pragma unroll
        for (unsigned j = 0; j < 16; ++j) { const unsigned c = xb_ld(&bar[XB_XCNT(j)]); sum += c; cnt += (c > 0u) ? 1u : 0u; mine = (j == x) ? c : mine; }
        if (sum == G) break;
        __builtin_amdgcn_s_sleep(1);
        if ((++sp & 255u) == 0u) { if (xb_ld(&bar[XB_TMO])) break; if (sp > XB_SPIN_CAP) { atomicAdd(&bar[XB_TMO], 1u); break; } }
    }
    nloc = mine > 0u ? mine : 1u; nx = cnt > 0u ? cnt : 1u;
}

__device__ __forceinline__ void xcd_barrier(const XcdBarrier& b) {
    asm volatile("s_waitcnt vmcnt(0)" ::: "memory");
    __syncthreads();
    if (threadIdx.x == 0) {
        unsigned* bar = b.bar;
        __builtin_amdgcn_s_waitcnt(0);
        unsigned nloc = b.st[0], nx = b.st[1];
        if (nloc == 0u) { xcd_barrier_complete(bar, b.x, nloc, nx); b.st[0] = nloc; b.st[1] = nx; }
        const unsigned old = xb_add(&bar[XB_XSUB(b.x)], 1u);
        const unsigned gen = old / nloc;
        if (old + 1u == (gen + 1u) * nloc) {
            __builtin_amdgcn_fence(__ATOMIC_RELEASE, "agent");
            asm volatile("s_waitcnt vmcnt(0)" ::: "memory");
            const unsigned og = xb_add(&bar[XB_TOP], 1u);
            const unsigned tg = og / nx;
            if (og + 1u == (tg + 1u) * nx) xb_add(&bar[XB_TOPGEN], 1u);
            else XB_SPIN(xb_ld(&bar[XB_TOPGEN]) == tg, bar);
            __builtin_amdgcn_fence(__ATOMIC_ACQUIRE, "agent");
            xb_add(&bar[XB_XGEN(b.x)], 1u);
            asm volatile("s_waitcnt vmcnt(0)" ::: "memory");
        } else {
            XB_SPIN(xb_ld(&bar[XB_XGEN(b.x)]) == gen, bar);
            __builtin_amdgcn_fence(__ATOMIC_ACQUIRE, "agent");
            asm volatile("s_waitcnt vmcnt(0)" ::: "memory");
        }
    }
    __syncthreads();
}

typedef unsigned short bf16_t;
typedef short bf16x8 __attribute__((ext_vector_type(8)));
typedef float f32x4 __attribute__((ext_vector_type(4)));
typedef unsigned u32x4 __attribute__((ext_vector_type(4)));
typedef unsigned u32x2 __attribute__((ext_vector_type(2)));

constexpr int IDSTR = 132;
#ifndef GATHER_SWEEP
#define GATHER_SWEEP 6
#endif
#ifndef DUP_MASK
#define DUP_MASK 0
#ifndef S8_REPS
#define S8_REPS 1
#endif
#ifndef S8_HOT
#define S8_HOT 1
#endif
#define GEXP 3
#endif
#define DUP(k) ((DUP_MASK >> (k)) & 1)
constexpr int NT = 512;
constexpr int D = 1024, NB = 8, SEQ = 2048, CTXL = 256;
constexpr int MLAT = NB * SEQ, MCTX = NB * CTXL, MALL = MLAT + MCTX;
constexpr int ZG_LD = 2048, ZR_LD = 3584, Z3_LD = 3072;
constexpr int N1 = 5632, N2 = 3072, NIN = N1 + N2;
constexpr int ZR_OFF = 32;
constexpr int NSC = 18432 / 16, ZRL_LD = 512;
__host__ __device__ __forceinline__ size_t orf(int T, int head, int lq, int half) { return (size_t)((((((T >> 4) * 16 + head) * 2 + half) * 4 + lq) * 16) + (T & 15)) << 3; }
__host__ __device__ __forceinline__ size_t zrf(int qn, int T, int head, int lq, int half) { return (size_t)(((((((qn * NSC + (T >> 4)) * 16 + head) * 2 + half) * 4 + lq) * 16) + (T & 15))) << 3; }
constexpr int MODW = 6144;
constexpr int LDS_BYTES = 163840, LDS_HDR = 64;

constexpr size_t WS_CTL   = 0;
constexpr size_t WS_MOD   = 65536;
constexpr size_t WS_BONUS = WS_MOD + 262144;
constexpr size_t WS_WIN   = WS_BONUS + 1048576;
constexpr size_t WS_WOUT  = WS_WIN + (size_t)NIN * 1024 * 2;
constexpr size_t WS_WQ    = WS_WOUT + (size_t)1024 * 1024 * 2;
constexpr size_t WS_G2T   = WS_WQ + (size_t)2048 * 1024 * 2;
constexpr size_t WS_SK    = WS_G2T + (size_t)1024 * 192 * 2;
constexpr size_t WS_A1    = WS_SK + (size_t)16 * 128 * 128 * 2;
constexpr size_t WS_ZG    = WS_A1 + (size_t)MALL * 1024 * 2;
constexpr size_t WS_ZR    = WS_ZG + (size_t)MALL * ZG_LD * 2;
constexpr size_t WS_ZL    = WS_ZR + (size_t)MALL * ZR_LD * 2;
constexpr int ZL_LD = 352;
constexpr size_t WS_END   = WS_ZL + (size_t)MALL * ZL_LD * 2;
constexpr size_t WS_ZQ    = WS_ZG;
constexpr size_t WS_ZK    = WS_ZG + (size_t)MALL * 512 * 2;
constexpr size_t WS_ZV    = WS_ZG + (size_t)MALL * 1024 * 2;
constexpr size_t WS_ALO   = WS_ZQ + (size_t)MLAT * 512 * 2;
constexpr size_t WS_ORF   = WS_ZG;
constexpr size_t WS_ORB   = WS_ZG + (size_t)MLAT * 1024 * 2;
constexpr size_t WS_Q     = WS_ZG;
constexpr size_t WS_ZRL   = WS_ZR + (size_t)18432 * 3072 * 2;
constexpr size_t WS_Z3    = WS_ZR;
constexpr size_t WS_UT    = WS_ZR;
constexpr size_t WS_VT    = WS_UT + (size_t)16384 * 1024;
constexpr size_t WS_IDX   = WS_VT + (size_t)16384 * 1024;
constexpr size_t WS_GATE  = WS_IDX + (size_t)MLAT * 128 * 4;
static_assert(WS_GATE + (size_t)MLAT * 128 * 4 <= WS_ZL, "ws map");
static_assert(WS_ORB + (size_t)MLAT * 1024 * 2 <= WS_ZR, "ws map");

typedef const float* const __attribute__((address_space(4))) * KArgPtr;
struct Ctx { KArgPtr in; float* out; unsigned char* ws; };
#define CIN(k) (c.in[k])
struct Args { const float* in[29]; float* out; unsigned char* ws; int ph_lo, ph_hi; };

typedef __bf16 hwbf16x2 __attribute__((ext_vector_type(2)));
typedef float f32x2v __attribute__((ext_vector_type(2)));
__device__ __forceinline__ unsigned pk2(float lo, float hi) { const f32x2v f = {lo, hi}; const hwbf16x2 v = __builtin_convertvector(f, hwbf16x2); return __builtin_bit_cast(unsigned, v); }
__device__ __forceinline__ bf16_t f2bf(float f) { return (bf16_t)(pk2(f, 0.f) & 0xffffu); }
__device__ __forceinline__ float bflo(unsigned w) { return __uint_as_float(w << 16); }
__device__ __forceinline__ float bfhi(unsigned w) { return __uint_as_float(w & 0xffff0000u); }
__device__ __forceinline__ float bf2f(bf16_t b) { return __uint_as_float(((unsigned)b) << 16); }
__device__ __forceinline__ void unpack8(const u32x4 w, float* o) { o[0] = bflo(w.x); o[1] = bfhi(w.x); o[2] = bflo(w.y); o[3] = bfhi(w.y); o[4] = bflo(w.z); o[5] = bfhi(w.z); o[6] = bflo(w.w); o[7] = bfhi(w.w); }
__device__ __forceinline__ u32x4 pack8(const float* v) { u32x4 w; w.x = pk2(v[0], v[1]); w.y = pk2(v[2], v[3]); w.z = pk2(v[4], v[5]); w.w = pk2(v[6], v[7]); return w; }
__device__ __forceinline__ u32x4 ldg16(const bf16_t* p) { return *(const u32x4*)p; }
__device__ __forceinline__ float fexp(float x) { return __builtin_amdgcn_exp2f(x * 1.4426950408889634f); }
__device__ __forceinline__ float flog(float x) { return __builtin_amdgcn_logf(x) * 0.6931471805599453f; }
__device__ __forceinline__ float sigmoidf_(float x) { return __builtin_amdgcn_rcpf(1.0f + fexp(-x)); }
__device__ __forceinline__ float wave_sum(float v) {
#pragma unroll
    for (int o = 32; o > 0; o >>= 1) v += __shfl_xor(v, o);
    return v;
}
#define LDS_FENCE() asm volatile("s_waitcnt lgkmcnt(0)" ::: "memory")

__device__ __forceinline__ int win_src(int n) {
    if (n < 2048) return n;
    if (n < N1) { const int j = n - 2048; if (j < 16) return 3072 + j; if (j < 32) return 3088 + (j - 16); if (j < 32 + 3424) { int cr = j - 32; if (cr < 3072) { const int p = cr & 15; cr = (cr & ~15) + (p & 3) * 4 + (p >> 2); } return 3104 + cr; } return -1; }
    const int j = n - N1; return j < 1024 ? 2048 + j : 6528 + (j - 1024);
}
template <int MODE> __device__ __forceinline__ void transpose_tile(const float* __restrict__ src, int ld, bf16_t* __restrict__ dst, int n0, int k0, LAS float* tile) {
    const int tid = threadIdx.x;
#pragma unroll
    for (int e = 0; e < 8; ++e) { const int idx = tid + e * NT, kk = idx >> 6, nn = idx & 63; const int n = n0 + nn; const int s = MODE == 0 ? win_src(n) : n;
        tile[kk * 65 + nn] = s >= 0 ? src[(size_t)(k0 + kk) * ld + s] : 0.f; }
    __syncthreads();
#pragma unroll
    for (int e = 0; e < 4; ++e) { const int idx = tid + e * NT, nn = idx >> 5, kp = idx & 31;
        *(unsigned*)(dst + (size_t)(n0 + nn) * 1024 + k0 + kp * 2) = pk2(tile[(kp * 2) * 65 + nn], tile[(kp * 2 + 1) * 65 + nn]); }
    __syncthreads();
}
__device__ __forceinline__ void p0_prologue(const Ctx& c, LAS unsigned char* lds) {
    const int tid = threadIdx.x, G = gridDim.x, bx = blockIdx.x;
    LAS float* tile = (LAS float*)lds;
    bf16_t* Wt_in = (bf16_t*)(c.ws + WS_WIN); bf16_t* Wt_out = (bf16_t*)(c.ws + WS_WOUT); bf16_t* Wt_q = (bf16_t*)(c.ws + WS_WQ);
    constexpr int T_IN = (NIN / 64) * 16, T_OUT = 16 * 16, T_Q = 32 * 16;
    for (int rep_ = 0; rep_ < (DUP(22) ? 2 : 1); ++rep_)
    for (int t = bx; t < T_IN + T_OUT + T_Q; t += G) {
        if (t < T_IN) transpose_tile<0>(CIN(7), 8576, Wt_in, (t >> 4) * 64, (t & 15) * 64, tile);
        else if (t < T_IN + T_OUT) { const int u = t - T_IN; transpose_tile<1>(CIN(22), 1024, Wt_out, (u >> 4) * 64, (u & 15) * 64, tile); }
        else { const int u = t - T_IN - T_OUT; transpose_tile<1>(CIN(24), 2048, Wt_q, (u >> 4) * 64, (u & 15) * 64, tile); }
    }
    bf16_t* g2t = (bf16_t*)(c.ws + WS_G2T); bf16_t* sk = (bf16_t*)(c.ws + WS_SK);
    for (int i = bx * NT + tid; i < 1024 * 192; i += G * NT) { const int n = i / 192, j = i - n * 192;
        g2t[(((((n >> 4) * 6 + (j >> 5)) * 64) + ((j >> 3) & 3) * 16 + (n & 15)) << 3) + (j & 7)] = f2bf(j < 160 ? CIN(16)[j * 1024 + n] : 0.f); }
    for (int i = bx * NT + tid; i < 16 * 128 * 128; i += G * NT) { const int hp = i >> 14, n = (i >> 7) & 127, k = i & 127;
        sk[((((hp * 8 + (n >> 4)) * 4 + (k >> 5)) * 64 + ((k >> 3) & 3) * 16 + (n & 15)) << 3) + (k & 7)] = f2bf(CIN(25)[i]); }
    LAS float* sc = (LAS float*)lds;
    LAS float* part = sc + 9 * 1024;
    float* m = (float*)(c.ws + WS_MOD);
    for (int rep_ = 0; rep_ < (DUP(23) ? 2 : 1); ++rep_)
    for (int cg = bx; cg < MODW / 24; cg += G) {
        __syncthreads();
        for (int i = tid; i < 9 * 1024; i += NT) { const float v = i < 8192 ? CIN(1)[i] : CIN(3)[i - 8192]; sc[i] = v * sigmoidf_(v); }
        __syncthreads();
        const int c0 = cg * 24;
        if (tid < 504) { const int col = tid % 24, kp = tid / 24; float acc[9];
#pragma unroll
            for (int r = 0; r < 9; ++r) acc[r] = 0.f;
            for (int k = kp; k < 1024; k += 21) { const float w = CIN(5)[(size_t)k * MODW + c0 + col];
#pragma unroll
                for (int r = 0; r < 9; ++r) acc[r] += sc[r * 1024 + k] * w; }
#pragma unroll
            for (int r = 0; r < 9; ++r) part[(kp * 9 + r) * 24 + col] = acc[r]; }
        __syncthreads();
        if (tid < 216) { const int r = tid / 24, col = tid % 24; float s = CIN(6)[c0 + col];
            for (int kp = 0; kp < 21; ++kp) s += part[(kp * 9 + r) * 24 + col];
            m[r * MODW + c0 + col] = s; }
    }
    __syncthreads();
}

__device__ __forceinline__ void norm_mod_row(const float* __restrict__ src, const float* __restrict__ nw, const float* __restrict__ shift, const float* __restrict__ scale, bf16_t* __restrict__ dst, int lane) {
    f32x4 v[4]; float ss = 0.f;
#pragma unroll
    for (int j = 0; j < 4; ++j) { v[j] = *(const f32x4*)(src + (j * 64 + lane) * 4); ss += v[j][0] * v[j][0] + v[j][1] * v[j][1] + v[j][2] * v[j][2] + v[j][3] * v[j][3]; }
    ss = wave_sum(ss);
    const float rstd = rsqrtf(ss * (1.0f / 1024.0f) + 1e-6f);
#pragma unroll
    for (int j = 0; j < 4; ++j) { const int c0 = (j * 64 + lane) * 4; const f32x4 w = *(const f32x4*)(nw + c0), sh = *(const f32x4*)(shift + c0), sc = *(const f32x4*)(scale + c0);
        float y[4];
#pragma unroll
        for (int e = 0; e < 4; ++e) y[e] = v[j][e] * rstd * w[e] * (1.0f + sc[e]) + sh[e];
        u32x2 o; o.x = pk2(y[0], y[1]); o.y = pk2(y[2], y[3]); *(u32x2*)(dst + c0) = o; }
}
__device__ __forceinline__ void norm_mod_row2(const float* __restrict__ s0, const float* __restrict__ s1, const float* __restrict__ nw, const float* __restrict__ sh0, const float* __restrict__ sc0,
                                              const float* __restrict__ sh1, const float* __restrict__ sc1, bf16_t* __restrict__ d0, bf16_t* __restrict__ d1, int lane) {
    f32x4 v0[4], v1[4]; float a0 = 0.f, a1 = 0.f;
#pragma unroll
    for (int j = 0; j < 4; ++j) { v0[j] = *(const f32x4*)(s0 + (j * 64 + lane) * 4); v1[j] = *(const f32x4*)(s1 + (j * 64 + lane) * 4); }
#pragma unroll
    for (int j = 0; j < 4; ++j) { a0 += v0[j][0] * v0[j][0] + v0[j][1] * v0[j][1] + v0[j][2] * v0[j][2] + v0[j][3] * v0[j][3]; a1 += v1[j][0] * v1[j][0] + v1[j][1] * v1[j][1] + v1[j][2] * v1[j][2] + v1[j][3] * v1[j][3]; }
#pragma unroll
    for (int o = 32; o > 0; o >>= 1) { a0 += __shfl_xor(a0, o); a1 += __shfl_xor(a1, o); }
    const float r0 = rsqrtf(a0 * (1.0f / 1024.0f) + 1e-6f), r1 = rsqrtf(a1 * (1.0f / 1024.0f) + 1e-6f);
#pragma unroll
    for (int j = 0; j < 4; ++j) { const int c0 = (j * 64 + lane) * 4; const f32x4 w = *(const f32x4*)(nw + c0), h0 = *(const f32x4*)(sh0 + c0), g0 = *(const f32x4*)(sc0 + c0), h1 = *(const f32x4*)(sh1 + c0), g1 = *(const f32x4*)(sc1 + c0);
        float y0[4], y1[4];
#pragma unroll
        for (int e = 0; e < 4; ++e) { y0[e] = v0[j][e] * r0 * w[e] * (1.0f + g0[e]) + h0[e]; y1[e] = v1[j][e] * r1 * w[e] * (1.0f + g1[e]) + h1[e]; }
        u32x2 o; o.x = pk2(y0[0], y0[1]); o.y = pk2(y0[2], y0[3]); *(u32x2*)(d0 + c0) = o; o.x = pk2(y1[0], y1[1]); o.y = pk2(y1[2], y1[3]); *(u32x2*)(d1 + c0) = o; }
}
__device__ __forceinline__ void p1_norm1(const Ctx& c) {
    const int lane = threadIdx.x & 63, wave = threadIdx.x >> 6; const float* m = (const float*)(c.ws + WS_MOD); bf16_t* A1 = (bf16_t*)(c.ws + WS_A1);
    const int stride = gridDim.x * 8;
    for (int row = blockIdx.x * 8 + wave; row < MALL; row += 2 * stride) {
        const int rb = row + stride;
        const float* s0 = row < MLAT ? CIN(0) + (size_t)row * D : CIN(2) + (size_t)(row - MLAT) * D; const int m0 = row < MLAT ? row / SEQ : 8;
        if (rb < MALL) { const float* s1 = rb < MLAT ? CIN(0) + (size_t)rb * D : CIN(2) + (size_t)(rb - MLAT) * D; const int m1 = rb < MLAT ? rb / SEQ : 8;
            norm_mod_row2(s0, s1, CIN(4), m + m0 * MODW, m + m0 * MODW + 1024, m + m1 * MODW, m + m1 * MODW + 1024, A1 + (size_t)row * D, A1 + (size_t)rb * D, lane); }
        else norm_mod_row(s0, CIN(4), m + m0 * MODW, m + m0 * MODW + 1024, A1 + (size_t)row * D, lane);
    }
}
template <int MODE  > struct EpiB {
    static constexpr bool PERM = true, AFTER_DRAIN = false;
    bf16_t* O0; bf16_t* O1; int ldc;
    __device__ __forceinline__ void operator()(const pg8::f32x4 (&acc)[2][2][4][2], const pg8::Unit& u, int wr, int wc, int fr, int fq) const {
        const int row0 = u.pm * 256 + wr * 64 + fr; int colt = u.pn * 256; bf16_t* base = O0; int ld = ldc;
        if (MODE == 0) { if (u.pn >= 8) { base = O1; ld = ZR_LD; colt -= 2048; } else { ld = ZG_LD; } }
        const int col0 = colt + wc * 32 + 8 * fq;
        const bool is_silu = (MODE == 1) && (u.pn < 4);
#pragma unroll
        for (int ai = 0; ai < 2; ++ai)
#pragma unroll
            for (int m = 0; m < 4; ++m) { bf16_t* rowp = base + (size_t)(row0 + ai * 128 + m * 16) * ld + col0;
#pragma unroll
                for (int bj = 0; bj < 2; ++bj) { float v[8];
#pragma unroll
                    for (int j = 0; j < 4; ++j) { v[j] = acc[ai][bj][m][0][j]; v[4 + j] = acc[ai][bj][m][1][j]; }
                    if (MODE == 1) {
#pragma unroll
                        for (int j = 0; j < 8; ++j) { const float s = sigmoidf_(v[j]); v[j] = is_silu ? v[j] * s : s; } }
                    if (MODE == 0 && u.pn < 4) {
                        const int chunk = (row0 + ai * 128 + m * 16) >> 6, head = (2 * u.pn + bj) & 3;
                        bf16_t* blk = O0 + (u.pn >= 2 ? (size_t)MALL * 512 : (size_t)0) + ((size_t)(chunk * 4 + head) << 13);
                        const u32x4 w = pack8(v); const int wv_c = 2 * wc + (fq >> 1), lq_c = 2 * (fq & 1);
                        *(u32x2*)(blk + (((wv_c * 4 + m) * 64 + lq_c * 16 + fr) << 2)) = (u32x2){w.x, w.y};
                        *(u32x2*)(blk + (((wv_c * 4 + m) * 64 + (lq_c + 1) * 16 + fr) << 2)) = (u32x2){w.z, w.w};
                    } else if (MODE == 0 && u.pn < 8) {
                        *(u32x4*)(O0 + (size_t)MALL * 1024 + (size_t)(row0 + ai * 128 + m * 16) * 1024 + (u.pn - 4) * 256 + bj * 128 + wc * 32 + 8 * fq) = pack8(v);
                    } else if (MODE == 0 && u.pn == 8 && bj == 0 && wc == 0) {
                        const int chunk = (row0 + ai * 128 + m * 16) >> 6;
                        *(u32x4*)(O0 + (size_t)MLAT * 512 + ((size_t)((((chunk * 2 + (fq >> 1)) * 4 + m) * 2 + (fq & 1)) * 16 + fr) << 3)) = pack8(v);
                    } else if (MODE == 0 && u.pn >= 8) {
                        const int row = row0 + ai * 128 + m * 16, zc = (u.pn - 8) * 256 + bj * 128 + wc * 32 + 8 * fq, rc = zc - 32;
                        const size_t fo = zrf(rc >> 10, row, (rc >> 6) & 15, (rc >> 4) & 3, (rc >> 3) & 1), lo = (size_t)MALL * 3072 + (size_t)row * ZRL_LD + (zc - 3072);
                        *(u32x4*)(O1 + (zc < 3104 ? fo : lo)) = pack8(v);
                    } else if (MODE == 3) {
                        const int tile = (row0 + ai * 128 + m * 16) >> 4;
                        *(u32x4*)(O0 + ((size_t)((((tile * 8 + u.pn) * 2 + bj) * 4 + wc) * 64 + fq * 16 + fr) << 3)) = pack8(v);
                    } else *(u32x4*)(rowp + bj * 128) = pack8(v); } }
    }
};
template <int STEP> struct EpiMix {
    static constexpr bool PERM = true, AFTER_DRAIN = false;
    bf16_t* T; bf16_t* YR;
    __device__ __forceinline__ void operator()(const pg8::f32x4 (&acc)[2][2][4][2], const pg8::Unit& u, int wr, int wc, int fr, int fq) const {
        const int row0 = u.pm * 256 + wr * 64 + fr, col0 = u.pn * 256 + wc * 32 + 8 * fq;
#pragma unroll
        for (int ai = 0; ai < 2; ++ai)
#pragma unroll
            for (int m = 0; m < 4; ++m) { const size_t ro = (size_t)(row0 + ai * 128 + m * 16) * D + col0;
#pragma unroll
                for (int bj = 0; bj < 2; ++bj) { float v[8], t[8];
#pragma unroll
                    for (int j = 0; j < 4; ++j) { v[j] = acc[ai][bj][m][0][j]; v[4 + j] = acc[ai][bj][m][1][j]; }
                    unpack8(ldg16(T + ro + bj * 128), t);
                    if (STEP == 0) {
#pragma unroll
                        for (int j = 0; j < 8; ++j) t[j] *= v[j] * sigmoidf_(v[j]);
                        *(u32x4*)(T + ro + bj * 128) = pack8(t);
                    } else if (STEP == 1) {
#pragma unroll
                        for (int j = 0; j < 8; ++j) t[j] *= sigmoidf_(v[j]);
                        *(u32x4*)(T + ro + bj * 128) = pack8(t);
                    } else { float r[8]; unpack8(ldg16(YR + ro + bj * 128), r);
#pragma unroll
                        for (int j = 0; j < 8; ++j) t[j] += sigmoidf_(v[j]) * r[j];
                        *(u32x4*)(YR + ro + bj * 128) = pack8(t); } } }
    }
};
struct EpiH1 {
    static constexpr bool PERM = false, AFTER_DRAIN = false;
    const float* x; const float* m; float* h1;
    __device__ __forceinline__ void operator()(const pg8::f32x4 (&acc)[2][2][4][2], const pg8::Unit& u, int wr, int wc, int fr, int fq) const {
        const int row0 = u.pm * 256 + wr * 64 + fr, col0 = u.pn * 256 + wc * 32 + 4 * fq;
        const float* g = m + (size_t)((u.pm * 256) / SEQ) * MODW + 2048;
        f32x4 gv[2][2];
#pragma unroll
        for (int bj = 0; bj < 2; ++bj)
#pragma unroll
            for (int n = 0; n < 2; ++n) gv[bj][n] = *(const f32x4*)(g + col0 + bj * 128 + n * 16);
#pragma unroll
        for (int ai = 0; ai < 2; ++ai)
#pragma unroll
            for (int mm = 0; mm < 4; ++mm) { const size_t ro = (size_t)(row0 + ai * 128 + mm * 16) * D + col0;
#pragma unroll
                for (int bj = 0; bj < 2; ++bj)
#pragma unroll
                    for (int n = 0; n < 2; ++n) { const f32x4 xv = *(const f32x4*)(x + ro + bj * 128 + n * 16); *(f32x4*)(h1 + ro + bj * 128 + n * 16) = xv + gv[bj][n] * acc[ai][bj][mm][n]; } }
    }
};

struct Gemm1Order : pg8::StaticOrder {
    __device__ bool next(int i, pg8::Unit& u) const {
        const long L = (long)i * G + c;
        if (L < 1408) return pg8::StaticOrder::next(i, u);
        const int k = (int)(L - 1408); if (k >= 128) return false;
        const int t = k >> 3; u.pm = 64 + (k & 7); u.pn = t < 6 ? 2 + t : (t == 6 ? 8 : 5 + t);
        return true;
    }
};

#define MFMA16(a, b, c) __builtin_amdgcn_mfma_f32_16x16x32_bf16(a, b, c, 0, 0, 0)
__device__ __forceinline__ float logsigmoidf_(float x) { return fminf(x, 0.f) - flog(1.0f + fexp(-fabsf(x))); }
#define DPP_F(x, ctrl) __builtin_bit_cast(float, __builtin_amdgcn_update_dpp(0, __builtin_bit_cast(int, (x)), (ctrl), 0xf, 0xf, true))
constexpr int GLA_OP_BYTES = 17408 + 17408 + 18432 + 9216 + 512;
__device__ __forceinline__ void p3_gla(const Ctx& c, LAS unsigned char* lds) {
    const int tid = threadIdx.x, lane = tid & 63, wave = tid >> 6, l15 = lane & 15, lq = lane >> 4;
    LAS bf16_t* St = (LAS bf16_t*)(lds + 2 * GLA_OP_BYTES);
    LAS bf16_t* WAT = St + 64 * 136;
    LAS float* BA = (LAS float*)(WAT + 128 * 40);
    LAS bf16_t* OBF = (LAS bf16_t*)(BA + 128);
    const bf16_t* Zq = (const bf16_t*)(c.ws + WS_ZQ); const bf16_t* Zk = (const bf16_t*)(c.ws + WS_ZK); const bf16_t* Zv = (const bf16_t*)(c.ws + WS_ZV); const bf16_t* Alo = (const bf16_t*)(c.ws + WS_ALO);
    bf16_t* og_f = (bf16_t*)c.out; bf16_t* og_b = og_f + (size_t)MLAT * D;
    const int ti = tid >> 3, seg = tid & 7;
    for (int u = blockIdx.x; u < 256; u += gridDim.x) {
        const int dir = u & 1, dvs = (u >> 1) & 3, h = (u >> 3) & 3, b = u >> 5;
        bf16_t* og = dir ? og_b : og_f;
        __syncthreads();
        for (int i = tid; i < 128 * 40; i += NT) { const int d = i / 40, j = i - d * 40; WAT[i] = f2bf(j < 16 ? CIN(8)[(size_t)(dir * 16 + j) * 512 + h * 128 + d] : 0.f); }
        if (tid < 128) BA[tid] = CIN(9)[dir * 512 + h * 128 + tid];
        for (int i = tid; i < 64 * 136 / 2; i += NT) ((LAS unsigned*)St)[i] = 0u;
        f32x4 accS[4];
#pragma unroll
        for (int n = 0; n < 4; ++n) accS[n] = (f32x4){0.f, 0.f, 0.f, 0.f};
        __syncthreads();
        const int d0 = wave * 16 + lq * 4;
        const bf16x8 wfr = *(LAS bf16x8*)(WAT + (wave * 16 + l15) * 40 + lq * 8);
        float bad[4];
#pragma unroll
        for (int r = 0; r < 4; ++r) bad[r] = BA[d0 + r];
#pragma unroll 1
        for (int step = 0; step <= 36; ++step) {
            const bool latn = step >= 4;
            const int cidxn = latn ? (dir ? 31 - (step - 4) : step - 4) : (dir ? 3 - step : step);
            const int rbasen = (latn ? b * SEQ : MLAT + b * CTXL) + cidxn * 64;
            u32x4 vw = (u32x4){0u, 0u, 0u, 0u}, alw[4]; u32x2 qw[4], kw[4];
            if (step < 36) {
                vw = ldg16(Zv + (size_t)(rbasen + (dir ? 63 - ti : ti)) * 1024 + h * 256 + dvs * 64 + seg * 8);
                const int chk = rbasen >> 6;
#pragma unroll
                for (int mt = 0; mt < 4; ++mt) { const int mtp = dir ? 3 - mt : mt, lp = dir ? 15 - l15 : l15;
                    alw[mt] = (u32x4){0u, 0u, 0u, 0u}; if (lq < 2) alw[mt] = ldg16(Alo + ((size_t)((((chk * 2 + dir) * 4 + mtp) * 2 + lq) * 16 + lp) << 3));
                    const size_t fo = ((size_t)(chk * 4 + h) << 13) + (size_t)(((wave * 4 + mtp) * 64 + lq * 16 + lp) << 2);
                    qw[mt] = (u32x2){0u, 0u}; if (latn) qw[mt] = *(const u32x2*)(Zq + fo);
                    kw[mt] = *(const u32x2*)(Zk + fo); }
            }
            const int sp = step - 1; const bool lat = sp >= 4;
            const int cidx = lat ? (dir ? 31 - (sp - 4) : sp - 4) : (dir ? 3 - sp : sp);
            const int rbase = (lat ? b * SEQ : MLAT + b * CTXL) + cidx * 64;
            if (step >= 1) {
                LAS unsigned char* op = lds + (sp & 1) * GLA_OP_BYTES;
                LAS bf16_t* Qd = (LAS bf16_t*)op; LAS bf16_t* Kd = Qd + 64 * 136; LAS bf16_t* Kt = Kd + 64 * 136; LAS bf16_t* Vt = Kt + 128 * 72; LAS float* EBL = (LAS float*)(Vt + 64 * 72);
                const int mi = wave >> 1;
                if (lat) {
                    bf16x8 qf[4];
#pragma unroll
                    for (int ks = 0; ks < 4; ++ks) qf[ks] = *(LAS bf16x8*)(Qd + (mi * 16 + l15) * 136 + ks * 32 + lq * 8);
                    unsigned xa[4][2];
#pragma unroll
                    for (int jt = 0; jt < 4; ++jt) { f32x4 x = (f32x4){0.f, 0.f, 0.f, 0.f};
                        if (jt <= mi) {
#pragma unroll
                            for (int ks = 0; ks < 4; ++ks) x = MFMA16(*(LAS bf16x8*)(Kd + (jt * 16 + l15) * 136 + ks * 32 + lq * 8), qf[ks], x);
                            if (jt == mi) {
#pragma unroll
                                for (int r = 0; r < 4; ++r) x[r] = (lq * 4 + r <= l15) ? x[r] : 0.f; } }
                        xa[jt][0] = pk2(x[0], x[1]); xa[jt][1] = pk2(x[2], x[3]); }
#pragma unroll
                    for (int t2 = 0; t2 < 2; ++t2) { const int nt = (wave & 1) * 2 + t2; f32x4 a = (f32x4){0.f, 0.f, 0.f, 0.f};
#pragma unroll
                        for (int ks = 0; ks < 4; ++ks) a = MFMA16(qf[ks], *(LAS bf16x8*)(St + (nt * 16 + l15) * 136 + ks * 32 + lq * 8), a);
#pragma unroll
                        for (int ks = 0; ks < 2; ++ks) {
                            const u32x4 aw = (u32x4){xa[2 * ks][0], xa[2 * ks][1], xa[2 * ks + 1][0], xa[2 * ks + 1][1]};
                            const u32x2 b0 = *(LAS u32x2*)(Vt + (nt * 16 + l15) * 72 + ks * 32 + lq * 4), b1 = *(LAS u32x2*)(Vt + (nt * 16 + l15) * 72 + ks * 32 + 16 + lq * 4);
                            const u32x4 bw = (u32x4){b0.x, b0.y, b1.x, b1.y};
                            a = MFMA16(__builtin_bit_cast(bf16x8, aw), __builtin_bit_cast(bf16x8, bw), a); }
#pragma unroll
                        for (int r = 0; r < 4; ++r) OBF[(mi * 16 + lq * 4 + r) * 72 + nt * 16 + l15] = f2bf(a[r]); }
                }
                { float eb[4];
#pragma unroll
                    for (int r = 0; r < 4; ++r) eb[r] = EBL[wave * 16 + lq * 4 + r];
#pragma unroll
                    for (int nt = 0; nt < 4; ++nt) {
#pragma unroll
                        for (int r = 0; r < 4; ++r) accS[nt][r] *= eb[r];
#pragma unroll
                        for (int ks = 0; ks < 2; ++ks) accS[nt] = MFMA16(*(LAS bf16x8*)(Kt + (wave * 16 + l15) * 72 + ks * 32 + lq * 8), *(LAS bf16x8*)(Vt + (nt * 16 + l15) * 72 + ks * 32 + lq * 8), accS[nt]); } }
            }
            if (step < 36) {
                LAS unsigned char* op = lds + (step & 1) * GLA_OP_BYTES;
                LAS bf16_t* Qd = (LAS bf16_t*)op; LAS bf16_t* Kd = Qd + 64 * 136; LAS bf16_t* Kt = Kd + 64 * 136; LAS bf16_t* Vt = Kt + 128 * 72; LAS float* EBL = (LAS float*)(Vt + 64 * 72);
                { float v8[8]; unpack8(vw, v8);
#pragma unroll
                    for (int e = 0; e < 8; ++e) Vt[(seg * 8 + e) * 72 + ti] = f2bf(v8[e]); }
                float run[4] = {0.f, 0.f, 0.f, 0.f}, bc[4][4];
#pragma unroll
                for (int mt = 0; mt < 4; ++mt) {
                    const f32x4 sd = MFMA16(wfr, __builtin_bit_cast(bf16x8, alw[mt]), ((f32x4){0.f, 0.f, 0.f, 0.f}));
#pragma unroll
                    for (int r = 0; r < 4; ++r) { float x = logsigmoidf_(sd[r] + bad[r]) * 0.0625f;
                        x += DPP_F(x, 0x111); x += DPP_F(x, 0x112); x += DPP_F(x, 0x114); x += DPP_F(x, 0x118);
                        bc[mt][r] = run[r] + x; run[r] += DPP_F(x, 0x15F); }
                }
                float ebl[4];
#pragma unroll
                for (int r = 0; r < 4; ++r) ebl[r] = fexp(run[r]);
                if (l15 == 0) *(LAS f32x4*)(EBL + d0) = (f32x4){ebl[0], ebl[1], ebl[2], ebl[3]};
#pragma unroll
                for (int mt = 0; mt < 4; ++mt) { const int t = mt * 16 + l15; float qd[4], kd[4];
                    const float q4[4] = {bflo(qw[mt].x), bfhi(qw[mt].x), bflo(qw[mt].y), bfhi(qw[mt].y)}, k4[4] = {bflo(kw[mt].x), bfhi(kw[mt].x), bflo(kw[mt].y), bfhi(kw[mt].y)};
#pragma unroll
                    for (int r = 0; r < 4; ++r) { const float e1 = fexp(bc[mt][r]), e2 = __builtin_amdgcn_rcpf(e1);
                        qd[r] = q4[r] * 0.08838834764831845f * e1; kd[r] = k4[r] * e2; Kt[(d0 + r) * 72 + t] = f2bf(kd[r] * ebl[r]); }
                    u32x2 w; w.x = pk2(qd[0], qd[1]); w.y = pk2(qd[2], qd[3]); *(LAS u32x2*)(Qd + t * 136 + d0) = w;
                    w.x = pk2(kd[0], kd[1]); w.y = pk2(kd[2], kd[3]); *(LAS u32x2*)(Kd + t * 136 + d0) = w; }
            }
            __syncthreads();
            if (step >= 1) {
#pragma unroll
                for (int nt = 0; nt < 4; ++nt) { u32x2 w; w.x = pk2(accS[nt][0], accS[nt][1]); w.y = pk2(accS[nt][2], accS[nt][3]); *(LAS u32x2*)(St + (nt * 16 + l15) * 136 + wave * 16 + lq * 4) = w; }
                if (lat) *(u32x4*)(og + (size_t)(rbase + (dir ? 63 - ti : ti)) * D + h * 256 + dvs * 64 + seg * 8) = *(LAS u32x4*)(OBF + ti * 72 + seg * 8);
            }
            __syncthreads();
        }
    }
    __syncthreads();
}
template <bool LAT> __device__ __forceinline__ void load_mixed8(const bf16_t* __restrict__ Zr, int rowbase, int tl, int col, const float* mu8, float* out) {
    float own[8], zs[8], nb[8];
    const bf16_t* p = Zr + (size_t)(rowbase + tl) * ZRL_LD + col;
    unpack8(ldg16(p), own);
    if (LAT) {
        const int x = tl & 63, y = tl >> 6;
#pragma unroll
        for (int ty = 0; ty < 4; ++ty) {
            const bool ok = ty == 0 ? (x > 0) : ty == 1 ? (x < 63) : ty == 2 ? (y > 0) : (y < 31);
            const int dl = ty == 0 ? -1 : ty == 1 ? 1 : ty == 2 ? -64 : 64;
            u32x4 w = (u32x4){0u, 0u, 0u, 0u};
            if (ok) w = ldg16(p + (ptrdiff_t)dl * ZRL_LD);
            unpack8(w, nb); zs[ty] = nb[ty]; zs[ty + 4] = nb[ty + 4];
        }
    } else {
#pragma unroll
        for (int ty = 0; ty < 2; ++ty) {
            const bool ok = ty == 0 ? (tl > 0) : (tl < CTXL - 1);
            u32x4 w = (u32x4){0u, 0u, 0u, 0u};
            if (ok) w = ldg16(p + (ptrdiff_t)(ty == 0 ? -1 : 1) * ZRL_LD);
            unpack8(w, nb); zs[ty] = nb[ty]; zs[ty + 2] = nb[ty + 2]; zs[ty + 4] = nb[ty + 4]; zs[ty + 6] = nb[ty + 6];
        }
    }
#pragma unroll
    for (int e = 0; e < 8; ++e) out[e] = own[e] + (zs[e] - own[e]) * mu8[e];
}

__device__ __forceinline__ float fast_tanh(float x) { const float e = fexp(2.0f * x); return 1.0f - 2.0f * __builtin_amdgcn_rcpf(1.0f + e); }
__device__ __forceinline__ void premix_lora(const Ctx& c) {
    const bf16_t* Zr = (const bf16_t*)(c.ws + WS_ZRL); bf16_t* ZL = (bf16_t*)(c.ws + WS_ZL);
    for (int idx = blockIdx.x * NT + threadIdx.x; idx < MALL * 44; idx += gridDim.x * NT) {
        const int row = idx / 44, sg = idx - row * 44; float v8[8], mu8[8];
#pragma unroll
        for (int e = 0; e < 8; ++e) mu8[e] = CIN(11)[3072 + sg * 8 + e];
        if (row < MLAT) load_mixed8<true>(Zr, (row / SEQ) * SEQ, row % SEQ, ZR_OFF + sg * 8, mu8, v8);
        else { const int rc = row - MLAT; load_mixed8<false>(Zr, MLAT + (rc / CTXL) * CTXL, rc % CTXL, ZR_OFF + sg * 8, mu8, v8); }
#pragma unroll
        for (int e = 0; e < 8; ++e) v8[e] = sg < 16 ? fast_tanh(v8[e]) : (sg < 24 ? v8[e] : sigmoidf_(v8[e]));
        *(u32x4*)(ZL + (size_t)row * ZL_LD + sg * 8) = pack8(v8);
    }
}
__device__ __forceinline__ u32x2 ldg8(const bf16_t* p) { return *(const u32x2*)p; }
__device__ __forceinline__ void mix16_direct_lat(const bf16_t* __restrict__ Zrf, int rowbase, int tl, int qn, int head, int lq, const float* __restrict__ mu, float* out) {
    const int T = rowbase + tl;
    const u32x4 o0 = ldg16(Zrf + zrf(qn, T, head, lq, 0)), o1 = ldg16(Zrf + zrf(qn, T, head, lq, 1));
    const int x = tl & 63, y = tl >> 6; const u32x2 z2 = (u32x2){0u, 0u};
    u32x2 lf = z2, rt = z2, up = z2, dn = z2;
    if (x > 0) lf = ldg8(Zrf + zrf(qn, T - 1, head, lq, 0)); if (x < 63) rt = ldg8(Zrf + zrf(qn, T + 1, head, lq, 0) + 4); if (y > 0) up = ldg8(Zrf + zrf(qn, T - 64, head, lq, 1)); if (y < 31) dn = ldg8(Zrf + zrf(qn, T + 64, head, lq, 1) + 4);
    const unsigned own[8] = {o0.x, o0.y, o0.z, o0.w, o1.x, o1.y, o1.z, o1.w}, nb[8] = {lf.x, lf.y, rt.x, rt.y, up.x, up.y, dn.x, dn.y};
#pragma unroll
    for (int j = 0; j < 8; ++j)
#pragma unroll
        for (int hh = 0; hh < 2; ++hh) { const int pp = 2 * j + hh, i = (pp & 3) * 4 + (pp >> 2); const float z = hh ? bfhi(own[j]) : bflo(own[j]), zs = hh ? bfhi(nb[j]) : bflo(nb[j]); out[i] = z + (zs - z) * mu[i]; }
}
constexpr int RW_SLOT = 12544, RW_KAP = 0, RW_RT = 2048, RW_KBT = 4096, RW_VT = 8192, RW_ARR = 10240, RW_MKK = 11264, RW_PM = 11776, RW_GC = 12288;
constexpr int RW_OST = 8 * RW_SLOT, RW_W2T = RW_OST + 16384, RW_A2T = RW_W2T + 9216, RW_PAR = RW_A2T + 9216, RW_MS = RW_PAR + 2560;
#define DPP_U(x, ctrl) ((unsigned)__builtin_amdgcn_update_dpp(0, (int)(x), (ctrl), 0xf, 0xf, false))
__device__ __forceinline__ float reduce4f(float x) {
    auto r = __builtin_amdgcn_permlane32_swap(__float_as_uint(x), __float_as_uint(x), false, false);
    const float y = __uint_as_float(r[0]) + __uint_as_float(r[1]);
    auto s = __builtin_amdgcn_permlane16_swap(__float_as_uint(y), __float_as_uint(y), false, false);
    return __uint_as_float(s[0]) + __uint_as_float(s[1]);
}
struct Raw16 { u32x4 o0, o1; u32x2 hal, up, dn; };
template <bool LAT> __device__ __forceinline__ void mix16_issue(Raw16& w, const bf16_t* __restrict__ Zrf, int rowbase, int tl, int dir, int l15, int qn, int head, int lq) {
    const int T = rowbase + tl;
    w.o0 = ldg16(Zrf + zrf(qn, T, head, lq, 0)); w.o1 = ldg16(Zrf + zrf(qn, T, head, lq, 1));
    const bool e0 = (l15 == 0), e15 = (l15 == 15);
    const int hdl = e0 ? (dir ? 1 : -1) : (dir ? -1 : 1);
    const int lim = LAT ? 64 : CTXL; const int pos = LAT ? (tl & 63) : tl;
    const bool hok = (e0 || e15) && (pos + hdl >= 0) && (pos + hdl < lim);
    const u32x2 z = (u32x2){0u, 0u};
    w.hal = z; w.up = z; w.dn = z;
    const int hoff = hdl < 0 ? 0 : 4;
    if (hok) w.hal = ldg8(Zrf + zrf(qn, T + hdl, head, lq, 0) + hoff);
    if (LAT) {
        if ((tl >> 6) > 0) w.up = ldg8(Zrf + zrf(qn, T - 64, head, lq, 1));
        if ((tl >> 6) < 31) w.dn = ldg8(Zrf + zrf(qn, T + 64, head, lq, 1) + 4);
    } else {
        if (hok) w.up = ldg8(Zrf + zrf(qn, T + hdl, head, lq, 1) + hoff);
    }
}
template <bool LAT> __device__ __forceinline__ void mix16_finish(const Raw16& w, int tl, int dir, int l15, const LAS float* mu, float* out) {
    const unsigned own[8] = {w.o0.x, w.o0.y, w.o0.z, w.o0.w, w.o1.x, w.o1.y, w.o1.z, w.o1.w};
    const int lim = LAT ? 64 : CTXL; const int pos = LAT ? (tl & 63) : tl;
    const bool pv_ok = pos > 0, nx_ok = pos < lim - 1;
    const bool pv_edge = (l15 == (dir ? 15 : 0)), nx_edge = (l15 == (dir ? 0 : 15));
    unsigned nb[8];
#define NB_PREV(j, hv) { const unsigned a_ = DPP_U(own[j], 0x111), b_ = DPP_U(own[j], 0x101); unsigned v_ = dir ? b_ : a_; if (pv_edge) v_ = (hv); nb[j] = pv_ok ? v_ : 0u; }
#define NB_NEXT(j, hv) { const unsigned a_ = DPP_U(own[j], 0x111), b_ = DPP_U(own[j], 0x101); unsigned v_ = dir ? a_ : b_; if (nx_edge) v_ = (hv); nb[j] = nx_ok ? v_ : 0u; }
    NB_PREV(0, w.hal.x) NB_PREV(1, w.hal.y) NB_NEXT(2, w.hal.x) NB_NEXT(3, w.hal.y)
    if (LAT) { nb[4] = w.up.x; nb[5] = w.up.y; nb[6] = w.dn.x; nb[7] = w.dn.y; }
    else { NB_PREV(4, w.up.x) NB_PREV(5, w.up.y) NB_NEXT(6, w.up.x) NB_NEXT(7, w.up.y) }
#undef NB_PREV
#undef NB_NEXT
    float mu16[16];
#pragma unroll
    for (int q = 0; q < 4; ++q) { const f32x4 m = *(const LAS f32x4*)(mu + q * 4); mu16[q * 4] = m[0]; mu16[q * 4 + 1] = m[1]; mu16[q * 4 + 2] = m[2]; mu16[q * 4 + 3] = m[3]; }
#pragma unroll
    for (int j = 0; j < 8; ++j)
#pragma unroll
        for (int hh = 0; hh < 2; ++hh) { const int pp = 2 * j + hh, i = (pp & 3) * 4 + (pp >> 2); const float z = hh ? bfhi(own[j]) : bflo(own[j]), zs = hh ? bfhi(nb[j]) : bflo(nb[j]); out[i] = z + (zs - z) * mu16[i]; }
}
#define MIX_ISSUE(w, qn) do { if (lat) mix16_issue<true>(w, Zr, rowbase, tl, dir, l15, (qn), h, lq); else mix16_issue<false>(w, Zr, rowbase, tl, dir, l15, (qn), h, lq); } while (0)
#define MIX_FINISH(w, k, outv) do { if (lat) mix16_finish<true>(w, tl, dir, l15, PAR + (k) * 64 + lq * 16, outv); else mix16_finish<false>(w, tl, dir, l15, PAR + (k) * 64 + lq * 16, outv); } while (0)
#define SCHED_FENCE() __builtin_amdgcn_sched_barrier(0)
__device__ __forceinline__ u32x4 packv8(const float* v) { return pack8(v); }
__device__ __forceinline__ void p4_rwkv_chunked(const Ctx& c, LAS unsigned char* lds) {
    const int tid = threadIdx.x, lane = tid & 63, wave = tid >> 6, l15 = lane & 15, lq = lane >> 4;
    LAS bf16_t* W2T = (LAS bf16_t*)(lds + RW_W2T); LAS bf16_t* A2T = (LAS bf16_t*)(lds + RW_A2T); LAS float* PAR = (LAS float*)(lds + RW_PAR);
    const bf16_t* Zr = (const bf16_t*)(c.ws + WS_ZR);
    float* bonus = (float*)(c.ws + WS_BONUS);
    for (int u = blockIdx.x; u < 256; u += gridDim.x) {
        const int dir = u & 1, h = (u >> 1) & 15, b = u >> 5;
        bf16_t* orr = (bf16_t*)(c.ws + (dir ? WS_ORB : WS_ORF));
        __syncthreads();
        for (int i = tid; i < 4096; i += NT) { const int j = i >> 6, ch = i & 63; W2T[ch * 72 + j] = f2bf(CIN(13)[(size_t)(dir * 64 + j) * 1024 + h * 64 + ch]); A2T[ch * 72 + j] = f2bf(CIN(15)[(size_t)j * 1024 + h * 64 + ch]); }
        if (tid < 64) { const int ch = tid, hc = h * 64 + ch;
            PAR[0 * 64 + ch] = CIN(11)[hc]; PAR[1 * 64 + ch] = CIN(11)[1024 + hc]; PAR[2 * 64 + ch] = CIN(11)[2048 + hc]; PAR[3 * 64 + ch] = CIN(11)[3072 + dir * 64 + ch]; PAR[4 * 64 + ch] = CIN(11)[3200 + ch];
            PAR[5 * 64 + ch] = CIN(12)[dir * 1024 + hc]; PAR[6 * 64 + ch] = CIN(14)[hc]; PAR[7 * 64 + ch] = CIN(17)[hc]; PAR[8 * 64 + ch] = CIN(18)[hc]; PAR[9 * 64 + ch] = CIN(19)[hc]; }
        __syncthreads();
        f32x4 Tt[4];
#pragma unroll
        for (int kt = 0; kt < 4; ++kt) Tt[kt] = (f32x4){0.f, 0.f, 0.f, 0.f};
        Raw16 wa, wb, wc; u32x4 bw0, bw1, ba0, ba1;
#define RW_ISSUE(qq) do { const int q_ = (qq); { const u32x4 z4_ = (u32x4){0u, 0u, 0u, 0u}; const u32x2 z2_ = (u32x2){0u, 0u}; wa.o0 = z4_; wa.o1 = z4_; wa.hal = z2_; wa.up = z2_; wa.dn = z2_; wb = wa; wc = wa; bw0 = z4_; bw1 = z4_; ba0 = z4_; ba1 = z4_; } if (q_ < 144) { const bool lat = q_ >= 16; const int cidx_ = lat ? (dir ? 127 - (q_ - 16) : q_ - 16) : (dir ? 15 - q_ : q_); \
            const int tl = cidx_ * 16 + (dir ? 15 - l15 : l15), rowbase = lat ? b * SEQ : MLAT + b * CTXL; \
            MIX_ISSUE(wa, 2); MIX_ISSUE(wb, 1); MIX_ISSUE(wc, 0); \
            const bf16_t* zl = (const bf16_t*)(c.ws + WS_ZL) + (size_t)(rowbase + tl) * ZL_LD; \
            bw0 = ldg16(zl + dir * 64 + lq * 16); bw1 = ldg16(zl + dir * 64 + lq * 16 + 8); ba0 = ldg16(zl + 128 + lq * 16); ba1 = ldg16(zl + 128 + lq * 16 + 8); } } while (0)
#pragma unroll 1
        for (int rho = 0; rho <= 18; ++rho) {
            RW_ISSUE(8 * rho + wave);
            SCHED_FENCE();
            if (wave < 4 && rho >= 1) {
                const int vt = wave;
#pragma unroll 1
                for (int j4 = 0; j4 < 8; ++j4) {
                    const int q = 8 * (rho - 1) + j4; const bool lat = q >= 16;
                    const LAS unsigned char* slot = lds + j4 * RW_SLOT;
                    const u32x4 kf0 = *(const LAS u32x4*)(slot + RW_KAP + lane * 16), kf1 = *(const LAS u32x4*)(slot + RW_KAP + 1024 + lane * 16);
                    const u32x4 rf0 = *(const LAS u32x4*)(slot + RW_RT + lane * 16), rf1 = *(const LAS u32x4*)(slot + RW_RT + 1024 + lane * 16);
                    const u32x2 mkkf = *(const LAS u32x2*)(slot + RW_MKK + lane * 8), pmf = *(const LAS u32x2*)(slot + RW_PM + lane * 8);
                    const u32x4 arrf = *(const LAS u32x4*)(slot + RW_ARR + lane * 16);
                    const u32x2 vf = *(const LAS u32x2*)(slot + RW_VT + ((vt * 16 + l15) * 16 + lq * 4) * 2);
                    const u32x4 tb0 = (u32x4){pk2(Tt[0][0], Tt[0][1]), pk2(Tt[0][2], Tt[0][3]), pk2(Tt[1][0], Tt[1][1]), pk2(Tt[1][2], Tt[1][3])};
                    const u32x4 tb1 = (u32x4){pk2(Tt[2][0], Tt[2][1]), pk2(Tt[2][2], Tt[2][3]), pk2(Tt[3][0], Tt[3][1]), pk2(Tt[3][2], Tt[3][3])};
                    const f32x4 z4 = (f32x4){0.f, 0.f, 0.f, 0.f};
                    f32x4 xy = MFMA16(__builtin_bit_cast(bf16x8, kf0), __builtin_bit_cast(bf16x8, tb0), z4); xy = MFMA16(__builtin_bit_cast(bf16x8, kf1), __builtin_bit_cast(bf16x8, tb1), xy);
                    xy = MFMA16(__builtin_bit_cast(bf16x8, ((u32x4){mkkf.x, mkkf.y, 0u, 0u})), __builtin_bit_cast(bf16x8, ((u32x4){vf.x, vf.y, 0u, 0u})), xy);
                    const f32x4 uu = MFMA16(__builtin_bit_cast(bf16x8, ((u32x4){pmf.x, pmf.y, 0u, 0u})), __builtin_bit_cast(bf16x8, ((u32x4){pk2(xy[0], xy[1]), pk2(xy[2], xy[3]), 0u, 0u})), z4);
                    const u32x4 vub = (u32x4){vf.x, vf.y, pk2(uu[0], uu[1]), pk2(uu[2], uu[3])};
                    if (lat) {
                        f32x4 o = MFMA16(__builtin_bit_cast(bf16x8, rf0), __builtin_bit_cast(bf16x8, tb0), z4); o = MFMA16(__builtin_bit_cast(bf16x8, rf1), __builtin_bit_cast(bf16x8, tb1), o);
                        o = MFMA16(__builtin_bit_cast(bf16x8, arrf), __builtin_bit_cast(bf16x8, vub), o);
                        LAS bf16_t* ost = (LAS bf16_t*)(lds + RW_OST) + j4 * 1024;
#pragma unroll
                        for (int r = 0; r < 4; ++r) ost[(lq * 4 + r) * 64 + vt * 16 + l15] = f2bf(o[r]);
                    }
                    const LAS float* GCs = (const LAS float*)(slot + RW_GC) + lq * 16;
#pragma unroll
                    for (int kt = 0; kt < 4; ++kt) { const f32x4 gc = *(const LAS f32x4*)(GCs + kt * 4); const u32x4 kbf = *(const LAS u32x4*)(slot + RW_KBT + (kt * 64 + lane) * 16);
                        f32x4 t = Tt[kt];
#pragma unroll
                        for (int r = 0; r < 4; ++r) t[r] *= gc[r];
                        Tt[kt] = MFMA16(__builtin_bit_cast(bf16x8, kbf), __builtin_bit_cast(bf16x8, vub), t); }
                }
            }
            __syncthreads();
            {
                const int pw = wave;
                { const int q = 8 * (rho - 1) + pw;
                    if (rho >= 1 && q >= 16) { const int cidx = dir ? 127 - (q - 16) : q - 16; const int tl = cidx * 16 + (dir ? 15 - l15 : l15);
                        const LAS bf16_t* src = (const LAS bf16_t*)(lds + RW_OST) + pw * 1024 + l15 * 64 + lq * 16;
                        *(u32x4*)(orr + orf(b * SEQ + tl, h, lq, 0)) = *(const LAS u32x4*)src; *(u32x4*)(orr + orf(b * SEQ + tl, h, lq, 1)) = *(const LAS u32x4*)(src + 8); } }
                const int q = 8 * rho + pw;
                if (q < 144) {
                    const bool lat = q >= 16;
                    const int cidx = lat ? (dir ? 127 - (q - 16) : q - 16) : (dir ? 15 - q : q);
                    const int tl = cidx * 16 + (dir ? 15 - l15 : l15), rowbase = lat ? b * SEQ : MLAT + b * CTXL;
                    LAS unsigned char* slot = lds + pw * RW_SLOT;
                    float rm[16], km[16];
                    {
                        SCHED_FENCE();
                        { float vm[16]; MIX_FINISH(wa, 2, vm);
                            LAS bf16_t* VT = (LAS bf16_t*)(slot + RW_VT);
#pragma unroll
                            for (int i = 0; i < 16; ++i) VT[(lq * 16 + i) * 16 + l15] = f2bf(vm[i]); }
                        SCHED_FENCE();
                        MIX_FINISH(wb, 1, km);
                        SCHED_FENCE();
                        MIX_FINISH(wc, 0, rm);
                    }
                    SCHED_FENCE();
                    float inv;
                    { float ss = 0.f;
#pragma unroll
                        for (int qd = 0; qd < 4; ++qd) { const f32x4 kkm = *(const LAS f32x4*)(PAR + 7 * 64 + lq * 16 + qd * 4);
#pragma unroll
                            for (int e = 0; e < 4; ++e) { const float x = km[qd * 4 + e] * kkm[e]; ss += x * x; } }
                        ss = reduce4f(ss); inv = fminf(__builtin_amdgcn_rsqf(ss), 1e12f); }
                    unsigned kapw[8], betw[8], ktw[8], rtw[8]; float bs = 0.f;
                    { LAS bf16_t* KB = (LAS bf16_t*)(slot + RW_KBT) + ((l15 >> 2) * 16 + lq * 4) * 8 + (l15 & 3); LAS float* GCs = (LAS float*)(slot + RW_GC) + lq * 16;
                        const int arow = (l15 >> 2) * 16 + (l15 & 3);
#pragma unroll
                        for (int nt = 0; nt < 4; ++nt) { SCHED_FENCE();
                            const LAS bf16_t* wr = W2T + (arow + nt * 4) * 72 + lq * 16; const LAS bf16_t* ar = A2T + (arow + nt * 4) * 72 + lq * 16;
                            f32x4 xw = MFMA16(*(const LAS bf16x8*)wr, __builtin_bit_cast(bf16x8, bw0), ((f32x4){0.f, 0.f, 0.f, 0.f})); xw = MFMA16(*(const LAS bf16x8*)(wr + 8), __builtin_bit_cast(bf16x8, bw1), xw);
                            f32x4 xa = MFMA16(*(const LAS bf16x8*)ar, __builtin_bit_cast(bf16x8, ba0), ((f32x4){0.f, 0.f, 0.f, 0.f})); xa = MFMA16(*(const LAS bf16x8*)(ar + 8), __builtin_bit_cast(bf16x8, ba1), xa);
                            const f32x4 w0 = *(const LAS f32x4*)(PAR + 5 * 64 + lq * 16 + nt * 4), a0 = *(const LAS f32x4*)(PAR + 6 * 64 + lq * 16 + nt * 4);
                            const f32x4 kkm = *(const LAS f32x4*)(PAR + 7 * 64 + lq * 16 + nt * 4), kam = *(const LAS f32x4*)(PAR + 8 * 64 + lq * 16 + nt * 4), rkm = *(const LAS f32x4*)(PAR + 9 * 64 + lq * 16 + nt * 4);
                            float ka4[4], be4[4], kt4[4], rt4[4], g4[4], lw4[4], kapn4[4], kpi4[4], betn4[4];
#pragma unroll
                            for (int r = 0; r < 4; ++r) { const int i = nt * 4 + r;
                                lw4[r] = -0.6065306597126334f * __builtin_amdgcn_rcpf(1.0f + fexp(-(w0[r] + xw[r])));
                                const float avi = sigmoidf_(a0[r] + xa[r]);
                                kapn4[r] = km[i] * kkm[r] * inv; kpi4[r] = km[i] * (1.0f + (avi - 1.0f) * kam[r]); betn4[r] = kapn4[r] * avi;
                                bs += rm[i] * kpi4[r] * rkm[r]; g4[r] = lw4[r]; }
                            asm volatile("s_nop 1\n"
                                "v_add_f32_dpp %0, %0, %0 row_shr:1 row_mask:0xf bank_mask:0xf\n" "v_add_f32_dpp %1, %1, %1 row_shr:1 row_mask:0xf bank_mask:0xf\n" "v_add_f32_dpp %2, %2, %2 row_shr:1 row_mask:0xf bank_mask:0xf\n" "v_add_f32_dpp %3, %3, %3 row_shr:1 row_mask:0xf bank_mask:0xf\n"
                                "v_add_f32_dpp %0, %0, %0 row_shr:2 row_mask:0xf bank_mask:0xf\n" "v_add_f32_dpp %1, %1, %1 row_shr:2 row_mask:0xf bank_mask:0xf\n" "v_add_f32_dpp %2, %2, %2 row_shr:2 row_mask:0xf bank_mask:0xf\n" "v_add_f32_dpp %3, %3, %3 row_shr:2 row_mask:0xf bank_mask:0xf\n"
                                "v_add_f32_dpp %0, %0, %0 row_shr:4 row_mask:0xf bank_mask:0xf\n" "v_add_f32_dpp %1, %1, %1 row_shr:4 row_mask:0xf bank_mask:0xf\n" "v_add_f32_dpp %2, %2, %2 row_shr:4 row_mask:0xf bank_mask:0xf\n" "v_add_f32_dpp %3, %3, %3 row_shr:4 row_mask:0xf bank_mask:0xf\n"
                                "v_add_f32_dpp %0, %0, %0 row_shr:8 row_mask:0xf bank_mask:0xf\n" "v_add_f32_dpp %1, %1, %1 row_shr:8 row_mask:0xf bank_mask:0xf\n" "v_add_f32_dpp %2, %2, %2 row_shr:8 row_mask:0xf bank_mask:0xf\n" "v_add_f32_dpp %3, %3, %3 row_shr:8 row_mask:0xf bank_mask:0xf\n"
                                "s_nop 1\n"
                                : "+v"(g4[0]), "+v"(g4[1]), "+v"(g4[2]), "+v"(g4[3]));
#pragma unroll
                            for (int r = 0; r < 4; ++r) { const int i = nt * 4 + r; const float g = g4[r], kapn = kapn4[r], kpi = kpi4[r], betn = betn4[r];
                                const float e1 = fexp(g), e2 = __builtin_amdgcn_rcpf(e1);
                                const float eC = DPP_F(e1, 0x15F);
                                float ep = DPP_F(e1, 0x111); ep = l15 == 0 ? 1.0f : ep;
                                const float kt_ = kpi * e2, bt_ = betn * e2;
                                ka4[r] = kapn * ep; be4[r] = bt_; kt4[r] = kt_; rt4[r] = rm[i] * e1;
                                KB[(nt * 64 + r) * 8] = f2bf(kt_ * eC); KB[(nt * 64 + r) * 8 + 4] = f2bf(-bt_ * eC);
                                if (l15 == 0) GCs[i] = eC; }
                            kapw[2 * nt] = pk2(ka4[0], ka4[1]); kapw[2 * nt + 1] = pk2(ka4[2], ka4[3]); betw[2 * nt] = pk2(be4[0], be4[1]); betw[2 * nt + 1] = pk2(be4[2], be4[3]);
                            ktw[2 * nt] = pk2(kt4[0], kt4[1]); ktw[2 * nt + 1] = pk2(kt4[2], kt4[3]); rtw[2 * nt] = pk2(rt4[0], rt4[1]); rtw[2 * nt + 1] = pk2(rt4[2], rt4[3]); }
                        SCHED_FENCE();
                        bs = reduce4f(bs);
                        if (lat && dir == 0 && lq == 0) bonus[(size_t)(b * SEQ + tl) * 16 + h] = bs; }
                    const u32x4 kapf0 = (u32x4){kapw[0], kapw[1], kapw[2], kapw[3]}, kapf1 = (u32x4){kapw[4], kapw[5], kapw[6], kapw[7]}, betf0 = (u32x4){betw[0], betw[1], betw[2], betw[3]}, betf1 = (u32x4){betw[4], betw[5], betw[6], betw[7]};
                    const u32x4 ktf0 = (u32x4){ktw[0], ktw[1], ktw[2], ktw[3]}, ktf1 = (u32x4){ktw[4], ktw[5], ktw[6], ktw[7]}, rtf0 = (u32x4){rtw[0], rtw[1], rtw[2], rtw[3]}, rtf1 = (u32x4){rtw[4], rtw[5], rtw[6], rtw[7]};
                    *(LAS u32x4*)(slot + RW_KAP + lane * 16) = kapf0; *(LAS u32x4*)(slot + RW_KAP + 1024 + lane * 16) = kapf1;
                    *(LAS u32x4*)(slot + RW_RT + lane * 16) = rtf0; *(LAS u32x4*)(slot + RW_RT + 1024 + lane * 16) = rtf1;
                    const f32x4 z4 = (f32x4){0.f, 0.f, 0.f, 0.f};
                    f32x4 mkb = MFMA16(__builtin_bit_cast(bf16x8, betf0), __builtin_bit_cast(bf16x8, kapf0), z4); mkb = MFMA16(__builtin_bit_cast(bf16x8, betf1), __builtin_bit_cast(bf16x8, kapf1), mkb);
                    f32x4 mkk = MFMA16(__builtin_bit_cast(bf16x8, ktf0), __builtin_bit_cast(bf16x8, kapf0), z4); mkk = MFMA16(__builtin_bit_cast(bf16x8, ktf1), __builtin_bit_cast(bf16x8, kapf1), mkk);
                    f32x4 ark = MFMA16(__builtin_bit_cast(bf16x8, ktf0), __builtin_bit_cast(bf16x8, rtf0), z4); ark = MFMA16(__builtin_bit_cast(bf16x8, ktf1), __builtin_bit_cast(bf16x8, rtf1), ark);
                    f32x4 arb = MFMA16(__builtin_bit_cast(bf16x8, betf0), __builtin_bit_cast(bf16x8, rtf0), z4); arb = MFMA16(__builtin_bit_cast(bf16x8, betf1), __builtin_bit_cast(bf16x8, rtf1), arb);
                    float arr8[8], mk4[4], mb4[4];
#pragma unroll
                    for (int r = 0; r < 4; ++r) { const int s = lq * 4 + r; mb4[r] = s < l15 ? mkb[r] : 0.f; mk4[r] = s < l15 ? mkk[r] : 0.f; arr8[r] = s <= l15 ? ark[r] : 0.f; arr8[4 + r] = s <= l15 ? -arb[r] : 0.f; }
                    *(LAS u32x4*)(slot + RW_ARR + lane * 16) = packv8(arr8);
                    { u32x2 w; w.x = pk2(mk4[0], mk4[1]); w.y = pk2(mk4[2], mk4[3]); *(LAS u32x2*)(slot + RW_MKK + lane * 8) = w; }
                    { LAS float* MS = (LAS float*)(lds + RW_MS) + pw * 320;
                        *(LAS f32x4*)(MS + l15 * 20 + lq * 4) = (f32x4){mb4[0], mb4[1], mb4[2], mb4[3]};
                        LDS_FENCE();
                        float mrow[16];
#pragma unroll
                        for (int qd = 0; qd < 4; ++qd) { const f32x4 m = *(const LAS f32x4*)(MS + l15 * 20 + qd * 4); mrow[qd * 4] = m[0]; mrow[qd * 4 + 1] = m[1]; mrow[qd * 4 + 2] = m[2]; mrow[qd * 4 + 3] = m[3]; }
                        LDS_FENCE();
                        float p4[4];
#pragma unroll
                        for (int j = 0; j < 4; ++j) p4[j] = (l15 == lq * 4 + j) ? 1.0f : 0.f;
                        float nm[15];
#pragma unroll
                        for (int q = 0; q < 15; ++q) nm[q] = -mrow[q];
#define PS4(sidx, op) "v_fmac_f32_dpp %0, %0, %" #op " row_newbcast:" #sidx " row_mask:0xf bank_mask:0xf\n" "v_fmac_f32_dpp %1, %1, %" #op " row_newbcast:" #sidx " row_mask:0xf bank_mask:0xf\n" \
                    "v_fmac_f32_dpp %2, %2, %" #op " row_newbcast:" #sidx " row_mask:0xf bank_mask:0xf\n" "v_fmac_f32_dpp %3, %3, %" #op " row_newbcast:" #sidx " row_mask:0xf bank_mask:0xf\n"
                        asm volatile("s_nop 1\n"
                            PS4(0, 4) PS4(1, 5) PS4(2, 6) PS4(3, 7) PS4(4, 8) PS4(5, 9) PS4(6, 10) PS4(7, 11) PS4(8, 12) PS4(9, 13) PS4(10, 14) PS4(11, 15) PS4(12, 16) PS4(13, 17) PS4(14, 18)
                            "s_nop 1\n"
                            : "+v"(p4[0]), "+v"(p4[1]), "+v"(p4[2]), "+v"(p4[3])
                            : "v"(nm[0]), "v"(nm[1]), "v"(nm[2]), "v"(nm[3]), "v"(nm[4]), "v"(nm[5]), "v"(nm[6]), "v"(nm[7]), "v"(nm[8]), "v"(nm[9]), "v"(nm[10]), "v"(nm[11]), "v"(nm[12]), "v"(nm[13]), "v"(nm[14]));
#undef PS4
                        u32x2 w; w.x = pk2(p4[0], p4[1]); w.y = pk2(p4[2], p4[3]); *(LAS u32x2*)(slot + RW_PM + lane * 8) = w; }
                }
            }
            __syncthreads();
        }
    }
}
__device__ __forceinline__ void p5_post(const Ctx& c, LAS unsigned char* lds, bool dry = false) {
    const int tid = threadIdx.x, lane = tid & 63, wave = tid >> 6, l15 = lane & 15, lq = lane >> 4;
    LAS bf16_t* SG = (LAS bf16_t*)lds;
    LAS bf16_t* GL = SG + 64 * 200;
    const bf16_t* Zr = (const bf16_t*)(c.ws + WS_ZR); const bf16_t* g2t = (const bf16_t*)(c.ws + WS_G2T);
    bf16_t* og_f = (bf16_t*)c.out; const bf16_t* og_b = og_f + (size_t)MLAT * D;
    bf16_t* or_f = (bf16_t*)(c.ws + WS_ORF); const bf16_t* or_b = (const bf16_t*)(c.ws + WS_ORB);
    const float* bonus = (const float*)(c.ws + WS_BONUS);
    for (int u = blockIdx.x; u < MLAT / 64; u += gridDim.x) {
        const int rowbase = (u >> 5) * SEQ, tl0 = (u & 31) * 64;
        __syncthreads();
        { const int tok = tid >> 3, seg = tid & 7; const bf16_t* zl = (const bf16_t*)(c.ws + WS_ZL) + (size_t)(rowbase + tl0 + tok) * ZL_LD + 192;
#pragma unroll
            for (int k = 0; k < 3; ++k) { const int sgi = seg + 8 * k; u32x4 w = (u32x4){0u, 0u, 0u, 0u};
                if (sgi < 20) w = ldg16(zl + sgi * 8);
                *(LAS u32x4*)(SG + tok * 200 + sgi * 8) = w; } }
        __syncthreads();
#pragma unroll 1
        for (int half = 0; half < 2; ++half) {
            f32x4 acc[4][4];
#pragma unroll
            for (int mt = 0; mt < 4; ++mt)
#pragma unroll
                for (int nt = 0; nt < 4; ++nt) acc[mt][nt] = (f32x4){0.f, 0.f, 0.f, 0.f};
#pragma unroll
            for (int ks = 0; ks < 6; ++ks) { bf16x8 bfr[4], afr[4];
#pragma unroll
                for (int nt = 0; nt < 4; ++nt) bfr[nt] = *(const bf16x8*)(g2t + (size_t)(((((wave * 8 + half * 4 + nt) * 6 + ks) * 64) + lane) << 3));
#pragma unroll
                for (int mt = 0; mt < 4; ++mt) afr[mt] = *(LAS bf16x8*)(SG + (mt * 16 + l15) * 200 + ks * 32 + lq * 8);
#pragma unroll
                for (int mt = 0; mt < 4; ++mt)
#pragma unroll
                    for (int nt = 0; nt < 4; ++nt) acc[mt][nt] = MFMA16(afr[mt], bfr[nt], acc[mt][nt]); }
#pragma unroll
            for (int mt = 0; mt < 4; ++mt)
#pragma unroll
                for (int nt = 0; nt < 4; ++nt)
#pragma unroll
                    for (int r = 0; r < 4; ++r) GL[(mt * 16 + lq * 4 + r) * 1032 + wave * 128 + (half * 4 + nt) * 16 + l15] = f2bf(acc[mt][nt][r]);
        }
        __syncthreads();
        for (int ii = 0; ii < 8; ++ii) {
            const int i = wave * 8 + ii; const size_t R = (size_t)rowbase + tl0 + i; const int ch0 = lane * 16;
            { float s[16], t[16]; unpack8(ldg16(og_f + R * D + ch0), s); unpack8(ldg16(og_f + R * D + ch0 + 8), s + 8); unpack8(ldg16(og_b + R * D + ch0), t); unpack8(ldg16(og_b + R * D + ch0 + 8), t + 8);
                float ssq = 0.f;
#pragma unroll
                for (int e = 0; e < 16; ++e) { s[e] += t[e]; ssq += s[e] * s[e]; }
                ssq += __shfl_xor(ssq, 1); ssq += __shfl_xor(ssq, 2); ssq += __shfl_xor(ssq, 4); ssq += __shfl_xor(ssq, 8);
                const float rs = rsqrtf(ssq * (1.0f / 256.0f) + 1e-6f);
#pragma unroll
                for (int e = 0; e < 16; ++e) s[e] = s[e] * rs * CIN(10)[ch0 + e];
                bf16_t* wp = dry ? (bf16_t*)(c.ws + WS_WIN) + (R & 4095) * D + ch0 : og_f + R * D + ch0;
                *(u32x4*)wp = pack8(s); *(u32x4*)(wp + 8) = pack8(s + 8); }
        }
        for (int ii = 0; ii < 8; ++ii) { const int un = wave * 8 + ii, scl = un >> 4, head = un & 15, tl = tl0 + scl * 16 + l15, T = rowbase + tl, hc = head * 64 + lq * 16;
            float s[16], t[16]; unpack8(ldg16(or_f + orf(T, head, lq, 0)), s); unpack8(ldg16(or_f + orf(T, head, lq, 1)), s + 8); unpack8(ldg16(or_b + orf(T, head, lq, 0)), t); unpack8(ldg16(or_b + orf(T, head, lq, 1)), t + 8);
            float sm = 0.f;
#pragma unroll
            for (int e = 0; e < 16; ++e) { s[e] += t[e]; sm += s[e]; }
            sm = reduce4f(sm);
            const float mean = sm * (1.0f / 64.0f); float sv = 0.f;
#pragma unroll
            for (int e = 0; e < 16; ++e) { s[e] -= mean; sv += s[e] * s[e]; }
            sv = reduce4f(sv);
            const float rs = rsqrtf(sv * (1.0f / 64.0f) + 64e-5f);
            const float bn = bonus[(size_t)T * 16 + head];
            float vm[16], g[16];
            mix16_direct_lat(Zr, rowbase, tl, 2, head, lq, CIN(11) + 2048 + hc, vm);
            LAS bf16_t* gp = GL + (scl * 16 + l15) * 1032 + hc;
            unpack8(*(LAS u32x4*)gp, g); unpack8(*(LAS u32x4*)(gp + 8), g + 8);
#pragma unroll
            for (int e = 0; e < 16; ++e) s[e] = (s[e] * rs * CIN(20)[hc + e] + CIN(21)[hc + e] + bn * vm[e]) * g[e];
            *(LAS u32x4*)gp = pack8(s); *(LAS u32x4*)(gp + 8) = pack8(s + 8); }
        __syncthreads();
        for (int ii = 0; ii < 8; ++ii) { const int i = wave * 8 + ii; const size_t R = (size_t)rowbase + tl0 + i; const int ch0 = lane * 16;
            bf16_t* wp = dry ? (bf16_t*)(c.ws + WS_WIN) + (R & 4095) * D + ch0 : or_f + R * D + ch0;
            *(u32x4*)wp = *(LAS u32x4*)(GL + i * 1032 + ch0); *(u32x4*)(wp + 8) = *(LAS u32x4*)(GL + i * 1032 + ch0 + 8); }
    }
    __syncthreads();
}

__device__ __forceinline__ void p7_combine(const Ctx& c) {
    const bf16_t* Z3 = (const bf16_t*)(c.ws + WS_Z3); const bf16_t* yg = (const bf16_t*)c.out; const bf16_t* yr = (const bf16_t*)(c.ws + WS_ORF); bf16_t* Y = (bf16_t*)(c.ws + WS_A1);
    for (int idx = blockIdx.x * NT + threadIdx.x; idx < MLAT * 128; idx += gridDim.x * NT) {
        const size_t row = idx >> 7; const int c8 = (idx & 127) * 8;
        float go[8], sg[8], sr[8], a[8], b[8], y[8];
        unpack8(ldg16(Z3 + row * Z3_LD + c8), go); unpack8(ldg16(Z3 + row * Z3_LD + 1024 + c8), sg); unpack8(ldg16(Z3 + row * Z3_LD + 2048 + c8), sr);
        unpack8(ldg16(yg + row * D + c8), a); unpack8(ldg16(yr + row * D + c8), b);
#pragma unroll
        for (int e = 0; e < 8; ++e) y[e] = sg[e] * a[e] * go[e] + sr[e] * b[e];
        *(u32x4*)(Y + row * D + c8) = pack8(y);
    }
}

__device__ __forceinline__ void p9_norm2_tables(const Ctx& c) {
    const int lane = threadIdx.x & 63, wave = threadIdx.x >> 6; const float* m = (const float*)(c.ws + WS_MOD); bf16_t* A2 = (bf16_t*)(c.ws + WS_A1);
    { const int stride = gridDim.x * 8;
        for (int row = blockIdx.x * 8 + wave; row < MLAT; row += 2 * stride) { const int rb = row + stride, b0 = row / SEQ;
            if (rb < MLAT) { const int b1 = rb / SEQ; norm_mod_row2(c.out + (size_t)row * D, c.out + (size_t)rb * D, CIN(23), m + b0 * MODW + 3072, m + b0 * MODW + 4096, m + b1 * MODW + 3072, m + b1 * MODW + 4096, A2 + (size_t)row * D, A2 + (size_t)rb * D, lane); }
            else norm_mod_row(c.out + (size_t)row * D, CIN(23), m + b0 * MODW + 3072, m + b0 * MODW + 4096, A2 + (size_t)row * D, lane); } }
    unsigned* UT = (unsigned*)(c.ws + WS_UT); unsigned* VT = (unsigned*)(c.ws + WS_VT);
    for (size_t i = ((size_t)blockIdx.x * NT + threadIdx.x) * 4; i < (size_t)16384 * 1024; i += (size_t)gridDim.x * NT * 4) {
        const f32x4 a = *(const f32x4*)(CIN(26) + i), b = *(const f32x4*)(CIN(27) + i); const size_t e = i >> 10, cc = i & 1023, o = ((cc >> 9) * (size_t)8388608 + e * 512 + (cc & 511)) >> 2;
        int w = __builtin_amdgcn_cvt_pk_fp8_f32(a[0] * 64.0f, a[1] * 64.0f, 0, false); w = __builtin_amdgcn_cvt_pk_fp8_f32(a[2] * 64.0f, a[3] * 64.0f, w, true); UT[o] = (unsigned)w;
        w = __builtin_amdgcn_cvt_pk_fp8_f32(b[0], b[1], 0, false); w = __builtin_amdgcn_cvt_pk_fp8_f32(b[2], b[3], w, true); VT[o] = (unsigned)w; }
}
typedef float f32x2p __attribute__((ext_vector_type(2)));
__device__ __forceinline__ void fp8x16_to_f32(const u32x4 w, float* o) {
#pragma unroll
    for (int q = 0; q < 4; ++q) { const f32x2p lo = __builtin_amdgcn_cvt_pk_f32_fp8((int)w[q], false), hi = __builtin_amdgcn_cvt_pk_f32_fp8((int)w[q], true); o[q * 4] = lo[0]; o[q * 4 + 1] = lo[1]; o[q * 4 + 2] = hi[0]; o[q * 4 + 3] = hi[1]; }
}
__device__ __forceinline__ float row16_sum(float x) {
    x += __builtin_bit_cast(float, __builtin_amdgcn_update_dpp(0, __builtin_bit_cast(int, x), 0x128, 0xf, 0xf, false));
    x += __builtin_bit_cast(float, __builtin_amdgcn_update_dpp(0, __builtin_bit_cast(int, x), 0x124, 0xf, 0xf, false));
    x += __builtin_bit_cast(float, __builtin_amdgcn_update_dpp(0, __builtin_bit_cast(int, x), 0x122, 0xf, 0xf, false));
    x += __builtin_bit_cast(float, __builtin_amdgcn_update_dpp(0, __builtin_bit_cast(int, x), 0x121, 0xf, 0xf, false));
    return x;
}
__device__ __forceinline__ float row32_sum(float x) {
    x = row16_sum(x);
    auto r = __builtin_amdgcn_permlane16_swap(__float_as_uint(x), __float_as_uint(x), false, false);
    return __uint_as_float(r[0]) + __uint_as_float(r[1]);
}
__device__ __forceinline__ float gelu_as(float v) {
    const float av = fabsf(v), t = __builtin_amdgcn_rcpf(av * 0.2316418882f + 1.0f);
    float q = t * 0.5307027145f - 0.7265760135f; q = q * t + 0.7107068705f; q = q * t - 0.142248368f; q = q * t + 0.127414796f; q = q * t;
    const float e = __builtin_amdgcn_exp2f(v * v * -0.72134752044f), mneg = v * (q * e);
    return v < 0.f ? mneg : v - mneg;
}

typedef int i32x8 __attribute__((ext_vector_type(8)));
constexpr int BF_HL = 4096, BF_WAVE = 2 * BF_HL;
#define S9_ROW(e) ((unsigned)(e) & rmask)
template <int EXP> __device__ __forceinline__ void p12_sweep12(const Ctx& c, int R0, LAS unsigned char* lds, int tid) {
    constexpr bool dry = EXP != 0;
    const int lane = tid & 63, wave = __builtin_amdgcn_readfirstlane(tid >> 6), l15 = lane & 15, lq = lane >> 4;
    LAS int* SIDX = (LAS int*)lds; LAS float* SGATE = (LAS float*)(SIDX + 8192);
    const LAS int* IDXL = (const LAS int*)lds + 16384; const LAS float* GATEL = (const LAS float*)(IDXL + 64 * IDSTR);
    LAS unsigned char* BF = lds + 65536 + wave * BF_WAVE;
    LAS int* HIST = (LAS int*)(lds + 133120) + wave * 64;
    LAS bf16_t* XP = (LAS bf16_t*)(lds + 135168) + wave * 1024;
    const bf16_t* A2 = (const bf16_t*)(c.ws + WS_A1); const unsigned char* UT = (const unsigned char*)(c.ws + WS_UT); const unsigned char* VT = (const unsigned char*)(c.ws + WS_VT); const float* m = (const float*)(c.ws + WS_MOD);
    for (int k = 0; k < 8; ++k) { const int tok = wave + 8 * k;
        if (lane < 32) HIST[lane] = 0;
        const int e0 = IDXL[tok * IDSTR + lane], e1 = IDXL[tok * IDSTR + 64 + lane]; const float g0 = GATEL[tok * IDSTR + lane], g1 = GATEL[tok * IDSTR + 64 + lane];
        const int b0 = e0 >> 9, b1 = e1 >> 9;
        const int r0 = __hip_atomic_fetch_add(HIST + b0, 1, __ATOMIC_RELAXED, __HIP_MEMORY_SCOPE_WORKGROUP), r1 = __hip_atomic_fetch_add(HIST + b1, 1, __ATOMIC_RELAXED, __HIP_MEMORY_SCOPE_WORKGROUP);
        const int cnt = lane < 32 ? __hip_atomic_load(HIST + (lane & 31), __ATOMIC_RELAXED, __HIP_MEMORY_SCOPE_WORKGROUP) : 0; int incl = cnt;
#pragma unroll
        for (int o = 1; o < 32; o <<= 1) { const int v = __shfl_up(incl, o); if (lane >= o) incl += v; }
        if (lane < 32) HIST[32 + lane] = incl - cnt;
        LDS_FENCE();
        const int pos0 = HIST[32 + b0] + r0, pos1 = HIST[32 + b1] + r1;
        SIDX[tok * 128 + pos0] = e0; SGATE[tok * 128 + pos0] = g0; SIDX[tok * 128 + pos1] = e1; SGATE[tok * 128 + pos1] = g1;
        LDS_FENCE(); }
    __syncthreads();
    const int psel = l15 & 3;
    float wsel[4];
#pragma unroll
    for (int r = 0; r < 4; ++r) wsel[r] = ((l15 >> 2) == lq && psel == r) ? 1.0f : 0.f;
    const bool wr_lane = (l15 == 4 * lq);
#pragma unroll 1
    for (int rep = 0; rep < S8_REPS; ++rep) {
        const bool dryrep = dry || (rep + 1 < S8_REPS); const unsigned rmask = (dryrep && S8_HOT) ? 63u : 16383u;
        const LAS int* LV[2]; LAS float* LG[2]; LAS bf16_t* XPv[2]; const LAS int* LU[2];
#pragma unroll
        for (int tb = 0; tb < 2; ++tb) { const int tokv = wave + 8 * (4 * tb + lq); LV[tb] = SIDX + tokv * 128; LG[tb] = SGATE + tokv * 128; XPv[tb] = XP + (4 * tb + lq) * 128;
            LU[tb] = SIDX + (wave + 8 * (4 * tb + (l15 >> 2))) * 128; }
        const unsigned offU = (unsigned)(lq * 64 + psel * 16), offV = (unsigned)(l15 * 16);
#pragma unroll 1
        for (int jj = 0; jj < 2; ++jj) {
            { const int kt = lane >> 3, b8 = lane & 7; const bf16_t* ap = A2 + (size_t)(R0 + wave + 8 * kt) * D + jj * 512 + b8 * 64;
                LAS unsigned char* bp = BF + ((((kt >> 2) * 2 * 4 + (b8 & 3)) * 2 + (b8 >> 2)) * 16 + 4 * (kt & 3)) * 16;
#pragma unroll
                for (int p = 0; p < 4; ++p) { float a[16]; unpack8(ldg16(ap + p * 16), a); unpack8(ldg16(ap + p * 16 + 8), a + 8);
                    u32x4 hi, lo;
#pragma unroll
                    for (int q = 0; q < 4; ++q) { int w = __builtin_amdgcn_cvt_pk_fp8_f32(a[4 * q], a[4 * q + 1], 0, false); w = __builtin_amdgcn_cvt_pk_fp8_f32(a[4 * q + 2], a[4 * q + 3], w, true);
                        const f32x2p h01 = __builtin_amdgcn_cvt_pk_f32_fp8(w, false), h23 = __builtin_amdgcn_cvt_pk_f32_fp8(w, true);
                        int v = __builtin_amdgcn_cvt_pk_fp8_f32(a[4 * q] - h01[0], a[4 * q + 1] - h01[1], 0, false); v = __builtin_amdgcn_cvt_pk_fp8_f32(a[4 * q + 2] - h23[0], a[4 * q + 3] - h23[1], v, true);
                        hi[q] = (unsigned)w; lo[q] = (unsigned)v; }
                    *(LAS u32x4*)(bp + p * 16) = hi; *(LAS u32x4*)(bp + 2048 + p * 16) = lo; }
                LDS_FENCE(); }
            const unsigned char* UTj = UT + (size_t)jj * 8388608;
            i32x8 Bh[2], Bl[2];
#pragma unroll
            for (int tb = 0; tb < 2; ++tb) { const LAS unsigned char* BFr = BF + tb * 4096 + (lq * 32 + l15) * 16;
                const u32x4 b0 = *(const LAS u32x4*)BFr, b1 = *(const LAS u32x4*)(BFr + 256), c0 = *(const LAS u32x4*)(BFr + 2048), c1 = *(const LAS u32x4*)(BFr + 2048 + 256);
                Bh[tb] = (i32x8){(int)b0.x, (int)b0.y, (int)b0.z, (int)b0.w, (int)b1.x, (int)b1.y, (int)b1.z, (int)b1.w}; Bl[tb] = (i32x8){(int)c0.x, (int)c0.y, (int)c0.z, (int)c0.w, (int)c1.x, (int)c1.y, (int)c1.z, (int)c1.w}; }
            u32x4 U[4][2][2];
#pragma unroll
            for (int s2 = 0; s2 < 4; ++s2)
#pragma unroll
                for (int tb = 0; tb < 2; ++tb) { const unsigned char* up = UTj + (size_t)((S9_ROW(LU[tb][s2]) << 9) + offU);
                    U[s2][tb][0] = *(const u32x4*)up; U[s2][tb][1] = *(const u32x4*)(up + 256); }
#pragma unroll 1
            for (int g = 0; g < 32; ++g) {
                u32x4 ln[2];
#pragma unroll
                for (int tb = 0; tb < 2; ++tb) ln[tb] = *(const LAS u32x4*)(LU[tb] + ((4 * g + 4) & 127));
                float x[2][4];
#pragma unroll
                for (int i = 0; i < 4; ++i) {
#pragma unroll
                    for (int tb = 0; tb < 2; ++tb) {
                        const u32x4 a0 = U[i][tb][0], a1 = U[i][tb][1];
                        const i32x8 a8 = {(int)a0.x, (int)a0.y, (int)a0.z, (int)a0.w, (int)a1.x, (int)a1.y, (int)a1.z, (int)a1.w};
                        f32x4 d = __builtin_amdgcn_mfma_scale_f32_16x16x128_f8f6f4(a8, Bh[tb], ((f32x4){0.f, 0.f, 0.f, 0.f}), 0, 0, 0, 0, 0, 0);
                        d = __builtin_amdgcn_mfma_scale_f32_16x16x128_f8f6f4(a8, Bl[tb], d, 0, 0, 0, 0, 0, 0);
                        { const unsigned char* up = UTj + (size_t)((S9_ROW(ln[tb][i]) << 9) + offU);
                            U[i][tb][0] = *(const u32x4*)up; U[i][tb][1] = *(const u32x4*)(up + 256); }
                        x[tb][i] = d[0] * wsel[0] + d[1] * wsel[1] + d[2] * wsel[2] + d[3] * wsel[3]; }
                    SCHED_FENCE(); }
#pragma unroll
                for (int tb = 0; tb < 2; ++tb) {
#pragma unroll
                    for (int i = 0; i < 4; ++i) { x[tb][i] += DPP_F(x[tb][i], 0xB1); x[tb][i] += DPP_F(x[tb][i], 0x4E); }
                    if (jj == 0) { if (wr_lane) *(LAS u32x2*)(XPv[tb] + 4 * g) = (u32x2){pk2(x[tb][0], x[tb][1]), pk2(x[tb][2], x[tb][3])}; }
                    else { const u32x2 pw = *(const LAS u32x2*)(XPv[tb] + 4 * g); const f32x4 gt = *(const LAS f32x4*)(LG[tb] + 4 * g);
                        const float xp[4] = {bflo(pw.x), bfhi(pw.x), bflo(pw.y), bfhi(pw.y)}; f32x4 cf;
#pragma unroll
                        for (int i = 0; i < 4; ++i) cf[i] = gt[i] * gelu_as((x[tb][i] + xp[i]) * (1.0f / 64.0f));
                        if (wr_lane && !(dryrep && S8_REPS > 1)) *(LAS f32x4*)(LG[tb] + 4 * g) = cf; } }
                SCHED_FENCE();
            }
            LDS_FENCE();
        }
        float ssq[2] = {0.f, 0.f};
#pragma unroll
        for (int hv = 0; hv < 2; ++hv) { u32x4 V[4][2][2]; f32x2p acc[2][16];
#pragma unroll
            for (int tb = 0; tb < 2; ++tb)
#pragma unroll
                for (int e = 0; e < 16; ++e) acc[tb][e] = (f32x2p){0.f, 0.f};
            const unsigned char* VTh = VT + (size_t)hv * 8388608;
#pragma unroll
            for (int s2 = 0; s2 < 4; ++s2)
#pragma unroll
                for (int tb = 0; tb < 2; ++tb) { const unsigned char* vp = VTh + (size_t)((S9_ROW(LV[tb][s2]) << 9) + offV);
                    V[s2][tb][0] = *(const u32x4*)vp; V[s2][tb][1] = *(const u32x4*)(vp + 256); }
#pragma unroll 1
            for (int g = 0; g < 32; ++g) {
                u32x4 ln[2]; f32x4 cf4[2];
#pragma unroll
                for (int tb = 0; tb < 2; ++tb) { ln[tb] = *(const LAS u32x4*)(LV[tb] + ((4 * g + 4) & 127)); cf4[tb] = *(const LAS f32x4*)(LG[tb] + 4 * g); }
#pragma unroll
                for (int i = 0; i < 4; ++i) {
#pragma unroll
                    for (int tb = 0; tb < 2; ++tb) {
                        const f32x2p cf2 = (f32x2p){cf4[tb][i], cf4[tb][i]};
#pragma unroll
                        for (int q = 0; q < 2; ++q)
#pragma unroll
                            for (int w = 0; w < 4; ++w) { acc[tb][q * 8 + w * 2] += cf2 * __builtin_amdgcn_cvt_pk_f32_fp8((int)V[i][tb][q][w], false); acc[tb][q * 8 + w * 2 + 1] += cf2 * __builtin_amdgcn_cvt_pk_f32_fp8((int)V[i][tb][q][w], true); }
                        SCHED_FENCE();
                        { const unsigned char* vp = VTh + (size_t)((S9_ROW(ln[tb][i]) << 9) + offV);
                            V[i][tb][0] = *(const u32x4*)vp; V[i][tb][1] = *(const u32x4*)(vp + 256); }
                        SCHED_FENCE(); } }
            }
#pragma unroll
            for (int tb = 0; tb < 2; ++tb) { const int R = R0 + wave + 8 * (4 * tb + lq); const int b = R / SEQ; const float* g2 = m + b * MODW + 5120; const float* hrow = c.out + (size_t)R * D;
                float* orow = dryrep ? (float*)(c.ws + WS_ZR + (size_t)56 * 1048576) + (size_t)(R & 8191) * D : c.out + (size_t)R * D;
#pragma unroll
                for (int q = 0; q < 2; ++q)
#pragma unroll
                    for (int w = 0; w < 4; ++w) { const int ch = hv * 512 + q * 256 + l15 * 16 + w * 4; const f32x4 hv4 = *(const f32x4*)(hrow + ch), gv = *(const f32x4*)(g2 + ch);
                        const float a4[4] = {acc[tb][q * 8 + 2 * w][0], acc[tb][q * 8 + 2 * w][1], acc[tb][q * 8 + 2 * w + 1][0], acc[tb][q * 8 + 2 * w + 1][1]}; f32x4 o;
#pragma unroll
                        for (int e = 0; e < 4; ++e) { o[e] = hv4[e] + gv[e] * a4[e]; ssq[tb] += o[e] * o[e]; }
                        *(f32x4*)(orow + ch) = o; } }
        }
#pragma unroll
        for (int tb = 0; tb < 2; ++tb) { const int R = R0 + wave + 8 * (4 * tb + lq); const float rstd = rsqrtf(row16_sum(ssq[tb]) * (1.0f / 1024.0f) + 1e-6f);
            float* orow = dryrep ? (float*)(c.ws + WS_ZR + (size_t)56 * 1048576) + (size_t)(R & 8191) * D : c.out + (size_t)R * D;
#pragma unroll
            for (int q = 0; q < 4; ++q)
#pragma unroll
                for (int w = 0; w < 4; ++w) { const int ch = q * 256 + l15 * 16 + w * 4; const f32x4 wv = *(const f32x4*)(CIN(28) + ch); const f32x4 h2 = *(const f32x4*)(orow + ch); f32x4 o;
#pragma unroll
                    for (int e = 0; e < 4; ++e) o[e] = h2[e] * rstd * wv[e];
                    *(f32x4*)(orow + ch) = o; } }
    }
}

__device__ __forceinline__ int sortable(float v) { const int b = __float_as_int(v); return b ^ ((b >> 31) & 0x7fffffff); }
__device__ __forceinline__ float unsortable(int k) { return __int_as_float(k ^ ((k >> 31) & 0x7fffffff)); }
#define CASD(a, b) { const int _hi = max(a, b), _lo = min(a, b); a = _hi; b = _lo; }
#define CAS16(t, x) { _Pragma("unroll") for (int _i = 0; _i < 16; ++_i) { const int _hi = max(t[_i], x); x = min(t[_i], x); t[_i] = _hi; } }
__device__ __forceinline__ void bitonic_merge16_desc(int* t) {
#pragma unroll
    for (int d = 8; d >= 1; d >>= 1)
#pragma unroll
        for (int i = 0; i < 16; ++i) if ((i & d) == 0) CASD(t[i], t[i + d]);
}
__device__ __forceinline__ void bitonic_sort16_desc(int* t) {
#pragma unroll
    for (int k = 2; k <= 16; k <<= 1)
#pragma unroll
        for (int d = k >> 1; d >= 1; d >>= 1)
#pragma unroll
            for (int i = 0; i < 16; ++i) { const int j = i ^ d; if (j > i) { if ((i & k) == 0 || k == 16) { CASD(t[i], t[j]); } else { CASD(t[j], t[i]); } } }
}
template <int EXP> __device__ __forceinline__ void p11_topk(const Ctx& c, LAS unsigned char* lds) {
    LAS int* KEYS = (LAS int*)lds;
    const bf16_t* Q = (const bf16_t*)(c.ws + WS_Q); const bf16_t* SK = (const bf16_t*)(c.ws + WS_SK);
    LAS int* IDXL = KEYS + 16384;
    LAS float* GATEL = (LAS float*)(IDXL + 64 * IDSTR);
    const int wv_s = __builtin_amdgcn_readfirstlane(threadIdx.x >> 6);
    for (int u = blockIdx.x; u < MLAT / 64; u += gridDim.x) {
        int tid; asm volatile("v_mbcnt_lo_u32_b32 %0, -1, 0\n\tv_mbcnt_hi_u32_b32 %0, -1, %0\n\tv_or_b32 %0, %1, %0" : "=&v"(tid) : "s"(wv_s << 6));
        const int lane = tid & 63, wave = tid >> 6, l15 = lane & 15, lq = lane >> 4;
        const int R0 = u * 64, tt = wave >> 1, p = wave & 1;
        __syncthreads();
#pragma unroll 1
        for (int h = 0; h < 8; ++h) {
            bf16x8 qf[4];
#pragma unroll
            for (int ks = 0; ks < 4; ++ks) qf[ks] = *(const bf16x8*)(Q + ((size_t)((((((R0 >> 4) + tt) * 8 + h) * 2 + p) * 4 + ks) * 64 + lane) << 3));
            int ta[16], tb[16];
#pragma unroll
            for (int nt = 0; nt < 8; ++nt) { f32x4 a = (f32x4){0.f, 0.f, 0.f, 0.f};
#pragma unroll
                for (int ks = 0; ks < 4; ++ks) a = MFMA16(*(const bf16x8*)(SK + (size_t)(((((h * 2 + p) * 8 + nt) * 4 + ks) * 64 + lane) * 8)), qf[ks], a);
#pragma unroll
                for (int r = 0; r < 4; ++r) { const int n = nt * 16 + lq * 4 + r; const int key = (sortable(a[r]) & ~127) | (127 - n);
                    if (nt < 4) ta[nt * 4 + r] = key; else tb[(nt - 4) * 4 + r] = key; } }
            bitonic_sort16_desc(ta); bitonic_sort16_desc(tb);
#pragma unroll
            for (int i = 0; i < 16; ++i) ta[i] = max(ta[i], tb[15 - i]);
            bitonic_merge16_desc(ta);
#pragma unroll
            for (int st = 0; st < 2; ++st) {
#pragma unroll
                for (int i = 0; i < 16; ++i) tb[i] = __shfl_xor(ta[i], st ? 32 : 16);
#pragma unroll
                for (int i = 0; i < 16; ++i) ta[i] = max(ta[i], tb[15 - i]);
                bitonic_merge16_desc(ta); }
            if (lq == 0) {
#pragma unroll
                for (int i = 0; i < 16; ++i) KEYS[((h * 2 + p) * 16 + i) * 64 + tt * 16 + l15] = ta[i]; }
        }
        __syncthreads();
        {
            const int tok = tid & 63, h = tid >> 6;
            int k1[16], k2[16]; float s1[16], s2[16];
#pragma unroll
            for (int i = 0; i < 16; ++i) { k1[i] = KEYS[((h * 2) * 16 + i) * 64 + tok]; k2[i] = KEYS[((h * 2 + 1) * 16 + i) * 64 + tok]; s1[i] = unsortable(k1[i] & ~127); s2[i] = unsortable(k2[i] & ~127); }
            int t[16];
#pragma unroll
            for (int j = 0; j < 16; ++j) t[j] = (sortable(s1[0] + s2[j]) & ~255) | (255 - j);
#pragma unroll
            for (int i = 1; i < 16; ++i)
#pragma unroll
                for (int j = 0; j < 16; ++j) if ((i + 1) * (j + 1) <= 16) { int x = (sortable(s1[i] + s2[j]) & ~255) | (255 - (i * 16 + j)); CAS16(t, x); }
            float sv[16]; int ev[16]; float mx = -3.0e38f;
#pragma unroll
            for (int k = 0; k < 16; ++k) { const int id = 255 - (t[k] & 255), i = id >> 4, j = id & 15;
                const int ia = KEYS[((h * 2) * 16 + i) * 64 + tok], ib = KEYS[((h * 2 + 1) * 16 + j) * 64 + tok];
                sv[k] = unsortable(ia & ~127) + unsortable(ib & ~127); ev[k] = (127 - (ia & 127)) * 128 + (127 - (ib & 127)); mx = fmaxf(mx, sv[k]); }
            float den = 0.f;
#pragma unroll
            for (int k = 0; k < 16; ++k) { sv[k] = fexp(sv[k] - mx); den += sv[k]; }
            const float inv = 1.0f / den; const int o = tok * IDSTR + h * 16;
#pragma unroll
            for (int k = 0; k < 16; k += 4) { *(LAS u32x4*)(IDXL + o + k) = (u32x4){(unsigned)ev[k], (unsigned)ev[k + 1], (unsigned)ev[k + 2], (unsigned)ev[k + 3]};
                *(LAS f32x4*)(GATEL + o + k) = (f32x4){sv[k] * inv, sv[k + 1] * inv, sv[k + 2] * inv, sv[k + 3] * inv}; }
        }
        __syncthreads();
        if (EXP != 2) p12_sweep12<EXP>(c, R0, lds, tid);
    }
    __syncthreads();
}

constexpr int N_PHASES = 12;
#ifndef RWKV_IMPL
#define RWKV_IMPL 1
#endif
#ifndef RWKV_PROBE
#define RWKV_PROBE 0
#endif
__global__ void __launch_bounds__(NT, 2) fwd_kernel(Args args) {
    extern __shared__ __attribute__((aligned(16))) unsigned char lds_raw[];
    LAS unsigned char* lds0 = (LAS unsigned char*)lds_raw;
    LAS unsigned char* lds = lds0 + LDS_HDR;
    Ctx c; c.in = (KArgPtr)__builtin_amdgcn_kernarg_segment_ptr();
    c.out = args.out; c.ws = args.ws;
    if (threadIdx.x < 16) ((LAS unsigned*)lds0)[threadIdx.x] = 0u;
    __syncthreads();
    const int lo = args.ph_lo, hi = args.ph_hi;
    const bool multi = (hi - lo) > 1;
    XcdBarrier bar; bar.bar = (unsigned*)(c.ws + WS_CTL); bar.x = 0; bar.st = (volatile LAS unsigned*)lds0;
    if (multi) bar = xcd_barrier_post((unsigned*)(c.ws + WS_CTL), (volatile LAS unsigned*)lds0);
#ifndef PROBE_T
#define PROBE_T -1
#endif
    LAS unsigned long long* stamps = (LAS unsigned long long*)(lds0 + LDS_BYTES - 256);
#define STAMP(i) do { if (PROBE_T >= 0 && threadIdx.x == 0) stamps[i] = wall_clock64(); } while (0)
#define IN(k) (lo <= (k) && (k) < hi)
#define SEAM(k) do { STAMP(2 * (k) + 1); if (IN(k) && IN((k) + 1)) { xcd_barrier(bar); if (DUP(20)) xcd_barrier(bar); } STAMP(2 * (k) + 2); } while (0)
    STAMP(0);
    const bf16_t* Wt_in = (const bf16_t*)(c.ws + WS_WIN);
    if (IN(0)) { p0_prologue(c, lds); if (DUP(0)) p0_prologue(c, lds); } SEAM(0);
    if (IN(1)) { p1_norm1(c); if (DUP(1)) p1_norm1(c); } SEAM(1);
    if (IN(2)) { pg8::Gemm g{(const bf16_t*)(c.ws + WS_A1), Wt_in, MALL, N1, D}; Gemm1Order S; S.init(MLAT, N1, gridDim.x, blockIdx.x);
        EpiB<0> E{(bf16_t*)(c.ws + WS_ZG), (bf16_t*)(c.ws + WS_ZR), 0};
        pg8::gemm_phase<EpiB<0>, Gemm1Order, false>((PG8_LAS unsigned char*)lds, g, S, E, nullptr);
        if (DUP(2)) { if (DUP(21)) xcd_barrier(bar); pg8::gemm_phase<EpiB<0>, Gemm1Order, false>((PG8_LAS unsigned char*)lds, g, S, E, nullptr); } } SEAM(2);
    if (IN(3)) { premix_lora(c); p3_gla(c, lds); if (DUP(3)) p3_gla(c, lds); } SEAM(3);
    if (IN(4)) { p4_rwkv_chunked(c, lds); if (DUP(4)) { if (DUP(21)) xcd_barrier(bar); p4_rwkv_chunked(c, lds); } } SEAM(4);
    if (IN(5)) { if (DUP(5)) p5_post(c, lds, true); p5_post(c, lds); } SEAM(5);
    if (IN(6)) { pg8::StaticOrder S; S.init(MLAT, D, gridDim.x, blockIdx.x); bf16_t* Tb = (bf16_t*)c.out; bf16_t* Yr = (bf16_t*)(c.ws + WS_ORF);
        { pg8::Gemm g{(const bf16_t*)(c.ws + WS_A1), Wt_in + (size_t)N1 * D, MLAT, D, D}; EpiMix<0> E{Tb, Yr}; pg8::gemm_phase<EpiMix<0>, pg8::StaticOrder, false>((PG8_LAS unsigned char*)lds, g, S, E, nullptr); }
        __syncthreads();
        { pg8::Gemm g{(const bf16_t*)(c.ws + WS_A1), Wt_in + (size_t)(N1 + 1024) * D, MLAT, D, D}; EpiMix<1> E{Tb, Yr}; pg8::gemm_phase<EpiMix<1>, pg8::StaticOrder, false>((PG8_LAS unsigned char*)lds, g, S, E, nullptr); }
        __syncthreads();
        { pg8::Gemm g{(const bf16_t*)(c.ws + WS_A1), Wt_in + (size_t)(N1 + 2048) * D, MLAT, D, D}; EpiMix<2> E{Tb, Yr}; pg8::gemm_phase<EpiMix<2>, pg8::StaticOrder, false>((PG8_LAS unsigned char*)lds, g, S, E, nullptr); } } SEAM(6);
    if (IN(8)) { pg8::Gemm g{(const bf16_t*)(c.ws + WS_ORF), (const bf16_t*)(c.ws + WS_WOUT), MLAT, D, D}; pg8::StaticOrder S; S.init(MLAT, D, gridDim.x, blockIdx.x);
        EpiH1 E{CIN(0), (const float*)(c.ws + WS_MOD), c.out};
        pg8::gemm_phase<EpiH1, pg8::StaticOrder, false>((PG8_LAS unsigned char*)lds, g, S, E, nullptr); } SEAM(8);
    if (IN(9)) { p9_norm2_tables(c); if (DUP(9)) p9_norm2_tables(c); } SEAM(9);
    if (IN(10)) { pg8::Gemm g{(const bf16_t*)(c.ws + WS_A1), (const bf16_t*)(c.ws + WS_WQ), MLAT, 2048, D}; pg8::StaticOrder S; S.init(MLAT, 2048, gridDim.x, blockIdx.x);
        EpiB<3> E{(bf16_t*)(c.ws + WS_Q), nullptr, 2048};
        pg8::gemm_phase<EpiB<3>, pg8::StaticOrder, false>((PG8_LAS unsigned char*)lds, g, S, E, nullptr);
        if (DUP(10)) pg8::gemm_phase<EpiB<3>, pg8::StaticOrder, false>((PG8_LAS unsigned char*)lds, g, S, E, nullptr); } SEAM(10);
    if (IN(11)) { if (DUP(11)) p11_topk<GEXP>(c, lds); p11_topk<0>(c, lds); }
    STAMP(23);
    if (PROBE_T >= 0) {
        __syncthreads();
        const float us = (float)(stamps[PROBE_T + 1] - stamps[PROBE_T]) * 0.01f;
        for (int u = blockIdx.x; u < MLAT / 64; u += gridDim.x) for (int i = threadIdx.x; i < 64 * D; i += NT) c.out[(size_t)u * 64 * D + i] = us;
    }
#undef IN
#undef SEAM
}

__global__ void dbg_cmp2(const bf16_t* oldv, const bf16_t* nf, const bf16_t* nb, float* out) {
    for (size_t i = (size_t)blockIdx.x * blockDim.x + threadIdx.x; i < (size_t)MLAT * D; i += (size_t)gridDim.x * blockDim.x) {
        const float o = bf2f(oldv[i]); const float n = i < 8388608 ? bf2f(nf[i]) : bf2f(nb[i - 8388608]);
        float v = (n - o) * (100.0f / 12.2f); if (!(fabsf(v) < 1e30f)) v = 1e4f; out[i] = v; }
}
extern "C" void kernel_launch(void* const* d_in, const int* in_sizes, int n_in, void* d_out, int out_size, void* d_ws, size_t ws_size, hipStream_t stream) {
    static int grid = 0;
    if (grid == 0) {
        if (n_in != 29 || out_size != MLAT * D || ws_size < WS_END) { fprintf(stderr, "kernel_launch: unexpected shapes (n_in %d, out %d, ws %zu < %zu)\n", n_in, out_size, ws_size, (size_t)WS_END); grid = -1; return; }
        int dev = 0, cus = 0, per_cu = 0;
        if (hipGetDevice(&dev) != hipSuccess || hipDeviceGetAttribute(&cus, hipDeviceAttributeMultiprocessorCount, dev) != hipSuccess) { grid = -1; return; }
        if (hipFuncSetAttribute((const void*)fwd_kernel, hipFuncAttributeMaxDynamicSharedMemorySize, LDS_BYTES) != hipSuccess) { fprintf(stderr, "kernel_launch: hipFuncSetAttribute failed\n"); grid = -1; return; }
        if (hipOccupancyMaxActiveBlocksPerMultiprocessor(&per_cu, (const void*)fwd_kernel, NT, LDS_BYTES) != hipSuccess || per_cu < 1) fprintf(stderr, "kernel_launch: occupancy query reports %d\n", per_cu);
        (void)hipGetLastError();
        grid = cus;
    }
    if (grid < 0) return;
    (void)hipMemsetAsync((char*)d_ws + WS_CTL, 0, 65536, stream);
    Args a{};
    for (int i = 0; i < 29; ++i) a.in[i] = (const float*)d_in[i];
    a.out = (float*)d_out; a.ws = (unsigned char*)d_ws;
#if MK_N_LAUNCHES == 1
    a.ph_lo = 0; a.ph_hi = N_PHASES;
    hipLaunchKernelGGL(fwd_kernel, dim3(grid), dim3(NT), LDS_BYTES, stream, a);
#else
    for (int p = 0; p < N_PHASES; ++p) { a.ph_lo = p; a.ph_hi = p + 1; hipLaunchKernelGGL(fwd_kernel, dim3(grid), dim3(NT), LDS_BYTES, stream, a); }
#endif
}
```

```cpp
#include <hip/hip_runtime.h>
#include <stdint.h>
#include <stdio.h>

#ifndef MK_N_LAUNCHES
#define MK_N_LAUNCHES 1
#endif

namespace pg8 {
#define PG8_LAS __attribute__((address_space(3)))
typedef unsigned short bf16_t;
typedef short bf16x8 __attribute__((ext_vector_type(8)));
typedef float f32x4 __attribute__((ext_vector_type(4)));
typedef unsigned u32x4 __attribute__((ext_vector_type(4)));
constexpr int BM = 256, BK = 64, HALF = 128, HTB = HALF * BK * 2  , STAGE_BYTES = 8 * HTB, NXCD = 8, WGM = 8;

__host__ __device__ __forceinline__ int lds_byte(int r, int c) { const int st = (r >> 4) * 2 + (c >> 5), rr = r & 15, cc = c & 31, ob = rr * 64 + cc * 2; return st * 1024 + (ob ^ (((ob >> 9) & 1) << 5)); }
__host__ __device__ __forceinline__ void stage_rc(int b, int& R, int& C) { const int st = b / 1024, sb = b % 1024, swz = sb ^ (((sb >> 9) & 1) << 5); R = (st >> 1) * 16 + swz / 64; C = (st & 1) * 32 + (swz % 64) / 2; }
__host__ __device__ __forceinline__ int perm32(int rho) { const int n = rho >> 4, i = rho & 15; return 8 * (i >> 2) + 4 * n + (i & 3); }

struct Unit { int pm, pn; };
struct Gemm { const bf16_t* A; const bf16_t* Bt; int M, N, K; };

struct StaticOrder {
    int nM, nN, nwg, G, c;
    __host__ __device__ void init(int M, int N, int G_, int c_) { nM = M / BM; nN = N / BM; nwg = nM * nN; G = G_; c = c_; }
    __host__ __device__ bool next(int i, Unit& u) const {
        const long L = (long)i * G + c; if (L >= nwg) return false;
        int wgid = (int)L; { const int q = nwg / NXCD, r = nwg % NXCD, xcd = wgid % NXCD, off = wgid / NXCD; wgid = (xcd < r ? xcd * (q + 1) : r * (q + 1) + (xcd - r) * q) + off; }
        const int nig = WGM * nN, gid = wgid / nig, fm = gid * WGM, gsz = (nM - fm) < WGM ? (nM - fm) : WGM;
        u.pm = fm + ((wgid % nig) % gsz); u.pn = (wgid % nig) / gsz; return true;
    }
    __device__ __forceinline__ void a_ready(const Unit&) const {}
    __device__ __forceinline__ void done(const Unit&) const {}
};
__device__ __forceinline__ unsigned cvt_pk_bf16(float lo, float hi) { unsigned r; asm volatile("v_cvt_pk_bf16_f32 %0, %1, %2" : "=v"(r) : "v"(lo), "v"(hi)); return r; }
template <class Epi, class Sched, bool STAMP = false>
__device__ __forceinline__ void gemm_phase(PG8_LAS unsigned char* lds, const Gemm g, const Sched& S, const Epi& E, unsigned long long* stamps) {
    const int tid = threadIdx.x, wid = __builtin_amdgcn_readfirstlane(tid >> 6), lane = tid & 63, wr = wid >> 2, wc = wid & 3, fr = lane & 15, fq = lane >> 4;
    const int K = g.K, nt = K / BK;
    int ts_lo = 0, ts_hi = 0, nts = 0; const unsigned long long rt_entry = STAMP ? (unsigned long long)wall_clock64() : 0ull;
#define PG8_STAMP() do { if (STAMP && wid == 0 && nts < 64) { const unsigned long long _c = (unsigned long long)clock64(); \
        ts_lo = (lane == nts) ? (int)(unsigned)_c : ts_lo; ts_hi = (lane == nts) ? (int)(unsigned)(_c >> 32) : ts_hi; ++nts; } } while (0)
    PG8_STAMP();
    unsigned voffA[2], voffB[2];
#pragma unroll
    for (int i = 0; i < 2; ++i) { int R, C; stage_rc(tid * 16 + i * 8192, R, C); const int Rb = Epi::PERM ? ((R & ~31) + perm32(R & 31)) : R;
        voffA[i] = (unsigned)(R * K + C) * 2u; voffB[i] = (unsigned)(Rb * K + C) * 2u; }
    const size_t kstep = (size_t)(BK * 2);
    const size_t hstep = (size_t)HALF * K * 2;
    const size_t tstep = 2 * hstep;
    const unsigned ldsw = (unsigned)wid * 1024u;
    const int aoff = lds_byte(wr * 64 + fr, fq * 8), boff = lds_byte(wc * 32 + fr, fq * 8);
#define PG8_SA(b, h) (((b) * 2 + (h)) * HTB)
#define PG8_SB(b, h) ((4 + (b) * 2 + (h)) * HTB)
#define PG8_STAGE(bufoff, gbase, voff) do { _Pragma("unroll") for (int _i = 0; _i < 2; ++_i) \
        __builtin_amdgcn_global_load_lds((const unsigned*)((const char*)(gbase) + (voff)[_i]), (PG8_LAS unsigned*)(lds + (bufoff) + ldsw + _i * 8192), 16, 0, 0); } while (0)
#define PG8_LDA(dst, b, h) do { _Pragma("unroll") for (int m = 0; m < 4; ++m) _Pragma("unroll") for (int k = 0; k < 2; ++k) dst[m][k] = *(const PG8_LAS bf16x8*)(lds + PG8_SA(b, h) + aoff + m * 2048 + k * 1024); } while (0)
#define PG8_LDB(dst, b, h) do { _Pragma("unroll") for (int n = 0; n < 2; ++n) _Pragma("unroll") for (int k = 0; k < 2; ++k) dst[n][k] = *(const PG8_LAS bf16x8*)(lds + PG8_SB(b, h) + boff + n * 2048 + k * 1024); } while (0)
#define PG8_MMA(ai, bj, At, Bt) do { __builtin_amdgcn_s_setprio(1); _Pragma("unroll") for (int m = 0; m < 4; ++m) _Pragma("unroll") for (int n = 0; n < 2; ++n) _Pragma("unroll") for (int k = 0; k < 2; ++k) \
        acc[ai][bj][m][n] = __builtin_amdgcn_mfma_f32_16x16x32_bf16(Bt[n][k], At[m][k], acc[ai][bj][m][n], 0, 0, 0); __builtin_amdgcn_s_setprio(0); } while (0)
#define PG8_WAIT_V(n) asm volatile("s_waitcnt vmcnt(" #n ")" ::: "memory")
#define PG8_WAIT_L(n) asm volatile("s_waitcnt lgkmcnt(" #n ")" ::: "memory")
#define PG8_BAR __builtin_amdgcn_s_barrier()
#define PG8_SCHED __builtin_amdgcn_sched_barrier(0)
    Unit cur, nxt; int ui = 0;
    if (!S.next(0, cur)) return;
    f32x4 acc[2][2][4][2];
#pragma unroll
    for (int a = 0; a < 2; ++a)
#pragma unroll
        for (int b = 0; b < 2; ++b)
#pragma unroll
            for (int m = 0; m < 4; ++m)
#pragma unroll
                for (int n = 0; n < 2; ++n) acc[a][b][m][n] = (f32x4){0.f, 0.f, 0.f, 0.f};
    bf16x8 At[4][2], B0[2][2], B1[2][2];
    const char* cA = (const char*)g.A + (size_t)cur.pm * tstep; const char* cB = (const char*)g.Bt + (size_t)cur.pn * tstep;
    S.a_ready(cur);
    PG8_STAGE(PG8_SB(0, 0), cB, voffB); PG8_STAGE(PG8_SA(0, 0), cA, voffA); PG8_STAGE(PG8_SB(0, 1), cB + hstep, voffB); PG8_STAGE(PG8_SA(0, 1), cA + hstep, voffA);
    if (wr == 1) PG8_BAR;
    PG8_WAIT_V(4); PG8_BAR;
    PG8_STAGE(PG8_SB(1, 0), cB + kstep, voffB); PG8_STAGE(PG8_SA(1, 0), cA + kstep, voffA); PG8_STAGE(PG8_SB(1, 1), cB + hstep + kstep, voffB);
    PG8_WAIT_V(6); PG8_BAR;
    PG8_STAMP();
    for (;;) {
        const bool has_next = S.next(ui + 1, nxt);
        const char* nA = has_next ? (const char*)g.A + (size_t)nxt.pm * tstep : cA; const char* nB = has_next ? (const char*)g.Bt + (size_t)nxt.pn * tstep : cB;
        for (int t = 0; t < nt; t += 2) {
            const bool last = (t == nt - 2);
            const char* a1 = cA + (size_t)(t + 1) * kstep;
            const char* a2 = last ? nA : cA + (size_t)(t + 2) * kstep; const char* b2 = last ? nB : cB + (size_t)(t + 2) * kstep;
            const char* a3 = a2 + kstep; const char* b3 = b2 + kstep;
            if (last && has_next) S.a_ready(nxt);
            PG8_LDB(B0, 0, 0); PG8_SCHED; PG8_LDA(At, 0, 0); PG8_STAGE(PG8_SA(1, 1), a1 + hstep, voffA);
            PG8_WAIT_L(8); PG8_BAR; PG8_WAIT_L(0); PG8_MMA(0, 0, At, B0); PG8_BAR; PG8_SCHED;
            PG8_LDB(B1, 0, 1); PG8_STAGE(PG8_SB(0, 0), b2, voffB);
            PG8_BAR; PG8_WAIT_L(0); PG8_MMA(0, 1, At, B1); PG8_BAR;
            PG8_LDA(At, 0, 1); PG8_STAGE(PG8_SA(0, 0), a2, voffA);
            PG8_BAR; PG8_WAIT_L(0); PG8_MMA(1, 0, At, B0); PG8_BAR; PG8_SCHED;
            PG8_STAGE(PG8_SB(0, 1), b2 + hstep, voffB);
            PG8_WAIT_V(6); PG8_BAR; PG8_MMA(1, 1, At, B1); PG8_BAR;
            PG8_LDB(B0, 1, 0); PG8_SCHED; PG8_LDA(At, 1, 0); PG8_STAGE(PG8_SA(0, 1), a2 + hstep, voffA);
            PG8_WAIT_L(8); PG8_BAR; PG8_WAIT_L(0); PG8_MMA(0, 0, At, B0); PG8_BAR; PG8_SCHED;
            PG8_LDB(B1, 1, 1); PG8_STAGE(PG8_SB(1, 0), b3, voffB);
            PG8_BAR; PG8_WAIT_L(0); PG8_MMA(0, 1, At, B1); PG8_BAR;
            PG8_LDA(At, 1, 1); PG8_STAGE(PG8_SA(1, 0), a3, voffA);
            PG8_BAR; PG8_WAIT_L(0); PG8_MMA(1, 0, At, B0); PG8_BAR; PG8_SCHED;
            PG8_STAGE(PG8_SB(1, 1), b3 + hstep, voffB);
            PG8_WAIT_V(6); PG8_BAR; PG8_MMA(1, 1, At, B1); PG8_BAR;
        }
        PG8_STAMP();
        if constexpr (!Epi::AFTER_DRAIN) { E(acc, cur, wr, wc, fr, fq); S.done(cur); }
        PG8_STAMP();
        if (!has_next) break;
#pragma unroll
        for (int a = 0; a < 2; ++a)
#pragma unroll
            for (int b = 0; b < 2; ++b)
#pragma unroll
                for (int m = 0; m < 4; ++m)
#pragma unroll
                    for (int n = 0; n < 2; ++n) acc[a][b][m][n] = (f32x4){0.f, 0.f, 0.f, 0.f};
        cur = nxt; cA = nA; cB = nB; ++ui;
    }
    PG8_WAIT_V(0);
    if (wr == 0) PG8_BAR;
    PG8_BAR;
    if constexpr (Epi::AFTER_DRAIN) { E.fused(acc, cur, wr, wc, fr, fq, lds, wid, lane); S.done(cur); }
    PG8_STAMP();
    if (STAMP && wid == 0) { stamps[lane] = lane < nts ? (((unsigned long long)(unsigned)ts_hi << 32) | (unsigned)ts_lo) : 0ull;
        if (lane == 62) stamps[62] = rt_entry; if (lane == 63) stamps[63] = (unsigned long long)wall_clock64(); }
#undef PG8_STAMP
#undef PG8_SA
#undef PG8_SB
#undef PG8_STAGE
#undef PG8_LDA
#undef PG8_LDB
#undef PG8_MMA
#undef PG8_WAIT_V
#undef PG8_WAIT_L
#undef PG8_BAR
#undef PG8_SCHED
}
}

#define XB_TMO      128
#define XB_XCNT(j)  (256  + 64 * (j))
#define XB_XSUB(j)  (1280 + 64 * (j))
#define XB_XGEN(j)  (2304 + 64 * (j))
#define XB_TOP      3328
#define XB_TOPGEN   3392
#define XCD_BAR_WORDS 3456
#define XB_SPIN_CAP (1u << 18)
#define LAS __attribute__((address_space(3)))

__device__ __forceinline__ unsigned xb_ld(unsigned* p)              { return __hip_atomic_load(p, __ATOMIC_RELAXED, __HIP_MEMORY_SCOPE_AGENT); }
__device__ __forceinline__ unsigned xb_add(unsigned* p, unsigned v) { return __hip_atomic_fetch_add(p, v, __ATOMIC_RELAXED, __HIP_MEMORY_SCOPE_AGENT); }
__device__ __forceinline__ unsigned xb_xcc_id() { return (unsigned)__builtin_amdgcn_s_getreg((3 << 11) | 20) & 0xFu; }
#define XB_SPIN(cond, bar) do { unsigned _sp = 0; while (cond) { __builtin_amdgcn_s_sleep(1); \
    if ((++_sp & 255u) == 0u) { if (xb_ld(&(bar)[XB_TMO])) break; if (_sp > XB_SPIN_CAP) { atomicAdd(&(bar)[XB_TMO], 1u); break; } } } } while (0)

struct XcdBarrier {
    unsigned* bar; unsigned x;
    volatile LAS unsigned* st;
};

__device__ __forceinline__ XcdBarrier xcd_barrier_post(unsigned* bar, volatile LAS unsigned* st) {
    XcdBarrier b; b.bar = bar; b.x = xb_xcc_id(); b.st = st;
    if (threadIdx.x == 0) (void)xb_add(&bar[XB_XCNT(b.x)], 1u);
    return b;
}
__device__ __forceinline__ void xcd_barrier_complete(unsigned* bar, unsigned x, unsigned& nloc, unsigned& nx) {
    const unsigned G = gridDim.x * gridDim.y * gridDim.z;
    unsigned sum, cnt, mine, sp = 0u;
    for (;;) {
        sum = 0u; cnt = 0u; mine = 0u;
#pragma unroll
        for (unsigned j = 0; j < 16; ++j) { const unsigned c = xb_ld(&bar[XB_XCNT(j)]); sum += c; cnt += (c > 0u) ? 1u : 0u; mine = (j == x) ? c : mine; }
        if (sum == G) break;
        __builtin_amdgcn_s_sleep(1);
        if ((++sp & 255u) == 0u) { if (xb_ld(&bar[XB_TMO])) break; if (sp > XB_SPIN_CAP) { atomicAdd(&bar[XB_TMO], 1u); break; } }
    }
    nloc = mine > 0u ? mine : 1u; nx = cnt > 0u ? cnt : 1u;
}

__device__ __forceinline__ void xcd_barrier(const XcdBarrier& b) {
    asm volatile("s_waitcnt vmcnt(0)" ::: "memory");
    __syncthreads();
    if (threadIdx.x == 0) {
        unsigned* bar = b.bar;
        __builtin_amdgcn_s_waitcnt(0);
        unsigned nloc = b.st[0], nx = b.st[1];
        if (nloc == 0u) { xcd_barrier_complete(bar, b.x, nloc, nx); b.st[0] = nloc; b.st[1] = nx; }
        const unsigned old = xb_add(&bar[XB_XSUB(b.x)], 1u);
        const unsigned gen = old / nloc;
        if (old + 1u == (gen + 1u) * nloc) {
            __builtin_amdgcn_fence(__ATOMIC_RELEASE, "agent");
            asm volatile("s_waitcnt vmcnt(0)" ::: "memory");
            const unsigned og = xb_add(&bar[XB_TOP], 1u);
            const unsigned tg = og / nx;
            if (og + 1u == (tg + 1u) * nx) xb_add(&bar[XB_TOPGEN], 1u);
            else XB_SPIN(xb_ld(&bar[XB_TOPGEN]) == tg, bar);
            __builtin_amdgcn_fence(__ATOMIC_ACQUIRE, "agent");
            xb_add(&bar[XB_XGEN(b.x)], 1u);
            asm volatile("s_waitcnt vmcnt(0)" ::: "memory");
        } else {
            XB_SPIN(xb_ld(&bar[XB_XGEN(b.x)]) == gen, bar);
            __builtin_amdgcn_fence(__ATOMIC_ACQUIRE, "agent");
            asm volatile("s_waitcnt vmcnt(0)" ::: "memory");
        }
    }
    __syncthreads();
}

typedef unsigned short bf16_t;
typedef short bf16x8 __attribute__((ext_vector_type(8)));
typedef float f32x4 __attribute__((ext_vector_type(4)));
typedef unsigned u32x4 __attribute__((ext_vector_type(4)));
typedef unsigned u32x2 __attribute__((ext_vector_type(2)));

constexpr int IDSTR = 132;
#ifndef GATHER_SWEEP
#define GATHER_SWEEP 6
#endif
#ifndef DUP_MASK
#define DUP_MASK 0
#ifndef S8_REPS
#define S8_REPS 1
#endif
#ifndef S8_HOT
#define S8_HOT 1
#endif
#define GEXP 3
#endif
#define DUP(k) ((DUP_MASK >> (k)) & 1)
constexpr int NT = 512;
constexpr int D = 1024, NB = 8, SEQ = 2048, CTXL = 256;
constexpr int MLAT = NB * SEQ, MCTX = NB * CTXL, MALL = MLAT + MCTX;
constexpr int ZG_LD = 2048, ZR_LD = 3584, Z3_LD = 3072;
constexpr int N1 = 5632, N2 = 3072, NIN = N1 + N2;
constexpr int ZR_OFF = 32;
constexpr int NSC = 18432 / 16, ZRL_LD = 512;
__host__ __device__ __forceinline__ size_t orf(int T, int head, int lq, int half) { return (size_t)((((((T >> 4) * 16 + head) * 2 + half) * 4 + lq) * 16) + (T & 15)) << 3; }
__host__ __device__ __forceinline__ size_t zlf(int T, int blk, int lq, int half) { return (size_t)((((((T >> 4) * 3 + blk) * 2 + half) * 4 + lq) * 16) + (T & 15)) << 3; }
__host__ __device__ __forceinline__ size_t zrf(int qn, int T, int head, int lq, int half) { return (size_t)(((((((qn * NSC + (T >> 4)) * 16 + head) * 2 + half) * 4 + lq) * 16) + (T & 15))) << 3; }
constexpr int MODW = 6144;
constexpr int LDS_BYTES = 163840, LDS_HDR = 64;

constexpr size_t WS_CTL   = 0;
constexpr size_t WS_MOD   = 65536;
constexpr size_t WS_BONUS = WS_MOD + 262144;
constexpr size_t WS_WIN   = WS_BONUS + 1048576;
constexpr size_t WS_WOUT  = WS_WIN + (size_t)NIN * 1024 * 2;
constexpr size_t WS_WQ    = WS_WOUT + (size_t)1024 * 1024 * 2;
constexpr size_t WS_G2T   = WS_WQ + (size_t)2048 * 1024 * 2;
constexpr size_t WS_SK    = WS_G2T + (size_t)1024 * 192 * 2;
constexpr size_t WS_A1    = WS_SK + (size_t)16 * 128 * 128 * 2;
constexpr size_t WS_ZG    = WS_A1 + (size_t)MALL * 1024 * 2;
constexpr size_t WS_ZR    = WS_ZG + (size_t)MALL * ZG_LD * 2;
constexpr size_t WS_ZL    = WS_ZR + (size_t)MALL * ZR_LD * 2;
constexpr int ZL_LD = 352;
constexpr size_t WS_END   = WS_ZL + (size_t)MALL * ZL_LD * 2;
constexpr size_t WS_ZQ    = WS_ZG;
constexpr size_t WS_ZK    = WS_ZG + (size_t)MALL * 512 * 2;
constexpr size_t WS_ZV    = WS_ZG + (size_t)MALL * 1024 * 2;
constexpr size_t WS_ALO   = WS_ZQ + (size_t)MLAT * 512 * 2;
constexpr size_t WS_ORF   = WS_ZG;
constexpr size_t WS_ORB   = WS_ZG + (size_t)MLAT * 1024 * 2;
constexpr size_t WS_Q     = WS_ZG;
constexpr size_t WS_ZRL   = WS_ZR + (size_t)18432 * 3072 * 2;
constexpr size_t WS_Z3    = WS_ZR;
constexpr size_t WS_UT    = WS_ZR;
constexpr size_t WS_VT    = WS_UT + (size_t)16384 * 1024;
constexpr size_t WS_IDX   = WS_VT + (size_t)16384 * 1024;
constexpr size_t WS_GATE  = WS_IDX + (size_t)MLAT * 128 * 4;
static_assert(WS_GATE + (size_t)MLAT * 128 * 4 <= WS_ZL, "ws map");
static_assert(WS_ORB + (size_t)MLAT * 1024 * 2 <= WS_ZR, "ws map");

typedef const float* const __attribute__((address_space(4))) * KArgPtr;
struct Ctx { KArgPtr in; float* out; unsigned char* ws; };
#define CIN(k) (c.in[k])
struct Args { const float* in[29]; float* out; unsigned char* ws; int ph_lo, ph_hi; };

typedef __bf16 hwbf16x2 __attribute__((ext_vector_type(2)));
typedef float f32x2v __attribute__((ext_vector_type(2)));
__device__ __forceinline__ unsigned pk2(float lo, float hi) { const f32x2v f = {lo, hi}; const hwbf16x2 v = __builtin_convertvector(f, hwbf16x2); return __builtin_bit_cast(unsigned, v); }
__device__ __forceinline__ bf16_t f2bf(float f) { return (bf16_t)(pk2(f, 0.f) & 0xffffu); }
__device__ __forceinline__ float bflo(unsigned w) { return __uint_as_float(w << 16); }
__device__ __forceinline__ float bfhi(unsigned w) { return __uint_as_float(w & 0xffff0000u); }
__device__ __forceinline__ float bf2f(bf16_t b) { return __uint_as_float(((unsigned)b) << 16); }
__device__ __forceinline__ void unpack8(const u32x4 w, float* o) { o[0] = bflo(w.x); o[1] = bfhi(w.x); o[2] = bflo(w.y); o[3] = bfhi(w.y); o[4] = bflo(w.z); o[5] = bfhi(w.z); o[6] = bflo(w.w); o[7] = bfhi(w.w); }
__device__ __forceinline__ u32x4 pack8(const float* v) { u32x4 w; w.x = pk2(v[0], v[1]); w.y = pk2(v[2], v[3]); w.z = pk2(v[4], v[5]); w.w = pk2(v[6], v[7]); return w; }
__device__ __forceinline__ u32x4 ldg16(const bf16_t* p) { return *(const u32x4*)p; }
__device__ __forceinline__ float fexp(float x) { return __builtin_amdgcn_exp2f(x * 1.4426950408889634f); }
__device__ __forceinline__ float flog(float x) { return __builtin_amdgcn_logf(x) * 0.6931471805599453f; }
__device__ __forceinline__ float sigmoidf_(float x) { return __builtin_amdgcn_rcpf(1.0f + fexp(-x)); }
__device__ __forceinline__ float wave_sum(float v) {
#pragma unroll
    for (int o = 32; o > 0; o >>= 1) v += __shfl_xor(v, o);
    return v;
}
#define LDS_FENCE() asm volatile("s_waitcnt lgkmcnt(0)" ::: "memory")

__device__ __forceinline__ int win_src(int n) {
    if (n < 2048) return n;
    if (n < N1) { const int j = n - 2048; if (j < 16) return 3072 + j; if (j < 32) return 3088 + (j - 16); if (j < 32 + 3424) { int cr = j - 32; if (cr < 3072) { const int p = cr & 15; cr = (cr & ~15) + (p & 3) * 4 + (p >> 2); } return 3104 + cr; } return -1; }
    const int j = n - N1; return j < 1024 ? 2048 + j : 6528 + (j - 1024);
}
template <int MODE> __device__ __forceinline__ void transpose_tile(const float* __restrict__ src, int ld, bf16_t* __restrict__ dst, int n0, int k0, LAS float* tile) {
    const int tid = threadIdx.x;
#pragma unroll
    for (int e = 0; e < 8; ++e) { const int idx = tid + e * NT, kk = idx >> 6, nn = idx & 63; const int n = n0 + nn; const int s = MODE == 0 ? win_src(n) : n;
        tile[kk * 65 + nn] = s >= 0 ? src[(size_t)(k0 + kk) * ld + s] : 0.f; }
    __syncthreads();
#pragma unroll
    for (int e = 0; e < 4; ++e) { const int idx = tid + e * NT, nn = idx >> 5, kp = idx & 31;
        *(unsigned*)(dst + (size_t)(n0 + nn) * 1024 + k0 + kp * 2) = pk2(tile[(kp * 2) * 65 + nn], tile[(kp * 2 + 1) * 65 + nn]); }
    __syncthreads();
}
__device__ __forceinline__ void p0_prologue(const Ctx& c, LAS unsigned char* lds) {
    const int tid = threadIdx.x, G = gridDim.x, bx = blockIdx.x;
    LAS float* tile = (LAS float*)lds;
    bf16_t* Wt_in = (bf16_t*)(c.ws + WS_WIN); bf16_t* Wt_out = (bf16_t*)(c.ws + WS_WOUT); bf16_t* Wt_q = (bf16_t*)(c.ws + WS_WQ);
    constexpr int T_IN = (NIN / 64) * 16, T_OUT = 16 * 16, T_Q = 32 * 16;
    for (int rep_ = 0; rep_ < (DUP(22) ? 2 : 1); ++rep_)
    for (int t = bx; t < T_IN + T_OUT + T_Q; t += G) {
        if (t < T_IN) transpose_tile<0>(CIN(7), 8576, Wt_in, (t >> 4) * 64, (t & 15) * 64, tile);
        else if (t < T_IN + T_OUT) { const int u = t - T_IN; transpose_tile<1>(CIN(22), 1024, Wt_out, (u >> 4) * 64, (u & 15) * 64, tile); }
        else { const int u = t - T_IN - T_OUT; transpose_tile<1>(CIN(24), 2048, Wt_q, (u >> 4) * 64, (u & 15) * 64, tile); }
    }
    bf16_t* g2t = (bf16_t*)(c.ws + WS_G2T); bf16_t* sk = (bf16_t*)(c.ws + WS_SK);
    for (int i = bx * NT + tid; i < 1024 * 192; i += G * NT) { const int n = i / 192, j = i - n * 192;
        g2t[(((((n >> 4) * 6 + (j >> 5)) * 64) + ((j >> 3) & 3) * 16 + (n & 15)) << 3) + (j & 7)] = f2bf(j < 160 ? CIN(16)[j * 1024 + n] : 0.f); }
    for (int i = bx * NT + tid; i < 16 * 128 * 128; i += G * NT) { const int hp = i >> 14, n = (i >> 7) & 127, k = i & 127;
        sk[((((hp * 8 + (n >> 4)) * 4 + (k >> 5)) * 64 + ((k >> 3) & 3) * 16 + (n & 15)) << 3) + (k & 7)] = f2bf(CIN(25)[i]); }
    LAS float* sc = (LAS float*)lds;
    LAS float* part = sc + 9 * 1024;
    float* m = (float*)(c.ws + WS_MOD);
    for (int rep_ = 0; rep_ < (DUP(23) ? 2 : 1); ++rep_)
    for (int cg = bx; cg < MODW / 24; cg += G) {
        __syncthreads();
        for (int i = tid; i < 9 * 1024; i += NT) { const float v = i < 8192 ? CIN(1)[i] : CIN(3)[i - 8192]; sc[i] = v * sigmoidf_(v); }
        __syncthreads();
        const int c0 = cg * 24;
        if (tid < 504) { const int col = tid % 24, kp = tid / 24; float acc[9];
#pragma unroll
            for (int r = 0; r < 9; ++r) acc[r] = 0.f;
            for (int k = kp; k < 1024; k += 21) { const float w = CIN(5)[(size_t)k * MODW + c0 + col];
#pragma unroll
                for (int r = 0; r < 9; ++r) acc[r] += sc[r * 1024 + k] * w; }
#pragma unroll
            for (int r = 0; r < 9; ++r) part[(kp * 9 + r) * 24 + col] = acc[r]; }
        __syncthreads();
        if (tid < 216) { const int r = tid / 24, col = tid % 24; float s = CIN(6)[c0 + col];
            for (int kp = 0; kp < 21; ++kp) s += part[(kp * 9 + r) * 24 + col];
            m[r * MODW + c0 + col] = s; }
    }
    __syncthreads();
}

__device__ __forceinline__ void norm_mod_row(const float* __restrict__ src, const float* __restrict__ nw, const float* __restrict__ shift, const float* __restrict__ scale, bf16_t* __restrict__ dst, int lane) {
    f32x4 v[4]; float ss = 0.f;
#pragma unroll
    for (int j = 0; j < 4; ++j) { v[j] = *(const f32x4*)(src + (j * 64 + lane) * 4); ss += v[j][0] * v[j][0] + v[j][1] * v[j][1] + v[j][2] * v[j][2] + v[j][3] * v[j][3]; }
    ss = wave_sum(ss);
    const float rstd = rsqrtf(ss * (1.0f / 1024.0f) + 1e-6f);
#pragma unroll
    for (int j = 0; j < 4; ++j) { const int c0 = (j * 64 + lane) * 4; const f32x4 w = *(const f32x4*)(nw + c0), sh = *(const f32x4*)(shift + c0), sc = *(const f32x4*)(scale + c0);
        float y[4];
#pragma unroll
        for (int e = 0; e < 4; ++e) y[e] = v[j][e] * rstd * w[e] * (1.0f + sc[e]) + sh[e];
        u32x2 o; o.x = pk2(y[0], y[1]); o.y = pk2(y[2], y[3]); *(u32x2*)(dst + c0) = o; }
}
__device__ __forceinline__ void norm_mod_row2(const float* __restrict__ s0, const float* __restrict__ s1, const float* __restrict__ nw, const float* __restrict__ sh0, const float* __restrict__ sc0,
                                              const float* __restrict__ sh1, const float* __restrict__ sc1, bf16_t* __restrict__ d0, bf16_t* __restrict__ d1, int lane) {
    f32x4 v0[4], v1[4]; float a0 = 0.f, a1 = 0.f;
#pragma unroll
    for (int j = 0; j < 4; ++j) { v0[j] = *(const f32x4*)(s0 + (j * 64 + lane) * 4); v1[j] = *(const f32x4*)(s1 + (j * 64 + lane) * 4); }
#pragma unroll
    for (int j = 0; j < 4; ++j) { a0 += v0[j][0] * v0[j][0] + v0[j][1] * v0[j][1] + v0[j][2] * v0[j][2] + v0[j][3] * v0[j][3]; a1 += v1[j][0] * v1[j][0] + v1[j][1] * v1[j][1] + v1[j][2] * v1[j][2] + v1[j][3] * v1[j][3]; }
#pragma unroll
    for (int o = 32; o > 0; o >>= 1) { a0 += __shfl_xor(a0, o); a1 += __shfl_xor(a1, o); }
    const float r0 = rsqrtf(a0 * (1.0f / 1024.0f) + 1e-6f), r1 = rsqrtf(a1 * (1.0f / 1024.0f) + 1e-6f);
#pragma unroll
    for (int j = 0; j < 4; ++j) { const int c0 = (j * 64 + lane) * 4; const f32x4 w = *(const f32x4*)(nw + c0), h0 = *(const f32x4*)(sh0 + c0), g0 = *(const f32x4*)(sc0 + c0), h1 = *(const f32x4*)(sh1 + c0), g1 = *(const f32x4*)(sc1 + c0);
        float y0[4], y1[4];
#pragma unroll
        for (int e = 0; e < 4; ++e) { y0[e] = v0[j][e] * r0 * w[e] * (1.0f + g0[e]) + h0[e]; y1[e] = v1[j][e] * r1 * w[e] * (1.0f + g1[e]) + h1[e]; }
        u32x2 o; o.x = pk2(y0[0], y0[1]); o.y = pk2(y0[2], y0[3]); *(u32x2*)(d0 + c0) = o; o.x = pk2(y1[0], y1[1]); o.y = pk2(y1[2], y1[3]); *(u32x2*)(d1 + c0) = o; }
}
__device__ __forceinline__ void p1_norm1(const Ctx& c) {
    const int lane = threadIdx.x & 63, wave = threadIdx.x >> 6; const float* m = (const float*)(c.ws + WS_MOD); bf16_t* A1 = (bf16_t*)(c.ws + WS_A1);
    const int stride = gridDim.x * 8;
    for (int row = blockIdx.x * 8 + wave; row < MALL; row += 2 * stride) {
        const int rb = row + stride;
        const float* s0 = row < MLAT ? CIN(0) + (size_t)row * D : CIN(2) + (size_t)(row - MLAT) * D; const int m0 = row < MLAT ? row / SEQ : 8;
        if (rb < MALL) { const float* s1 = rb < MLAT ? CIN(0) + (size_t)rb * D : CIN(2) + (size_t)(rb - MLAT) * D; const int m1 = rb < MLAT ? rb / SEQ : 8;
            norm_mod_row2(s0, s1, CIN(4), m + m0 * MODW, m + m0 * MODW + 1024, m + m1 * MODW, m + m1 * MODW + 1024, A1 + (size_t)row * D, A1 + (size_t)rb * D, lane); }
        else norm_mod_row(s0, CIN(4), m + m0 * MODW, m + m0 * MODW + 1024, A1 + (size_t)row * D, lane);
    }
}
template <int MODE  > struct EpiB {
    static constexpr bool PERM = true, AFTER_DRAIN = false;
    bf16_t* O0; bf16_t* O1; int ldc;
    __device__ __forceinline__ void operator()(const pg8::f32x4 (&acc)[2][2][4][2], const pg8::Unit& u, int wr, int wc, int fr, int fq) const {
        const int row0 = u.pm * 256 + wr * 64 + fr; int colt = u.pn * 256; bf16_t* base = O0; int ld = ldc;
        if (MODE == 0) { if (u.pn >= 8) { base = O1; ld = ZR_LD; colt -= 2048; } else { ld = ZG_LD; } }
        const int col0 = colt + wc * 32 + 8 * fq;
        const bool is_silu = (MODE == 1) && (u.pn < 4);
#pragma unroll
        for (int ai = 0; ai < 2; ++ai)
#pragma unroll
            for (int m = 0; m < 4; ++m) { bf16_t* rowp = base + (size_t)(row0 + ai * 128 + m * 16) * ld + col0;
#pragma unroll
                for (int bj = 0; bj < 2; ++bj) { float v[8];
#pragma unroll
                    for (int j = 0; j < 4; ++j) { v[j] = acc[ai][bj][m][0][j]; v[4 + j] = acc[ai][bj][m][1][j]; }
                    if (MODE == 1) {
#pragma unroll
                        for (int j = 0; j < 8; ++j) { const float s = sigmoidf_(v[j]); v[j] = is_silu ? v[j] * s : s; } }
                    if (MODE == 0 && u.pn < 4) {
                        const int chunk = (row0 + ai * 128 + m * 16) >> 6, head = (2 * u.pn + bj) & 3;
                        bf16_t* blk = O0 + (u.pn >= 2 ? (size_t)MALL * 512 : (size_t)0) + ((size_t)(chunk * 4 + head) << 13);
                        const u32x4 w = pack8(v); const int wv_c = 2 * wc + (fq >> 1), lq_c = 2 * (fq & 1);
                        *(u32x2*)(blk + (((wv_c * 4 + m) * 64 + lq_c * 16 + fr) << 2)) = (u32x2){w.x, w.y};
                        *(u32x2*)(blk + (((wv_c * 4 + m) * 64 + (lq_c + 1) * 16 + fr) << 2)) = (u32x2){w.z, w.w};
                    } else if (MODE == 0 && u.pn < 8) {
                        *(u32x4*)(O0 + (size_t)MALL * 1024 + (size_t)(row0 + ai * 128 + m * 16) * 1024 + (u.pn - 4) * 256 + bj * 128 + wc * 32 + 8 * fq) = pack8(v);
                    } else if (MODE == 0 && u.pn == 8 && bj == 0 && wc == 0) {
                        const int chunk = (row0 + ai * 128 + m * 16) >> 6;
                        *(u32x4*)(O0 + (size_t)MLAT * 512 + ((size_t)((((chunk * 2 + (fq >> 1)) * 4 + m) * 2 + (fq & 1)) * 16 + fr) << 3)) = pack8(v);
                    } else if (MODE == 0 && u.pn >= 8) {
                        const int row = row0 + ai * 128 + m * 16, zc = (u.pn - 8) * 256 + bj * 128 + wc * 32 + 8 * fq, rc = zc - 32;
                        const size_t fo = zrf(rc >> 10, row, (rc >> 6) & 15, (rc >> 4) & 3, (rc >> 3) & 1), lo = (size_t)MALL * 3072 + (size_t)row * ZRL_LD + (zc - 3072);
                        *(u32x4*)(O1 + (zc < 3104 ? fo : lo)) = pack8(v);
                    } else if (MODE == 3) {
                        const int tile = (row0 + ai * 128 + m * 16) >> 4;
                        *(u32x4*)(O0 + ((size_t)((((tile * 8 + u.pn) * 2 + bj) * 4 + wc) * 64 + fq * 16 + fr) << 3)) = pack8(v);
                    } else *(u32x4*)(rowp + bj * 128) = pack8(v); } }
    }
};
template <int STEP> struct EpiMix {
    static constexpr bool PERM = true, AFTER_DRAIN = false;
    bf16_t* T; bf16_t* YR;
    __device__ __forceinline__ void operator()(const pg8::f32x4 (&acc)[2][2][4][2], const pg8::Unit& u, int wr, int wc, int fr, int fq) const {
        const int row0 = u.pm * 256 + wr * 64 + fr, col0 = u.pn * 256 + wc * 32 + 8 * fq;
#pragma unroll
        for (int ai = 0; ai < 2; ++ai)
#pragma unroll
            for (int m = 0; m < 4; ++m) { const size_t ro = (size_t)(row0 + ai * 128 + m * 16) * D + col0;
#pragma unroll
                for (int bj = 0; bj < 2; ++bj) { float v[8], t[8];
#pragma unroll
                    for (int j = 0; j < 4; ++j) { v[j] = acc[ai][bj][m][0][j]; v[4 + j] = acc[ai][bj][m][1][j]; }
                    unpack8(ldg16(T + ro + bj * 128), t);
                    if (STEP == 0) {
#pragma unroll
                        for (int j = 0; j < 8; ++j) t[j] *= v[j] * sigmoidf_(v[j]);
                        *(u32x4*)(T + ro + bj * 128) = pack8(t);
                    } else if (STEP == 1) {
#pragma unroll
                        for (int j = 0; j < 8; ++j) t[j] *= sigmoidf_(v[j]);
                        *(u32x4*)(T + ro + bj * 128) = pack8(t);
                    } else { float r[8]; unpack8(ldg16(YR + ro + bj * 128), r);
#pragma unroll
                        for (int j = 0; j < 8; ++j) t[j] += sigmoidf_(v[j]) * r[j];
                        *(u32x4*)(YR + ro + bj * 128) = pack8(t); } } }
    }
};
struct EpiH1 {
    static constexpr bool PERM = false, AFTER_DRAIN = false;
    const float* x; const float* m; float* h1;
    __device__ __forceinline__ void operator()(const pg8::f32x4 (&acc)[2][2][4][2], const pg8::Unit& u, int wr, int wc, int fr, int fq) const {
        const int row0 = u.pm * 256 + wr * 64 + fr, col0 = u.pn * 256 + wc * 32 + 4 * fq;
        const float* g = m + (size_t)((u.pm * 256) / SEQ) * MODW + 2048;
        f32x4 gv[2][2];
#pragma unroll
        for (int bj = 0; bj < 2; ++bj)
#pragma unroll
            for (int n = 0; n < 2; ++n) gv[bj][n] = *(const f32x4*)(g + col0 + bj * 128 + n * 16);
#pragma unroll
        for (int ai = 0; ai < 2; ++ai)
#pragma unroll
            for (int mm = 0; mm < 4; ++mm) { const size_t ro = (size_t)(row0 + ai * 128 + mm * 16) * D + col0;
#pragma unroll
                for (int bj = 0; bj < 2; ++bj)
#pragma unroll
                    for (int n = 0; n < 2; ++n) { const f32x4 xv = *(const f32x4*)(x + ro + bj * 128 + n * 16); *(f32x4*)(h1 + ro + bj * 128 + n * 16) = xv + gv[bj][n] * acc[ai][bj][mm][n]; } }
    }
};

struct Gemm1Order : pg8::StaticOrder {
    __device__ bool next(int i, pg8::Unit& u) const {
        const long L = (long)i * G + c;
        if (L < 1408) return pg8::StaticOrder::next(i, u);
        const int k = (int)(L - 1408); if (k >= 128) return false;
        const int t = k >> 3; u.pm = 64 + (k & 7); u.pn = t < 6 ? 2 + t : (t == 6 ? 8 : 5 + t);
        return true;
    }
};

#define MFMA16(a, b, c) __builtin_amdgcn_mfma_f32_16x16x32_bf16(a, b, c, 0, 0, 0)
__device__ __forceinline__ float logsigmoidf_(float x) { return fminf(x, 0.f) - flog(1.0f + fexp(-fabsf(x))); }
#define DPP_F(x, ctrl) __builtin_bit_cast(float, __builtin_amdgcn_update_dpp(0, __builtin_bit_cast(int, (x)), (ctrl), 0xf, 0xf, true))
constexpr int GLA_OP_BYTES = 17408 + 17408 + 18432 + 9216 + 512;
__device__ __forceinline__ void p3_gla(const Ctx& c, LAS unsigned char* lds) {
    const int tid = threadIdx.x, lane = tid & 63, wave = tid >> 6, l15 = lane & 15, lq = lane >> 4;
    LAS bf16_t* St = (LAS bf16_t*)(lds + 2 * GLA_OP_BYTES);
    LAS bf16_t* WAT = St + 64 * 136;
    LAS float* BA = (LAS float*)(WAT + 128 * 40);
    LAS bf16_t* OBF = (LAS bf16_t*)(BA + 128);
    const bf16_t* Zq = (const bf16_t*)(c.ws + WS_ZQ); const bf16_t* Zk = (const bf16_t*)(c.ws + WS_ZK); const bf16_t* Zv = (const bf16_t*)(c.ws + WS_ZV); const bf16_t* Alo = (const bf16_t*)(c.ws + WS_ALO);
    bf16_t* og_f = (bf16_t*)c.out; bf16_t* og_b = og_f + (size_t)MLAT * D;
    const int ti = tid >> 3, seg = tid & 7;
    for (int u = blockIdx.x; u < 256; u += gridDim.x) {
        const int dir = u & 1, dvs = (u >> 1) & 3, h = (u >> 3) & 3, b = u >> 5;
        bf16_t* og = dir ? og_b : og_f;
        __syncthreads();
        for (int i = tid; i < 128 * 40; i += NT) { const int d = i / 40, j = i - d * 40; WAT[i] = f2bf(j < 16 ? CIN(8)[(size_t)(dir * 16 + j) * 512 + h * 128 + d] : 0.f); }
        if (tid < 128) BA[tid] = CIN(9)[dir * 512 + h * 128 + tid];
        for (int i = tid; i < 64 * 136 / 2; i += NT) ((LAS unsigned*)St)[i] = 0u;
        f32x4 accS[4];
#pragma unroll
        for (int n = 0; n < 4; ++n) accS[n] = (f32x4){0.f, 0.f, 0.f, 0.f};
        __syncthreads();
        const int d0 = wave * 16 + lq * 4;
        const bf16x8 wfr = *(LAS bf16x8*)(WAT + (wave * 16 + l15) * 40 + lq * 8);
        float bad[4];
#pragma unroll
        for (int r = 0; r < 4; ++r) bad[r] = BA[d0 + r];
#pragma unroll 1
        for (int step = 0; step <= 36; ++step) {
            const bool latn = step >= 4;
            const int cidxn = latn ? (dir ? 31 - (step - 4) : step - 4) : (dir ? 3 - step : step);
            const int rbasen = (latn ? b * SEQ : MLAT + b * CTXL) + cidxn * 64;
            u32x4 vw = (u32x4){0u, 0u, 0u, 0u}, alw[4]; u32x2 qw[4], kw[4];
            if (step < 36) {
                vw = ldg16(Zv + (size_t)(rbasen + (dir ? 63 - ti : ti)) * 1024 + h * 256 + dvs * 64 + seg * 8);
                const int chk = rbasen >> 6;
#pragma unroll
                for (int mt = 0; mt < 4; ++mt) { const int mtp = dir ? 3 - mt : mt, lp = dir ? 15 - l15 : l15;
                    alw[mt] = (u32x4){0u, 0u, 0u, 0u}; if (lq < 2) alw[mt] = ldg16(Alo + ((size_t)((((chk * 2 + dir) * 4 + mtp) * 2 + lq) * 16 + lp) << 3));
                    const size_t fo = ((size_t)(chk * 4 + h) << 13) + (size_t)(((wave * 4 + mtp) * 64 + lq * 16 + lp) << 2);
                    qw[mt] = (u32x2){0u, 0u}; if (latn) qw[mt] = *(const u32x2*)(Zq + fo);
                    kw[mt] = *(const u32x2*)(Zk + fo); }
            }
            const int sp = step - 1; const bool lat = sp >= 4;
            const int cidx = lat ? (dir ? 31 - (sp - 4) : sp - 4) : (dir ? 3 - sp : sp);
            const int rbase = (lat ? b * SEQ : MLAT + b * CTXL) + cidx * 64;
            if (step >= 1) {
                LAS unsigned char* op = lds + (sp & 1) * GLA_OP_BYTES;
                LAS bf16_t* Qd = (LAS bf16_t*)op; LAS bf16_t* Kd = Qd + 64 * 136; LAS bf16_t* Kt = Kd + 64 * 136; LAS bf16_t* Vt = Kt + 128 * 72; LAS float* EBL = (LAS float*)(Vt + 64 * 72);
                const int mi = wave >> 1;
                if (lat) {
                    bf16x8 qf[4];
#pragma unroll
                    for (int ks = 0; ks < 4; ++ks) qf[ks] = *(LAS bf16x8*)(Qd + (mi * 16 + l15) * 136 + ks * 32 + lq * 8);
                    unsigned xa[4][2];
#pragma unroll
                    for (int jt = 0; jt < 4; ++jt) { f32x4 x = (f32x4){0.f, 0.f, 0.f, 0.f};
                        if (jt <= mi) {
#pragma unroll
                            for (int ks = 0; ks < 4; ++ks) x = MFMA16(*(LAS bf16x8*)(Kd + (jt * 16 + l15) * 136 + ks * 32 + lq * 8), qf[ks], x);
                            if (jt == mi) {
#pragma unroll
                                for (int r = 0; r < 4; ++r) x[r] = (lq * 4 + r <= l15) ? x[r] : 0.f; } }
                        xa[jt][0] = pk2(x[0], x[1]); xa[jt][1] = pk2(x[2], x[3]); }
#pragma unroll
                    for (int t2 = 0; t2 < 2; ++t2) { const int nt = (wave & 1) * 2 + t2; f32x4 a = (f32x4){0.f, 0.f, 0.f, 0.f};
#pragma unroll
                        for (int ks = 0; ks < 4; ++ks) a = MFMA16(qf[ks], *(LAS bf16x8*)(St + (nt * 16 + l15) * 136 + ks * 32 + lq * 8), a);
#pragma unroll
                        for (int ks = 0; ks < 2; ++ks) {
                            const u32x4 aw = (u32x4){xa[2 * ks][0], xa[2 * ks][1], xa[2 * ks + 1][0], xa[2 * ks + 1][1]};
                            const u32x2 b0 = *(LAS u32x2*)(Vt + (nt * 16 + l15) * 72 + ks * 32 + lq * 4), b1 = *(LAS u32x2*)(Vt + (nt * 16 + l15) * 72 + ks * 32 + 16 + lq * 4);
                            const u32x4 bw = (u32x4){b0.x, b0.y, b1.x, b1.y};
                            a = MFMA16(__builtin_bit_cast(bf16x8, aw), __builtin_bit_cast(bf16x8, bw), a); }
#pragma unroll
                        for (int r = 0; r < 4; ++r) OBF[(mi * 16 + lq * 4 + r) * 72 + nt * 16 + l15] = f2bf(a[r]); }
                }
                { float eb[4];
#pragma unroll
                    for (int r = 0; r < 4; ++r) eb[r] = EBL[wave * 16 + lq * 4 + r];
#pragma unroll
                    for (int nt = 0; nt < 4; ++nt) {
#pragma unroll
                        for (int r = 0; r < 4; ++r) accS[nt][r] *= eb[r];
#pragma unroll
                        for (int ks = 0; ks < 2; ++ks) accS[nt] = MFMA16(*(LAS bf16x8*)(Kt + (wave * 16 + l15) * 72 + ks * 32 + lq * 8), *(LAS bf16x8*)(Vt + (nt * 16 + l15) * 72 + ks * 32 + lq * 8), accS[nt]); } }
            }
            if (step < 36) {
                LAS unsigned char* op = lds + (step & 1) * GLA_OP_BYTES;
                LAS bf16_t* Qd = (LAS bf16_t*)op; LAS bf16_t* Kd = Qd + 64 * 136; LAS bf16_t* Kt = Kd + 64 * 136; LAS bf16_t* Vt = Kt + 128 * 72; LAS float* EBL = (LAS float*)(Vt + 64 * 72);
                { float v8[8]; unpack8(vw, v8);
#pragma unroll
                    for (int e = 0; e < 8; ++e) Vt[(seg * 8 + e) * 72 + ti] = f2bf(v8[e]); }
                float run[4] = {0.f, 0.f, 0.f, 0.f}, bc[4][4];
#pragma unroll
                for (int mt = 0; mt < 4; ++mt) {
                    const f32x4 sd = MFMA16(wfr, __builtin_bit_cast(bf16x8, alw[mt]), ((f32x4){0.f, 0.f, 0.f, 0.f}));
#pragma unroll
                    for (int r = 0; r < 4; ++r) { float x = logsigmoidf_(sd[r] + bad[r]) * 0.0625f;
                        x += DPP_F(x, 0x111); x += DPP_F(x, 0x112); x += DPP_F(x, 0x114); x += DPP_F(x, 0x118);
                        bc[mt][r] = run[r] + x; run[r] += DPP_F(x, 0x15F); }
                }
                float ebl[4];
#pragma unroll
                for (int r = 0; r < 4; ++r) ebl[r] = fexp(run[r]);
                if (l15 == 0) *(LAS f32x4*)(EBL + d0) = (f32x4){ebl[0], ebl[1], ebl[2], ebl[3]};
#pragma unroll
                for (int mt = 0; mt < 4; ++mt) { const int t = mt * 16 + l15; float qd[4], kd[4];
                    const float q4[4] = {bflo(qw[mt].x), bfhi(qw[mt].x), bflo(qw[mt].y), bfhi(qw[mt].y)}, k4[4] = {bflo(kw[mt].x), bfhi(kw[mt].x), bflo(kw[mt].y), bfhi(kw[mt].y)};
#pragma unroll
                    for (int r = 0; r < 4; ++r) { const float e1 = fexp(bc[mt][r]), e2 = __builtin_amdgcn_rcpf(e1);
                        qd[r] = q4[r] * 0.08838834764831845f * e1; kd[r] = k4[r] * e2; Kt[(d0 + r) * 72 + t] = f2bf(kd[r] * ebl[r]); }
                    u32x2 w; w.x = pk2(qd[0], qd[1]); w.y = pk2(qd[2], qd[3]); *(LAS u32x2*)(Qd + t * 136 + d0) = w;
                    w.x = pk2(kd[0], kd[1]); w.y = pk2(kd[2], kd[3]); *(LAS u32x2*)(Kd + t * 136 + d0) = w; }
            }
            __syncthreads();
            if (step >= 1) {
#pragma unroll
                for (int nt = 0; nt < 4; ++nt) { u32x2 w; w.x = pk2(accS[nt][0], accS[nt][1]); w.y = pk2(accS[nt][2], accS[nt][3]); *(LAS u32x2*)(St + (nt * 16 + l15) * 136 + wave * 16 + lq * 4) = w; }
                if (lat) *(u32x4*)(og + (size_t)(rbase + (dir ? 63 - ti : ti)) * D + h * 256 + dvs * 64 + seg * 8) = *(LAS u32x4*)(OBF + ti * 72 + seg * 8);
            }
            __syncthreads();
        }
    }
    __syncthreads();
}
template <bool LAT> __device__ __forceinline__ void load_mixed8(const bf16_t* __restrict__ Zr, int rowbase, int tl, int col, const float* mu8, float* out) {
    float own[8], zs[8], nb[8];
    const bf16_t* p = Zr + (size_t)(rowbase + tl) * ZRL_LD + col;
    unpack8(ldg16(p), own);
    if (LAT) {
        const int x = tl & 63, y = tl >> 6;
#pragma unroll
        for (int ty = 0; ty < 4; ++ty) {
            const bool ok = ty == 0 ? (x > 0) : ty == 1 ? (x < 63) : ty == 2 ? (y > 0) : (y < 31);
            const int dl = ty == 0 ? -1 : ty == 1 ? 1 : ty == 2 ? -64 : 64;
            u32x4 w = (u32x4){0u, 0u, 0u, 0u};
            if (ok) w = ldg16(p + (ptrdiff_t)dl * ZRL_LD);
            unpack8(w, nb); zs[ty] = nb[ty]; zs[ty + 4] = nb[ty + 4];
        }
    } else {
#pragma unroll
        for (int ty = 0; ty < 2; ++ty) {
            const bool ok = ty == 0 ? (tl > 0) : (tl < CTXL - 1);
            u32x4 w = (u32x4){0u, 0u, 0u, 0u};
            if (ok) w = ldg16(p + (ptrdiff_t)(ty == 0 ? -1 : 1) * ZRL_LD);
            unpack8(w, nb); zs[ty] = nb[ty]; zs[ty + 2] = nb[ty + 2]; zs[ty + 4] = nb[ty + 4]; zs[ty + 6] = nb[ty + 6];
        }
    }
#pragma unroll
    for (int e = 0; e < 8; ++e) out[e] = own[e] + (zs[e] - own[e]) * mu8[e];
}

__device__ __forceinline__ float fast_tanh(float x) { const float e = fexp(2.0f * x); return 1.0f - 2.0f * __builtin_amdgcn_rcpf(1.0f + e); }
__device__ __forceinline__ void premix_lora(const Ctx& c) {
    const bf16_t* Zr = (const bf16_t*)(c.ws + WS_ZRL); bf16_t* ZL = (bf16_t*)(c.ws + WS_ZL);
    for (int idx = blockIdx.x * NT + threadIdx.x; idx < MALL * 44; idx += gridDim.x * NT) {
        const int row = idx / 44, sg = idx - row * 44; float v8[8], mu8[8];
#pragma unroll
        for (int e = 0; e < 8; ++e) mu8[e] = CIN(11)[3072 + sg * 8 + e];
        if (row < MLAT) load_mixed8<true>(Zr, (row / SEQ) * SEQ, row % SEQ, ZR_OFF + sg * 8, mu8, v8);
        else { const int rc = row - MLAT; load_mixed8<false>(Zr, MLAT + (rc / CTXL) * CTXL, rc % CTXL, ZR_OFF + sg * 8, mu8, v8); }
#pragma unroll
        for (int e = 0; e < 8; ++e) v8[e] = sg < 16 ? fast_tanh(v8[e]) : (sg < 24 ? v8[e] : sigmoidf_(v8[e]));
        const int cc = sg * 8;
        *(u32x4*)(ZL + (sg < 24 ? zlf(row, cc >> 6, (cc >> 4) & 3, (cc >> 3) & 1) : (size_t)MALL * 192 + (size_t)row * 160 + (cc - 192))) = pack8(v8);
    }
}
__device__ __forceinline__ u32x2 ldg8(const bf16_t* p) { return *(const u32x2*)p; }
__device__ __forceinline__ void mix16_direct_lat(const bf16_t* __restrict__ Zrf, int rowbase, int tl, int qn, int head, int lq, const float* __restrict__ mu, float* out) {
    const int T = rowbase + tl;
    const u32x4 o0 = ldg16(Zrf + zrf(qn, T, head, lq, 0)), o1 = ldg16(Zrf + zrf(qn, T, head, lq, 1));
    const int x = tl & 63, y = tl >> 6; const u32x2 z2 = (u32x2){0u, 0u};
    u32x2 lf = z2, rt = z2, up = z2, dn = z2;
    if (x > 0) lf = ldg8(Zrf + zrf(qn, T - 1, head, lq, 0)); if (x < 63) rt = ldg8(Zrf + zrf(qn, T + 1, head, lq, 0) + 4); if (y > 0) up = ldg8(Zrf + zrf(qn, T - 64, head, lq, 1)); if (y < 31) dn = ldg8(Zrf + zrf(qn, T + 64, head, lq, 1) + 4);
    const unsigned own[8] = {o0.x, o0.y, o0.z, o0.w, o1.x, o1.y, o1.z, o1.w}, nb[8] = {lf.x, lf.y, rt.x, rt.y, up.x, up.y, dn.x, dn.y};
#pragma unroll
    for (int j = 0; j < 8; ++j)
#pragma unroll
        for (int hh = 0; hh < 2; ++hh) { const int pp = 2 * j + hh, i = (pp & 3) * 4 + (pp >> 2); const float z = hh ? bfhi(own[j]) : bflo(own[j]), zs = hh ? bfhi(nb[j]) : bflo(nb[j]); out[i] = z + (zs - z) * mu[i]; }
}
constexpr int RW_SLOT = 12544, RW_KAP = 0, RW_RT = 2048, RW_KBT = 4096, RW_VT = 8192, RW_ARR = 10240, RW_MKK = 11264, RW_PM = 11776, RW_GC = 12288;
constexpr int RW_OST = 8 * RW_SLOT, RW_W2T = RW_OST + 16384, RW_A2T = RW_W2T + 9216, RW_PAR = RW_A2T + 9216, RW_MS = RW_PAR + 2560;
#define DPP_U(x, ctrl) ((unsigned)__builtin_amdgcn_update_dpp(0, (int)(x), (ctrl), 0xf, 0xf, false))
__device__ __forceinline__ float reduce4f(float x) {
    auto r = __builtin_amdgcn_permlane32_swap(__float_as_uint(x), __float_as_uint(x), false, false);
    const float y = __uint_as_float(r[0]) + __uint_as_float(r[1]);
    auto s = __builtin_amdgcn_permlane16_swap(__float_as_uint(y), __float_as_uint(y), false, false);
    return __uint_as_float(s[0]) + __uint_as_float(s[1]);
}
struct Raw16 { u32x4 o0, o1; u32x2 hal, up, dn; };
template <bool LAT> __device__ __forceinline__ void mix16_issue(Raw16& w, const bf16_t* __restrict__ Zrf, int rowbase, int tl, int dir, int l15, int qn, int head, int lq) {
    const int T = rowbase + tl;
    w.o0 = ldg16(Zrf + zrf(qn, T, head, lq, 0)); w.o1 = ldg16(Zrf + zrf(qn, T, head, lq, 1));
    const bool e0 = (l15 == 0), e15 = (l15 == 15);
    const int hdl = e0 ? (dir ? 1 : -1) : (dir ? -1 : 1);
    const int lim = LAT ? 64 : CTXL; const int pos = LAT ? (tl & 63) : tl;
    const bool hok = (e0 || e15) && (pos + hdl >= 0) && (pos + hdl < lim);
    const u32x2 z = (u32x2){0u, 0u};
    w.hal = z; w.up = z; w.dn = z;
    const int hoff = hdl < 0 ? 0 : 4;
    if (hok) w.hal = ldg8(Zrf + zrf(qn, T + hdl, head, lq, 0) + hoff);
    if (LAT) {
        if ((tl >> 6) > 0) w.up = ldg8(Zrf + zrf(qn, T - 64, head, lq, 1));
        if ((tl >> 6) < 31) w.dn = ldg8(Zrf + zrf(qn, T + 64, head, lq, 1) + 4);
    } else {
        if (hok) w.up = ldg8(Zrf + zrf(qn, T + hdl, head, lq, 1) + hoff);
    }
}
template <bool LAT> __device__ __forceinline__ void mix16_finish(const Raw16& w, int tl, int dir, int l15, const LAS float* mu, float* out) {
    const unsigned own[8] = {w.o0.x, w.o0.y, w.o0.z, w.o0.w, w.o1.x, w.o1.y, w.o1.z, w.o1.w};
    const int lim = LAT ? 64 : CTXL; const int pos = LAT ? (tl & 63) : tl;
    const bool pv_ok = pos > 0, nx_ok = pos < lim - 1;
    const bool pv_edge = (l15 == (dir ? 15 : 0)), nx_edge = (l15 == (dir ? 0 : 15));
    unsigned nb[8];
#define NB_PREV(j, hv) { const unsigned a_ = DPP_U(own[j], 0x111), b_ = DPP_U(own[j], 0x101); unsigned v_ = dir ? b_ : a_; if (pv_edge) v_ = (hv); nb[j] = pv_ok ? v_ : 0u; }
#define NB_NEXT(j, hv) { const unsigned a_ = DPP_U(own[j], 0x111), b_ = DPP_U(own[j], 0x101); unsigned v_ = dir ? a_ : b_; if (nx_edge) v_ = (hv); nb[j] = nx_ok ? v_ : 0u; }
    NB_PREV(0, w.hal.x) NB_PREV(1, w.hal.y) NB_NEXT(2, w.hal.x) NB_NEXT(3, w.hal.y)
    if (LAT) { nb[4] = w.up.x; nb[5] = w.up.y; nb[6] = w.dn.x; nb[7] = w.dn.y; }
    else { NB_PREV(4, w.up.x) NB_PREV(5, w.up.y) NB_NEXT(6, w.up.x) NB_NEXT(7, w.up.y) }
#undef NB_PREV
#undef NB_NEXT
    float mu16[16];
#pragma unroll
    for (int q = 0; q < 4; ++q) { const f32x4 m = *(const LAS f32x4*)(mu + q * 4); mu16[q * 4] = m[0]; mu16[q * 4 + 1] = m[1]; mu16[q * 4 + 2] = m[2]; mu16[q * 4 + 3] = m[3]; }
#pragma unroll
    for (int j = 0; j < 8; ++j)
#pragma unroll
        for (int hh = 0; hh < 2; ++hh) { const int pp = 2 * j + hh, i = (pp & 3) * 4 + (pp >> 2); const float z = hh ? bfhi(own[j]) : bflo(own[j]), zs = hh ? bfhi(nb[j]) : bflo(nb[j]); out[i] = z + (zs - z) * mu16[i]; }
}
#define MIX_ISSUE(w, qn) do { if (lat) mix16_issue<true>(w, Zr, rowbase, tl, dir, l15, (qn), h, lq); else mix16_issue<false>(w, Zr, rowbase, tl, dir, l15, (qn), h, lq); } while (0)
#define MIX_FINISH(w, k, outv) do { if (lat) mix16_finish<true>(w, tl, dir, l15, PAR + (k) * 64 + lq * 16, outv); else mix16_finish<false>(w, tl, dir, l15, PAR + (k) * 64 + lq * 16, outv); } while (0)
#define SCHED_FENCE() __builtin_amdgcn_sched_barrier(0)
__device__ __forceinline__ u32x4 packv8(const float* v) { return pack8(v); }
__device__ __forceinline__ void p4_rwkv_chunked(const Ctx& c, LAS unsigned char* lds) {
    const int tid = threadIdx.x, lane = tid & 63, wave = tid >> 6, l15 = lane & 15, lq = lane >> 4;
    LAS bf16_t* W2T = (LAS bf16_t*)(lds + RW_W2T); LAS bf16_t* A2T = (LAS bf16_t*)(lds + RW_A2T); LAS float* PAR = (LAS float*)(lds + RW_PAR);
    const bf16_t* Zr = (const bf16_t*)(c.ws + WS_ZR);
    float* bonus = (float*)(c.ws + WS_BONUS);
    for (int u = blockIdx.x; u < 256; u += gridDim.x) {
        const int dir = u & 1, h = (u >> 1) & 15, b = u >> 5;
        bf16_t* orr = (bf16_t*)(c.ws + (dir ? WS_ORB : WS_ORF));
        __syncthreads();
        for (int i = tid; i < 4096; i += NT) { const int j = i >> 6, ch = i & 63; W2T[ch * 72 + j] = f2bf(CIN(13)[(size_t)(dir * 64 + j) * 1024 + h * 64 + ch]); A2T[ch * 72 + j] = f2bf(CIN(15)[(size_t)j * 1024 + h * 64 + ch]); }
        if (tid < 64) { const int ch = tid, hc = h * 64 + ch;
            PAR[0 * 64 + ch] = CIN(11)[hc]; PAR[1 * 64 + ch] = CIN(11)[1024 + hc]; PAR[2 * 64 + ch] = CIN(11)[2048 + hc]; PAR[3 * 64 + ch] = CIN(11)[3072 + dir * 64 + ch]; PAR[4 * 64 + ch] = CIN(11)[3200 + ch];
            PAR[5 * 64 + ch] = CIN(12)[dir * 1024 + hc]; PAR[6 * 64 + ch] = CIN(14)[hc]; PAR[7 * 64 + ch] = CIN(17)[hc]; PAR[8 * 64 + ch] = CIN(18)[hc]; PAR[9 * 64 + ch] = CIN(19)[hc]; }
        __syncthreads();
        f32x4 Tt[4];
#pragma unroll
        for (int kt = 0; kt < 4; ++kt) Tt[kt] = (f32x4){0.f, 0.f, 0.f, 0.f};
        Raw16 wa, wb, wc; u32x4 bw0, bw1, ba0, ba1;
#define RW_ISSUE(qq) do { const int q_ = (qq); { const u32x4 z4_ = (u32x4){0u, 0u, 0u, 0u}; const u32x2 z2_ = (u32x2){0u, 0u}; wa.o0 = z4_; wa.o1 = z4_; wa.hal = z2_; wa.up = z2_; wa.dn = z2_; wb = wa; wc = wa; bw0 = z4_; bw1 = z4_; ba0 = z4_; ba1 = z4_; } if (q_ < 144) { const bool lat = q_ >= 16; const int cidx_ = lat ? (dir ? 127 - (q_ - 16) : q_ - 16) : (dir ? 15 - q_ : q_); \
            const int tl = cidx_ * 16 + (dir ? 15 - l15 : l15), rowbase = lat ? b * SEQ : MLAT + b * CTXL; \
            MIX_ISSUE(wa, 2); MIX_ISSUE(wb, 1); MIX_ISSUE(wc, 0); \
            const bf16_t* zl = (const bf16_t*)(c.ws + WS_ZL); const int T_ = rowbase + tl; \
            bw0 = ldg16(zl + zlf(T_, dir, lq, 0)); bw1 = ldg16(zl + zlf(T_, dir, lq, 1)); ba0 = ldg16(zl + zlf(T_, 2, lq, 0)); ba1 = ldg16(zl + zlf(T_, 2, lq, 1)); } } while (0)
#pragma unroll 1
        for (int rho = 0; rho <= 18; ++rho) {
            RW_ISSUE(8 * rho + wave);
            SCHED_FENCE();
            if (wave < 4 && rho >= 1) {
                const int vt = wave;
#pragma unroll 1
                for (int j4 = 0; j4 < 8; ++j4) {
                    const int q = 8 * (rho - 1) + j4; const bool lat = q >= 16;
                    const LAS unsigned char* slot = lds + j4 * RW_SLOT;
                    const u32x4 kf0 = *(const LAS u32x4*)(slot + RW_KAP + lane * 16), kf1 = *(const LAS u32x4*)(slot + RW_KAP + 1024 + lane * 16);
                    const u32x4 rf0 = *(const LAS u32x4*)(slot + RW_RT + lane * 16), rf1 = *(const LAS u32x4*)(slot + RW_RT + 1024 + lane * 16);
                    const u32x2 mkkf = *(const LAS u32x2*)(slot + RW_MKK + lane * 8), pmf = *(const LAS u32x2*)(slot + RW_PM + lane * 8);
                    const u32x4 arrf = *(const LAS u32x4*)(slot + RW_ARR + lane * 16);
                    const u32x2 vf = *(const LAS u32x2*)(slot + RW_VT + ((vt * 16 + l15) * 16 + lq * 4) * 2);
                    const u32x4 tb0 = (u32x4){pk2(Tt[0][0], Tt[0][1]), pk2(Tt[0][2], Tt[0][3]), pk2(Tt[1][0], Tt[1][1]), pk2(Tt[1][2], Tt[1][3])};
                    const u32x4 tb1 = (u32x4){pk2(Tt[2][0], Tt[2][1]), pk2(Tt[2][2], Tt[2][3]), pk2(Tt[3][0], Tt[3][1]), pk2(Tt[3][2], Tt[3][3])};
                    const f32x4 z4 = (f32x4){0.f, 0.f, 0.f, 0.f};
                    f32x4 xy = MFMA16(__builtin_bit_cast(bf16x8, kf0), __builtin_bit_cast(bf16x8, tb0), z4); xy = MFMA16(__builtin_bit_cast(bf16x8, kf1), __builtin_bit_cast(bf16x8, tb1), xy);
                    xy = MFMA16(__builtin_bit_cast(bf16x8, ((u32x4){mkkf.x, mkkf.y, 0u, 0u})), __builtin_bit_cast(bf16x8, ((u32x4){vf.x, vf.y, 0u, 0u})), xy);
                    const f32x4 uu = MFMA16(__builtin_bit_cast(bf16x8, ((u32x4){pmf.x, pmf.y, 0u, 0u})), __builtin_bit_cast(bf16x8, ((u32x4){pk2(xy[0], xy[1]), pk2(xy[2], xy[3]), 0u, 0u})), z4);
                    const u32x4 vub = (u32x4){vf.x, vf.y, pk2(uu[0], uu[1]), pk2(uu[2], uu[3])};
                    if (lat) {
                        f32x4 o = MFMA16(__builtin_bit_cast(bf16x8, rf0), __builtin_bit_cast(bf16x8, tb0), z4); o = MFMA16(__builtin_bit_cast(bf16x8, rf1), __builtin_bit_cast(bf16x8, tb1), o);
                        o = MFMA16(__builtin_bit_cast(bf16x8, arrf), __builtin_bit_cast(bf16x8, vub), o);
                        LAS bf16_t* ost = (LAS bf16_t*)(lds + RW_OST) + j4 * 1024;
#pragma unroll
                        for (int r = 0; r < 4; ++r) ost[(lq * 4 + r) * 64 + vt * 16 + l15] = f2bf(o[r]);
                    }
                    const LAS float* GCs = (const LAS float*)(slot + RW_GC) + lq * 16;
#pragma unroll
                    for (int kt = 0; kt < 4; ++kt) { const f32x4 gc = *(const LAS f32x4*)(GCs + kt * 4); const u32x4 kbf = *(const LAS u32x4*)(slot + RW_KBT + (kt * 64 + lane) * 16);
                        f32x4 t = Tt[kt];
#pragma unroll
                        for (int r = 0; r < 4; ++r) t[r] *= gc[r];
                        Tt[kt] = MFMA16(__builtin_bit_cast(bf16x8, kbf), __builtin_bit_cast(bf16x8, vub), t); }
                }
            }
            __syncthreads();
            {
                const int pw = wave;
                { const int q = 8 * (rho - 1) + pw;
                    if (rho >= 1 && q >= 16) { const int cidx = dir ? 127 - (q - 16) : q - 16; const int tl = cidx * 16 + (dir ? 15 - l15 : l15);
                        const LAS bf16_t* src = (const LAS bf16_t*)(lds + RW_OST) + pw * 1024 + l15 * 64 + lq * 16;
                        *(u32x4*)(orr + orf(b * SEQ + tl, h, lq, 0)) = *(const LAS u32x4*)src; *(u32x4*)(orr + orf(b * SEQ + tl, h, lq, 1)) = *(const LAS u32x4*)(src + 8); } }
                const int q = 8 * rho + pw;
                if (q < 144) {
                    const bool lat = q >= 16;
                    const int cidx = lat ? (dir ? 127 - (q - 16) : q - 16) : (dir ? 15 - q : q);
                    const int tl = cidx * 16 + (dir ? 15 - l15 : l15), rowbase = lat ? b * SEQ : MLAT + b * CTXL;
                    LAS unsigned char* slot = lds + pw * RW_SLOT;
                    float rm[16], km[16];
                    {
                        SCHED_FENCE();
                        { float vm[16]; MIX_FINISH(wa, 2, vm);
                            LAS bf16_t* VT = (LAS bf16_t*)(slot + RW_VT);
#pragma unroll
                            for (int i = 0; i < 16; ++i) VT[(lq * 16 + i) * 16 + l15] = f2bf(vm[i]); }
                        SCHED_FENCE();
                        MIX_FINISH(wb, 1, km);
                        SCHED_FENCE();
                        MIX_FINISH(wc, 0, rm);
                    }
                    SCHED_FENCE();
                    float inv;
                    { float ss = 0.f;
#pragma unroll
                        for (int qd = 0; qd < 4; ++qd) { const f32x4 kkm = *(const LAS f32x4*)(PAR + 7 * 64 + lq * 16 + qd * 4);
#pragma unroll
                            for (int e = 0; e < 4; ++e) { const float x = km[qd * 4 + e] * kkm[e]; ss += x * x; } }
                        ss = reduce4f(ss); inv = fminf(__builtin_amdgcn_rsqf(ss), 1e12f); }
                    unsigned kapw[8], betw[8], ktw[8], rtw[8]; float bs = 0.f;
                    { LAS bf16_t* KB = (LAS bf16_t*)(slot + RW_KBT) + ((l15 >> 2) * 16 + lq * 4) * 8 + (l15 & 3); LAS float* GCs = (LAS float*)(slot + RW_GC) + lq * 16;
                        const int arow = (l15 >> 2) * 16 + (l15 & 3);
#pragma unroll
                        for (int nt = 0; nt < 4; ++nt) { SCHED_FENCE();
                            const LAS bf16_t* wr = W2T + (arow + nt * 4) * 72 + lq * 16; const LAS bf16_t* ar = A2T + (arow + nt * 4) * 72 + lq * 16;
                            f32x4 xw = MFMA16(*(const LAS bf16x8*)wr, __builtin_bit_cast(bf16x8, bw0), ((f32x4){0.f, 0.f, 0.f, 0.f})); xw = MFMA16(*(const LAS bf16x8*)(wr + 8), __builtin_bit_cast(bf16x8, bw1), xw);
                            f32x4 xa = MFMA16(*(const LAS bf16x8*)ar, __builtin_bit_cast(bf16x8, ba0), ((f32x4){0.f, 0.f, 0.f, 0.f})); xa = MFMA16(*(const LAS bf16x8*)(ar + 8), __builtin_bit_cast(bf16x8, ba1), xa);
                            const f32x4 w0 = *(const LAS f32x4*)(PAR + 5 * 64 + lq * 16 + nt * 4), a0 = *(const LAS f32x4*)(PAR + 6 * 64 + lq * 16 + nt * 4);
                            const f32x4 kkm = *(const LAS f32x4*)(PAR + 7 * 64 + lq * 16 + nt * 4), kam = *(const LAS f32x4*)(PAR + 8 * 64 + lq * 16 + nt * 4), rkm = *(const LAS f32x4*)(PAR + 9 * 64 + lq * 16 + nt * 4);
                            float ka4[4], be4[4], kt4[4], rt4[4], g4[4], lw4[4], kapn4[4], kpi4[4], betn4[4];
#pragma unroll
                            for (int r = 0; r < 4; ++r) { const int i = nt * 4 + r;
                                lw4[r] = -0.6065306597126334f * __builtin_amdgcn_rcpf(1.0f + fexp(-(w0[r] + xw[r])));
                                const float avi = sigmoidf_(a0[r] + xa[r]);
                                kapn4[r] = km[i] * kkm[r] * inv; kpi4[r] = km[i] * (1.0f + (avi - 1.0f) * kam[r]); betn4[r] = kapn4[r] * avi;
                                bs += rm[i] * kpi4[r] * rkm[r]; g4[r] = lw4[r]; }
                            asm volatile("s_nop 1\n"
                                "v_add_f32_dpp %0, %0, %0 row_shr:1 row_mask:0xf bank_mask:0xf\n" "v_add_f32_dpp %1, %1, %1 row_shr:1 row_mask:0xf bank_mask:0xf\n" "v_add_f32_dpp %2, %2, %2 row_shr:1 row_mask:0xf bank_mask:0xf\n" "v_add_f32_dpp %3, %3, %3 row_shr:1 row_mask:0xf bank_mask:0xf\n"
                                "v_add_f32_dpp %0, %0, %0 row_shr:2 row_mask:0xf bank_mask:0xf\n" "v_add_f32_dpp %1, %1, %1 row_shr:2 row_mask:0xf bank_mask:0xf\n" "v_add_f32_dpp %2, %2, %2 row_shr:2 row_mask:0xf bank_mask:0xf\n" "v_add_f32_dpp %3, %3, %3 row_shr:2 row_mask:0xf bank_mask:0xf\n"
                                "v_add_f32_dpp %0, %0, %0 row_shr:4 row_mask:0xf bank_mask:0xf\n" "v_add_f32_dpp %1, %1, %1 row_shr:4 row_mask:0xf bank_mask:0xf\n" "v_add_f32_dpp %2, %2, %2 row_shr:4 row_mask:0xf bank_mask:0xf\n" "v_add_f32_dpp %3, %3, %3 row_shr:4 row_mask:0xf bank_mask:0xf\n"
                                "v_add_f32_dpp %0, %0, %0 row_shr:8 row_mask:0xf bank_mask:0xf\n" "v_add_f32_dpp %1, %1, %1 row_shr:8 row_mask:0xf bank_mask:0xf\n" "v_add_f32_dpp %2, %2, %2 row_shr:8 row_mask:0xf bank_mask:0xf\n" "v_add_f32_dpp %3, %3, %3 row_shr:8 row_mask:0xf bank_mask:0xf\n"
                                "s_nop 1\n"
                                : "+v"(g4[0]), "+v"(g4[1]), "+v"(g4[2]), "+v"(g4[3]));
#pragma unroll
                            for (int r = 0; r < 4; ++r) { const int i = nt * 4 + r; const float g = g4[r], kapn = kapn4[r], kpi = kpi4[r], betn = betn4[r];
                                const float e1 = fexp(g), e2 = __builtin_amdgcn_rcpf(e1);
                                const float eC = DPP_F(e1, 0x15F);
                                float ep = DPP_F(e1, 0x111); ep = l15 == 0 ? 1.0f : ep;
                                const float kt_ = kpi * e2, bt_ = betn * e2;
                                ka4[r] = kapn * ep; be4[r] = bt_; kt4[r] = kt_; rt4[r] = rm[i] * e1;
                                KB[(nt * 64 + r) * 8] = f2bf(kt_ * eC); KB[(nt * 64 + r) * 8 + 4] = f2bf(-bt_ * eC);
                                if (l15 == 0) GCs[i] = eC; }
                            kapw[2 * nt] = pk2(ka4[0], ka4[1]); kapw[2 * nt + 1] = pk2(ka4[2], ka4[3]); betw[2 * nt] = pk2(be4[0], be4[1]); betw[2 * nt + 1] = pk2(be4[2], be4[3]);
                            ktw[2 * nt] = pk2(kt4[0], kt4[1]); ktw[2 * nt + 1] = pk2(kt4[2], kt4[3]); rtw[2 * nt] = pk2(rt4[0], rt4[1]); rtw[2 * nt + 1] = pk2(rt4[2], rt4[3]); }
                        SCHED_FENCE();
                        bs = reduce4f(bs);
                        if (lat && dir == 0 && lq == 0) bonus[(size_t)(b * SEQ + tl) * 16 + h] = bs; }
                    const u32x4 kapf0 = (u32x4){kapw[0], kapw[1], kapw[2], kapw[3]}, kapf1 = (u32x4){kapw[4], kapw[5], kapw[6], kapw[7]}, betf0 = (u32x4){betw[0], betw[1], betw[2], betw[3]}, betf1 = (u32x4){betw[4], betw[5], betw[6], betw[7]};
                    const u32x4 ktf0 = (u32x4){ktw[0], ktw[1], ktw[2], ktw[3]}, ktf1 = (u32x4){ktw[4], ktw[5], ktw[6], ktw[7]}, rtf0 = (u32x4){rtw[0], rtw[1], rtw[2], rtw[3]}, rtf1 = (u32x4){rtw[4], rtw[5], rtw[6], rtw[7]};
                    *(LAS u32x4*)(slot + RW_KAP + lane * 16) = kapf0; *(LAS u32x4*)(slot + RW_KAP + 1024 + lane * 16) = kapf1;
                    *(LAS u32x4*)(slot + RW_RT + lane * 16) = rtf0; *(LAS u32x4*)(slot + RW_RT + 1024 + lane * 16) = rtf1;
                    const f32x4 z4 = (f32x4){0.f, 0.f, 0.f, 0.f};
                    f32x4 mkb = MFMA16(__builtin_bit_cast(bf16x8, betf0), __builtin_bit_cast(bf16x8, kapf0), z4); mkb = MFMA16(__builtin_bit_cast(bf16x8, betf1), __builtin_bit_cast(bf16x8, kapf1), mkb);
                    f32x4 mkk = MFMA16(__builtin_bit_cast(bf16x8, ktf0), __builtin_bit_cast(bf16x8, kapf0), z4); mkk = MFMA16(__builtin_bit_cast(bf16x8, ktf1), __builtin_bit_cast(bf16x8, kapf1), mkk);
                    f32x4 ark = MFMA16(__builtin_bit_cast(bf16x8, ktf0), __builtin_bit_cast(bf16x8, rtf0), z4); ark = MFMA16(__builtin_bit_cast(bf16x8, ktf1), __builtin_bit_cast(bf16x8, rtf1), ark);
                    f32x4 arb = MFMA16(__builtin_bit_cast(bf16x8, betf0), __builtin_bit_cast(bf16x8, rtf0), z4); arb = MFMA16(__builtin_bit_cast(bf16x8, betf1), __builtin_bit_cast(bf16x8, rtf1), arb);
                    float arr8[8], mk4[4], mb4[4];
#pragma unroll
                    for (int r = 0; r < 4; ++r) { const int s = lq * 4 + r; mb4[r] = s < l15 ? mkb[r] : 0.f; mk4[r] = s < l15 ? mkk[r] : 0.f; arr8[r] = s <= l15 ? ark[r] : 0.f; arr8[4 + r] = s <= l15 ? -arb[r] : 0.f; }
                    *(LAS u32x4*)(slot + RW_ARR + lane * 16) = packv8(arr8);
                    { u32x2 w; w.x = pk2(mk4[0], mk4[1]); w.y = pk2(mk4[2], mk4[3]); *(LAS u32x2*)(slot + RW_MKK + lane * 8) = w; }
                    { LAS float* MS = (LAS float*)(lds + RW_MS) + pw * 320;
                        *(LAS f32x4*)(MS + l15 * 20 + lq * 4) = (f32x4){mb4[0], mb4[1], mb4[2], mb4[3]};
                        LDS_FENCE();
                        float mrow[16];
#pragma unroll
                        for (int qd = 0; qd < 4; ++qd) { const f32x4 m = *(const LAS f32x4*)(MS + l15 * 20 + qd * 4); mrow[qd * 4] = m[0]; mrow[qd * 4 + 1] = m[1]; mrow[qd * 4 + 2] = m[2]; mrow[qd * 4 + 3] = m[3]; }
                        LDS_FENCE();
                        float p4[4];
#pragma unroll
                        for (int j = 0; j < 4; ++j) p4[j] = (l15 == lq * 4 + j) ? 1.0f : 0.f;
                        float nm[15];
#pragma unroll
                        for (int q = 0; q < 15; ++q) nm[q] = -mrow[q];
#define PS4(sidx, op) "v_fmac_f32_dpp %0, %0, %" #op " row_newbcast:" #sidx " row_mask:0xf bank_mask:0xf\n" "v_fmac_f32_dpp %1, %1, %" #op " row_newbcast:" #sidx " row_mask:0xf bank_mask:0xf\n" \
                    "v_fmac_f32_dpp %2, %2, %" #op " row_newbcast:" #sidx " row_mask:0xf bank_mask:0xf\n" "v_fmac_f32_dpp %3, %3, %" #op " row_newbcast:" #sidx " row_mask:0xf bank_mask:0xf\n"
                        asm volatile("s_nop 1\n"
                            PS4(0, 4) PS4(1, 5) PS4(2, 6) PS4(3, 7) PS4(4, 8) PS4(5, 9) PS4(6, 10) PS4(7, 11) PS4(8, 12) PS4(9, 13) PS4(10, 14) PS4(11, 15) PS4(12, 16) PS4(13, 17) PS4(14, 18)
                            "s_nop 1\n"
                            : "+v"(p4[0]), "+v"(p4[1]), "+v"(p4[2]), "+v"(p4[3])
                            : "v"(nm[0]), "v"(nm[1]), "v"(nm[2]), "v"(nm[3]), "v"(nm[4]), "v"(nm[5]), "v"(nm[6]), "v"(nm[7]), "v"(nm[8]), "v"(nm[9]), "v"(nm[10]), "v"(nm[11]), "v"(nm[12]), "v"(nm[13]), "v"(nm[14]));
#undef PS4
                        u32x2 w; w.x = pk2(p4[0], p4[1]); w.y = pk2(p4[2], p4[3]); *(LAS u32x2*)(slot + RW_PM + lane * 8) = w; }
                }
            }
            __syncthreads();
        }
    }
}
__device__ __forceinline__ void p5_post(const Ctx& c, LAS unsigned char* lds, bool dry = false) {
    const int tid = threadIdx.x, lane = tid & 63, wave = tid >> 6, l15 = lane & 15, lq = lane >> 4;
    LAS bf16_t* SG = (LAS bf16_t*)lds;
    LAS bf16_t* GL = SG + 64 * 200;
    const bf16_t* Zr = (const bf16_t*)(c.ws + WS_ZR); const bf16_t* g2t = (const bf16_t*)(c.ws + WS_G2T);
    bf16_t* og_f = (bf16_t*)c.out; const bf16_t* og_b = og_f + (size_t)MLAT * D;
    bf16_t* or_f = (bf16_t*)(c.ws + WS_ORF); const bf16_t* or_b = (const bf16_t*)(c.ws + WS_ORB);
    const float* bonus = (const float*)(c.ws + WS_BONUS);
    for (int u = blockIdx.x; u < MLAT / 64; u += gridDim.x) {
        const int rowbase = (u >> 5) * SEQ, tl0 = (u & 31) * 64;
        __syncthreads();
        { const int tok = tid >> 3, seg = tid & 7; const bf16_t* zl = (const bf16_t*)(c.ws + WS_ZL) + (size_t)MALL * 192 + (size_t)(rowbase + tl0 + tok) * 160;
#pragma unroll
            for (int k = 0; k < 3; ++k) { const int sgi = seg + 8 * k; u32x4 w = (u32x4){0u, 0u, 0u, 0u};
                if (sgi < 20) w = ldg16(zl + sgi * 8);
                *(LAS u32x4*)(SG + tok * 200 + sgi * 8) = w; } }
        __syncthreads();
#pragma unroll 1
        for (int half = 0; half < 2; ++half) {
            f32x4 acc[4][4];
#pragma unroll
            for (int mt = 0; mt < 4; ++mt)
#pragma unroll
                for (int nt = 0; nt < 4; ++nt) acc[mt][nt] = (f32x4){0.f, 0.f, 0.f, 0.f};
#pragma unroll
            for (int ks = 0; ks < 6; ++ks) { bf16x8 bfr[4], afr[4];
#pragma unroll
                for (int nt = 0; nt < 4; ++nt) bfr[nt] = *(const bf16x8*)(g2t + (size_t)(((((wave * 8 + half * 4 + nt) * 6 + ks) * 64) + lane) << 3));
#pragma unroll
                for (int mt = 0; mt < 4; ++mt) afr[mt] = *(LAS bf16x8*)(SG + (mt * 16 + l15) * 200 + ks * 32 + lq * 8);
#pragma unroll
                for (int mt = 0; mt < 4; ++mt)
#pragma unroll
                    for (int nt = 0; nt < 4; ++nt) acc[mt][nt] = MFMA16(afr[mt], bfr[nt], acc[mt][nt]); }
#pragma unroll
            for (int mt = 0; mt < 4; ++mt)
#pragma unroll
                for (int nt = 0; nt < 4; ++nt)
#pragma unroll
                    for (int r = 0; r < 4; ++r) GL[(mt * 16 + lq * 4 + r) * 1032 + wave * 128 + (half * 4 + nt) * 16 + l15] = f2bf(acc[mt][nt][r]);
        }
        __syncthreads();
        for (int ii = 0; ii < 8; ++ii) {
            const int i = wave * 8 + ii; const size_t R = (size_t)rowbase + tl0 + i; const int ch0 = lane * 16;
            { float s[16], t[16]; unpack8(ldg16(og_f + R * D + ch0), s); unpack8(ldg16(og_f + R * D + ch0 + 8), s + 8); unpack8(ldg16(og_b + R * D + ch0), t); unpack8(ldg16(og_b + R * D + ch0 + 8), t + 8);
                float ssq = 0.f;
#pragma unroll
                for (int e = 0; e < 16; ++e) { s[e] += t[e]; ssq += s[e] * s[e]; }
                ssq += __shfl_xor(ssq, 1); ssq += __shfl_xor(ssq, 2); ssq += __shfl_xor(ssq, 4); ssq += __shfl_xor(ssq, 8);
                const float rs = rsqrtf(ssq * (1.0f / 256.0f) + 1e-6f);
#pragma unroll
                for (int e = 0; e < 16; ++e) s[e] = s[e] * rs * CIN(10)[ch0 + e];
                bf16_t* wp = dry ? (bf16_t*)(c.ws + WS_WIN) + (R & 4095) * D + ch0 : og_f + R * D + ch0;
                *(u32x4*)wp = pack8(s); *(u32x4*)(wp + 8) = pack8(s + 8); }
        }
        for (int ii = 0; ii < 8; ++ii) { const int un = wave * 8 + ii, scl = un >> 4, head = un & 15, tl = tl0 + scl * 16 + l15, T = rowbase + tl, hc = head * 64 + lq * 16;
            float s[16], t[16]; unpack8(ldg16(or_f + orf(T, head, lq, 0)), s); unpack8(ldg16(or_f + orf(T, head, lq, 1)), s + 8); unpack8(ldg16(or_b + orf(T, head, lq, 0)), t); unpack8(ldg16(or_b + orf(T, head, lq, 1)), t + 8);
            float sm = 0.f;
#pragma unroll
            for (int e = 0; e < 16; ++e) { s[e] += t[e]; sm += s[e]; }
            sm = reduce4f(sm);
            const float mean = sm * (1.0f / 64.0f); float sv = 0.f;
#pragma unroll
            for (int e = 0; e < 16; ++e) { s[e] -= mean; sv += s[e] * s[e]; }
            sv = reduce4f(sv);
            const float rs = rsqrtf(sv * (1.0f / 64.0f) + 64e-5f);
            const float bn = bonus[(size_t)T * 16 + head];
            float vm[16], g[16];
            mix16_direct_lat(Zr, rowbase, tl, 2, head, lq, CIN(11) + 2048 + hc, vm);
            LAS bf16_t* gp = GL + (scl * 16 + l15) * 1032 + hc;
            unpack8(*(LAS u32x4*)gp, g); unpack8(*(LAS u32x4*)(gp + 8), g + 8);
#pragma unroll
            for (int e = 0; e < 16; ++e) s[e] = (s[e] * rs * CIN(20)[hc + e] + CIN(21)[hc + e] + bn * vm[e]) * g[e];
            *(LAS u32x4*)gp = pack8(s); *(LAS u32x4*)(gp + 8) = pack8(s + 8); }
        __syncthreads();
        for (int ii = 0; ii < 8; ++ii) { const int i = wave * 8 + ii; const size_t R = (size_t)rowbase + tl0 + i; const int ch0 = lane * 16;
            bf16_t* wp = dry ? (bf16_t*)(c.ws + WS_WIN) + (R & 4095) * D + ch0 : or_f + R * D + ch0;
            *(u32x4*)wp = *(LAS u32x4*)(GL + i * 1032 + ch0); *(u32x4*)(wp + 8) = *(LAS u32x4*)(GL + i * 1032 + ch0 + 8); }
    }
    __syncthreads();
}

__device__ __forceinline__ void p7_combine(const Ctx& c) {
    const bf16_t* Z3 = (const bf16_t*)(c.ws + WS_Z3); const bf16_t* yg = (const bf16_t*)c.out; const bf16_t* yr = (const bf16_t*)(c.ws + WS_ORF); bf16_t* Y = (bf16_t*)(c.ws + WS_A1);
    for (int idx = blockIdx.x * NT + threadIdx.x; idx < MLAT * 128; idx += gridDim.x * NT) {
        const size_t row = idx >> 7; const int c8 = (idx & 127) * 8;
        float go[8], sg[8], sr[8], a[8], b[8], y[8];
        unpack8(ldg16(Z3 + row * Z3_LD + c8), go); unpack8(ldg16(Z3 + row * Z3_LD + 1024 + c8), sg); unpack8(ldg16(Z3 + row * Z3_LD + 2048 + c8), sr);
        unpack8(ldg16(yg + row * D + c8), a); unpack8(ldg16(yr + row * D + c8), b);
#pragma unroll
        for (int e = 0; e < 8; ++e) y[e] = sg[e] * a[e] * go[e] + sr[e] * b[e];
        *(u32x4*)(Y + row * D + c8) = pack8(y);
    }
}

__device__ __forceinline__ void p9_norm2_tables(const Ctx& c) {
    const int lane = threadIdx.x & 63, wave = threadIdx.x >> 6; const float* m = (const float*)(c.ws + WS_MOD); bf16_t* A2 = (bf16_t*)(c.ws + WS_A1);
    { const int stride = gridDim.x * 8;
        for (int row = blockIdx.x * 8 + wave; row < MLAT; row += 2 * stride) { const int rb = row + stride, b0 = row / SEQ;
            if (rb < MLAT) { const int b1 = rb / SEQ; norm_mod_row2(c.out + (size_t)row * D, c.out + (size_t)rb * D, CIN(23), m + b0 * MODW + 3072, m + b0 * MODW + 4096, m + b1 * MODW + 3072, m + b1 * MODW + 4096, A2 + (size_t)row * D, A2 + (size_t)rb * D, lane); }
            else norm_mod_row(c.out + (size_t)row * D, CIN(23), m + b0 * MODW + 3072, m + b0 * MODW + 4096, A2 + (size_t)row * D, lane); } }
    unsigned* UT = (unsigned*)(c.ws + WS_UT); unsigned* VT = (unsigned*)(c.ws + WS_VT);
    for (size_t i = ((size_t)blockIdx.x * NT + threadIdx.x) * 4; i < (size_t)16384 * 1024; i += (size_t)gridDim.x * NT * 4) {
        const f32x4 a = *(const f32x4*)(CIN(26) + i), b = *(const f32x4*)(CIN(27) + i); const size_t e = i >> 10, cc = i & 1023, o = ((cc >> 9) * (size_t)8388608 + e * 512 + (cc & 511)) >> 2;
        int w = __builtin_amdgcn_cvt_pk_fp8_f32(a[0] * 64.0f, a[1] * 64.0f, 0, false); w = __builtin_amdgcn_cvt_pk_fp8_f32(a[2] * 64.0f, a[3] * 64.0f, w, true); UT[o] = (unsigned)w;
        w = __builtin_amdgcn_cvt_pk_fp8_f32(b[0], b[1], 0, false); w = __builtin_amdgcn_cvt_pk_fp8_f32(b[2], b[3], w, true); VT[o] = (unsigned)w; }
}
typedef float f32x2p __attribute__((ext_vector_type(2)));
__device__ __forceinline__ void fp8x16_to_f32(const u32x4 w, float* o) {
#pragma unroll
    for (int q = 0; q < 4; ++q) { const f32x2p lo = __builtin_amdgcn_cvt_pk_f32_fp8((int)w[q], false), hi = __builtin_amdgcn_cvt_pk_f32_fp8((int)w[q], true); o[q * 4] = lo[0]; o[q * 4 + 1] = lo[1]; o[q * 4 + 2] = hi[0]; o[q * 4 + 3] = hi[1]; }
}
__device__ __forceinline__ float row16_sum(float x) {
    x += __builtin_bit_cast(float, __builtin_amdgcn_update_dpp(0, __builtin_bit_cast(int, x), 0x128, 0xf, 0xf, false));
    x += __builtin_bit_cast(float, __builtin_amdgcn_update_dpp(0, __builtin_bit_cast(int, x), 0x124, 0xf, 0xf, false));
    x += __builtin_bit_cast(float, __builtin_amdgcn_update_dpp(0, __builtin_bit_cast(int, x), 0x122, 0xf, 0xf, false));
    x += __builtin_bit_cast(float, __builtin_amdgcn_update_dpp(0, __builtin_bit_cast(int, x), 0x121, 0xf, 0xf, false));
    return x;
}
__device__ __forceinline__ float row32_sum(float x) {
    x = row16_sum(x);
    auto r = __builtin_amdgcn_permlane16_swap(__float_as_uint(x), __float_as_uint(x), false, false);
    return __uint_as_float(r[0]) + __uint_as_float(r[1]);
}
__device__ __forceinline__ float gelu_as(float v) {
    const float av = fabsf(v), t = __builtin_amdgcn_rcpf(av * 0.2316418882f + 1.0f);
    float q = t * 0.5307027145f - 0.7265760135f; q = q * t + 0.7107068705f; q = q * t - 0.142248368f; q = q * t + 0.127414796f; q = q * t;
    const float e = __builtin_amdgcn_exp2f(v * v * -0.72134752044f), mneg = v * (q * e);
    return v < 0.f ? mneg : v - mneg;
}

typedef int i32x8 __attribute__((ext_vector_type(8)));
constexpr int BF_HL = 4096, BF_WAVE = 2 * BF_HL;
#define S9_ROW(e) ((unsigned)(e) & rmask)
template <int EXP> __device__ __forceinline__ void p12_sweep12(const Ctx& c, int R0, LAS unsigned char* lds, int tid) {
    constexpr bool dry = EXP != 0;
    const int lane = tid & 63, wave = __builtin_amdgcn_readfirstlane(tid >> 6), l15 = lane & 15, lq = lane >> 4;
    LAS int* SIDX = (LAS int*)lds; LAS float* SGATE = (LAS float*)(SIDX + 8192);
    const LAS int* IDXL = (const LAS int*)lds + 16384; const LAS float* GATEL = (const LAS float*)(IDXL + 64 * IDSTR);
    LAS unsigned char* BF = lds + 65536 + wave * BF_WAVE;
    LAS int* HIST = (LAS int*)(lds + 133120) + wave * 64;
    LAS bf16_t* XP = (LAS bf16_t*)(lds + 135168) + wave * 1024;
    const bf16_t* A2 = (const bf16_t*)(c.ws + WS_A1); const unsigned char* UT = (const unsigned char*)(c.ws + WS_UT); const unsigned char* VT = (const unsigned char*)(c.ws + WS_VT); const float* m = (const float*)(c.ws + WS_MOD);
    for (int k = 0; k < 8; ++k) { const int tok = wave + 8 * k;
        if (lane < 32) HIST[lane] = 0;
        const int e0 = IDXL[tok * IDSTR + lane], e1 = IDXL[tok * IDSTR + 64 + lane]; const float g0 = GATEL[tok * IDSTR + lane], g1 = GATEL[tok * IDSTR + 64 + lane];
        const int b0 = e0 >> 9, b1 = e1 >> 9;
        const int r0 = __hip_atomic_fetch_add(HIST + b0, 1, __ATOMIC_RELAXED, __HIP_MEMORY_SCOPE_WORKGROUP), r1 = __hip_atomic_fetch_add(HIST + b1, 1, __ATOMIC_RELAXED, __HIP_MEMORY_SCOPE_WORKGROUP);
        const int cnt = lane < 32 ? __hip_atomic_load(HIST + (lane & 31), __ATOMIC_RELAXED, __HIP_MEMORY_SCOPE_WORKGROUP) : 0; int incl = cnt;
#pragma unroll
        for (int o = 1; o < 32; o <<= 1) { const int v = __shfl_up(incl, o); if (lane >= o) incl += v; }
        if (lane < 32) HIST[32 + lane] = incl - cnt;
        LDS_FENCE();
        const int pos0 = HIST[32 + b0] + r0, pos1 = HIST[32 + b1] + r1;
        SIDX[tok * 128 + pos0] = e0; SGATE[tok * 128 + pos0] = g0; SIDX[tok * 128 + pos1] = e1; SGATE[tok * 128 + pos1] = g1;
        LDS_FENCE(); }
    __syncthreads();
    const int psel = l15 & 3;
    float wsel[4];
#pragma unroll
    for (int r = 0; r < 4; ++r) wsel[r] = ((l15 >> 2) == lq && psel == r) ? 1.0f : 0.f;
    const bool wr_lane = (l15 == 4 * lq);
#pragma unroll 1
    for (int rep = 0; rep < S8_REPS; ++rep) {
        const bool dryrep = dry || (rep + 1 < S8_REPS); const unsigned rmask = (dryrep && S8_HOT) ? 63u : 16383u;
        const LAS int* LV[2]; LAS float* LG[2]; LAS bf16_t* XPv[2]; const LAS int* LU[2];
#pragma unroll
        for (int tb = 0; tb < 2; ++tb) { const int tokv = wave + 8 * (4 * tb + lq); LV[tb] = SIDX + tokv * 128; LG[tb] = SGATE + tokv * 128; XPv[tb] = XP + (4 * tb + lq) * 128;
            LU[tb] = SIDX + (wave + 8 * (4 * tb + (l15 >> 2))) * 128; }
        const unsigned offU = (unsigned)(lq * 64 + psel * 16), offV = (unsigned)(l15 * 16);
#pragma unroll 1
        for (int jj = 0; jj < 2; ++jj) {
            { const int kt = lane >> 3, b8 = lane & 7; const bf16_t* ap = A2 + (size_t)(R0 + wave + 8 * kt) * D + jj * 512 + b8 * 64;
                LAS unsigned char* bp = BF + ((((kt >> 2) * 2 * 4 + (b8 & 3)) * 2 + (b8 >> 2)) * 16 + 4 * (kt & 3)) * 16;
#pragma unroll
                for (int p = 0; p < 4; ++p) { float a[16]; unpack8(ldg16(ap + p * 16), a); unpack8(ldg16(ap + p * 16 + 8), a + 8);
                    u32x4 hi, lo;
#pragma unroll
                    for (int q = 0; q < 4; ++q) { int w = __builtin_amdgcn_cvt_pk_fp8_f32(a[4 * q], a[4 * q + 1], 0, false); w = __builtin_amdgcn_cvt_pk_fp8_f32(a[4 * q + 2], a[4 * q + 3], w, true);
                        const f32x2p h01 = __builtin_amdgcn_cvt_pk_f32_fp8(w, false), h23 = __builtin_amdgcn_cvt_pk_f32_fp8(w, true);
                        int v = __builtin_amdgcn_cvt_pk_fp8_f32(a[4 * q] - h01[0], a[4 * q + 1] - h01[1], 0, false); v = __builtin_amdgcn_cvt_pk_fp8_f32(a[4 * q + 2] - h23[0], a[4 * q + 3] - h23[1], v, true);
                        hi[q] = (unsigned)w; lo[q] = (unsigned)v; }
                    *(LAS u32x4*)(bp + p * 16) = hi; *(LAS u32x4*)(bp + 2048 + p * 16) = lo; }
                LDS_FENCE(); }
            const unsigned char* UTj = UT + (size_t)jj * 8388608;
            i32x8 Bh[2], Bl[2];
#pragma unroll
            for (int tb = 0; tb < 2; ++tb) { const LAS unsigned char* BFr = BF + tb * 4096 + (lq * 32 + l15) * 16;
                const u32x4 b0 = *(const LAS u32x4*)BFr, b1 = *(const LAS u32x4*)(BFr + 256), c0 = *(const LAS u32x4*)(BFr + 2048), c1 = *(const LAS u32x4*)(BFr + 2048 + 256);
                Bh[tb] = (i32x8){(int)b0.x, (int)b0.y, (int)b0.z, (int)b0.w, (int)b1.x, (int)b1.y, (int)b1.z, (int)b1.w}; Bl[tb] = (i32x8){(int)c0.x, (int)c0.y, (int)c0.z, (int)c0.w, (int)c1.x, (int)c1.y, (int)c1.z, (int)c1.w}; }
            u32x4 U[4][2][2];
#pragma unroll
            for (int s2 = 0; s2 < 4; ++s2)
#pragma unroll
                for (int tb = 0; tb < 2; ++tb) { const unsigned char* up = UTj + (size_t)((S9_ROW(LU[tb][s2]) << 9) + offU);
                    U[s2][tb][0] = *(const u32x4*)up; U[s2][tb][1] = *(const u32x4*)(up + 256); }
#pragma unroll 1
            for (int g = 0; g < 32; ++g) {
                u32x4 ln[2];
#pragma unroll
                for (int tb = 0; tb < 2; ++tb) ln[tb] = *(const LAS u32x4*)(LU[tb] + ((4 * g + 4) & 127));
                float x[2][4];
#pragma unroll
                for (int i = 0; i < 4; ++i) {
#pragma unroll
                    for (int tb = 0; tb < 2; ++tb) {
                        const u32x4 a0 = U[i][tb][0], a1 = U[i][tb][1];
                        const i32x8 a8 = {(int)a0.x, (int)a0.y, (int)a0.z, (int)a0.w, (int)a1.x, (int)a1.y, (int)a1.z, (int)a1.w};
                        f32x4 d = __builtin_amdgcn_mfma_scale_f32_16x16x128_f8f6f4(a8, Bh[tb], ((f32x4){0.f, 0.f, 0.f, 0.f}), 0, 0, 0, 0, 0, 0);
                        d = __builtin_amdgcn_mfma_scale_f32_16x16x128_f8f6f4(a8, Bl[tb], d, 0, 0, 0, 0, 0, 0);
                        { const unsigned char* up = UTj + (size_t)((S9_ROW(ln[tb][i]) << 9) + offU);
                            U[i][tb][0] = *(const u32x4*)up; U[i][tb][1] = *(const u32x4*)(up + 256); }
                        x[tb][i] = d[0] * wsel[0] + d[1] * wsel[1] + d[2] * wsel[2] + d[3] * wsel[3]; }
                    SCHED_FENCE(); }
#pragma unroll
                for (int tb = 0; tb < 2; ++tb) {
#pragma unroll
                    for (int i = 0; i < 4; ++i) { x[tb][i] += DPP_F(x[tb][i], 0xB1); x[tb][i] += DPP_F(x[tb][i], 0x4E); }
                    if (jj == 0) { if (wr_lane) *(LAS u32x2*)(XPv[tb] + 4 * g) = (u32x2){pk2(x[tb][0], x[tb][1]), pk2(x[tb][2], x[tb][3])}; }
                    else { const u32x2 pw = *(const LAS u32x2*)(XPv[tb] + 4 * g); const f32x4 gt = *(const LAS f32x4*)(LG[tb] + 4 * g);
                        const float xp[4] = {bflo(pw.x), bfhi(pw.x), bflo(pw.y), bfhi(pw.y)}; f32x4 cf;
#pragma unroll
                        for (int i = 0; i < 4; ++i) cf[i] = gt[i] * gelu_as((x[tb][i] + xp[i]) * (1.0f / 64.0f));
                        if (wr_lane && !(dryrep && S8_REPS > 1)) *(LAS f32x4*)(LG[tb] + 4 * g) = cf; } }
                SCHED_FENCE();
            }
            LDS_FENCE();
        }
        float ssq[2] = {0.f, 0.f};
#pragma unroll
        for (int hv = 0; hv < 2; ++hv) { u32x4 V[4][2][2]; f32x2p acc[2][16];
#pragma unroll
            for (int tb = 0; tb < 2; ++tb)
#pragma unroll
                for (int e = 0; e < 16; ++e) acc[tb][e] = (f32x2p){0.f, 0.f};
            const unsigned char* VTh = VT + (size_t)hv * 8388608;
#pragma unroll
            for (int s2 = 0; s2 < 4; ++s2)
#pragma unroll
                for (int tb = 0; tb < 2; ++tb) { const unsigned char* vp = VTh + (size_t)((S9_ROW(LV[tb][s2]) << 9) + offV);
                    V[s2][tb][0] = *(const u32x4*)vp; V[s2][tb][1] = *(const u32x4*)(vp + 256); }
#pragma unroll 1
            for (int g = 0; g < 32; ++g) {
                u32x4 ln[2]; f32x4 cf4[2];
#pragma unroll
                for (int tb = 0; tb < 2; ++tb) { ln[tb] = *(const LAS u32x4*)(LV[tb] + ((4 * g + 4) & 127)); cf4[tb] = *(const LAS f32x4*)(LG[tb] + 4 * g); }
#pragma unroll
                for (int i = 0; i < 4; ++i) {
#pragma unroll
                    for (int tb = 0; tb < 2; ++tb) {
                        const f32x2p cf2 = (f32x2p){cf4[tb][i], cf4[tb][i]};
#pragma unroll
                        for (int q = 0; q < 2; ++q)
#pragma unroll
                            for (int w = 0; w < 4; ++w) { acc[tb][q * 8 + w * 2] += cf2 * __builtin_amdgcn_cvt_pk_f32_fp8((int)V[i][tb][q][w], false); acc[tb][q * 8 + w * 2 + 1] += cf2 * __builtin_amdgcn_cvt_pk_f32_fp8((int)V[i][tb][q][w], true); }
                        SCHED_FENCE();
                        { const unsigned char* vp = VTh + (size_t)((S9_ROW(ln[tb][i]) << 9) + offV);
                            V[i][tb][0] = *(const u32x4*)vp; V[i][tb][1] = *(const u32x4*)(vp + 256); }
                        SCHED_FENCE(); } }
            }
#pragma unroll
            for (int tb = 0; tb < 2; ++tb) { const int R = R0 + wave + 8 * (4 * tb + lq); const int b = R / SEQ; const float* g2 = m + b * MODW + 5120; const float* hrow = c.out + (size_t)R * D;
                float* orow = dryrep ? (float*)(c.ws + WS_ZR + (size_t)56 * 1048576) + (size_t)(R & 8191) * D : c.out + (size_t)R * D;
#pragma unroll
                for (int q = 0; q < 2; ++q)
#pragma unroll
                    for (int w = 0; w < 4; ++w) { const int ch = hv * 512 + q * 256 + l15 * 16 + w * 4; const f32x4 hv4 = *(const f32x4*)(hrow + ch), gv = *(const f32x4*)(g2 + ch);
                        const float a4[4] = {acc[tb][q * 8 + 2 * w][0], acc[tb][q * 8 + 2 * w][1], acc[tb][q * 8 + 2 * w + 1][0], acc[tb][q * 8 + 2 * w + 1][1]}; f32x4 o;
#pragma unroll
                        for (int e = 0; e < 4; ++e) { o[e] = hv4[e] + gv[e] * a4[e]; ssq[tb] += o[e] * o[e]; }
                        *(f32x4*)(orow + ch) = o; } }
        }
#pragma unroll
        for (int tb = 0; tb < 2; ++tb) { const int R = R0 + wave + 8 * (4 * tb + lq); const float rstd = rsqrtf(row16_sum(ssq[tb]) * (1.0f / 1024.0f) + 1e-6f);
            float* orow = dryrep ? (float*)(c.ws + WS_ZR + (size_t)56 * 1048576) + (size_t)(R & 8191) * D : c.out + (size_t)R * D;
#pragma unroll
            for (int q = 0; q < 4; ++q)
#pragma unroll
                for (int w = 0; w < 4; ++w) { const int ch = q * 256 + l15 * 16 + w * 4; const f32x4 wv = *(const f32x4*)(CIN(28) + ch); const f32x4 h2 = *(const f32x4*)(orow + ch); f32x4 o;
#pragma unroll
                    for (int e = 0; e < 4; ++e) o[e] = h2[e] * rstd * wv[e];
                    *(f32x4*)(orow + ch) = o; } }
    }
}

__device__ __forceinline__ int sortable(float v) { const int b = __float_as_int(v); return b ^ ((b >> 31) & 0x7fffffff); }
__device__ __forceinline__ float unsortable(int k) { return __int_as_float(k ^ ((k >> 31) & 0x7fffffff)); }
#define CASD(a, b) { const int _hi = max(a, b), _lo = min(a, b); a = _hi; b = _lo; }
#define CAS16(t, x) { _Pragma("unroll") for (int _i = 0; _i < 16; ++_i) { const int _hi = max(t[_i], x); x = min(t[_i], x); t[_i] = _hi; } }
__device__ __forceinline__ void bitonic_merge16_desc(int* t) {
#pragma unroll
    for (int d = 8; d >= 1; d >>= 1)
#pragma unroll
        for (int i = 0; i < 16; ++i) if ((i & d) == 0) CASD(t[i], t[i + d]);
}
__device__ __forceinline__ void bitonic_sort16_desc(int* t) {
#pragma unroll
    for (int k = 2; k <= 16; k <<= 1)
#pragma unroll
        for (int d = k >> 1; d >= 1; d >>= 1)
#pragma unroll
            for (int i = 0; i < 16; ++i) { const int j = i ^ d; if (j > i) { if ((i & k) == 0 || k == 16) { CASD(t[i], t[j]); } else { CASD(t[j], t[i]); } } }
}
template <int EXP> __device__ __forceinline__ void p11_topk(const Ctx& c, LAS unsigned char* lds) {
    LAS int* KEYS = (LAS int*)lds;
    const bf16_t* Q = (const bf16_t*)(c.ws + WS_Q); const bf16_t* SK = (const bf16_t*)(c.ws + WS_SK);
    LAS int* IDXL = KEYS + 16384;
    LAS float* GATEL = (LAS float*)(IDXL + 64 * IDSTR);
    const int wv_s = __builtin_amdgcn_readfirstlane(threadIdx.x >> 6);
    for (int u = blockIdx.x; u < MLAT / 64; u += gridDim.x) {
        int tid; asm volatile("v_mbcnt_lo_u32_b32 %0, -1, 0\n\tv_mbcnt_hi_u32_b32 %0, -1, %0\n\tv_or_b32 %0, %1, %0" : "=&v"(tid) : "s"(wv_s << 6));
        const int lane = tid & 63, wave = tid >> 6, l15 = lane & 15, lq = lane >> 4;
        const int R0 = u * 64, tt = wave >> 1, p = wave & 1;
        __syncthreads();
#pragma unroll 1
        for (int h = 0; h < 8; ++h) {
            bf16x8 qf[4];
#pragma unroll
            for (int ks = 0; ks < 4; ++ks) qf[ks] = *(const bf16x8*)(Q + ((size_t)((((((R0 >> 4) + tt) * 8 + h) * 2 + p) * 4 + ks) * 64 + lane) << 3));
            int ta[16], tb[16];
#pragma unroll
            for (int nt = 0; nt < 8; ++nt) { f32x4 a = (f32x4){0.f, 0.f, 0.f, 0.f};
#pragma unroll
                for (int ks = 0; ks < 4; ++ks) a = MFMA16(*(const bf16x8*)(SK + (size_t)(((((h * 2 + p) * 8 + nt) * 4 + ks) * 64 + lane) * 8)), qf[ks], a);
#pragma unroll
                for (int r = 0; r < 4; ++r) { const int n = nt * 16 + lq * 4 + r; const int key = (sortable(a[r]) & ~127) | (127 - n);
                    if (nt < 4) ta[nt * 4 + r] = key; else tb[(nt - 4) * 4 + r] = key; } }
            bitonic_sort16_desc(ta); bitonic_sort16_desc(tb);
#pragma unroll
            for (int i = 0; i < 16; ++i) ta[i] = max(ta[i], tb[15 - i]);
            bitonic_merge16_desc(ta);
#pragma unroll
            for (int st = 0; st < 2; ++st) {
#pragma unroll
                for (int i = 0; i < 16; ++i) tb[i] = __shfl_xor(ta[i], st ? 32 : 16);
#pragma unroll
                for (int i = 0; i < 16; ++i) ta[i] = max(ta[i], tb[15 - i]);
                bitonic_merge16_desc(ta); }
            if (lq == 0) {
#pragma unroll
                for (int i = 0; i < 16; ++i) KEYS[((h * 2 + p) * 16 + i) * 64 + tt * 16 + l15] = ta[i]; }
        }
        __syncthreads();
        {
            const int tok = tid & 63, h = tid >> 6;
            int k1[16], k2[16]; float s1[16], s2[16];
#pragma unroll
            for (int i = 0; i < 16; ++i) { k1[i] = KEYS[((h * 2) * 16 + i) * 64 + tok]; k2[i] = KEYS[((h * 2 + 1) * 16 + i) * 64 + tok]; s1[i] = unsortable(k1[i] & ~127); s2[i] = unsortable(k2[i] & ~127); }
            int t[16];
#pragma unroll
            for (int j = 0; j < 16; ++j) t[j] = (sortable(s1[0] + s2[j]) & ~255) | (255 - j);
#pragma unroll
            for (int i = 1; i < 16; ++i)
#pragma unroll
                for (int j = 0; j < 16; ++j) if ((i + 1) * (j + 1) <= 16) { int x = (sortable(s1[i] + s2[j]) & ~255) | (255 - (i * 16 + j)); CAS16(t, x); }
            float sv[16]; int ev[16]; float mx = -3.0e38f;
#pragma unroll
            for (int k = 0; k < 16; ++k) { const int id = 255 - (t[k] & 255), i = id >> 4, j = id & 15;
                const int ia = KEYS[((h * 2) * 16 + i) * 64 + tok], ib = KEYS[((h * 2 + 1) * 16 + j) * 64 + tok];
                sv[k] = unsortable(ia & ~127) + unsortable(ib & ~127); ev[k] = (127 - (ia & 127)) * 128 + (127 - (ib & 127)); mx = fmaxf(mx, sv[k]); }
            float den = 0.f;
#pragma unroll
            for (int k = 0; k < 16; ++k) { sv[k] = fexp(sv[k] - mx); den += sv[k]; }
            const float inv = 1.0f / den; const int o = tok * IDSTR + h * 16;
#pragma unroll
            for (int k = 0; k < 16; k += 4) { *(LAS u32x4*)(IDXL + o + k) = (u32x4){(unsigned)ev[k], (unsigned)ev[k + 1], (unsigned)ev[k + 2], (unsigned)ev[k + 3]};
                *(LAS f32x4*)(GATEL + o + k) = (f32x4){sv[k] * inv, sv[k + 1] * inv, sv[k + 2] * inv, sv[k + 3] * inv}; }
        }
        __syncthreads();
        if (EXP != 2) p12_sweep12<EXP>(c, R0, lds, tid);
    }
    __syncthreads();
}

constexpr int N_PHASES = 12;
#ifndef RWKV_IMPL
#define RWKV_IMPL 1
#endif
#ifndef RWKV_PROBE
#define RWKV_PROBE 0
#endif
__global__ void __launch_bounds__(NT, 2) fwd_kernel(Args args) {
    extern __shared__ __attribute__((aligned(16))) unsigned char lds_raw[];
    LAS unsigned char* lds0 = (LAS unsigned char*)lds_raw;
    LAS unsigned char* lds = lds0 + LDS_HDR;
    Ctx c; c.in = (KArgPtr)__builtin_amdgcn_kernarg_segment_ptr();
    c.out = args.out; c.ws = args.ws;
    if (threadIdx.x < 16) ((LAS unsigned*)lds0)[threadIdx.x] = 0u;
    __syncthreads();
    const int lo = args.ph_lo, hi = args.ph_hi;
    const bool multi = (hi - lo) > 1;
    XcdBarrier bar; bar.bar = (unsigned*)(c.ws + WS_CTL); bar.x = 0; bar.st = (volatile LAS unsigned*)lds0;
    if (multi) bar = xcd_barrier_post((unsigned*)(c.ws + WS_CTL), (volatile LAS unsigned*)lds0);
#ifndef PROBE_T
#define PROBE_T -1
#endif
    LAS unsigned long long* stamps = (LAS unsigned long long*)(lds0 + LDS_BYTES - 256);
#define STAMP(i) do { if (PROBE_T >= 0 && threadIdx.x == 0) stamps[i] = wall_clock64(); } while (0)
#define IN(k) (lo <= (k) && (k) < hi)
#define SEAM(k) do { STAMP(2 * (k) + 1); if (IN(k) && IN((k) + 1)) { xcd_barrier(bar); if (DUP(20)) xcd_barrier(bar); } STAMP(2 * (k) + 2); } while (0)
    STAMP(0);
    const bf16_t* Wt_in = (const bf16_t*)(c.ws + WS_WIN);
    if (IN(0)) { p0_prologue(c, lds); if (DUP(0)) p0_prologue(c, lds); } SEAM(0);
    if (IN(1)) { p1_norm1(c); if (DUP(1)) p1_norm1(c); } SEAM(1);
    if (IN(2)) { pg8::Gemm g{(const bf16_t*)(c.ws + WS_A1), Wt_in, MALL, N1, D}; Gemm1Order S; S.init(MLAT, N1, gridDim.x, blockIdx.x);
        EpiB<0> E{(bf16_t*)(c.ws + WS_ZG), (bf16_t*)(c.ws + WS_ZR), 0};
        pg8::gemm_phase<EpiB<0>, Gemm1Order, false>((PG8_LAS unsigned char*)lds, g, S, E, nullptr);
        if (DUP(2)) { if (DUP(21)) xcd_barrier(bar); pg8::gemm_phase<EpiB<0>, Gemm1Order, false>((PG8_LAS unsigned char*)lds, g, S, E, nullptr); } } SEAM(2);
    if (IN(3)) { premix_lora(c); p3_gla(c, lds); if (DUP(3)) p3_gla(c, lds); } SEAM(3);
    if (IN(4)) { p4_rwkv_chunked(c, lds); if (DUP(4)) { if (DUP(21)) xcd_barrier(bar); p4_rwkv_chunked(c, lds); } } SEAM(4);
    if (IN(5)) { if (DUP(5)) p5_post(c, lds, true); p5_post(c, lds); } SEAM(5);
    if (IN(6)) { pg8::StaticOrder S; S.init(MLAT, D, gridDim.x, blockIdx.x); bf16_t* Tb = (bf16_t*)c.out; bf16_t* Yr = (bf16_t*)(c.ws + WS_ORF);
        { pg8::Gemm g{(const bf16_t*)(c.ws + WS_A1), Wt_in + (size_t)N1 * D, MLAT, D, D}; EpiMix<0> E{Tb, Yr}; pg8::gemm_phase<EpiMix<0>, pg8::StaticOrder, false>((PG8_LAS unsigned char*)lds, g, S, E, nullptr); }
        __syncthreads();
        { pg8::Gemm g{(const bf16_t*)(c.ws + WS_A1), Wt_in + (size_t)(N1 + 1024) * D, MLAT, D, D}; EpiMix<1> E{Tb, Yr}; pg8::gemm_phase<EpiMix<1>, pg8::StaticOrder, false>((PG8_LAS unsigned char*)lds, g, S, E, nullptr); }
        __syncthreads();
        { pg8::Gemm g{(const bf16_t*)(c.ws + WS_A1), Wt_in + (size_t)(N1 + 2048) * D, MLAT, D, D}; EpiMix<2> E{Tb, Yr}; pg8::gemm_phase<EpiMix<2>, pg8::StaticOrder, false>((PG8_LAS unsigned char*)lds, g, S, E, nullptr); } } SEAM(6);
    if (IN(8)) { pg8::Gemm g{(const bf16_t*)(c.ws + WS_ORF), (const bf16_t*)(c.ws + WS_WOUT), MLAT, D, D}; pg8::StaticOrder S; S.init(MLAT, D, gridDim.x, blockIdx.x);
        EpiH1 E{CIN(0), (const float*)(c.ws + WS_MOD), c.out};
        pg8::gemm_phase<EpiH1, pg8::StaticOrder, false>((PG8_LAS unsigned char*)lds, g, S, E, nullptr); } SEAM(8);
    if (IN(9)) { p9_norm2_tables(c); if (DUP(9)) p9_norm2_tables(c); } SEAM(9);
    if (IN(10)) { pg8::Gemm g{(const bf16_t*)(c.ws + WS_A1), (const bf16_t*)(c.ws + WS_WQ), MLAT, 2048, D}; pg8::StaticOrder S; S.init(MLAT, 2048, gridDim.x, blockIdx.x);
        EpiB<3> E{(bf16_t*)(c.ws + WS_Q), nullptr, 2048};
        pg8::gemm_phase<EpiB<3>, pg8::StaticOrder, false>((PG8_LAS unsigned char*)lds, g, S, E, nullptr);
        if (DUP(10)) pg8::gemm_phase<EpiB<3>, pg8::StaticOrder, false>((PG8_LAS unsigned char*)lds, g, S, E, nullptr); } SEAM(10);
    if (IN(11)) { if (DUP(11)) p11_topk<GEXP>(c, lds); p11_topk<0>(c, lds); }
    STAMP(23);
    if (PROBE_T >= 0) {
        __syncthreads();
        const float us = (float)(stamps[PROBE_T + 1] - stamps[PROBE_T]) * 0.01f;
        for (int u = blockIdx.x; u < MLAT / 64; u += gridDim.x) for (int i = threadIdx.x; i < 64 * D; i += NT) c.out[(size_t)u * 64 * D + i] = us;
    }
#undef IN
#undef SEAM
}

__global__ void dbg_cmp2(const bf16_t* oldv, const bf16_t* nf, const bf16_t* nb, float* out) {
    for (size_t i = (size_t)blockIdx.x * blockDim.x + threadIdx.x; i < (size_t)MLAT * D; i += (size_t)gridDim.x * blockDim.x) {
        const float o = bf2f(oldv[i]); const float n = i < 8388608 ? bf2f(nf[i]) : bf2f(nb[i - 8388608]);
        float v = (n - o) * (100.0f / 12.2f); if (!(fabsf(v) < 1e30f)) v = 1e4f; out[i] = v; }
}
extern "C" void kernel_launch(void* const* d_in, const int* in_sizes, int n_in, void* d_out, int out_size, void* d_ws, size_t ws_size, hipStream_t stream) {
    static int grid = 0;
    if (grid == 0) {
        if (n_in != 29 || out_size != MLAT * D || ws_size < WS_END) { fprintf(stderr, "kernel_launch: unexpected shapes (n_in %d, out %d, ws %zu < %zu)\n", n_in, out_size, ws_size, (size_t)WS_END); grid = -1; return; }
        int dev = 0, cus = 0, per_cu = 0;
        if (hipGetDevice(&dev) != hipSuccess || hipDeviceGetAttribute(&cus, hipDeviceAttributeMultiprocessorCount, dev) != hipSuccess) { grid = -1; return; }
        if (hipFuncSetAttribute((const void*)fwd_kernel, hipFuncAttributeMaxDynamicSharedMemorySize, LDS_BYTES) != hipSuccess) { fprintf(stderr, "kernel_launch: hipFuncSetAttribute failed\n"); grid = -1; return; }
        if (hipOccupancyMaxActiveBlocksPerMultiprocessor(&per_cu, (const void*)fwd_kernel, NT, LDS_BYTES) != hipSuccess || per_cu < 1) fprintf(stderr, "kernel_launch: occupancy query reports %d\n", per_cu);
        (void)hipGetLastError();
        grid = cus;
    }
    if (grid < 0) return;
    (void)hipMemsetAsync((char*)d_ws + WS_CTL, 0, 65536, stream);
    Args a{};
    for (int i = 0; i < 29; ++i) a.in[i] = (const float*)d_in[i];
    a.out = (float*)d_out; a.ws = (unsigned char*)d_ws;
#if MK_N_LAUNCHES == 1
    a.ph_lo = 0; a.ph_hi = N_PHASES;
    hipLaunchKernelGGL(fwd_kernel, dim3(grid), dim3(NT), LDS_BYTES, stream, a);
#else
    for (int p = 0; p < N_PHASES; ++p) { a.ph_lo = p; a.ph_hi = p + 1; hipLaunchKernelGGL(fwd_kernel, dim3(grid), dim3(NT), LDS_BYTES, stream, a); }
#endif
}
```
